# Optimizing an MI355X kernel written in HIP

```python
import jax, jax.numpy as jnp
from jax import lax
import numpy as np

D_MODEL = 1024
BATCH = 8
SEQ = 4096
DEPTH = 1

POOL_WINDOWS = (2, 4, 8, 16)
POOL_GROUPS = len(POOL_WINDOWS)
POOL_WIDTH = D_MODEL // 4
POOL_GROUP_DIM = POOL_WIDTH // POOL_GROUPS
ATT_CONFIGS = ((128, 1), (512, 4), (2048, 16))
ATT_GROUPS = len(ATT_CONFIGS)
ATT_HEAD_DIM = 64
ATT_WIDTH = D_MODEL - POOL_WIDTH
ATT_HEADS = ATT_WIDTH // ATT_HEAD_DIM
ATT_HEADS_PER_GROUP = ATT_HEADS // ATT_GROUPS
ATT_OUT_WIDTH = ATT_HEADS_PER_GROUP * ATT_HEAD_DIM
ATT_BLOCK = 128
IN_PROJ_WIDTH = POOL_WIDTH + 3 * ATT_WIDTH
MIX_OUT_WIDTH = POOL_WIDTH + ATT_OUT_WIDTH
N_EXPERTS = 256
TOP_K = 8
N_EXPERT_GROUPS = 8
TOPK_GROUPS = 4
EXPERT_FF = D_MODEL // 4
SHARED_FF = D_MODEL // 4
ROUTED_SCALE = 2.5
MOE_BLOCK = 128
NORM_EPS = 1e-6

kernel_name = "hybrid_pool_dilatedattn_moe_adaln"


def rmsnorm(x, g):
    xf = x.astype(jnp.float32)
    y = xf * lax.rsqrt(jnp.mean(xf * xf, axis=-1, keepdims=True) + NORM_EPS)
    return (y * g.astype(jnp.float32)).astype(x.dtype)


def modulate(x, g, shift, scale):
    return rmsnorm(x, g) * (1 + scale[:, None, :]) + shift[:, None, :]


def pool_mixer(u, pool_w, pool_scale):
    B, S, _ = u.shape
    uf = u.astype(jnp.float32).reshape(B, S, POOL_GROUPS, POOL_GROUP_DIM)
    cs = jnp.cumsum(uf, axis=1)
    t = jnp.arange(S)
    outs = []
    for g, w in enumerate(POOL_WINDOWS):
        csg = cs[:, :, g]
        lag = jnp.pad(csg, ((0, 0), (w, 0), (0, 0)))[:, :S]
        cnt = jnp.minimum(t + 1, w).astype(jnp.float32)[None, :, None]
        outs.append((csg - lag) / cnt - uf[:, :, g])
    pooled = jnp.stack(outs, axis=2).astype(u.dtype)
    mixed = jnp.einsum('bsgc,gcd->bsgd', pooled, pool_w)
    return mixed.reshape(B, S, POOL_WIDTH) * pool_scale


def dilated_window_attention(q, k, v, window, dilation):
    B, S, H, E = q.shape
    steps = window // dilation
    span = dilation * ATT_BLOCK
    Sp = -(-S // span) * span
    L = Sp // dilation
    nb = L // ATT_BLOCK

    def to_blocks(a):
        a = jnp.pad(a, ((0, 0), (0, Sp - S), (0, 0), (0, 0)))
        a = a.reshape(B, L, dilation, H, E).transpose(0, 2, 1, 3, 4)
        return a.reshape(B, dilation, nb, ATT_BLOCK, H, E)

    def with_prev(a):
        prev = jnp.pad(a, ((0, 0), (0, 0), (1, 0), (0, 0), (0, 0), (0, 0)))[:, :, :nb]
        return jnp.concatenate([prev, a], axis=3)

    qb = to_blocks(q)
    kk = with_prev(to_blocks(k))
    vv = with_prev(to_blocks(v))
    s = jnp.einsum('brnqhe,brnkhe->brnhqk', qb, kk,
                   preferred_element_type=jnp.float32) * (E ** -0.5)
    i = jnp.arange(ATT_BLOCK)[:, None]
    j = jnp.arange(2 * ATT_BLOCK)[None, :]
    n = jnp.arange(nb)[:, None, None]
    dist = ATT_BLOCK + i - j
    valid = (dist >= 0) & (dist <= steps) & (n * ATT_BLOCK + j - ATT_BLOCK >= 0)
    s = jnp.where(valid[:, None], s, -jnp.inf)
    m = jnp.max(s, axis=-1, keepdims=True)
    p = jnp.exp(s - m)
    l = jnp.sum(p, axis=-1)
    o = jnp.einsum('brnhqk,brnkhe->brnqhe', p.astype(v.dtype), vv,
                   preferred_element_type=jnp.float32)
    o = o / jnp.swapaxes(l, 3, 4)[..., None]
    lse = jnp.swapaxes(m[..., 0] + jnp.log(l), 3, 4)

    def from_blocks(a):
        a = a.reshape((B, dilation, L) + a.shape[4:])
        a = jnp.swapaxes(a, 1, 2)
        return a.reshape((B, Sp) + a.shape[3:])[:, :S]

    return from_blocks(o), from_blocks(lse)


def attention_mixer(qkv):
    B, S, _ = qkv.shape
    qkv = qkv.reshape(B, S, 3, ATT_GROUPS, ATT_HEADS_PER_GROUP, ATT_HEAD_DIM)
    outs, lses = [], []
    for g, (w, d) in enumerate(ATT_CONFIGS):
        o, lse = dilated_window_attention(qkv[:, :, 0, g], qkv[:, :, 1, g], qkv[:, :, 2, g], w, d)
        outs.append(o)
        lses.append(lse)
    o = jnp.stack(outs, axis=0)
    alpha = jax.nn.softmax(jnp.stack(lses, axis=0), axis=0)
    out = jnp.sum(alpha[..., None] * o, axis=0)
    return out.reshape(B, S, ATT_OUT_WIDTH).astype(qkv.dtype)


def swiglu(h, w_gate, w_up, w_down):
    return (jax.nn.silu(h @ w_gate) * (h @ w_up)) @ w_down


def moe_ffn(h, w_router, router_bias, w_gate, w_up, w_down, ws_gate, ws_up, ws_down):
    B, S, D = h.shape
    N = B * S
    hf = h.reshape(N, D)
    scores = jax.nn.sigmoid((hf @ w_router).astype(jnp.float32))
    biased = scores + router_bias.astype(jnp.float32)
    grp = biased.reshape(N, N_EXPERT_GROUPS, N_EXPERTS // N_EXPERT_GROUPS)
    grp_score = jnp.sum(lax.top_k(grp, 2)[0], axis=-1)
    _, gidx = lax.top_k(grp_score, TOPK_GROUPS)
    gmask = jnp.sum(jax.nn.one_hot(gidx, N_EXPERT_GROUPS, dtype=jnp.float32), axis=1)
    emask = jnp.repeat(gmask, N_EXPERTS // N_EXPERT_GROUPS, axis=1) > 0
    _, eidx = lax.top_k(jnp.where(emask, biased, -jnp.inf), TOP_K)
    gates = jnp.take_along_axis(scores, eidx, axis=1)
    gates = gates / jnp.sum(gates, axis=-1, keepdims=True) * ROUTED_SCALE

    NK = N * TOP_K
    flat_e = eidx.reshape(NK)
    flat_tok = jnp.repeat(jnp.arange(N, dtype=jnp.int32), TOP_K)
    flat_w = gates.reshape(NK)
    order = jnp.argsort(flat_e, stable=True)
    se, stok, sw = flat_e[order], flat_tok[order], flat_w[order]
    counts = jnp.bincount(flat_e, length=N_EXPERTS)
    offs = jnp.cumsum(counts) - counts
    pcounts = (counts + MOE_BLOCK - 1) // MOE_BLOCK * MOE_BLOCK
    pend = jnp.cumsum(pcounts)
    poffs = pend - pcounts
    dest = poffs[se] + (jnp.arange(NK) - offs[se])
    P = NK + N_EXPERTS * MOE_BLOCK
    nblk = P // MOE_BLOCK
    row_tok = jnp.full((P,), N, jnp.int32).at[dest].set(stok)
    row_w = jnp.zeros((P,), jnp.float32).at[dest].set(sw)
    blk_e = jnp.minimum(jnp.searchsorted(pend, jnp.arange(nblk) * MOE_BLOCK, side='right'),
                        N_EXPERTS - 1).astype(jnp.int32)
    xpad = jnp.concatenate([hf, jnp.zeros((1, D), hf.dtype)], axis=0)

    def expert_block(args):
        e, toks, ws = args
        xb = xpad[toks]
        yb = swiglu(xb, w_gate[e], w_up[e], w_down[e])
        return yb * ws[:, None].astype(yb.dtype)

    ys = lax.map(expert_block, (blk_e, row_tok.reshape(nblk, MOE_BLOCK),
                                row_w.reshape(nblk, MOE_BLOCK)))
    routed = jax.ops.segment_sum(ys.reshape(P, D), row_tok, num_segments=N + 1)[:N]
    shared = swiglu(hf, ws_gate, ws_up, ws_down)
    return (routed + shared).reshape(B, S, D)


def setup_inputs(seed: int = 0) -> dict:
    key = jax.random.key(seed)
    ks = jax.random.split(key, 20)
    L, D, E, F = DEPTH, D_MODEL, N_EXPERTS, EXPERT_FF
    nrm = lambda k, shape, s: jax.random.normal(k, shape, jnp.float32) * s
    return {
        "x": nrm(ks[0], (BATCH, SEQ, D), 1.0),
        "c": nrm(ks[1], (BATCH, D), 1.0),
        "w_ada": nrm(ks[2], (L, D, 6 * D), 0.5 * D ** -0.5),
        "b_ada": nrm(ks[3], (L, 6 * D), 0.02),
        "g_mix": 1.0 + nrm(ks[4], (L, D), 0.05),
        "w_in": nrm(ks[5], (L, D, IN_PROJ_WIDTH), D ** -0.5),
        "pool_w": nrm(ks[6], (L, POOL_GROUPS, POOL_GROUP_DIM, POOL_GROUP_DIM), POOL_GROUP_DIM ** -0.5),
        "pool_scale": 1.0 + nrm(ks[7], (L, POOL_WIDTH), 0.1),
        "w_out": nrm(ks[8], (L, MIX_OUT_WIDTH, D), MIX_OUT_WIDTH ** -0.5),
        "g_ffn": 1.0 + nrm(ks[9], (L, D), 0.05),
        "w_router": nrm(ks[10], (L, D, E), D ** -0.5),
        "router_bias": nrm(ks[11], (L, E), 0.01),
        "w_gate": nrm(ks[12], (L, E, D, F), D ** -0.5),
        "w_up": nrm(ks[13], (L, E, D, F), D ** -0.5),
        "w_down": nrm(ks[14], (L, E, F, D), F ** -0.5),
        "ws_gate": nrm(ks[15], (L, D, SHARED_FF), D ** -0.5),
        "ws_up": nrm(ks[16], (L, D, SHARED_FF), D ** -0.5),
        "ws_down": nrm(ks[17], (L, SHARED_FF, D), SHARED_FF ** -0.5),
        "g_final": 1.0 + nrm(ks[18], (D,), 0.05),
    }


def reference(x, c, w_ada, b_ada, g_mix, w_in, pool_w, pool_scale, w_out, g_ffn,
              w_router, router_bias, w_gate, w_up, w_down, ws_gate, ws_up, ws_down, g_final):
    cs = jax.nn.silu(c.astype(jnp.float32))
    for l in range(DEPTH):
        mod = (cs @ w_ada[l].astype(jnp.float32) + b_ada[l].astype(jnp.float32)).astype(x.dtype)
        shift1, scale1, gate1, shift2, scale2, gate2 = jnp.split(mod, 6, axis=-1)
        h = modulate(x, g_mix[l], shift1, scale1)
        proj = h @ w_in[l]
        pool_out = pool_mixer(proj[..., :POOL_WIDTH], pool_w[l], pool_scale[l])
        attn_out = attention_mixer(proj[..., POOL_WIDTH:])
        mixed = jnp.concatenate([pool_out, attn_out], axis=-1) @ w_out[l]
        x = x + gate1[:, None, :] * mixed
        h = modulate(x, g_ffn[l], shift2, scale2)
        y = moe_ffn(h, w_router[l], router_bias[l], w_gate[l], w_up[l], w_down[l],
                    ws_gate[l], ws_up[l], ws_down[l])
        x = x + gate2[:, None, :] * y
    return rmsnorm(x, g_final)
```

```cpp
#include <hip/hip_runtime.h>
#include <cstdio>
#include <cstdint>

#ifndef MK_ONE_LAUNCH
#define MK_ONE_LAUNCH 1
#endif
#ifndef MK_FAST_GEMM
#define MK_FAST_GEMM 1
#endif
#ifndef MK_REP_MASK
#define MK_REP_MASK 0x000
#endif
#ifndef MK_NAIVE_ATTN
#define MK_NAIVE_ATTN 0
#endif

#define LAS __attribute__((address_space(3)))
#define GAS __attribute__((address_space(1)))
typedef unsigned short bf16;
typedef short bf16x8 __attribute__((ext_vector_type(8)));
typedef short s16x4 __attribute__((ext_vector_type(4)));
typedef float f32x4 __attribute__((ext_vector_type(4)));
typedef float f32x2 __attribute__((ext_vector_type(2)));
typedef unsigned v4u __attribute__((ext_vector_type(4)));
typedef unsigned v2u __attribute__((ext_vector_type(2)));

constexpr int D = 1024, NB = 8, SEQ = 4096, NT = NB * SEQ;
constexpr int NPROJ = 2560, NE = 256, TOPK = 8, FF = 256, NMIX = 512;
constexpr int CAP = NT;
constexpr int MAXBLK = NT * TOPK / 256 + NE;
constexpr float NORM_EPS = 1e-6f;
constexpr int NWAVES = 8, NTHREADS = 512;

constexpr size_t MiB = 1u << 20;
constexpr size_t WS_CTL = 0, CTL_ZERO_BYTES = 1 * MiB;
constexpr size_t WS_MOD = 1 * MiB;
constexpr size_t WS_GATEW = 2 * MiB;
constexpr size_t WS_WIN_T = 4 * MiB;
constexpr size_t WS_WOUT_T = 9 * MiB;
constexpr size_t WS_WR_T = 10 * MiB;
constexpr size_t WS_WSGU_T = 11 * MiB;
constexpr size_t WS_WSD_T = 12 * MiB;
constexpr size_t WS_LSE = 13 * MiB;
constexpr size_t WS_WD_T = 16 * MiB;
constexpr size_t WS_ACT = 144 * MiB;
constexpr size_t WS_ACTS = 304 * MiB;
constexpr size_t WS_BUCKET = 320 * MiB;
constexpr size_t WS_WGU_T = 352 * MiB;
constexpr size_t WS_PROJ = 608 * MiB;
constexpr size_t WS_H = 768 * MiB;
constexpr size_t WS_ATTO = 832 * MiB;
constexpr size_t WS_MIXIN = 880 * MiB;
constexpr size_t WS_LOGIT = 912 * MiB;
constexpr size_t WS_Y = 352 * MiB;
constexpr size_t WS_POS = 3 * MiB;
constexpr size_t WS_END = 992 * MiB;
constexpr int CW_BAR = 4096;
constexpr int CW_GCNT = 16384;

constexpr int RING_BYTES = 131072;
constexpr int TAB_OFF = RING_BYTES;
constexpr int MISC_OFF = TAB_OFF + 4096;
constexpr int PT_OFF = MISC_OFF + 256;
constexpr int LDS_BYTES = 147456;

__device__ __forceinline__ unsigned f2bf(float f) { unsigned u = __builtin_bit_cast(unsigned, f); return (u + 0x7fffu + ((u >> 16) & 1u)) >> 16; }
__device__ __forceinline__ unsigned pk2(float lo, float hi) { unsigned r; asm("v_cvt_pk_bf16_f32 %0, %1, %2" : "=v"(r) : "v"(lo), "v"(hi)); return r; }
__device__ __forceinline__ float bf2f(unsigned short b) { return __builtin_bit_cast(float, ((unsigned)b) << 16); }
__device__ __forceinline__ float bflo(unsigned u) { return __builtin_bit_cast(float, u << 16); }
__device__ __forceinline__ float bfhi(unsigned u) { return __builtin_bit_cast(float, u & 0xffff0000u); }
__device__ __forceinline__ float wave_sum(float v) {
#pragma unroll
    for (int o = 1; o < 64; o <<= 1) v += __shfl_xor(v, o);
    return v;
}
__device__ __forceinline__ float silu_f(float g) { return g * __builtin_amdgcn_rcpf(1.f + __builtin_amdgcn_exp2f(-1.44269504f * g)); }

__device__ __forceinline__ const float* ld_ptr(LAS unsigned char* lds, int i) {
    const unsigned long long v = ((const LAS unsigned long long*)(lds + PT_OFF))[i];
    const unsigned lo = __builtin_amdgcn_readfirstlane((unsigned)v), hi = __builtin_amdgcn_readfirstlane((unsigned)(v >> 32));
    return (const float*)(((unsigned long long)hi << 32) | lo);
}
#define XB_TMO      128
#define XB_XCNT(j)  (256  + 64 * (j))
#define XB_XSUB(j)  (1280 + 64 * (j))
#define XB_XGEN(j)  (2304 + 64 * (j))
#define XB_TOP      3328
#define XB_TOPGEN   3392
#define XCD_BAR_WORDS 3456
#define XB_SPIN_CAP (1u << 18)
__device__ __forceinline__ unsigned xb_ld(unsigned* p)              { return __hip_atomic_load(p, __ATOMIC_RELAXED, __HIP_MEMORY_SCOPE_AGENT); }
__device__ __forceinline__ unsigned xb_add(unsigned* p, unsigned v) { return __hip_atomic_fetch_add(p, v, __ATOMIC_RELAXED, __HIP_MEMORY_SCOPE_AGENT); }
__device__ __forceinline__ unsigned xb_xcc_id() { return (unsigned)__builtin_amdgcn_s_getreg((3 << 11) | 20) & 0xFu; }
#define XB_SPIN(cond, bar) do { unsigned _sp = 0; while (cond) { __builtin_amdgcn_s_sleep(1); \
    if ((++_sp & 255u) == 0u) { if (xb_ld(&(bar)[XB_TMO])) break; if (_sp > XB_SPIN_CAP) { atomicAdd(&(bar)[XB_TMO], 1u); break; } } } } while (0)
struct XcdBarrier { unsigned* bar; unsigned x; volatile LAS unsigned* st; };
__device__ __forceinline__ XcdBarrier xcd_barrier_post(unsigned* bar, volatile LAS unsigned* st) {
    XcdBarrier b; b.bar = bar; b.x = xb_xcc_id(); b.st = st;
    if (threadIdx.x == 0) (void)xb_add(&bar[XB_XCNT(b.x)], 1u);
    return b;
}
__device__ __forceinline__ void xcd_barrier_complete(unsigned* bar, unsigned x, unsigned& nloc, unsigned& nx) {
    const unsigned G = gridDim.x * gridDim.y * gridDim.z;
    unsigned sum, cnt, mine, sp = 0u;
    for (;;) {
        sum = 0u; cnt = 0u; mine = 0u;
#pragma unroll
        for (unsigned j = 0; j < 16; ++j) { const unsigned c = xb_ld(&bar[XB_XCNT(j)]); sum += c; cnt += (c > 0u) ? 1u : 0u; mine = (j == x) ? c : mine; }
        if (sum == G) break;
        __builtin_amdgcn_s_sleep(1);
        if ((++sp & 255u) == 0u) { if (xb_ld(&bar[XB_TMO])) break; if (sp > XB_SPIN_CAP) { atomicAdd(&bar[XB_TMO], 1u); break; } }
    }
    nloc = mine > 0u ? mine : 1u; nx = cnt > 0u ? cnt : 1u;
}
__device__ __forceinline__ void xcd_barrier(const XcdBarrier& b) {
    asm volatile("s_waitcnt vmcnt(0)" ::: "memory");
    __syncthreads();
    if (threadIdx.x == 0) {
        unsigned* bar = b.bar;
        __builtin_amdgcn_s_waitcnt(0);
        unsigned nloc = b.st[0], nx = b.st[1];
        if (nloc == 0u) { xcd_barrier_complete(bar, b.x, nloc, nx); b.st[0] = nloc; b.st[1] = nx; }
        const unsigned old = xb_add(&bar[XB_XSUB(b.x)], 1u);
        const unsigned gen = old / nloc;
        if (old + 1u == (gen + 1u) * nloc) {
            __builtin_amdgcn_fence(__ATOMIC_RELEASE, "agent");
            asm volatile("s_waitcnt vmcnt(0)" ::: "memory");
            const unsigned og = xb_add(&bar[XB_TOP], 1u);
            const unsigned tg = og / nx;
            if (og + 1u == (tg + 1u) * nx) xb_add(&bar[XB_TOPGEN], 1u);
            else XB_SPIN(xb_ld(&bar[XB_TOPGEN]) == tg, bar);
            __builtin_amdgcn_fence(__ATOMIC_ACQUIRE, "agent");
            xb_add(&bar[XB_XGEN(b.x)], 1u);
            asm volatile("s_waitcnt vmcnt(0)" ::: "memory");
        } else {
            XB_SPIN(xb_ld(&bar[XB_XGEN(b.x)]) == gen, bar);
            __builtin_amdgcn_fence(__ATOMIC_ACQUIRE, "agent");
            asm volatile("s_waitcnt vmcnt(0)" ::: "memory");
        }
    }
    __syncthreads();
}

constexpr int BK = 64, HALF = 128, HTB = HALF * BK * 2;
__device__ __forceinline__ int lds_byte(int r, int c) { const int st = (r >> 4) * 2 + (c >> 5), rr = r & 15, cc = c & 31, ob = rr * 64 + cc * 2; return st * 1024 + (ob ^ (((ob >> 9) & 1) << 5)); }
__device__ __forceinline__ void stage_rc(int b, int& R, int& C) { const int st = b / 1024, sb = b % 1024, swz = sb ^ (((sb >> 9) & 1) << 5); R = (st >> 1) * 16 + swz / 64; C = (st & 1) * 32 + (swz % 64) / 2; }
__device__ __forceinline__ int perm32(int rho) { const int n = rho >> 4, i = rho & 15; return 8 * (i >> 2) + 4 * n + (i & 3); }

template <class Epi, class Sched>
__device__ __forceinline__ void gemm_simple(const int K, const int ldb, const Sched& S, const Epi& E) {
    const int tid = threadIdx.x, wid = __builtin_amdgcn_readfirstlane(tid >> 6), lane = tid & 63, wr = wid >> 2, wc = wid & 3, fr = lane & 15, fq = lane >> 4;
    typename Sched::Unit u;
    for (int ui = 0; S.next(ui, u); ++ui) {
        f32x4 acc[2][2][4][2];
#pragma unroll
        for (int a = 0; a < 2; ++a)
#pragma unroll
            for (int b = 0; b < 2; ++b)
#pragma unroll
                for (int m = 0; m < 4; ++m)
#pragma unroll
                    for (int n = 0; n < 2; ++n) acc[a][b][m][n] = (f32x4){0.f, 0.f, 0.f, 0.f};
        const char* A = S.a_base(u); const char* B = S.b_base(u);
        unsigned aoff[2][4], boff[2][2];
#pragma unroll
        for (int ai = 0; ai < 2; ++ai)
#pragma unroll
            for (int m = 0; m < 4; ++m) aoff[ai][m] = S.a_off(u, 128 * ai + 64 * wr + 16 * m + fr) + fq * 16;
#pragma unroll
        for (int bj = 0; bj < 2; ++bj)
#pragma unroll
            for (int n = 0; n < 2; ++n) { const int row = 128 * bj + 32 * wc + (Epi::PERM ? perm32(16 * n + fr) : 16 * n + fr); boff[bj][n] = (unsigned)(row * ldb) * 2u + fq * 16; }
        for (int k = 0; k < K; k += 32) {
            bf16x8 a[2][4], b[2][2];
#pragma unroll
            for (int ai = 0; ai < 2; ++ai)
#pragma unroll
                for (int m = 0; m < 4; ++m) a[ai][m] = *(const bf16x8*)(A + aoff[ai][m] + k * 2);
#pragma unroll
            for (int bj = 0; bj < 2; ++bj)
#pragma unroll
                for (int n = 0; n < 2; ++n) b[bj][n] = *(const bf16x8*)(B + boff[bj][n] + k * 2);
#pragma unroll
            for (int ai = 0; ai < 2; ++ai)
#pragma unroll
                for (int bj = 0; bj < 2; ++bj)
#pragma unroll
                    for (int m = 0; m < 4; ++m)
#pragma unroll
                        for (int n = 0; n < 2; ++n) acc[ai][bj][m][n] = __builtin_amdgcn_mfma_f32_16x16x32_bf16(b[bj][n], a[ai][m], acc[ai][bj][m][n], 0, 0, 0);
        }
        E(acc, u, wr, wc, fr, fq);
    }
}

template <class Epi, class Sched>
__device__ __forceinline__ void gemm_fast(LAS unsigned char* lds, const int K, const int ldb, const Sched& S, const Epi& E) {
    int tid0 = threadIdx.x; asm volatile("" : "+v"(tid0));
    const int tid = tid0, wid = __builtin_amdgcn_readfirstlane(tid >> 6), lane = tid & 63, wr = wid >> 2, wc = wid & 3, fr = lane & 15, fq = lane >> 4;
    int nt = K / BK; asm volatile("" : "+s"(nt));
    unsigned voffB[2];
#pragma unroll
    for (int i = 0; i < 2; ++i) { int R, C; stage_rc(tid * 16 + i * 8192, R, C); const int Rb = Epi::PERM ? ((R & ~31) + perm32(R & 31)) : R;
        voffB[i] = (unsigned)(Rb * ldb + C) * 2u; }
#define PG8_AOFF(u) do { int _tz = threadIdx.x; asm volatile("" : "+v"(_tz)); _Pragma("unroll") for (int _i = 0; _i < 2; ++_i) { int _R, _C; stage_rc(_tz * 16 + _i * 8192, _R, _C); \
        vA0[_i] = S.a_off(u, _R) + (unsigned)_C * 2u; vA1[_i] = S.a_off(u, HALF + _R) + (unsigned)_C * 2u; } } while (0)
    const size_t kstep = (size_t)(BK * 2);
    const size_t hstepB = (size_t)HALF * ldb * 2;
    const unsigned ldsw = (unsigned)wid * 1024u;
    const int aoff = lds_byte(wr * 64 + fr, fq * 8), boff = lds_byte(wc * 32 + fr, fq * 8);
#define PG8_SA(b, h) (((b) * 2 + (h)) * HTB)
#define PG8_SB(b, h) ((4 + (b) * 2 + (h)) * HTB)
#define PG8_STAGE(bufoff, gbase, voff) do { _Pragma("unroll") for (int _i = 0; _i < 2; ++_i) \
        __builtin_amdgcn_global_load_lds((const unsigned*)((const char*)(gbase) + (voff)[_i]), (LAS unsigned*)(lds + (bufoff) + ldsw + _i * 8192), 16, 0, 0); } while (0)
#define PG8_LDA(dst, b, h) do { _Pragma("unroll") for (int m = 0; m < 4; ++m) _Pragma("unroll") for (int k = 0; k < 2; ++k) dst[m][k] = *(const LAS bf16x8*)(lds + PG8_SA(b, h) + aoff + m * 2048 + k * 1024); } while (0)
#define PG8_LDB(dst, b, h) do { _Pragma("unroll") for (int n = 0; n < 2; ++n) _Pragma("unroll") for (int k = 0; k < 2; ++k) dst[n][k] = *(const LAS bf16x8*)(lds + PG8_SB(b, h) + boff + n * 2048 + k * 1024); } while (0)
#define PG8_MMA(ai, bj, At, Bt) do { __builtin_amdgcn_s_setprio(1); _Pragma("unroll") for (int m = 0; m < 4; ++m) _Pragma("unroll") for (int n = 0; n < 2; ++n) _Pragma("unroll") for (int k = 0; k < 2; ++k) \
        acc[ai][bj][m][n] = __builtin_amdgcn_mfma_f32_16x16x32_bf16(Bt[n][k], At[m][k], acc[ai][bj][m][n], 0, 0, 0); __builtin_amdgcn_s_setprio(0); } while (0)
#define PG8_WAIT_V(n) asm volatile("s_waitcnt vmcnt(" #n ")" ::: "memory")
#define PG8_WAIT_L(n) asm volatile("s_waitcnt lgkmcnt(" #n ")" ::: "memory")
#define PG8_BAR __builtin_amdgcn_s_barrier()
#define PG8_SCHED __builtin_amdgcn_sched_barrier(0)
    typename Sched::Unit cur, nxt; int ui = 0;
    if (!S.next(0, cur)) return;
    f32x4 acc[2][2][4][2];
#pragma unroll
    for (int a = 0; a < 2; ++a)
#pragma unroll
        for (int b = 0; b < 2; ++b)
#pragma unroll
            for (int m = 0; m < 4; ++m)
#pragma unroll
                for (int n = 0; n < 2; ++n) acc[a][b][m][n] = (f32x4){0.f, 0.f, 0.f, 0.f};
    bf16x8 At[4][2], B0[2][2], B1[2][2];
    const char* cA = S.a_base(cur); const char* cB = S.b_base(cur);
    unsigned vA0[2], vA1[2];
    PG8_AOFF(cur);
    PG8_STAGE(PG8_SB(0, 0), cB, voffB); PG8_STAGE(PG8_SA(0, 0), cA, vA0); PG8_STAGE(PG8_SB(0, 1), cB + hstepB, voffB); PG8_STAGE(PG8_SA(0, 1), cA, vA1);
    if (wr == 1) PG8_BAR;
    PG8_WAIT_V(4); PG8_BAR;
    PG8_STAGE(PG8_SB(1, 0), cB + kstep, voffB); PG8_STAGE(PG8_SA(1, 0), cA + kstep, vA0); PG8_STAGE(PG8_SB(1, 1), cB + hstepB + kstep, voffB);
    PG8_WAIT_V(6); PG8_BAR;
    for (;;) {
        const bool has_next = S.next(ui + 1, nxt);
        const char* nA = has_next ? S.a_base(nxt) : cA; const char* nB = has_next ? S.b_base(nxt) : cB;
        for (int t = 0; t < nt; t += 2) {
            const bool last = (t == nt - 2);
            const char* a1 = cA + (size_t)(t + 1) * kstep;
            const char* a2 = last ? nA : cA + (size_t)(t + 2) * kstep; const char* b2 = last ? nB : cB + (size_t)(t + 2) * kstep;
            const char* a3 = a2 + kstep; const char* b3 = b2 + kstep;
            PG8_LDB(B0, 0, 0); PG8_SCHED; PG8_LDA(At, 0, 0); PG8_STAGE(PG8_SA(1, 1), a1, vA1);
            if (last && has_next) PG8_AOFF(nxt);
            PG8_WAIT_L(8); PG8_BAR; PG8_WAIT_L(0); PG8_MMA(0, 0, At, B0); PG8_BAR; PG8_SCHED;
            PG8_LDB(B1, 0, 1); PG8_STAGE(PG8_SB(0, 0), b2, voffB);
            PG8_BAR; PG8_WAIT_L(0); PG8_MMA(0, 1, At, B1); PG8_BAR;
            PG8_LDA(At, 0, 1); PG8_STAGE(PG8_SA(0, 0), a2, vA0);
            PG8_BAR; PG8_WAIT_L(0); PG8_MMA(1, 0, At, B0); PG8_BAR; PG8_SCHED;
            PG8_STAGE(PG8_SB(0, 1), b2 + hstepB, voffB);
            PG8_WAIT_V(6); PG8_BAR; PG8_MMA(1, 1, At, B1); PG8_BAR;
            PG8_LDB(B0, 1, 0); PG8_SCHED; PG8_LDA(At, 1, 0); PG8_STAGE(PG8_SA(0, 1), a2, vA1);
            PG8_WAIT_L(8); PG8_BAR; PG8_WAIT_L(0); PG8_MMA(0, 0, At, B0); PG8_BAR; PG8_SCHED;
            PG8_LDB(B1, 1, 1); PG8_STAGE(PG8_SB(1, 0), b3, voffB);
            PG8_BAR; PG8_WAIT_L(0); PG8_MMA(0, 1, At, B1); PG8_BAR;
            PG8_LDA(At, 1, 1); PG8_STAGE(PG8_SA(1, 0), a3, vA0);
            PG8_BAR; PG8_WAIT_L(0); PG8_MMA(1, 0, At, B0); PG8_BAR; PG8_SCHED;
            PG8_STAGE(PG8_SB(1, 1), b3 + hstepB, voffB);
            PG8_WAIT_V(6); PG8_BAR; PG8_MMA(1, 1, At, B1); PG8_BAR;
        }
        { int tz = threadIdx.x; asm volatile("" : "+v"(tz)); const int wz = tz >> 6, lz = tz & 63;
          E(acc, cur, wz >> 2, wz & 3, lz & 15, lz >> 4);
#if defined(MK_EPI_TWICE)
          if (Epi::TWICE) { asm volatile("" ::: "memory"); E(acc, cur, wz >> 2, wz & 3, lz & 15, lz >> 4); }
#endif
          }
        if (!has_next) break;
#pragma unroll
        for (int a = 0; a < 2; ++a)
#pragma unroll
            for (int b = 0; b < 2; ++b)
#pragma unroll
                for (int m = 0; m < 4; ++m)
#pragma unroll
                    for (int n = 0; n < 2; ++n) acc[a][b][m][n] = (f32x4){0.f, 0.f, 0.f, 0.f};
        cur = nxt; cA = nA; cB = nB; ++ui;
    }
    PG8_WAIT_V(0);
    if (wr == 0) PG8_BAR;
    PG8_BAR;
#undef PG8_AOFF
#undef PG8_SA
#undef PG8_SB
#undef PG8_STAGE
#undef PG8_LDA
#undef PG8_LDB
#undef PG8_MMA
#undef PG8_WAIT_V
#undef PG8_WAIT_L
#undef PG8_BAR
#undef PG8_SCHED
}

template <class Epi, class Sched>
__device__ __forceinline__ void gemm_phase(LAS unsigned char* lds, const int K, const int ldb, const Sched& S, const Epi& E) {
#if MK_FAST_GEMM
    gemm_fast<Epi, Sched>(lds, K, ldb, S, E);
#else
    gemm_simple<Epi, Sched>(K, ldb, S, E);
#endif
}

struct DenseSched {
    struct Unit { int pm, pn, ks; };
    const char* A; const char* B; int lda2, ldb2, nM, nN, KS, ksub2, G, c, total, i0, i1;
    __device__ __forceinline__ void init(const void* A_, const void* B_, int lda, int ldb, int M, int N, int KS_, int Ksub, int G_, int c_) {
        A = (const char*)A_; B = (const char*)B_; lda2 = lda * 2; ldb2 = ldb * 2; nM = M / 256; nN = N / 256; KS = KS_; ksub2 = Ksub * 2; G = G_; c = c_; total = nM * nN * KS; i0 = 0; i1 = 0x3fffffff; }
    __device__ __forceinline__ bool next(int i, Unit& u) const {
        if (i + i0 >= i1) return false;
        const int L = (i + i0) * G + c; if (L >= total) return false;
        int id = L / KS; u.ks = L - id * KS;
        const int nwg = nM * nN;
        { const int q = nwg / 8, r = nwg % 8, xcd = id % 8, off = id / 8; id = (xcd < r ? xcd * (q + 1) : r * (q + 1) + (xcd - r) * q) + off; }
        const int nig = 8 * nN, gid = id / nig, fm = gid * 8, gsz = (nM - fm) < 8 ? (nM - fm) : 8;
        u.pm = fm + ((id % nig) % gsz); u.pn = (id % nig) / gsz; return true;
    }
    __device__ __forceinline__ const char* a_base(const Unit& u) const { return A + (size_t)u.pm * 256 * lda2 + (size_t)u.ks * ksub2; }
    __device__ __forceinline__ const char* b_base(const Unit& u) const { return B + (size_t)u.pn * 256 * ldb2 + (size_t)u.ks * ksub2; }
    __device__ __forceinline__ unsigned a_off(const Unit&, int r) const { return (unsigned)(r * lda2); }
};

template <int PN, bool DOWN>
struct MoeSched {
    struct Unit { int kind, e, rb, blk, valid, pm, pn; };
    const LAS int* prefix; const LAS int* cnt; const unsigned* bucket;
    const char* Ar; const char* As; const char* Br; const char* Bs;
    int nRouted, total, G, c, i0, i1;
    __device__ __forceinline__ bool next(int i, Unit& u) const {
        if (i + i0 >= i1) return false;
        const int id = (i + i0) * G + c; if (id >= total) return false;
        u.e = 0; u.rb = 0; u.blk = 0; u.pm = 0;
        if (id < nRouted) {
            const int blk = id / PN; u.pn = id % PN;
            const int lo = ((const LAS unsigned char*)(cnt + 256))[blk];
            u.kind = 0; u.e = lo; u.rb = blk - prefix[lo]; u.blk = blk; const int rem = cnt[lo] - u.rb * 256; u.valid = rem < 256 ? rem : 256;
        } else { const int s = id - nRouted; u.kind = 1; u.pm = s / PN; u.pn = s % PN; u.valid = 256; }
        return true;
    }
    __device__ __forceinline__ const char* a_base(const Unit& u) const { return u.kind == 0 ? Ar : As; }
    __device__ __forceinline__ const char* b_base(const Unit& u) const {
        if (!DOWN) return u.kind == 0 ? Br + ((size_t)u.e * 512 + (size_t)u.pn * 256) * (D * 2) : Bs + (size_t)u.pn * 256 * (D * 2);
        else       return u.kind == 0 ? Br + ((size_t)u.e * 1024 + (size_t)u.pn * 256) * (FF * 2) : Bs + (size_t)u.pn * 256 * (FF * 2);
    }
    __device__ __forceinline__ unsigned a_off(const Unit& u, int r) const {
        if (!DOWN) {
            if (u.kind == 0) { const int rr = r < u.valid ? r : u.valid - 1; const unsigned slot = bucket[(size_t)u.e * CAP + u.rb * 256 + rr]; return (slot >> 3) * (unsigned)(D * 2); }
            return (unsigned)(u.pm * 256 + r) * (unsigned)(D * 2);
        } else {
            return (unsigned)((u.kind == 0 ? u.blk : u.pm) * 256 + r) * (unsigned)(FF * 2);
        }
    }
};

struct EpiProj {
    static constexpr bool PERM = true, TWICE = false;
    bf16* O;
    __device__ __forceinline__ void operator()(const f32x4 (&acc)[2][2][4][2], const DenseSched::Unit& u, int wr, int wc, int fr, int fq) const {
        const int row0 = u.pm * 256 + wr * 64 + fr, col0 = u.pn * 256 + wc * 32 + 8 * fq;
#pragma unroll
        for (int ai = 0; ai < 2; ++ai)
#pragma unroll
            for (int m = 0; m < 4; ++m) { bf16* rowp = O + (size_t)(row0 + ai * 128 + m * 16) * NPROJ + col0;
#pragma unroll
                for (int bj = 0; bj < 2; ++bj) { const f32x4 v0 = acc[ai][bj][m][0], v1 = acc[ai][bj][m][1];
                    *(v4u*)(rowp + bj * 128) = (v4u){pk2(v0[0], v0[1]), pk2(v0[2], v0[3]), pk2(v1[0], v1[1]), pk2(v1[2], v1[3])}; } }
    }
};
struct EpiOut {
    static constexpr bool PERM = true, TWICE = false;
    bf16* O;
    __device__ __forceinline__ void operator()(const f32x4 (&acc)[2][2][4][2], const DenseSched::Unit& u, int wr, int wc, int fr, int fq) const {
        const int row0 = u.pm * 256 + wr * 64 + fr, col0 = u.pn * 256 + wc * 32 + 8 * fq;
#pragma unroll
        for (int ai = 0; ai < 2; ++ai)
#pragma unroll
            for (int m = 0; m < 4; ++m) { bf16* rowp = O + (size_t)(row0 + ai * 128 + m * 16) * (2 * D) + col0;
#pragma unroll
                for (int bj = 0; bj < 2; ++bj) { const f32x4 v0 = acc[ai][bj][m][0], v1 = acc[ai][bj][m][1];
                    *(v4u*)(rowp + bj * 128) = (v4u){pk2(v0[0], v0[1]), pk2(v0[2], v0[3]), pk2(v1[0], v1[1]), pk2(v1[2], v1[3])}; } }
    }
};
struct EpiRouter {
    static constexpr bool PERM = false, TWICE = false;
    float* L;
    __device__ __forceinline__ void operator()(const f32x4 (&acc)[2][2][4][2], const DenseSched::Unit& u, int wr, int wc, int fr, int fq) const {
        const int row0 = u.pm * 256 + wr * 64 + fr, col0 = wc * 32 + 4 * fq;
        float* Lp = L + (size_t)u.ks * NT * NE;
#pragma unroll
        for (int ai = 0; ai < 2; ++ai)
#pragma unroll
            for (int m = 0; m < 4; ++m) { const size_t ro = (size_t)(row0 + ai * 128 + m * 16) * NE + col0;
#pragma unroll
                for (int bj = 0; bj < 2; ++bj)
#pragma unroll
                    for (int n = 0; n < 2; ++n) *(f32x4*)(Lp + ro + bj * 128 + n * 16) = acc[ai][bj][m][n]; }
    }
};
struct EpiGU {
    static constexpr bool PERM = true, TWICE = false;
    bf16* act; bf16* acts; const unsigned* bucket; unsigned* pos;
    __device__ __forceinline__ void operator()(const f32x4 (&acc)[2][2][4][2], const MoeSched<2, false>::Unit& u, int wr, int wc, int fr, int fq) const {
        bf16* O = u.kind == 0 ? act : acts;
        const int row0 = (u.kind == 0 ? u.blk : u.pm) * 256 + wr * 64 + fr, col0 = u.pn * 128 + wc * 32 + 8 * fq;
        if (u.kind == 0 && u.pn == 0 && wc == 0 && fq == 0) {
#pragma unroll
            for (int ai = 0; ai < 2; ++ai)
#pragma unroll
                for (int m = 0; m < 4; ++m) { const int r = ai * 128 + wr * 64 + m * 16 + fr;
                    if (r < u.valid) pos[bucket[(size_t)u.e * CAP + u.rb * 256 + r]] = (unsigned)(u.blk * 256 + r); } }
#pragma unroll
        for (int ai = 0; ai < 2; ++ai)
#pragma unroll
            for (int m = 0; m < 4; ++m) {
                const f32x4 g0 = acc[ai][0][m][0], g1 = acc[ai][0][m][1], u0 = acc[ai][1][m][0], u1 = acc[ai][1][m][1];
                float a[8];
#pragma unroll
                for (int j = 0; j < 4; j += 2) {
                    const f32x2 ga = (f32x2){g0[j], g0[j + 1]}, gb = (f32x2){g1[j], g1[j + 1]}, ua = (f32x2){u0[j], u0[j + 1]}, ub = (f32x2){u1[j], u1[j + 1]};
                    const f32x2 ea = ga * (-1.44269504f), eb = gb * (-1.44269504f);
                    f32x2 da, db; da.x = __builtin_amdgcn_exp2f(ea.x); da.y = __builtin_amdgcn_exp2f(ea.y); db.x = __builtin_amdgcn_exp2f(eb.x); db.y = __builtin_amdgcn_exp2f(eb.y);
                    da = da + 1.0f; db = db + 1.0f;
                    f32x2 ra, rb; ra.x = __builtin_amdgcn_rcpf(da.x); ra.y = __builtin_amdgcn_rcpf(da.y); rb.x = __builtin_amdgcn_rcpf(db.x); rb.y = __builtin_amdgcn_rcpf(db.y);
                    const f32x2 oa = (ga * ua) * ra, ob = (gb * ub) * rb;
                    a[j] = oa.x; a[j + 1] = oa.y; a[4 + j] = ob.x; a[4 + j + 1] = ob.y; }
                *(v4u*)(O + (size_t)(row0 + ai * 128 + m * 16) * FF + col0) = (v4u){pk2(a[0], a[1]), pk2(a[2], a[3]), pk2(a[4], a[5]), pk2(a[6], a[7])};
            }
    }
};
constexpr float Y_SCALE = 8.f, Y_INV_SCALE = 0.125f;
struct EpiDown {
    static constexpr bool PERM = true, TWICE = false;
    unsigned char* Y; bf16* O;
    __device__ __forceinline__ void operator()(const f32x4 (&acc)[2][2][4][2], const MoeSched<4, true>::Unit& u, int wr, int wc, int fr, int fq) const {
        const int col0 = u.pn * 256 + wc * 32 + 8 * fq;
        if (u.kind == 0) {
            const int row0 = u.blk * 256 + wr * 64 + fr;
#pragma unroll
            for (int ai = 0; ai < 2; ++ai)
#pragma unroll
                for (int m = 0; m < 4; ++m) { unsigned char* rowp = Y + (size_t)(row0 + ai * 128 + m * 16) * D + col0;
#pragma unroll
                    for (int bj = 0; bj < 2; ++bj) { f32x4 v0 = acc[ai][bj][m][0] * Y_SCALE, v1 = acc[ai][bj][m][1] * Y_SCALE;
#pragma unroll
                        for (int j = 0; j < 4; ++j) { v0[j] = __builtin_amdgcn_fmed3f(v0[j], -448.f, 448.f); v1[j] = __builtin_amdgcn_fmed3f(v1[j], -448.f, 448.f); }
                        int w0 = __builtin_amdgcn_cvt_pk_fp8_f32(v0[0], v0[1], 0, false); w0 = __builtin_amdgcn_cvt_pk_fp8_f32(v0[2], v0[3], w0, true);
                        int w1 = __builtin_amdgcn_cvt_pk_fp8_f32(v1[0], v1[1], 0, false); w1 = __builtin_amdgcn_cvt_pk_fp8_f32(v1[2], v1[3], w1, true);
                        *(v2u*)(rowp + bj * 128) = (v2u){(unsigned)w0, (unsigned)w1}; } }
        } else {
            const int row0 = u.pm * 256 + wr * 64 + fr;
#pragma unroll
            for (int ai = 0; ai < 2; ++ai)
#pragma unroll
                for (int m = 0; m < 4; ++m) { bf16* rowp = O + (size_t)(row0 + ai * 128 + m * 16) * (2 * D) + D + col0;
#pragma unroll
                    for (int bj = 0; bj < 2; ++bj) { const f32x4 v0 = acc[ai][bj][m][0], v1 = acc[ai][bj][m][1];
                        *(v4u*)(rowp + bj * 128) = (v4u){pk2(v0[0], v0[1]), pk2(v0[2], v0[3]), pk2(v1[0], v1[1]), pk2(v1[2], v1[3])}; } }
        }
    }
};

struct Args { const float* in[19]; float* out; unsigned char* ws; int ph_lo, ph_hi; };

struct Frame {
    LAS unsigned char* lds; int tid, lane, wave, G, bid;
    float* out; unsigned char* ws;
};

__device__ __forceinline__ void titem_load(const float* W, int N, int kb, int nb, int lane, float (&v)[32]) {
    const float* Wu = W + (size_t)(64 * kb) * N + 32 * nb;
    const unsigned loff = (unsigned)((lane >> 5) * N + (lane & 31)) * 4u;
#pragma unroll
    for (int i = 0; i < 32; ++i) v[i] = *(const float*)((const char*)(Wu + (size_t)(2 * i) * N) + loff);
}
__device__ __forceinline__ void titem_store(const float (&v)[32], int K, bf16* WT, int kb, int dst_row0, LAS float* scr, int lane) {
    const int k0 = 64 * kb;
#pragma unroll
    for (int i = 0; i < 32; ++i) { const int kk = 2 * i + (lane >> 5); scr[kk * 33 + (lane & 31)] = v[i]; }
    asm volatile("s_waitcnt lgkmcnt(0)" ::: "memory");
    const int c = lane & 7;
#pragma unroll
    for (int j = 0; j < 4; ++j) { const int n = (lane >> 3) + 8 * j; const LAS float* s = scr + (8 * c) * 33 + n;
        v4u o; o.x = pk2(s[0 * 33], s[1 * 33]); o.y = pk2(s[2 * 33], s[3 * 33]); o.z = pk2(s[4 * 33], s[5 * 33]); o.w = pk2(s[6 * 33], s[7 * 33]);
        *(v4u*)(WT + (size_t)(dst_row0 + n) * K + k0 + 8 * c) = o; }
    asm volatile("s_waitcnt lgkmcnt(0)" ::: "memory");
}
__device__ __forceinline__ void transpose_item(const float* W, int K, int N, bf16* WT, int kb, int nb, int dst_row0, LAS float* scr, int lane) {
    float v[32]; titem_load(W, N, kb, nb, lane, v); titem_store(v, K, WT, kb, dst_row0, scr, lane);
}
template <bool DOWN>
__device__ __forceinline__ void convert_expert(Frame& F, const float* Wa, const float* Wb, bf16* dst) {
    LAS float* scr = (LAS float*)(F.lds + F.wave * 16384);
    constexpr int PER_WAVE = DOWN ? 16 : 32;
    const int base = 0, wv = F.wave;
    auto ld = [&](int i, float (&v)[32]) {
        if (!DOWN) titem_load((i >> 4) ? Wb : Wa, FF, i & 15, wv, F.lane, v);
        else titem_load(Wa, D, i >> 2, wv + 8 * (i & 3), F.lane, v); };
    auto st = [&](int i, const float (&v)[32]) {
        if (!DOWN) { const int n0 = wv * 32; titem_store(v, D, dst, i & 15, (n0 >> 7) * 256 + ((i >> 4) ? 128 : 0) + (n0 & 127), scr, F.lane); }
        else titem_store(v, FF, dst, i >> 2, (wv + 8 * (i & 3)) * 32, scr, F.lane); };
    float v0[32], v1[32], v2[32], v3[32];
    ld(base, v0); ld(base + 1, v1); ld(base + 2, v2);
    for (int i = 0; i < PER_WAVE; i += 4) {
        ld(base + i + 3, v3); st(base + i, v0);
        if (i + 4 < PER_WAVE) ld(base + i + 4, v0);
        st(base + i + 1, v1);
        if (i + 5 < PER_WAVE) ld(base + i + 5, v1);
        st(base + i + 2, v2);
        if (i + 6 < PER_WAVE) ld(base + i + 6, v2);
        st(base + i + 3, v3);
    }
}

__device__ __forceinline__ void p0_prologue(Frame& F) {
#define INP(i) ld_ptr(F.lds, (i))
    if (F.bid < 192) {
        const float* cptr = INP(1); const float* w_ada = INP(2); const float* b_ada = INP(3);
        LAS float* cs = (LAS float*)F.lds;
        LAS float* red = (LAS float*)(F.lds + 32768);
        for (int i = F.tid; i < NB * D; i += NTHREADS) { const float v = cptr[i]; cs[i] = v / (1.f + __expf(-v)); }
        __syncthreads();
        const int col = F.tid & 31, kg = F.tid >> 5, j = F.bid * 32 + col;
        float a[NB];
#pragma unroll
        for (int b = 0; b < NB; ++b) a[b] = 0.f;
#pragma unroll 8
        for (int kk = 0; kk < 64; ++kk) { const int k = kg * 64 + kk; const float w = w_ada[(size_t)k * 6144 + j];
#pragma unroll
            for (int b = 0; b < NB; ++b) a[b] += cs[b * D + k] * w; }
#pragma unroll
        for (int b = 0; b < NB; ++b) red[(kg * NB + b) * 32 + col] = a[b];
        __syncthreads();
        if (F.tid < 256) { const int b = F.tid >> 5, cc = F.tid & 31; float s = 0.f;
#pragma unroll
            for (int g = 0; g < 16; ++g) s += red[(g * NB + b) * 32 + cc];
            ((float*)(F.ws + WS_MOD))[b * 6144 + F.bid * 32 + cc] = s + b_ada[F.bid * 32 + cc]; }
        __syncthreads();
    }
    LAS float* scr = (LAS float*)(F.lds + F.wave * 16384);
    const int gw = F.bid * NWAVES + F.wave, NGW = F.G * NWAVES;
    constexpr int I_IN = 16 * 80, I_OUT = 8 * 32, I_R = 16 * 8, I_G = 16 * 8, I_D = 4 * 32;
    constexpr int I_SMALL = I_IN + I_OUT + I_R + 2 * I_G + I_D, I_EXP = 2 * I_G + I_D;
    constexpr int NITEMS = I_SMALL;
    bf16* win_t = (bf16*)(F.ws + WS_WIN_T); bf16* wout_t = (bf16*)(F.ws + WS_WOUT_T); bf16* wr_t = (bf16*)(F.ws + WS_WR_T);
    bf16* wsgu_t = (bf16*)(F.ws + WS_WSGU_T); bf16* wsd_t = (bf16*)(F.ws + WS_WSD_T); bf16* wgu_t = (bf16*)(F.ws + WS_WGU_T); bf16* wd_t = (bf16*)(F.ws + WS_WD_T);
    for (int it = gw; it < NITEMS; it += NGW) {
        int r = it;
        if (r < I_IN) { transpose_item(INP(5), D, NPROJ, win_t, r / 80, r % 80, (r % 80) * 32, scr, F.lane); continue; } r -= I_IN;
        if (r < I_OUT) { transpose_item(INP(8), NMIX, D, wout_t, r / 32, r % 32, (r % 32) * 32, scr, F.lane); continue; } r -= I_OUT;
        if (r < I_R) { transpose_item(INP(10), D, NE, wr_t, r / 8, r % 8, (r % 8) * 32, scr, F.lane); continue; } r -= I_R;
        const float *Wg, *Wu, *Wd; bf16 *GU, *DN;
        if (r < 2 * I_G + I_D) { Wg = INP(15); Wu = INP(16); Wd = INP(17); GU = wsgu_t; DN = wsd_t; }
        else { r -= 2 * I_G + I_D; const int e = r / I_EXP; r -= e * I_EXP;
            Wg = INP(12) + (size_t)e * D * FF; Wu = INP(13) + (size_t)e * D * FF; Wd = INP(14) + (size_t)e * FF * D;
            GU = wgu_t + (size_t)e * 512 * D; DN = wd_t + (size_t)e * D * FF; }
        if (r < I_G) { const int nb = r % 8, n0 = nb * 32; transpose_item(Wg, D, FF, GU, r / 8, nb, (n0 >> 7) * 256 + (n0 & 127), scr, F.lane); continue; } r -= I_G;
        if (r < I_G) { const int nb = r % 8, n0 = nb * 32; transpose_item(Wu, D, FF, GU, r / 8, nb, (n0 >> 7) * 256 + 128 + (n0 & 127), scr, F.lane); continue; } r -= I_G;
        transpose_item(Wd, FF, D, DN, r / 32, r % 32, (r % 32) * 32, scr, F.lane);
    }
#undef INP
}

template <bool HAS_DX>
__device__ __forceinline__ void modnorm_phase(Frame& F, const float* X, const float* g, int shift_chunk, bf16* O) {
    const float* mod = (const float*)(F.ws + WS_MOD);
    constexpr int RW = 4;
    for (int blk = F.bid; blk < NT / 128; blk += F.G) {
        const int b = (blk * 128) >> 12;
        const float* sh = mod + (size_t)b * 6144 + shift_chunk * D; const float* sc = sh + D; const float* g1 = mod + (size_t)b * 6144 + 2 * D;
        f32x4 gg[4], ss[4], ga[4];
#pragma unroll
        for (int j = 0; j < 4; ++j) { const int col = 256 * j + 4 * F.lane; const f32x4 gv = *(const f32x4*)(g + col), scv = *(const f32x4*)(sc + col);
            gg[j] = gv * (scv + 1.f); ss[j] = *(const f32x4*)(sh + col); ga[j] = HAS_DX ? *(const f32x4*)(g1 + col) : (f32x4){0.f, 0.f, 0.f, 0.f}; }
        for (int rr = 0; rr < 16; rr += RW) {
            const int row = blk * 128 + F.wave * 16 + rr;
            f32x4 v[RW][4]; v2u dv[RW][4];
#pragma unroll
            for (int q = 0; q < RW; ++q) { const f32x4* xr = (const f32x4*)(X + (size_t)(row + q) * D) + F.lane;
#pragma unroll
                for (int j = 0; j < 4; ++j) v[q][j] = xr[64 * j];
                if (HAS_DX) { const v2u* dr = (const v2u*)((const bf16*)F.out + (size_t)(row + q) * (2 * D)) + F.lane;
#pragma unroll
                    for (int j = 0; j < 4; ++j) dv[q][j] = dr[64 * j]; } }
#pragma unroll
            for (int q = 0; q < RW; ++q) { float s = 0.f;
#pragma unroll
                for (int j = 0; j < 4; ++j) {
                    if (HAS_DX) v[q][j] = v[q][j] + ga[j] * (f32x4){bflo(dv[q][j].x), bfhi(dv[q][j].x), bflo(dv[q][j].y), bfhi(dv[q][j].y)};
                    s += (v[q][j].x * v[q][j].x + v[q][j].y * v[q][j].y) + (v[q][j].z * v[q][j].z + v[q][j].w * v[q][j].w); }
                const float rstd = 1.f / sqrtf(wave_sum(s) * (1.f / D) + NORM_EPS);
                v2u* o8 = (v2u*)(O + (size_t)(row + q) * D) + F.lane;
#pragma unroll
                for (int j = 0; j < 4; ++j) { const f32x4 y = v[q][j] * rstd * gg[j] + ss[j]; o8[64 * j] = (v2u){pk2(y.x, y.y), pk2(y.z, y.w)}; } }
        }
    }
}

__device__ __forceinline__ void pool_phase(Frame& F, const float* pool_w, const float* pool_scale) {
    const bf16* proj = (const bf16*)(F.ws + WS_PROJ); bf16* mixin = (bf16*)(F.ws + WS_MIXIN);
    LAS float* us = (LAS float*)F.lds;
    LAS float* pl = (LAS float*)(F.lds + 49152);
    for (int tile = F.bid; tile < NT / 32; tile += F.G) {
        const int row0 = tile * 32, tl0 = row0 & (SEQ - 1);
        __syncthreads();
        for (int p = F.tid; p < 47 * 32; p += NTHREADS) { const int rr = p >> 5, pc = p & 31; const int tl = tl0 - 15 + rr;
            v4u raw = (v4u){0u, 0u, 0u, 0u};
            if (tl >= 0) raw = *(const v4u*)(proj + (size_t)(row0 - 15 + rr) * NPROJ + pc * 8);
            LAS float* d = us + rr * 256 + pc * 8;
            d[0] = bflo(raw.x); d[1] = bfhi(raw.x); d[2] = bflo(raw.y); d[3] = bfhi(raw.y); d[4] = bflo(raw.z); d[5] = bfhi(raw.z); d[6] = bflo(raw.w); d[7] = bfhi(raw.w); }
        __syncthreads();
        { const int ch = F.tid & 255, half = F.tid >> 8, w = 2 << (ch >> 6);
            for (int i = 0; i < 16; ++i) { const int tt = half * 16 + i, tl = tl0 + tt; float s = 0.f;
                for (int k = 0; k < w; ++k) s += us[(15 + tt - k) * 256 + ch];
                const int cnt = (tl + 1) < w ? (tl + 1) : w;
                pl[tt * 256 + ch] = s / (float)cnt - us[(15 + tt) * 256 + ch]; } }
        __syncthreads();
        { const int col = F.tid & 255, half = F.tid >> 8, g = col >> 6, dc = col & 63;
            float acc[16];
#pragma unroll
            for (int i = 0; i < 16; ++i) acc[i] = 0.f;
            const float* pw = pool_w + (size_t)g * 64 * 64 + dc;
            for (int c4 = 0; c4 < 64; c4 += 4) {
                const float w0 = pw[(c4 + 0) * 64], w1 = pw[(c4 + 1) * 64], w2 = pw[(c4 + 2) * 64], w3 = pw[(c4 + 3) * 64];
#pragma unroll
                for (int i = 0; i < 16; ++i) { const f32x4 p = *(const LAS f32x4*)(pl + (half * 16 + i) * 256 + g * 64 + c4);
                    acc[i] += p.x * w0 + p.y * w1 + p.z * w2 + p.w * w3; } }
            const float sc = pool_scale[col];
#pragma unroll
            for (int i = 0; i < 16; ++i) mixin[(size_t)(row0 + half * 16 + i) * NMIX + col] = (bf16)f2bf(acc[i] * sc); }
    }
}

constexpr int KV_PITCH = 144;
__device__ __forceinline__ void attn_phase(Frame& F) {
    const bf16* proj = (const bf16*)(F.ws + WS_PROJ);
    bf16* atto = (bf16*)(F.ws + WS_ATTO); float* lse = (float*)(F.ws + WS_LSE);
    LAS unsigned char* Ks = F.lds; LAS unsigned char* Vs = F.lds + 256 * KV_PITCH;
    const int lane = F.lane, fr = lane & 15, fq = lane >> 4, w = F.wave;
    const int w_i0 = 16 * w, c0 = w >> 1, qi = w_i0 + fr;
#define ATT_DECODE(unit_, rowb_, d_, r_, n_, g_, h_, colQ_) \
        const int rn_##unit_ = (unit_) & 31; const int h_ = ((unit_) >> 5) & 3, g_ = ((unit_) >> 7) % 3; const size_t rowb_ = (size_t)((unit_) / 384) * SEQ; \
        const int d_ = 1 << (2 * g_), nbk_##unit_ = 32 >> (2 * g_), r_ = rn_##unit_ / nbk_##unit_, n_ = rn_##unit_ % nbk_##unit_; const int colQ_ = 256 + g_ * 256 + h_ * 64;
    v4u kreg[4], vreg[4]; bf16x8 qn[2];
    {   const int unit0 = F.bid;
        if (unit0 < NB * 3 * 4 * 32) { ATT_DECODE(unit0, rowb, d, r, n, g, h, colQ)
            const size_t qrow = rowb + (size_t)(n * 128 + qi) * d + r;
#pragma unroll
            for (int ks = 0; ks < 2; ++ks) qn[ks] = *(const bf16x8*)(proj + qrow * NPROJ + colQ + ks * 32 + fq * 8);
#pragma unroll
            for (int cidx = 0; cidx < 4; ++cidx) { const int ch = F.tid + 512 * cidx, j = ch >> 3, pc = ch & 7;
                int p = (n - 1) * 128 + j; p = p < 0 ? 0 : p; const size_t row = rowb + (size_t)p * d + r;
                kreg[cidx] = *(const v4u*)(proj + row * NPROJ + colQ + 768 + pc * 8); vreg[cidx] = *(const v4u*)(proj + row * NPROJ + colQ + 1536 + pc * 8); } } }
    for (int unit = F.bid; unit < NB * 3 * 4 * 32; unit += F.G) {
        ATT_DECODE(unit, rowb, d, r, n, g, h, colQ)
        __syncthreads();
#pragma unroll
        for (int cidx = 0; cidx < 4; ++cidx) { const int ch = F.tid + 512 * cidx, j = ch >> 3, pc = ch & 7;
            *(LAS v4u*)(Ks + j * KV_PITCH + pc * 16) = kreg[cidx]; *(LAS v4u*)(Vs + j * KV_PITCH + pc * 16) = vreg[cidx]; }
        const size_t qrow = rowb + (size_t)(n * 128 + qi) * d + r;
        bf16x8 qf[2]; qf[0] = qn[0]; qf[1] = qn[1];
        __syncthreads();
        {   const int unit2 = unit + F.G;
            if (unit2 < NB * 3 * 4 * 32) { ATT_DECODE(unit2, rowb2, d2, r2, n2, g2, h2, colQ2)
                const size_t qrow2 = rowb2 + (size_t)(n2 * 128 + qi) * d2 + r2;
#pragma unroll
                for (int ks = 0; ks < 2; ++ks) qn[ks] = *(const bf16x8*)(proj + qrow2 * NPROJ + colQ2 + ks * 32 + fq * 8);
#pragma unroll
                for (int cidx = 0; cidx < 4; ++cidx) { const int ch = F.tid + 512 * cidx, j = ch >> 3, pc = ch & 7;
                    int p = (n2 - 1) * 128 + j; p = p < 0 ? 0 : p; const size_t row = rowb2 + (size_t)p * d2 + r2;
                    kreg[cidx] = *(const v4u*)(proj + row * NPROJ + colQ2 + 768 + pc * 8); vreg[cidx] = *(const v4u*)(proj + row * NPROJ + colQ2 + 1536 + pc * 8); } } }
        f32x4 s[5][2];
#pragma unroll
        for (int cc = 0; cc < 5; ++cc)
#pragma unroll
            for (int hh = 0; hh < 2; ++hh) {
                const int j = 32 * (c0 + cc) + 8 * (fr >> 2) + 4 * hh + (fr & 3);
                const bf16x8 k0 = *(const LAS bf16x8*)(Ks + j * KV_PITCH + fq * 16), k1 = *(const LAS bf16x8*)(Ks + j * KV_PITCH + 64 + fq * 16);
                f32x4 a = (f32x4){0.f, 0.f, 0.f, 0.f};
                a = __builtin_amdgcn_mfma_f32_16x16x32_bf16(k0, qf[0], a, 0, 0, 0);
                a = __builtin_amdgcn_mfma_f32_16x16x32_bf16(k1, qf[1], a, 0, 0, 0);
                s[cc][hh] = a;
            }
        float mx = -1e30f;
        int qil = qi; asm volatile("" : "+v"(qil));
#pragma unroll
        for (int cc = 0; cc < 5; ++cc)
#pragma unroll
            for (int hh = 0; hh < 2; ++hh)
#pragma unroll
                for (int rr = 0; rr < 4; ++rr) { const int j = 32 * (c0 + cc) + 8 * fq + 4 * hh + rr; const int dist = 128 + qil - j;
                    const bool valid = (dist >= 0) && (dist <= 128) && (n > 0 || j >= 128);
                    const float v = valid ? s[cc][hh][rr] * 0.18033688f : -1e30f; s[cc][hh][rr] = v; mx = fmaxf(mx, v); }
        mx = fmaxf(mx, __shfl_xor(mx, 16)); mx = fmaxf(mx, __shfl_xor(mx, 32));
        float l = 0.f;
#pragma unroll
        for (int cc = 0; cc < 5; ++cc)
#pragma unroll
            for (int hh = 0; hh < 2; ++hh)
#pragma unroll
                for (int rr = 0; rr < 4; ++rr) { const float p = __builtin_amdgcn_exp2f(s[cc][hh][rr] - mx); s[cc][hh][rr] = p; l += p; }
        l += __shfl_xor(l, 16); l += __shfl_xor(l, 32);
        f32x4 o[4];
#pragma unroll
        for (int eb = 0; eb < 4; ++eb) o[eb] = (f32x4){0.f, 0.f, 0.f, 0.f};
#pragma unroll
        for (int cc = 0; cc < 5; ++cc) {
            const v4u pu = (v4u){pk2(s[cc][0][0], s[cc][0][1]), pk2(s[cc][0][2], s[cc][0][3]), pk2(s[cc][1][0], s[cc][1][1]), pk2(s[cc][1][2], s[cc][1][3])};
            const bf16x8 pf = __builtin_bit_cast(bf16x8, pu);
            const int key0 = 32 * (c0 + cc) + 8 * fq + (fr >> 2);
#pragma unroll
            for (int eb = 0; eb < 4; ++eb) {
                const LAS unsigned char* vp = Vs + key0 * KV_PITCH + (16 * eb + 4 * (fr & 3)) * 2;
                const s16x4 lo = __builtin_bit_cast(s16x4, __builtin_amdgcn_ds_read_tr16_b64_v4i16((LAS s16x4*)vp));
                const s16x4 hi = __builtin_bit_cast(s16x4, __builtin_amdgcn_ds_read_tr16_b64_v4i16((LAS s16x4*)(vp + 4 * KV_PITCH)));
                const bf16x8 vf = (bf16x8){lo[0], lo[1], lo[2], lo[3], hi[0], hi[1], hi[2], hi[3]};
                o[eb] = __builtin_amdgcn_mfma_f32_16x16x32_bf16(vf, pf, o[eb], 0, 0, 0);
            }
        }
        const float il = 1.f / l;
        bf16* op = atto + ((size_t)g * NT + qrow) * 256 + h * 64 + 4 * fq;
#pragma unroll
        for (int eb = 0; eb < 4; ++eb) { const f32x4 v = o[eb] * il; *(v2u*)(op + 16 * eb) = (v2u){pk2(v.x, v.y), pk2(v.z, v.w)}; }
        if (fq == 0) lse[((size_t)g * NT + qrow) * 4 + h] = mx + __builtin_amdgcn_logf(l);
    }
#undef ATT_DECODE
}

__device__ __forceinline__ void combine_phase(Frame& F) {
    const bf16* atto = (const bf16*)(F.ws + WS_ATTO); const float* lse = (const float*)(F.ws + WS_LSE); bf16* mixin = (bf16*)(F.ws + WS_MIXIN);
    for (size_t idx = (size_t)F.bid * NTHREADS + F.tid; idx < (size_t)NT * 32; idx += (size_t)F.G * NTHREADS) {
        const size_t t = idx >> 5; const int pc = (int)(idx & 31), h = pc >> 3;
        const float l0 = lse[(0 * (size_t)NT + t) * 4 + h], l1 = lse[(1 * (size_t)NT + t) * 4 + h], l2 = lse[(2 * (size_t)NT + t) * 4 + h];
        const float m = fmaxf(l0, fmaxf(l1, l2));
        float a0 = __builtin_amdgcn_exp2f(l0 - m), a1 = __builtin_amdgcn_exp2f(l1 - m), a2 = __builtin_amdgcn_exp2f(l2 - m);
        const float inv = 1.f / (a0 + a1 + a2); a0 *= inv; a1 *= inv; a2 *= inv;
        const v4u v0 = *(const v4u*)(atto + (0 * (size_t)NT + t) * 256 + pc * 8), v1 = *(const v4u*)(atto + (1 * (size_t)NT + t) * 256 + pc * 8), v2 = *(const v4u*)(atto + (2 * (size_t)NT + t) * 256 + pc * 8);
        v4u o;
        o.x = pk2(a0 * bflo(v0.x) + a1 * bflo(v1.x) + a2 * bflo(v2.x), a0 * bfhi(v0.x) + a1 * bfhi(v1.x) + a2 * bfhi(v2.x));
        o.y = pk2(a0 * bflo(v0.y) + a1 * bflo(v1.y) + a2 * bflo(v2.y), a0 * bfhi(v0.y) + a1 * bfhi(v1.y) + a2 * bfhi(v2.y));
        o.z = pk2(a0 * bflo(v0.z) + a1 * bflo(v1.z) + a2 * bflo(v2.z), a0 * bfhi(v0.z) + a1 * bfhi(v1.z) + a2 * bfhi(v2.z));
        o.w = pk2(a0 * bflo(v0.w) + a1 * bflo(v1.w) + a2 * bflo(v2.w), a0 * bfhi(v0.w) + a1 * bfhi(v1.w) + a2 * bfhi(v2.w));
        *(v4u*)(mixin + t * NMIX + 256 + pc * 8) = o;
    }
}

#if MK_NAIVE_ATTN
__device__ __forceinline__ void naive_attn_phase(Frame& F) {
    const bf16* proj = (const bf16*)(F.ws + WS_PROJ); bf16* mixin = (bf16*)(F.ws + WS_MIXIN);
    for (size_t idx = (size_t)F.bid * NTHREADS + F.tid; idx < (size_t)NT * 4; idx += (size_t)F.G * NTHREADS) {
        const size_t tg = idx >> 2; const int h = (int)(idx & 3), t = (int)(tg & (SEQ - 1)); const size_t rowb = tg - t;
        float m = -1e30f, l = 0.f, o[64];
        for (int e = 0; e < 64; ++e) o[e] = 0.f;
        for (int g = 0; g < 3; ++g) { const int d = 1 << (2 * g); const int colQ = 256 + g * 256 + h * 64;
            const bf16* q = proj + tg * NPROJ + colQ;
            for (int j = 0; j <= 128; ++j) { const int tk = t - j * d; if (tk < 0) break;
                const bf16* k = proj + (rowb + tk) * NPROJ + colQ + 768; const bf16* v = k + 768;
                float sdot = 0.f; for (int e = 0; e < 64; ++e) sdot += bf2f(q[e]) * bf2f(k[e]);
                sdot *= 0.125f;
                const float mn = fmaxf(m, sdot), corr = __expf(m - mn), p = __expf(sdot - mn);
                l = l * corr + p; for (int e = 0; e < 64; ++e) o[e] = o[e] * corr + p * bf2f(v[e]); m = mn; } }
        const float il = 1.f / l;
        for (int e = 0; e < 64; ++e) mixin[tg * NMIX + 256 + h * 64 + e] = (bf16)f2bf(o[e] * il);
    }
}
#endif

__device__ __forceinline__ void routing_phase(Frame& F, const float* router_bias) {
    const float* L0 = (const float*)(F.ws + WS_LOGIT); const float* L1 = L0 + (size_t)NT * NE;
    float* gatew = (float*)(F.ws + WS_GATEW); unsigned* bucket = (unsigned*)(F.ws + WS_BUCKET); unsigned* gcnt = (unsigned*)(F.ws + WS_CTL) + CW_GCNT;
    LAS unsigned* hist = (LAS unsigned*)F.lds; LAS unsigned* basel = hist + 256; LAS unsigned* asg = hist + 512;
    const int lane = F.lane;
    for (int blk = F.bid; blk < NT / 128; blk += F.G) {
        __syncthreads();
        if (F.tid < 256) hist[F.tid] = 0u;
        __syncthreads();
        const f32x4 bias = *(const f32x4*)(router_bias + 4 * lane);
        for (int tl = 0; tl < 16; ++tl) {
            const int tloc = F.wave * 16 + tl; const size_t t = (size_t)blk * 128 + tloc;
            const f32x4 lg = *(const f32x4*)(L0 + t * NE + 4 * lane) + *(const f32x4*)(L1 + t * NE + 4 * lane);
            float sc[4], cd[4];
#pragma unroll
            for (int i = 0; i < 4; ++i) { sc[i] = 1.f / (1.f + __expf(-lg[i])); cd[i] = sc[i] + bias[i]; }
            float a1 = fmaxf(cd[0], cd[1]), a2 = fminf(cd[0], cd[1]);
#pragma unroll
            for (int i = 2; i < 4; ++i) { const float v = cd[i]; a2 = fmaxf(a2, fminf(a1, v)); a1 = fmaxf(a1, v); }
#pragma unroll
            for (int off = 1; off < 8; off <<= 1) { const float b1 = __shfl_xor(a1, off), b2 = __shfl_xor(a2, off);
                const float n1 = fmaxf(a1, b1), n2 = fmaxf(fminf(a1, b1), fmaxf(a2, b2)); a1 = n1; a2 = n2; }
            const float gs = a1 + a2; const int myg = lane >> 3; int rank = 0;
#pragma unroll
            for (int gg = 0; gg < 8; ++gg) { const float o = __shfl(gs, gg * 8); rank += (o > gs || (o == gs && gg < myg)) ? 1 : 0; }
            if (rank >= 4) {
#pragma unroll
                for (int i = 0; i < 4; ++i) cd[i] = -1e30f; }
            int sel_e = 0; float sel_s = 0.f, ssum = 0.f;
#pragma unroll
            for (int k = 0; k < TOPK; ++k) {
                float bv = cd[0]; int bi = 0;
#pragma unroll
                for (int i = 1; i < 4; ++i) if (cd[i] > bv) { bv = cd[i]; bi = i; }
                int gi = 4 * lane + bi;
#pragma unroll
                for (int off = 32; off >= 1; off >>= 1) { const float ov = __shfl_xor(bv, off); const int oi = __shfl_xor(gi, off);
                    if (ov > bv || (ov == bv && oi < gi)) { bv = ov; gi = oi; } }
                const int own = gi >> 2, wi = gi & 3;
                float myv = sc[0]; myv = wi == 1 ? sc[1] : myv; myv = wi == 2 ? sc[2] : myv; myv = wi == 3 ? sc[3] : myv;
                const float sv = __shfl(myv, own);
                if (lane == own) {
#pragma unroll
                    for (int i = 0; i < 4; ++i) if (wi == i) cd[i] = -1e30f; }
                ssum += sv;
                if (lane == k) { sel_e = gi; sel_s = sv; }
            }
            if (lane < TOPK) {
                const unsigned rk = __hip_atomic_fetch_add(hist + sel_e, 1u, __ATOMIC_RELAXED, __HIP_MEMORY_SCOPE_WORKGROUP);
                asg[tloc * 8 + lane] = (unsigned)sel_e | (rk << 16);
                gatew[t * 8 + lane] = sel_s / ssum * 2.5f;
            }
        }
        __syncthreads();
        if (F.tid < 256) { const unsigned c = hist[F.tid]; basel[F.tid] = c ? atomicAdd(&gcnt[F.tid * 16], c) : 0u; }
        __syncthreads();
        for (int a = F.tid; a < 1024; a += NTHREADS) { const unsigned v = asg[a], e = v & 0xffffu, rk = v >> 16;
            bucket[(size_t)e * CAP + basel[e] + rk] = (unsigned)(blk * 1024 + a); }
    }
}

__device__ __forceinline__ void build_tables(Frame& F, int& nblk_total) {
    const unsigned* gcnt = (const unsigned*)(F.ws + WS_CTL) + CW_GCNT;
    LAS int* prefix = (LAS int*)(F.lds + TAB_OFF); LAS int* cnt = prefix + 260;
    __syncthreads();
    if (F.tid < 256) cnt[F.tid] = (int)__hip_atomic_load(&gcnt[F.tid * 16], __ATOMIC_RELAXED, __HIP_MEMORY_SCOPE_AGENT);
    __syncthreads();
    if (F.tid == 0) { int s = 0; for (int e = 0; e < NE; ++e) { prefix[e] = s; s += (cnt[e] + 255) >> 8; } prefix[NE] = s; }
    __syncthreads();
    if (F.tid < 256) { LAS unsigned char* b2e = (LAS unsigned char*)(cnt + 256); for (int b = prefix[F.tid]; b < prefix[F.tid + 1]; ++b) b2e[b] = (unsigned char)F.tid; }
    __syncthreads();
    nblk_total = prefix[NE];
}

__device__ __forceinline__ void final_phase(Frame& F, const float* X, const float* g_final) {
    const float* mod = (const float*)(F.ws + WS_MOD); const unsigned char* Y = (const unsigned char*)(F.ws + WS_Y);
    const unsigned* pos = (const unsigned*)(F.ws + WS_POS); const float* gatew = (const float*)(F.ws + WS_GATEW);
    constexpr int RW = 1;
    const int c0 = 16 * F.lane;
    for (int blk = F.bid; blk < NT / 128; blk += F.G) {
        const int b = (blk * 128) >> 12; const float* g1 = mod + (size_t)b * 6144 + 2 * D + c0; const float* g2 = mod + (size_t)b * 6144 + 5 * D + c0;
        f32x4 ga[4], gb[4];
#pragma unroll
        for (int j = 0; j < 4; ++j) { ga[j] = *(const f32x4*)(g1 + 4 * j); gb[j] = *(const f32x4*)(g2 + 4 * j); }
        const size_t rowbase = (size_t)blk * 128 + F.wave * 16;
        const unsigned p0 = pos[rowbase * 8 + F.lane], p1 = pos[rowbase * 8 + 64 + F.lane];
        const float w0 = gatew[rowbase * 8 + F.lane] * Y_INV_SCALE, w1 = gatew[rowbase * 8 + 64 + F.lane] * Y_INV_SCALE;
        for (int rr = 0; rr < 16; rr += RW) {
            f32x4 v[RW][4]; v4u dv[RW][2], sv[RW][2], yv[RW][TOPK]; float wk[RW][TOPK];
#pragma unroll
            for (int q = 0; q < RW; ++q) { const size_t row = rowbase + rr + q;
                const f32x4* xr = (const f32x4*)(X + row * D + c0); const v4u* dr = (const v4u*)((const bf16*)F.out + row * (2 * D) + c0);
#pragma unroll
                for (int j = 0; j < 4; ++j) v[q][j] = xr[j];
                dv[q][0] = dr[0]; dv[q][1] = dr[1]; sv[q][0] = dr[128]; sv[q][1] = dr[129];
#pragma unroll
                for (int k = 0; k < TOPK; ++k) { const int idx = (rr + q) * 8 + k;
                    const unsigned pk = (unsigned)__builtin_amdgcn_readlane((int)(idx < 64 ? p0 : p1), idx & 63);
                    wk[q][k] = __builtin_bit_cast(float, __builtin_amdgcn_readlane(__builtin_bit_cast(int, idx < 64 ? w0 : w1), idx & 63));
                    yv[q][k] = *(const v4u*)(Y + (size_t)pk * D + c0); } }
#pragma unroll
            for (int q = 0; q < RW; ++q) { float s = 0.f;
#pragma unroll
                for (int j = 0; j < 4; ++j) {
                    const unsigned sw0 = sv[q][j >> 1][(j & 1) * 2], sw1 = sv[q][j >> 1][(j & 1) * 2 + 1];
                    f32x4 r = (f32x4){bflo(sw0), bfhi(sw0), bflo(sw1), bfhi(sw1)};
#pragma unroll
                    for (int k = 0; k < TOPK; ++k) { const int wd = (int)yv[q][k][j];
                        const auto lo = __builtin_amdgcn_cvt_pk_f32_fp8(wd, false), hi = __builtin_amdgcn_cvt_pk_f32_fp8(wd, true);
                        r += wk[q][k] * (f32x4){lo[0], lo[1], hi[0], hi[1]}; }
                    const unsigned dw0 = dv[q][j >> 1][(j & 1) * 2], dw1 = dv[q][j >> 1][(j & 1) * 2 + 1];
                    v[q][j] = v[q][j] + ga[j] * (f32x4){bflo(dw0), bfhi(dw0), bflo(dw1), bfhi(dw1)} + gb[j] * r;
                    s += (v[q][j].x * v[q][j].x + v[q][j].y * v[q][j].y) + (v[q][j].z * v[q][j].z + v[q][j].w * v[q][j].w); }
                const float rstd = 1.f / sqrtf(wave_sum(s) * (1.f / D) + NORM_EPS);
                f32x4* orow = (f32x4*)(F.out + (rowbase + rr + q) * D + c0);
#pragma unroll
                for (int j = 0; j < 4; ++j) orow[j] = v[q][j] * rstd * *(const f32x4*)(g_final + c0 + 4 * j); }
        }
    }
}

constexpr int N_PHASES = 12;
__global__ void __launch_bounds__(NTHREADS, 2) fwd(Args args) {
    extern __shared__ __attribute__((aligned(16))) unsigned char lds_raw[];
    Frame F;
    F.lds = (LAS unsigned char*)lds_raw;
    F.tid = threadIdx.x; F.lane = F.tid & 63; F.wave = __builtin_amdgcn_readfirstlane(F.tid >> 6); F.G = gridDim.x; F.bid = blockIdx.x;
#define INP(i) ld_ptr(F.lds, (i))
    F.out = args.out; F.ws = args.ws;
    unsigned char* ws = args.ws;
    volatile LAS unsigned* MISC = (volatile LAS unsigned*)(F.lds + MISC_OFF);
    if (F.tid < 16) MISC[F.tid] = 0u;
    if (F.tid == 0) { LAS unsigned long long* pt = (LAS unsigned long long*)(F.lds + PT_OFF);
#pragma unroll
        for (int i = 0; i < 19; ++i) pt[i] = (unsigned long long)args.in[i]; }
    __syncthreads();
    const int lo = args.ph_lo, hi = args.ph_hi;
    XcdBarrier bar; bar.bar = (unsigned*)(ws + WS_CTL) + CW_BAR; bar.x = 0; bar.st = nullptr;
    if (hi - lo > 1) bar = xcd_barrier_post((unsigned*)(ws + WS_CTL) + CW_BAR, MISC + 8);
#ifndef PH_MASK
#define PH_MASK 0xfff
#endif
#define IN(k) (((PH_MASK >> (k)) & 1) && lo <= (k) && (k) < hi)
#define SEAM(k) do { if (IN(k) && IN((k) + 1)) xcd_barrier(bar); { int _t = threadIdx.x; asm volatile("" : "+v"(_t)); F.tid = _t; F.lane = _t & 63; } } while (0)

    const int vcu = (F.G % 8 == 0) ? (F.bid % 8) * (F.G / 8) + F.bid / 8 : F.bid;
    bf16* hbuf = (bf16*)(ws + WS_H); bf16* proj = (bf16*)(ws + WS_PROJ); bf16* mixin = (bf16*)(ws + WS_MIXIN);

    if (IN(0)) { p0_prologue(F); } SEAM(0);
    if (IN(1)) { modnorm_phase<false>(F, INP(0), INP(4), 0, hbuf); } SEAM(1);
    if (IN(2)) {
        DenseSched S; S.init(hbuf, ws + WS_WIN_T, D, D, NT, NPROJ, 1, 0, F.G, F.bid);
        EpiProj E{proj};
        const int ksplit = vcu % 6;
        S.i0 = 0; S.i1 = ksplit;
        gemm_phase<EpiProj, DenseSched>(F.lds, D, D, S, E);
        __syncthreads();
        for (int e = F.bid; e < NE; e += F.G)
            convert_expert<false>(F, INP(12) + (size_t)e * D * FF, INP(13) + (size_t)e * D * FF, (bf16*)(ws + WS_WGU_T) + (size_t)e * 512 * D);
        __syncthreads();
        S.i0 = ksplit; S.i1 = 0x3fffffff;
        gemm_phase<EpiProj, DenseSched>(F.lds, D, D, S, E);
    } SEAM(2);
    if (IN(3)) {
        pool_phase(F, INP(6), INP(7));
#if MK_NAIVE_ATTN
        naive_attn_phase(F);
#else
        attn_phase(F);
#endif
    } SEAM(3);
    if (IN(4)) {
#if !MK_NAIVE_ATTN
        combine_phase(F);
#endif
    } SEAM(4);
    if (IN(5)) {
        DenseSched S; S.init(mixin, ws + WS_WOUT_T, NMIX, NMIX, NT, D, 1, 0, F.G, F.bid);
        EpiOut E{(bf16*)F.out};
        gemm_phase<EpiOut, DenseSched>(F.lds, NMIX, NMIX, S, E);
    } SEAM(5);
    if (IN(6)) { modnorm_phase<true>(F, INP(0), INP(9), 3, hbuf); } SEAM(6);
    if (IN(7)) {
        DenseSched S; S.init(hbuf, ws + WS_WR_T, D, D, NT, NE, 2, 512, F.G, F.bid);
        EpiRouter E{(float*)(ws + WS_LOGIT)};
        gemm_phase<EpiRouter, DenseSched>(F.lds, 512, D, S, E);
    } SEAM(7);
    if (IN(8)) { routing_phase(F, INP(11)); } SEAM(8);
    if (IN(9)) {
        int nblk; build_tables(F, nblk);
        MoeSched<2, false> S; S.prefix = (const LAS int*)(F.lds + TAB_OFF); S.cnt = S.prefix + 260; S.bucket = (const unsigned*)(ws + WS_BUCKET);
        S.Ar = (const char*)hbuf; S.As = (const char*)hbuf; S.Br = (const char*)(ws + WS_WGU_T); S.Bs = (const char*)(ws + WS_WSGU_T);
        S.nRouted = nblk * 2; S.total = S.nRouted + (NT / 256) * 2; S.G = F.G; S.c = vcu;
        EpiGU E{(bf16*)(ws + WS_ACT), (bf16*)(ws + WS_ACTS), (const unsigned*)(ws + WS_BUCKET), (unsigned*)(ws + WS_POS)};
        const int ksplit = vcu % 11;
        S.i0 = 0; S.i1 = ksplit;
        gemm_phase<EpiGU, MoeSched<2, false>>(F.lds, D, D, S, E);
        __syncthreads();
        for (int e = F.bid; e < NE; e += F.G)
            convert_expert<true>(F, INP(14) + (size_t)e * FF * D, nullptr, (bf16*)(ws + WS_WD_T) + (size_t)e * D * FF);
        __syncthreads();
        S.i0 = ksplit; S.i1 = 0x3fffffff;
        gemm_phase<EpiGU, MoeSched<2, false>>(F.lds, D, D, S, E);
    } SEAM(9);
    if (IN(10)) {
        int nblk; build_tables(F, nblk);
        MoeSched<4, true> S; S.prefix = (const LAS int*)(F.lds + TAB_OFF); S.cnt = S.prefix + 260; S.bucket = (const unsigned*)(ws + WS_BUCKET);
        S.Ar = (const char*)(ws + WS_ACT); S.As = (const char*)(ws + WS_ACTS); S.Br = (const char*)(ws + WS_WD_T); S.Bs = (const char*)(ws + WS_WSD_T);
        S.nRouted = nblk * 4; S.total = S.nRouted + (NT / 256) * 4; S.G = F.G; S.c = vcu; S.i0 = 0; S.i1 = 0x3fffffff;
        EpiDown E{(unsigned char*)(ws + WS_Y), (bf16*)F.out};
        gemm_phase<EpiDown, MoeSched<4, true>>(F.lds, FF, FF, S, E);
    } SEAM(10);
    if (IN(11)) { final_phase(F, INP(0), INP(18)); }
#undef IN
#undef SEAM
#undef INP
}

extern "C" void kernel_launch(void* const* d_in, const int* in_sizes, int n_in, void* d_out, int out_size, void* d_ws, size_t ws_size, hipStream_t stream) {
    static int grid = 0;
    if (grid == 0) {
        if (n_in != 19 || out_size != NT * D || ws_size < WS_END) { fprintf(stderr, "kernel_launch: unexpected shapes (n_in %d out %d ws %zu)\n", n_in, out_size, ws_size); grid = -1; return; }
        int dev = 0, cus = 0;
        if (hipGetDevice(&dev) != hipSuccess || hipDeviceGetAttribute(&cus, hipDeviceAttributeMultiprocessorCount, dev) != hipSuccess) { grid = -1; return; }
        if (hipFuncSetAttribute((const void*)fwd, hipFuncAttributeMaxDynamicSharedMemorySize, LDS_BYTES) != hipSuccess) { fprintf(stderr, "kernel_launch: hipFuncSetAttribute failed\n"); grid = -1; return; }
        int per_cu = 0;
        if (hipOccupancyMaxActiveBlocksPerMultiprocessor(&per_cu, (const void*)fwd, NTHREADS, LDS_BYTES) != hipSuccess || per_cu < 1) { fprintf(stderr, "kernel_launch: occupancy query says %d\n", per_cu); }
        (void)hipGetLastError();
        grid = cus;
    }
    if (grid < 0) return;
    (void)hipMemsetAsync((char*)d_ws + WS_CTL, 0, CTL_ZERO_BYTES, stream);
    Args a{};
    for (int i = 0; i < 19; ++i) a.in[i] = (const float*)d_in[i];
    a.out = (float*)d_out; a.ws = (unsigned char*)d_ws;
#if MK_ONE_LAUNCH
    a.ph_lo = 0; a.ph_hi = N_PHASES;
    hipLaunchKernelGGL(fwd, dim3(grid), dim3(NTHREADS), LDS_BYTES, stream, a);
#else
    for (int p = 0; p < N_PHASES; ++p) { a.ph_lo = p; a.ph_hi = p + 1; const int reps = ((MK_REP_MASK >> p) & 1) ? 2 : 1;
        for (int r = 0; r < reps; ++r) hipLaunchKernelGGL(fwd, dim3(grid), dim3(NTHREADS), LDS_BYTES, stream, a); }
#endif
}
```

```cpp
#include <hip/hip_runtime.h>
#include <cstdio>
#include <cstdint>

#ifndef MK_ONE_LAUNCH
#define MK_ONE_LAUNCH 1
#endif
#ifndef MK_FAST_GEMM
#define MK_FAST_GEMM 1
#endif
#ifndef MK_REP_MASK
#define MK_REP_MASK 0x000
#endif
#ifndef MK_NAIVE_ATTN
#define MK_NAIVE_ATTN 0
#endif

#define LAS __attribute__((address_space(3)))
#define GAS __attribute__((address_space(1)))
typedef unsigned short bf16;
typedef short bf16x8 __attribute__((ext_vector_type(8)));
typedef short s16x4 __attribute__((ext_vector_type(4)));
typedef float f32x4 __attribute__((ext_vector_type(4)));
typedef float f32x2 __attribute__((ext_vector_type(2)));
typedef unsigned v4u __attribute__((ext_vector_type(4)));
typedef unsigned v2u __attribute__((ext_vector_type(2)));

constexpr int D = 1024, NB = 8, SEQ = 4096, NT = NB * SEQ;
constexpr int NPROJ = 2560, NE = 256, TOPK = 8, FF = 256, NMIX = 512;
constexpr int CAP = NT;
constexpr int MAXBLK = NT * TOPK / 256 + NE;
constexpr float NORM_EPS = 1e-6f;
constexpr int NWAVES = 8, NTHREADS = 512;

constexpr size_t MiB = 1u << 20;
constexpr size_t WS_CTL = 0, CTL_ZERO_BYTES = 1 * MiB;
constexpr size_t WS_MOD = 1 * MiB;
constexpr size_t WS_GATEW = 2 * MiB;
constexpr size_t WS_WIN_T = 4 * MiB;
constexpr size_t WS_WOUT_T = 9 * MiB;
constexpr size_t WS_WR_T = 10 * MiB;
constexpr size_t WS_WSGU_T = 11 * MiB;
constexpr size_t WS_WSD_T = 12 * MiB;
constexpr size_t WS_LSE = 13 * MiB;
constexpr size_t WS_WD_T = 16 * MiB;
constexpr size_t WS_ACT = 144 * MiB;
constexpr size_t WS_ACTS = 304 * MiB;
constexpr size_t WS_BUCKET = 320 * MiB;
constexpr size_t WS_WGU_T = 352 * MiB;
constexpr size_t WS_PROJ = 608 * MiB;
constexpr size_t WS_H = 768 * MiB;
constexpr size_t WS_ATTO = 832 * MiB;
constexpr size_t WS_MIXIN = 880 * MiB;
constexpr size_t WS_LOGIT = 912 * MiB;
constexpr size_t WS_Y = 352 * MiB;
constexpr size_t WS_POS = 3 * MiB;
constexpr size_t WS_END = 992 * MiB;
constexpr int CW_BAR = 4096;
constexpr int CW_GCNT = 16384;

constexpr int RING_BYTES = 131072;
constexpr int TAB_OFF = RING_BYTES;
constexpr int MISC_OFF = TAB_OFF + 4096;
constexpr int PT_OFF = MISC_OFF + 256;
constexpr int LDS_BYTES = 147456;

__device__ __forceinline__ unsigned f2bf(float f) { unsigned u = __builtin_bit_cast(unsigned, f); return (u + 0x7fffu + ((u >> 16) & 1u)) >> 16; }
__device__ __forceinline__ unsigned pk2(float lo, float hi) { unsigned r; asm("v_cvt_pk_bf16_f32 %0, %1, %2" : "=v"(r) : "v"(lo), "v"(hi)); return r; }
__device__ __forceinline__ float bf2f(unsigned short b) { return __builtin_bit_cast(float, ((unsigned)b) << 16); }
__device__ __forceinline__ float bflo(unsigned u) { return __builtin_bit_cast(float, u << 16); }
__device__ __forceinline__ float bfhi(unsigned u) { return __builtin_bit_cast(float, u & 0xffff0000u); }
__device__ __forceinline__ float wave_sum(float v) {
#pragma unroll
    for (int o = 1; o < 64; o <<= 1) v += __shfl_xor(v, o);
    return v;
}
__device__ __forceinline__ float silu_f(float g) { return g * __builtin_amdgcn_rcpf(1.f + __builtin_amdgcn_exp2f(-1.44269504f * g)); }

__device__ __forceinline__ const float* ld_ptr(LAS unsigned char* lds, int i) {
    const unsigned long long v = ((const LAS unsigned long long*)(lds + PT_OFF))[i];
    const unsigned lo = __builtin_amdgcn_readfirstlane((unsigned)v), hi = __builtin_amdgcn_readfirstlane((unsigned)(v >> 32));
    return (const float*)(((unsigned long long)hi << 32) | lo);
}
#define XB_TMO      128
#define XB_XCNT(j)  (256  + 64 * (j))
#define XB_XSUB(j)  (1280 + 64 * (j))
#define XB_XGEN(j)  (2304 + 64 * (j))
#define XB_TOP      3328
#define XB_TOPGEN   3392
#define XCD_BAR_WORDS 3456
#define XB_SPIN_CAP (1u << 18)
__device__ __forceinline__ unsigned xb_ld(unsigned* p)              { return __hip_atomic_load(p, __ATOMIC_RELAXED, __HIP_MEMORY_SCOPE_AGENT); }
__device__ __forceinline__ unsigned xb_add(unsigned* p, unsigned v) { return __hip_atomic_fetch_add(p, v, __ATOMIC_RELAXED, __HIP_MEMORY_SCOPE_AGENT); }
__device__ __forceinline__ unsigned xb_xcc_id() { return (unsigned)__builtin_amdgcn_s_getreg((3 << 11) | 20) & 0xFu; }
#define XB_SPIN(cond, bar) do { unsigned _sp = 0; while (cond) { __builtin_amdgcn_s_sleep(1); \
    if ((++_sp & 255u) == 0u) { if (xb_ld(&(bar)[XB_TMO])) break; if (_sp > XB_SPIN_CAP) { atomicAdd(&(bar)[XB_TMO], 1u); break; } } } } while (0)
struct XcdBarrier { unsigned* bar; unsigned x; volatile LAS unsigned* st; };
__device__ __forceinline__ XcdBarrier xcd_barrier_post(unsigned* bar, volatile LAS unsigned* st) {
    XcdBarrier b; b.bar = bar; b.x = xb_xcc_id(); b.st = st;
    if (threadIdx.x == 0) (void)xb_add(&bar[XB_XCNT(b.x)], 1u);
    return b;
}
__device__ __forceinline__ void xcd_barrier_complete(unsigned* bar, unsigned x, unsigned& nloc, unsigned& nx) {
    const unsigned G = gridDim.x * gridDim.y * gridDim.z;
    unsigned sum, cnt, mine, sp = 0u;
    for (;;) {
        sum = 0u; cnt = 0u; mine = 0u;
#pragma unroll
        for (unsigned j = 0; j < 16; ++j) { const unsigned c = xb_ld(&bar[XB_XCNT(j)]); sum += c; cnt += (c > 0u) ? 1u : 0u; mine = (j == x) ? c : mine; }
        if (sum == G) break;
        __builtin_amdgcn_s_sleep(1);
        if ((++sp & 255u) == 0u) { if (xb_ld(&bar[XB_TMO])) break; if (sp > XB_SPIN_CAP) { atomicAdd(&bar[XB_TMO], 1u); break; } }
    }
    nloc = mine > 0u ? mine : 1u; nx = cnt > 0u ? cnt : 1u;
}
__device__ __forceinline__ void xcd_barrier(const XcdBarrier& b) {
    asm volatile("s_waitcnt vmcnt(0)" ::: "memory");
    __syncthreads();
    if (threadIdx.x == 0) {
        unsigned* bar = b.bar;
        __builtin_amdgcn_s_waitcnt(0);
        unsigned nloc = b.st[0], nx = b.st[1];
        if (nloc == 0u) { xcd_barrier_complete(bar, b.x, nloc, nx); b.st[0] = nloc; b.st[1] = nx; }
        const unsigned old = xb_add(&bar[XB_XSUB(b.x)], 1u);
        const unsigned gen = old / nloc;
        if (old + 1u == (gen + 1u) * nloc) {
            __builtin_amdgcn_fence(__ATOMIC_RELEASE, "agent");
            asm volatile("s_waitcnt vmcnt(0)" ::: "memory");
            const unsigned og = xb_add(&bar[XB_TOP], 1u);
            const unsigned tg = og / nx;
            if (og + 1u == (tg + 1u) * nx) xb_add(&bar[XB_TOPGEN], 1u);
            else XB_SPIN(xb_ld(&bar[XB_TOPGEN]) == tg, bar);
            __builtin_amdgcn_fence(__ATOMIC_ACQUIRE, "agent");
            xb_add(&bar[XB_XGEN(b.x)], 1u);
            asm volatile("s_waitcnt vmcnt(0)" ::: "memory");
        } else {
            XB_SPIN(xb_ld(&bar[XB_XGEN(b.x)]) == gen, bar);
            __builtin_amdgcn_fence(__ATOMIC_ACQUIRE, "agent");
            asm volatile("s_waitcnt vmcnt(0)" ::: "memory");
        }
    }
    __syncthreads();
}

constexpr int BK = 64, HALF = 128, HTB = HALF * BK * 2;
__device__ __forceinline__ int lds_byte(int r, int c) { const int st = (r >> 4) * 2 + (c >> 5), rr = r & 15, cc = c & 31, ob = rr * 64 + cc * 2; return st * 1024 + (ob ^ (((ob >> 9) & 1) << 5)); }
__device__ __forceinline__ void stage_rc(int b, int& R, int& C) { const int st = b / 1024, sb = b % 1024, swz = sb ^ (((sb >> 9) & 1) << 5); R = (st >> 1) * 16 + swz / 64; C = (st & 1) * 32 + (swz % 64) / 2; }
__device__ __forceinline__ int perm32(int rho) { const int n = rho >> 4, i = rho & 15; return 8 * (i >> 2) + 4 * n + (i & 3); }

template <class Epi, class Sched>
__device__ __forceinline__ void gemm_simple(const int K, const int ldb, const Sched& S, const Epi& E) {
    const int tid = threadIdx.x, wid = __builtin_amdgcn_readfirstlane(tid >> 6), lane = tid & 63, wr = wid >> 2, wc = wid & 3, fr = lane & 15, fq = lane >> 4;
    typename Sched::Unit u;
    for (int ui = 0; S.next(ui, u); ++ui) {
        f32x4 acc[2][2][4][2];
#pragma unroll
        for (int a = 0; a < 2; ++a)
#pragma unroll
            for (int b = 0; b < 2; ++b)
#pragma unroll
                for (int m = 0; m < 4; ++m)
#pragma unroll
                    for (int n = 0; n < 2; ++n) acc[a][b][m][n] = (f32x4){0.f, 0.f, 0.f, 0.f};
        const char* A = S.a_base(u); const char* B = S.b_base(u);
        unsigned aoff[2][4], boff[2][2];
#pragma unroll
        for (int ai = 0; ai < 2; ++ai)
#pragma unroll
            for (int m = 0; m < 4; ++m) aoff[ai][m] = S.a_off(u, 128 * ai + 64 * wr + 16 * m + fr) + fq * 16;
#pragma unroll
        for (int bj = 0; bj < 2; ++bj)
#pragma unroll
            for (int n = 0; n < 2; ++n) { const int row = 128 * bj + 32 * wc + (Epi::PERM ? perm32(16 * n + fr) : 16 * n + fr); boff[bj][n] = (unsigned)(row * ldb) * 2u + fq * 16; }
        for (int k = 0; k < K; k += 32) {
            bf16x8 a[2][4], b[2][2];
#pragma unroll
            for (int ai = 0; ai < 2; ++ai)
#pragma unroll
                for (int m = 0; m < 4; ++m) a[ai][m] = *(const bf16x8*)(A + aoff[ai][m] + k * 2);
#pragma unroll
            for (int bj = 0; bj < 2; ++bj)
#pragma unroll
                for (int n = 0; n < 2; ++n) b[bj][n] = *(const bf16x8*)(B + boff[bj][n] + k * 2);
#pragma unroll
            for (int ai = 0; ai < 2; ++ai)
#pragma unroll
                for (int bj = 0; bj < 2; ++bj)
#pragma unroll
                    for (int m = 0; m < 4; ++m)
#pragma unroll
                        for (int n = 0; n < 2; ++n) acc[ai][bj][m][n] = __builtin_amdgcn_mfma_f32_16x16x32_bf16(b[bj][n], a[ai][m], acc[ai][bj][m][n], 0, 0, 0);
        }
        E(acc, u, wr, wc, fr, fq);
    }
}

template <class Epi, class Sched>
__device__ __forceinline__ void gemm_fast(LAS unsigned char* lds, const int K, const int ldb, const Sched& S, const Epi& E) {
    int tid0 = threadIdx.x; asm volatile("" : "+v"(tid0));
    const int tid = tid0, wid = __builtin_amdgcn_readfirstlane(tid >> 6), lane = tid & 63, wr = wid >> 2, wc = wid & 3, fr = lane & 15, fq = lane >> 4;
    int nt = K / BK; asm volatile("" : "+s"(nt));
    unsigned voffB[2];
#pragma unroll
    for (int i = 0; i < 2; ++i) { int R, C; stage_rc(tid * 16 + i * 8192, R, C); const int Rb = Epi::PERM ? ((R & ~31) + perm32(R & 31)) : R;
        voffB[i] = (unsigned)(Rb * ldb + C) * 2u; }
#define PG8_AOFF(u) do { int _tz = threadIdx.x; asm volatile("" : "+v"(_tz)); _Pragma("unroll") for (int _i = 0; _i < 2; ++_i) { int _R, _C; stage_rc(_tz * 16 + _i * 8192, _R, _C); \
        vA0[_i] = S.a_off(u, _R) + (unsigned)_C * 2u; vA1[_i] = S.a_off(u, HALF + _R) + (unsigned)_C * 2u; } } while (0)
    const size_t kstep = (size_t)(BK * 2);
    const size_t hstepB = (size_t)HALF * ldb * 2;
    const unsigned ldsw = (unsigned)wid * 1024u;
    const int aoff = lds_byte(wr * 64 + fr, fq * 8), boff = lds_byte(wc * 32 + fr, fq * 8);
#define PG8_SA(b, h) (((b) * 2 + (h)) * HTB)
#define PG8_SB(b, h) ((4 + (b) * 2 + (h)) * HTB)
#define PG8_STAGE(bufoff, gbase, voff) do { _Pragma("unroll") for (int _i = 0; _i < 2; ++_i) \
        __builtin_amdgcn_global_load_lds((const unsigned*)((const char*)(gbase) + (voff)[_i]), (LAS unsigned*)(lds + (bufoff) + ldsw + _i * 8192), 16, 0, 0); } while (0)
#define PG8_LDA(dst, b, h) do { _Pragma("unroll") for (int m = 0; m < 4; ++m) _Pragma("unroll") for (int k = 0; k < 2; ++k) dst[m][k] = *(const LAS bf16x8*)(lds + PG8_SA(b, h) + aoff + m * 2048 + k * 1024); } while (0)
#define PG8_LDB(dst, b, h) do { _Pragma("unroll") for (int n = 0; n < 2; ++n) _Pragma("unroll") for (int k = 0; k < 2; ++k) dst[n][k] = *(const LAS bf16x8*)(lds + PG8_SB(b, h) + boff + n * 2048 + k * 1024); } while (0)
#define PG8_MMA(ai, bj, At, Bt) do { __builtin_amdgcn_s_setprio(1); _Pragma("unroll") for (int m = 0; m < 4; ++m) _Pragma("unroll") for (int n = 0; n < 2; ++n) _Pragma("unroll") for (int k = 0; k < 2; ++k) \
        acc[ai][bj][m][n] = __builtin_amdgcn_mfma_f32_16x16x32_bf16(Bt[n][k], At[m][k], acc[ai][bj][m][n], 0, 0, 0); __builtin_amdgcn_s_setprio(0); } while (0)
#define PG8_WAIT_V(n) asm volatile("s_waitcnt vmcnt(" #n ")" ::: "memory")
#define PG8_WAIT_L(n) asm volatile("s_waitcnt lgkmcnt(" #n ")" ::: "memory")
#define PG8_BAR __builtin_amdgcn_s_barrier()
#define PG8_SCHED __builtin_amdgcn_sched_barrier(0)
    typename Sched::Unit cur, nxt; int ui = 0;
    if (!S.next(0, cur)) return;
    f32x4 acc[2][2][4][2];
#pragma unroll
    for (int a = 0; a < 2; ++a)
#pragma unroll
        for (int b = 0; b < 2; ++b)
#pragma unroll
            for (int m = 0; m < 4; ++m)
#pragma unroll
                for (int n = 0; n < 2; ++n) acc[a][b][m][n] = (f32x4){0.f, 0.f, 0.f, 0.f};
    bf16x8 At[4][2], B0[2][2], B1[2][2];
    const char* cA = S.a_base(cur); const char* cB = S.b_base(cur);
    unsigned vA0[2], vA1[2];
    PG8_AOFF(cur);
    PG8_STAGE(PG8_SB(0, 0), cB, voffB); PG8_STAGE(PG8_SA(0, 0), cA, vA0); PG8_STAGE(PG8_SB(0, 1), cB + hstepB, voffB); PG8_STAGE(PG8_SA(0, 1), cA, vA1);
    if (wr == 1) PG8_BAR;
    PG8_WAIT_V(4); PG8_BAR;
    PG8_STAGE(PG8_SB(1, 0), cB + kstep, voffB); PG8_STAGE(PG8_SA(1, 0), cA + kstep, vA0); PG8_STAGE(PG8_SB(1, 1), cB + hstepB + kstep, voffB);
    PG8_WAIT_V(6); PG8_BAR;
    for (;;) {
        const bool has_next = S.next(ui + 1, nxt);
        const char* nA = has_next ? S.a_base(nxt) : cA; const char* nB = has_next ? S.b_base(nxt) : cB;
        for (int t = 0; t < nt; t += 2) {
            const bool last = (t == nt - 2);
            const char* a1 = cA + (size_t)(t + 1) * kstep;
            const char* a2 = last ? nA : cA + (size_t)(t + 2) * kstep; const char* b2 = last ? nB : cB + (size_t)(t + 2) * kstep;
            const char* a3 = a2 + kstep; const char* b3 = b2 + kstep;
            PG8_LDB(B0, 0, 0); PG8_SCHED; PG8_LDA(At, 0, 0); PG8_STAGE(PG8_SA(1, 1), a1, vA1);
            if (last && has_next) PG8_AOFF(nxt);
            PG8_WAIT_L(8); PG8_BAR; PG8_WAIT_L(0); PG8_MMA(0, 0, At, B0); PG8_BAR; PG8_SCHED;
            PG8_LDB(B1, 0, 1); PG8_STAGE(PG8_SB(0, 0), b2, voffB);
            PG8_BAR; PG8_WAIT_L(0); PG8_MMA(0, 1, At, B1); PG8_BAR;
            PG8_LDA(At, 0, 1); PG8_STAGE(PG8_SA(0, 0), a2, vA0);
            PG8_BAR; PG8_WAIT_L(0); PG8_MMA(1, 0, At, B0); PG8_BAR; PG8_SCHED;
            PG8_STAGE(PG8_SB(0, 1), b2 + hstepB, voffB);
            PG8_WAIT_V(6); PG8_BAR; PG8_MMA(1, 1, At, B1); PG8_BAR;
            PG8_LDB(B0, 1, 0); PG8_SCHED; PG8_LDA(At, 1, 0); PG8_STAGE(PG8_SA(0, 1), a2, vA1);
            PG8_WAIT_L(8); PG8_BAR; PG8_WAIT_L(0); PG8_MMA(0, 0, At, B0); PG8_BAR; PG8_SCHED;
            PG8_LDB(B1, 1, 1); PG8_STAGE(PG8_SB(1, 0), b3, voffB);
            PG8_BAR; PG8_WAIT_L(0); PG8_MMA(0, 1, At, B1); PG8_BAR;
            PG8_LDA(At, 1, 1); PG8_STAGE(PG8_SA(1, 0), a3, vA0);
            PG8_BAR; PG8_WAIT_L(0); PG8_MMA(1, 0, At, B0); PG8_BAR; PG8_SCHED;
            PG8_STAGE(PG8_SB(1, 1), b3 + hstepB, voffB);
            PG8_WAIT_V(6); PG8_BAR; PG8_MMA(1, 1, At, B1); PG8_BAR;
        }
        { int tz = threadIdx.x; asm volatile("" : "+v"(tz)); const int wz = tz >> 6, lz = tz & 63;
          E(acc, cur, wz >> 2, wz & 3, lz & 15, lz >> 4);
#if defined(MK_EPI_TWICE)
          if (Epi::TWICE) { asm volatile("" ::: "memory"); E(acc, cur, wz >> 2, wz & 3, lz & 15, lz >> 4); }
#endif
          }
        if (!has_next) break;
#pragma unroll
        for (int a = 0; a < 2; ++a)
#pragma unroll
            for (int b = 0; b < 2; ++b)
#pragma unroll
                for (int m = 0; m < 4; ++m)
#pragma unroll
                    for (int n = 0; n < 2; ++n) acc[a][b][m][n] = (f32x4){0.f, 0.f, 0.f, 0.f};
        cur = nxt; cA = nA; cB = nB; ++ui;
    }
    PG8_WAIT_V(0);
    if (wr == 0) PG8_BAR;
    PG8_BAR;
#undef PG8_AOFF
#undef PG8_SA
#undef PG8_SB
#undef PG8_STAGE
#undef PG8_LDA
#undef PG8_LDB
#undef PG8_MMA
#undef PG8_WAIT_V
#undef PG8_WAIT_L
#undef PG8_BAR
#undef PG8_SCHED
}

template <class Epi, class Sched>
__device__ __forceinline__ void gemm_phase(LAS unsigned char* lds, const int K, const int ldb, const Sched& S, const Epi& E) {
#if MK_FAST_GEMM
    gemm_fast<Epi, Sched>(lds, K, ldb, S, E);
#else
    gemm_simple<Epi, Sched>(K, ldb, S, E);
#endif
}

struct DenseUnit { int pm, pn, ks; };
template <int NM, int NN, int KSPLIT>
struct DenseSchedT {
    typedef DenseUnit Unit;
    const char* A; const char* B; int lda2, ldb2, ksub2, G, c, i0, i1;
    __device__ __forceinline__ void init(const void* A_, const void* B_, int lda, int ldb, int Ksub, int G_, int c_) {
        A = (const char*)A_; B = (const char*)B_; lda2 = lda * 2; ldb2 = ldb * 2; ksub2 = Ksub * 2; G = G_; c = c_; i0 = 0; i1 = 0x3fffffff; }
    __device__ __forceinline__ bool next(int i, Unit& u) const {
        constexpr int nwg = NM * NN, total = nwg * KSPLIT;
        if (i + i0 >= i1) return false;
        const int L = (i + i0) * G + c; if (L >= total) return false;
        int id = L / KSPLIT; u.ks = L - id * KSPLIT;
        { constexpr int q = nwg / 8, r = nwg % 8; const int xcd = id % 8, off = id / 8; id = (xcd < r ? xcd * (q + 1) : r * (q + 1) + (xcd - r) * q) + off; }
        constexpr int nig = 8 * NN; const int gid = id / nig, fm = gid * 8, gsz = (NM - fm) < 8 ? (NM - fm) : 8;
        u.pm = fm + ((id % nig) % gsz); u.pn = (id % nig) / gsz; return true;
    }
    __device__ __forceinline__ const char* a_base(const Unit& u) const { return A + (size_t)u.pm * 256 * lda2 + (size_t)u.ks * ksub2; }
    __device__ __forceinline__ const char* b_base(const Unit& u) const { return B + (size_t)u.pn * 256 * ldb2 + (size_t)u.ks * ksub2; }
    __device__ __forceinline__ unsigned a_off(const Unit&, int r) const { return (unsigned)(r * lda2); }
};

template <int PN, bool DOWN>
struct MoeSched {
    struct Unit { int kind, e, rb, blk, valid, pm, pn; };
    const LAS int* prefix; const LAS int* cnt; const unsigned* bucket;
    const char* Ar; const char* As; const char* Br; const char* Bs;
    int nRouted, total, G, c, i0, i1;
    __device__ __forceinline__ bool next(int i, Unit& u) const {
        if (i + i0 >= i1) return false;
        const int id = (i + i0) * G + c; if (id >= total) return false;
        u.e = 0; u.rb = 0; u.blk = 0; u.pm = 0;
        if (id < nRouted) {
            const int blk = id / PN; u.pn = id % PN;
            const int lo = ((const LAS unsigned char*)(cnt + 256))[blk];
            u.kind = 0; u.e = lo; u.rb = blk - prefix[lo]; u.blk = blk; const int rem = cnt[lo] - u.rb * 256; u.valid = rem < 256 ? rem : 256;
        } else { const int s = id - nRouted; u.kind = 1; u.pm = s / PN; u.pn = s % PN; u.valid = 256; }
        return true;
    }
    __device__ __forceinline__ const char* a_base(const Unit& u) const { return u.kind == 0 ? Ar : As; }
    __device__ __forceinline__ const char* b_base(const Unit& u) const {
        if (!DOWN) return u.kind == 0 ? Br + ((size_t)u.e * 512 + (size_t)u.pn * 256) * (D * 2) : Bs + (size_t)u.pn * 256 * (D * 2);
        else       return u.kind == 0 ? Br + ((size_t)u.e * 1024 + (size_t)u.pn * 256) * (FF * 2) : Bs + (size_t)u.pn * 256 * (FF * 2);
    }
    __device__ __forceinline__ unsigned a_off(const Unit& u, int r) const {
        if (!DOWN) {
            if (u.kind == 0) { const int rr = r < u.valid ? r : u.valid - 1; const unsigned slot = bucket[(size_t)u.e * CAP + u.rb * 256 + rr]; return (slot >> 3) * (unsigned)(D * 2); }
            return (unsigned)(u.pm * 256 + r) * (unsigned)(D * 2);
        } else {
            return (unsigned)((u.kind == 0 ? u.blk : u.pm) * 256 + r) * (unsigned)(FF * 2);
        }
    }
};

struct EpiProj {
    static constexpr bool PERM = true, TWICE = false;
    bf16* O;
    __device__ __forceinline__ void operator()(const f32x4 (&acc)[2][2][4][2], const DenseUnit& u, int wr, int wc, int fr, int fq) const {
        const int row0 = u.pm * 256 + wr * 64 + fr, col0 = u.pn * 256 + wc * 32 + 8 * fq;
#pragma unroll
        for (int ai = 0; ai < 2; ++ai)
#pragma unroll
            for (int m = 0; m < 4; ++m) { bf16* rowp = O + (size_t)(row0 + ai * 128 + m * 16) * NPROJ + col0;
#pragma unroll
                for (int bj = 0; bj < 2; ++bj) { const f32x4 v0 = acc[ai][bj][m][0], v1 = acc[ai][bj][m][1];
                    *(v4u*)(rowp + bj * 128) = (v4u){pk2(v0[0], v0[1]), pk2(v0[2], v0[3]), pk2(v1[0], v1[1]), pk2(v1[2], v1[3])}; } }
    }
};
struct EpiOut {
    static constexpr bool PERM = true, TWICE = false;
    bf16* O;
    __device__ __forceinline__ void operator()(const f32x4 (&acc)[2][2][4][2], const DenseUnit& u, int wr, int wc, int fr, int fq) const {
        const int row0 = u.pm * 256 + wr * 64 + fr, col0 = u.pn * 256 + wc * 32 + 8 * fq;
#pragma unroll
        for (int ai = 0; ai < 2; ++ai)
#pragma unroll
            for (int m = 0; m < 4; ++m) { bf16* rowp = O + (size_t)(row0 + ai * 128 + m * 16) * (2 * D) + col0;
#pragma unroll
                for (int bj = 0; bj < 2; ++bj) { const f32x4 v0 = acc[ai][bj][m][0], v1 = acc[ai][bj][m][1];
                    *(v4u*)(rowp + bj * 128) = (v4u){pk2(v0[0], v0[1]), pk2(v0[2], v0[3]), pk2(v1[0], v1[1]), pk2(v1[2], v1[3])}; } }
    }
};
struct EpiRouter {
    static constexpr bool PERM = false, TWICE = false;
    float* L;
    __device__ __forceinline__ void operator()(const f32x4 (&acc)[2][2][4][2], const DenseUnit& u, int wr, int wc, int fr, int fq) const {
        const int row0 = u.pm * 256 + wr * 64 + fr, col0 = wc * 32 + 4 * fq;
        float* Lp = L + (size_t)u.ks * NT * NE;
#pragma unroll
        for (int ai = 0; ai < 2; ++ai)
#pragma unroll
            for (int m = 0; m < 4; ++m) { const size_t ro = (size_t)(row0 + ai * 128 + m * 16) * NE + col0;
#pragma unroll
                for (int bj = 0; bj < 2; ++bj)
#pragma unroll
                    for (int n = 0; n < 2; ++n) *(f32x4*)(Lp + ro + bj * 128 + n * 16) = acc[ai][bj][m][n]; }
    }
};
struct EpiGU {
    static constexpr bool PERM = true, TWICE = false;
    bf16* act; bf16* acts; const unsigned* bucket; unsigned* pos;
    __device__ __forceinline__ void operator()(const f32x4 (&acc)[2][2][4][2], const MoeSched<2, false>::Unit& u, int wr, int wc, int fr, int fq) const {
        bf16* O = u.kind == 0 ? act : acts;
        const int row0 = (u.kind == 0 ? u.blk : u.pm) * 256 + wr * 64 + fr, col0 = u.pn * 128 + wc * 32 + 8 * fq;
        if (u.kind == 0 && u.pn == 0 && wc == 0 && fq == 0) {
#pragma unroll
            for (int ai = 0; ai < 2; ++ai)
#pragma unroll
                for (int m = 0; m < 4; ++m) { const int r = ai * 128 + wr * 64 + m * 16 + fr;
                    if (r < u.valid) pos[bucket[(size_t)u.e * CAP + u.rb * 256 + r]] = (unsigned)(u.blk * 256 + r); } }
#pragma unroll
        for (int ai = 0; ai < 2; ++ai)
#pragma unroll
            for (int m = 0; m < 4; ++m) {
                const f32x4 g0 = acc[ai][0][m][0], g1 = acc[ai][0][m][1], u0 = acc[ai][1][m][0], u1 = acc[ai][1][m][1];
                float a[8];
#pragma unroll
                for (int j = 0; j < 4; j += 2) {
                    const f32x2 ga = (f32x2){g0[j], g0[j + 1]}, gb = (f32x2){g1[j], g1[j + 1]}, ua = (f32x2){u0[j], u0[j + 1]}, ub = (f32x2){u1[j], u1[j + 1]};
                    const f32x2 ea = ga * (-1.44269504f), eb = gb * (-1.44269504f);
                    f32x2 da, db; da.x = __builtin_amdgcn_exp2f(ea.x); da.y = __builtin_amdgcn_exp2f(ea.y); db.x = __builtin_amdgcn_exp2f(eb.x); db.y = __builtin_amdgcn_exp2f(eb.y);
                    da = da + 1.0f; db = db + 1.0f;
                    f32x2 ra, rb; ra.x = __builtin_amdgcn_rcpf(da.x); ra.y = __builtin_amdgcn_rcpf(da.y); rb.x = __builtin_amdgcn_rcpf(db.x); rb.y = __builtin_amdgcn_rcpf(db.y);
                    const f32x2 oa = (ga * ua) * ra, ob = (gb * ub) * rb;
                    a[j] = oa.x; a[j + 1] = oa.y; a[4 + j] = ob.x; a[4 + j + 1] = ob.y; }
                *(v4u*)(O + (size_t)(row0 + ai * 128 + m * 16) * FF + col0) = (v4u){pk2(a[0], a[1]), pk2(a[2], a[3]), pk2(a[4], a[5]), pk2(a[6], a[7])};
            }
    }
};
constexpr float Y_SCALE = 8.f, Y_INV_SCALE = 0.125f;
struct EpiDown {
    static constexpr bool PERM = true, TWICE = false;
    unsigned char* Y; bf16* O;
    __device__ __forceinline__ void operator()(const f32x4 (&acc)[2][2][4][2], const MoeSched<4, true>::Unit& u, int wr, int wc, int fr, int fq) const {
        const int col0 = u.pn * 256 + wc * 32 + 8 * fq;
        if (u.kind == 0) {
            const int row0 = u.blk * 256 + wr * 64 + fr;
#pragma unroll
            for (int ai = 0; ai < 2; ++ai)
#pragma unroll
                for (int m = 0; m < 4; ++m) { unsigned char* rowp = Y + (size_t)(row0 + ai * 128 + m * 16) * D + col0;
#pragma unroll
                    for (int bj = 0; bj < 2; ++bj) { f32x4 v0 = acc[ai][bj][m][0] * Y_SCALE, v1 = acc[ai][bj][m][1] * Y_SCALE;
#pragma unroll
                        for (int j = 0; j < 4; ++j) { v0[j] = __builtin_amdgcn_fmed3f(v0[j], -448.f, 448.f); v1[j] = __builtin_amdgcn_fmed3f(v1[j], -448.f, 448.f); }
                        int w0 = __builtin_amdgcn_cvt_pk_fp8_f32(v0[0], v0[1], 0, false); w0 = __builtin_amdgcn_cvt_pk_fp8_f32(v0[2], v0[3], w0, true);
                        int w1 = __builtin_amdgcn_cvt_pk_fp8_f32(v1[0], v1[1], 0, false); w1 = __builtin_amdgcn_cvt_pk_fp8_f32(v1[2], v1[3], w1, true);
                        *(v2u*)(rowp + bj * 128) = (v2u){(unsigned)w0, (unsigned)w1}; } }
        } else {
            const int row0 = u.pm * 256 + wr * 64 + fr;
#pragma unroll
            for (int ai = 0; ai < 2; ++ai)
#pragma unroll
                for (int m = 0; m < 4; ++m) { bf16* rowp = O + (size_t)(row0 + ai * 128 + m * 16) * (2 * D) + D + col0;
#pragma unroll
                    for (int bj = 0; bj < 2; ++bj) { const f32x4 v0 = acc[ai][bj][m][0], v1 = acc[ai][bj][m][1];
                        *(v4u*)(rowp + bj * 128) = (v4u){pk2(v0[0], v0[1]), pk2(v0[2], v0[3]), pk2(v1[0], v1[1]), pk2(v1[2], v1[3])}; } }
        }
    }
};

struct Args { const float* in[19]; float* out; unsigned char* ws; int ph_lo, ph_hi; };

struct Frame {
    LAS unsigned char* lds; int tid, lane, wave, G, bid;
    float* out; unsigned char* ws;
};

__device__ __forceinline__ void titem_load(const float* W, int N, int kb, int nb, int lane, float (&v)[32]) {
    const float* Wu = W + (size_t)(64 * kb) * N + 32 * nb;
    const unsigned loff = (unsigned)((lane >> 5) * N + (lane & 31)) * 4u;
#pragma unroll
    for (int i = 0; i < 32; ++i) v[i] = *(const float*)((const char*)(Wu + (size_t)(2 * i) * N) + loff);
}
__device__ __forceinline__ void titem_store(const float (&v)[32], int K, bf16* WT, int kb, int dst_row0, LAS float* scr, int lane) {
    const int k0 = 64 * kb;
#pragma unroll
    for (int i = 0; i < 32; ++i) { const int kk = 2 * i + (lane >> 5); scr[kk * 33 + (lane & 31)] = v[i]; }
    asm volatile("s_waitcnt lgkmcnt(0)" ::: "memory");
    const int c = lane & 7;
#pragma unroll
    for (int j = 0; j < 4; ++j) { const int n = (lane >> 3) + 8 * j; const LAS float* s = scr + (8 * c) * 33 + n;
        v4u o; o.x = pk2(s[0 * 33], s[1 * 33]); o.y = pk2(s[2 * 33], s[3 * 33]); o.z = pk2(s[4 * 33], s[5 * 33]); o.w = pk2(s[6 * 33], s[7 * 33]);
        *(v4u*)(WT + (size_t)(dst_row0 + n) * K + k0 + 8 * c) = o; }
    asm volatile("s_waitcnt lgkmcnt(0)" ::: "memory");
}
__device__ __forceinline__ void transpose_item(const float* W, int K, int N, bf16* WT, int kb, int nb, int dst_row0, LAS float* scr, int lane) {
    float v[32]; titem_load(W, N, kb, nb, lane, v); titem_store(v, K, WT, kb, dst_row0, scr, lane);
}
template <bool DOWN>
__device__ __forceinline__ void convert_expert(Frame& F, const float* Wa, const float* Wb, bf16* dst) {
    LAS float* scr = (LAS float*)(F.lds + F.wave * 16384);
    constexpr int PER_WAVE = DOWN ? 16 : 32;
    const int base = 0, wv = F.wave;
    auto ld = [&](int i, float (&v)[32]) {
        if (!DOWN) titem_load((i >> 4) ? Wb : Wa, FF, i & 15, wv, F.lane, v);
        else titem_load(Wa, D, i >> 2, wv + 8 * (i & 3), F.lane, v); };
    auto st = [&](int i, const float (&v)[32]) {
        if (!DOWN) { const int n0 = wv * 32; titem_store(v, D, dst, i & 15, (n0 >> 7) * 256 + ((i >> 4) ? 128 : 0) + (n0 & 127), scr, F.lane); }
        else titem_store(v, FF, dst, i >> 2, (wv + 8 * (i & 3)) * 32, scr, F.lane); };
    float v0[32], v1[32], v2[32], v3[32];
    ld(base, v0); ld(base + 1, v1); ld(base + 2, v2);
    for (int i = 0; i < PER_WAVE; i += 4) {
        ld(base + i + 3, v3); st(base + i, v0);
        if (i + 4 < PER_WAVE) ld(base + i + 4, v0);
        st(base + i + 1, v1);
        if (i + 5 < PER_WAVE) ld(base + i + 5, v1);
        st(base + i + 2, v2);
        if (i + 6 < PER_WAVE) ld(base + i + 6, v2);
        st(base + i + 3, v3);
    }
}

__device__ __forceinline__ void p0_prologue(Frame& F) {
#define INP(i) ld_ptr(F.lds, (i))
    if (F.bid < 192) {
        const float* cptr = INP(1); const float* w_ada = INP(2); const float* b_ada = INP(3);
        LAS float* cs = (LAS float*)F.lds;
        LAS float* red = (LAS float*)(F.lds + 32768);
        for (int i = F.tid; i < NB * D; i += NTHREADS) { const float v = cptr[i]; cs[i] = v / (1.f + __expf(-v)); }
        __syncthreads();
        const int col = F.tid & 31, kg = F.tid >> 5, j = F.bid * 32 + col;
        float a[NB];
#pragma unroll
        for (int b = 0; b < NB; ++b) a[b] = 0.f;
#pragma unroll 8
        for (int kk = 0; kk < 64; ++kk) { const int k = kg * 64 + kk; const float w = w_ada[(size_t)k * 6144 + j];
#pragma unroll
            for (int b = 0; b < NB; ++b) a[b] += cs[b * D + k] * w; }
#pragma unroll
        for (int b = 0; b < NB; ++b) red[(kg * NB + b) * 32 + col] = a[b];
        __syncthreads();
        if (F.tid < 256) { const int b = F.tid >> 5, cc = F.tid & 31; float s = 0.f;
#pragma unroll
            for (int g = 0; g < 16; ++g) s += red[(g * NB + b) * 32 + cc];
            ((float*)(F.ws + WS_MOD))[b * 6144 + F.bid * 32 + cc] = s + b_ada[F.bid * 32 + cc]; }
        __syncthreads();
    }
    LAS float* scr = (LAS float*)(F.lds + F.wave * 16384);
    const int gw = F.bid * NWAVES + F.wave, NGW = F.G * NWAVES;
    constexpr int I_IN = 16 * 80, I_OUT = 8 * 32, I_R = 16 * 8, I_G = 16 * 8, I_D = 4 * 32;
    constexpr int I_SMALL = I_IN + I_OUT + I_R + 2 * I_G + I_D, I_EXP = 2 * I_G + I_D;
    constexpr int NITEMS = I_SMALL;
    bf16* win_t = (bf16*)(F.ws + WS_WIN_T); bf16* wout_t = (bf16*)(F.ws + WS_WOUT_T); bf16* wr_t = (bf16*)(F.ws + WS_WR_T);
    bf16* wsgu_t = (bf16*)(F.ws + WS_WSGU_T); bf16* wsd_t = (bf16*)(F.ws + WS_WSD_T); bf16* wgu_t = (bf16*)(F.ws + WS_WGU_T); bf16* wd_t = (bf16*)(F.ws + WS_WD_T);
    for (int it = gw; it < NITEMS; it += NGW) {
        int r = it;
        if (r < I_IN) { transpose_item(INP(5), D, NPROJ, win_t, r / 80, r % 80, (r % 80) * 32, scr, F.lane); continue; } r -= I_IN;
        if (r < I_OUT) { transpose_item(INP(8), NMIX, D, wout_t, r / 32, r % 32, (r % 32) * 32, scr, F.lane); continue; } r -= I_OUT;
        if (r < I_R) { transpose_item(INP(10), D, NE, wr_t, r / 8, r % 8, (r % 8) * 32, scr, F.lane); continue; } r -= I_R;
        const float *Wg, *Wu, *Wd; bf16 *GU, *DN;
        if (r < 2 * I_G + I_D) { Wg = INP(15); Wu = INP(16); Wd = INP(17); GU = wsgu_t; DN = wsd_t; }
        else { r -= 2 * I_G + I_D; const int e = r / I_EXP; r -= e * I_EXP;
            Wg = INP(12) + (size_t)e * D * FF; Wu = INP(13) + (size_t)e * D * FF; Wd = INP(14) + (size_t)e * FF * D;
            GU = wgu_t + (size_t)e * 512 * D; DN = wd_t + (size_t)e * D * FF; }
        if (r < I_G) { const int nb = r % 8, n0 = nb * 32; transpose_item(Wg, D, FF, GU, r / 8, nb, (n0 >> 7) * 256 + (n0 & 127), scr, F.lane); continue; } r -= I_G;
        if (r < I_G) { const int nb = r % 8, n0 = nb * 32; transpose_item(Wu, D, FF, GU, r / 8, nb, (n0 >> 7) * 256 + 128 + (n0 & 127), scr, F.lane); continue; } r -= I_G;
        transpose_item(Wd, FF, D, DN, r / 32, r % 32, (r % 32) * 32, scr, F.lane);
    }
#undef INP
}

template <bool HAS_DX>
__device__ __forceinline__ void modnorm_phase(Frame& F, const float* X, const float* g, int shift_chunk, bf16* O) {
    const float* mod = (const float*)(F.ws + WS_MOD);
    constexpr int RW = 4;
    for (int blk = F.bid; blk < NT / 128; blk += F.G) {
        const int b = (blk * 128) >> 12;
        const float* sh = mod + (size_t)b * 6144 + shift_chunk * D; const float* sc = sh + D; const float* g1 = mod + (size_t)b * 6144 + 2 * D;
        f32x4 gg[4], ss[4], ga[4];
#pragma unroll
        for (int j = 0; j < 4; ++j) { const int col = 256 * j + 4 * F.lane; const f32x4 gv = *(const f32x4*)(g + col), scv = *(const f32x4*)(sc + col);
            gg[j] = gv * (scv + 1.f); ss[j] = *(const f32x4*)(sh + col); ga[j] = HAS_DX ? *(const f32x4*)(g1 + col) : (f32x4){0.f, 0.f, 0.f, 0.f}; }
        for (int rr = 0; rr < 16; rr += RW) {
            const int row = blk * 128 + F.wave * 16 + rr;
            f32x4 v[RW][4]; v2u dv[RW][4];
#pragma unroll
            for (int q = 0; q < RW; ++q) { const f32x4* xr = (const f32x4*)(X + (size_t)(row + q) * D) + F.lane;
#pragma unroll
                for (int j = 0; j < 4; ++j) v[q][j] = xr[64 * j];
                if (HAS_DX) { const v2u* dr = (const v2u*)((const bf16*)F.out + (size_t)(row + q) * (2 * D)) + F.lane;
#pragma unroll
                    for (int j = 0; j < 4; ++j) dv[q][j] = dr[64 * j]; } }
#pragma unroll
            for (int q = 0; q < RW; ++q) { float s = 0.f;
#pragma unroll
                for (int j = 0; j < 4; ++j) {
                    if (HAS_DX) v[q][j] = v[q][j] + ga[j] * (f32x4){bflo(dv[q][j].x), bfhi(dv[q][j].x), bflo(dv[q][j].y), bfhi(dv[q][j].y)};
                    s += (v[q][j].x * v[q][j].x + v[q][j].y * v[q][j].y) + (v[q][j].z * v[q][j].z + v[q][j].w * v[q][j].w); }
                const float rstd = 1.f / sqrtf(wave_sum(s) * (1.f / D) + NORM_EPS);
                v2u* o8 = (v2u*)(O + (size_t)(row + q) * D) + F.lane;
#pragma unroll
                for (int j = 0; j < 4; ++j) { const f32x4 y = v[q][j] * rstd * gg[j] + ss[j]; o8[64 * j] = (v2u){pk2(y.x, y.y), pk2(y.z, y.w)}; } }
        }
    }
}

__device__ __forceinline__ void pool_phase(Frame& F, const float* pool_w, const float* pool_scale) {
    const bf16* proj = (const bf16*)(F.ws + WS_PROJ); bf16* mixin = (bf16*)(F.ws + WS_MIXIN);
    LAS float* us = (LAS float*)F.lds;
    LAS float* pl = (LAS float*)(F.lds + 49152);
    for (int tile = F.bid; tile < NT / 32; tile += F.G) {
        const int row0 = tile * 32, tl0 = row0 & (SEQ - 1);
        __syncthreads();
        for (int p = F.tid; p < 47 * 32; p += NTHREADS) { const int rr = p >> 5, pc = p & 31; const int tl = tl0 - 15 + rr;
            v4u raw = (v4u){0u, 0u, 0u, 0u};
            if (tl >= 0) raw = *(const v4u*)(proj + (size_t)(row0 - 15 + rr) * NPROJ + pc * 8);
            LAS float* d = us + rr * 256 + pc * 8;
            d[0] = bflo(raw.x); d[1] = bfhi(raw.x); d[2] = bflo(raw.y); d[3] = bfhi(raw.y); d[4] = bflo(raw.z); d[5] = bfhi(raw.z); d[6] = bflo(raw.w); d[7] = bfhi(raw.w); }
        __syncthreads();
        { const int ch = F.tid & 255, half = F.tid >> 8, w = 2 << (ch >> 6);
            for (int i = 0; i < 16; ++i) { const int tt = half * 16 + i, tl = tl0 + tt; float s = 0.f;
                for (int k = 0; k < w; ++k) s += us[(15 + tt - k) * 256 + ch];
                const int cnt = (tl + 1) < w ? (tl + 1) : w;
                pl[tt * 256 + ch] = s / (float)cnt - us[(15 + tt) * 256 + ch]; } }
        __syncthreads();
        { const int col = F.tid & 255, half = F.tid >> 8, g = col >> 6, dc = col & 63;
            float acc[16];
#pragma unroll
            for (int i = 0; i < 16; ++i) acc[i] = 0.f;
            const float* pw = pool_w + (size_t)g * 64 * 64 + dc;
            for (int c4 = 0; c4 < 64; c4 += 4) {
                const float w0 = pw[(c4 + 0) * 64], w1 = pw[(c4 + 1) * 64], w2 = pw[(c4 + 2) * 64], w3 = pw[(c4 + 3) * 64];
#pragma unroll
                for (int i = 0; i < 16; ++i) { const f32x4 p = *(const LAS f32x4*)(pl + (half * 16 + i) * 256 + g * 64 + c4);
                    acc[i] += p.x * w0 + p.y * w1 + p.z * w2 + p.w * w3; } }
            const float sc = pool_scale[col];
#pragma unroll
            for (int i = 0; i < 16; ++i) mixin[(size_t)(row0 + half * 16 + i) * NMIX + col] = (bf16)f2bf(acc[i] * sc); }
    }
}

constexpr int KV_PITCH = 144;
__device__ __forceinline__ void attn_phase(Frame& F) {
    const bf16* proj = (const bf16*)(F.ws + WS_PROJ);
    bf16* atto = (bf16*)(F.ws + WS_ATTO); float* lse = (float*)(F.ws + WS_LSE);
    LAS unsigned char* Ks = F.lds; LAS unsigned char* Vs = F.lds + 256 * KV_PITCH;
    const int lane = F.lane, fr = lane & 15, fq = lane >> 4, w = F.wave;
    const int w_i0 = 16 * w, c0 = w >> 1, qi = w_i0 + fr;
#define ATT_DECODE(unit_, rowb_, d_, r_, n_, g_, h_, colQ_) \
        const int rn_##unit_ = (unit_) & 31; const int h_ = ((unit_) >> 5) & 3, g_ = ((unit_) >> 7) % 3; const size_t rowb_ = (size_t)((unit_) / 384) * SEQ; \
        const int d_ = 1 << (2 * g_), nbk_##unit_ = 32 >> (2 * g_), r_ = rn_##unit_ / nbk_##unit_, n_ = rn_##unit_ % nbk_##unit_; const int colQ_ = 256 + g_ * 256 + h_ * 64;
    v4u kreg[4], vreg[4]; bf16x8 qn[2];
    {   const int unit0 = F.bid;
        if (unit0 < NB * 3 * 4 * 32) { ATT_DECODE(unit0, rowb, d, r, n, g, h, colQ)
            const size_t qrow = rowb + (size_t)(n * 128 + qi) * d + r;
#pragma unroll
            for (int ks = 0; ks < 2; ++ks) qn[ks] = *(const bf16x8*)(proj + qrow * NPROJ + colQ + ks * 32 + fq * 8);
#pragma unroll
            for (int cidx = 0; cidx < 4; ++cidx) { const int ch = F.tid + 512 * cidx, j = ch >> 3, pc = ch & 7;
                int p = (n - 1) * 128 + j; p = p < 0 ? 0 : p; const size_t row = rowb + (size_t)p * d + r;
                kreg[cidx] = *(const v4u*)(proj + row * NPROJ + colQ + 768 + pc * 8); vreg[cidx] = *(const v4u*)(proj + row * NPROJ + colQ + 1536 + pc * 8); } } }
    for (int unit = F.bid; unit < NB * 3 * 4 * 32; unit += F.G) {
        ATT_DECODE(unit, rowb, d, r, n, g, h, colQ)
        __syncthreads();
#pragma unroll
        for (int cidx = 0; cidx < 4; ++cidx) { const int ch = F.tid + 512 * cidx, j = ch >> 3, pc = ch & 7;
            *(LAS v4u*)(Ks + j * KV_PITCH + pc * 16) = kreg[cidx]; *(LAS v4u*)(Vs + j * KV_PITCH + pc * 16) = vreg[cidx]; }
        const size_t qrow = rowb + (size_t)(n * 128 + qi) * d + r;
        bf16x8 qf[2]; qf[0] = qn[0]; qf[1] = qn[1];
        __syncthreads();
        {   const int unit2 = unit + F.G;
            if (unit2 < NB * 3 * 4 * 32) { ATT_DECODE(unit2, rowb2, d2, r2, n2, g2, h2, colQ2)
                const size_t qrow2 = rowb2 + (size_t)(n2 * 128 + qi) * d2 + r2;
#pragma unroll
                for (int ks = 0; ks < 2; ++ks) qn[ks] = *(const bf16x8*)(proj + qrow2 * NPROJ + colQ2 + ks * 32 + fq * 8);
#pragma unroll
                for (int cidx = 0; cidx < 4; ++cidx) { const int ch = F.tid + 512 * cidx, j = ch >> 3, pc = ch & 7;
                    int p = (n2 - 1) * 128 + j; p = p < 0 ? 0 : p; const size_t row = rowb2 + (size_t)p * d2 + r2;
                    kreg[cidx] = *(const v4u*)(proj + row * NPROJ + colQ2 + 768 + pc * 8); vreg[cidx] = *(const v4u*)(proj + row * NPROJ + colQ2 + 1536 + pc * 8); } } }
        f32x4 s[5][2];
#pragma unroll
        for (int cc = 0; cc < 5; ++cc)
#pragma unroll
            for (int hh = 0; hh < 2; ++hh) {
                const int j = 32 * (c0 + cc) + 8 * (fr >> 2) + 4 * hh + (fr & 3);
                const bf16x8 k0 = *(const LAS bf16x8*)(Ks + j * KV_PITCH + fq * 16), k1 = *(const LAS bf16x8*)(Ks + j * KV_PITCH + 64 + fq * 16);
                f32x4 a = (f32x4){0.f, 0.f, 0.f, 0.f};
                a = __builtin_amdgcn_mfma_f32_16x16x32_bf16(k0, qf[0], a, 0, 0, 0);
                a = __builtin_amdgcn_mfma_f32_16x16x32_bf16(k1, qf[1], a, 0, 0, 0);
                s[cc][hh] = a;
            }
        float mx = -1e30f;
        int qil = qi; asm volatile("" : "+v"(qil));
#pragma unroll
        for (int cc = 0; cc < 5; ++cc)
#pragma unroll
            for (int hh = 0; hh < 2; ++hh)
#pragma unroll
                for (int rr = 0; rr < 4; ++rr) { const int j = 32 * (c0 + cc) + 8 * fq + 4 * hh + rr; const int dist = 128 + qil - j;
                    const bool valid = (dist >= 0) && (dist <= 128) && (n > 0 || j >= 128);
                    const float v = valid ? s[cc][hh][rr] * 0.18033688f : -1e30f; s[cc][hh][rr] = v; mx = fmaxf(mx, v); }
        mx = fmaxf(mx, __shfl_xor(mx, 16)); mx = fmaxf(mx, __shfl_xor(mx, 32));
        float l = 0.f;
#pragma unroll
        for (int cc = 0; cc < 5; ++cc)
#pragma unroll
            for (int hh = 0; hh < 2; ++hh)
#pragma unroll
                for (int rr = 0; rr < 4; ++rr) { const float p = __builtin_amdgcn_exp2f(s[cc][hh][rr] - mx); s[cc][hh][rr] = p; l += p; }
        l += __shfl_xor(l, 16); l += __shfl_xor(l, 32);
        f32x4 o[4];
#pragma unroll
        for (int eb = 0; eb < 4; ++eb) o[eb] = (f32x4){0.f, 0.f, 0.f, 0.f};
#pragma unroll
        for (int cc = 0; cc < 5; ++cc) {
            const v4u pu = (v4u){pk2(s[cc][0][0], s[cc][0][1]), pk2(s[cc][0][2], s[cc][0][3]), pk2(s[cc][1][0], s[cc][1][1]), pk2(s[cc][1][2], s[cc][1][3])};
            const bf16x8 pf = __builtin_bit_cast(bf16x8, pu);
            const int key0 = 32 * (c0 + cc) + 8 * fq + (fr >> 2);
#pragma unroll
            for (int eb = 0; eb < 4; ++eb) {
                const LAS unsigned char* vp = Vs + key0 * KV_PITCH + (16 * eb + 4 * (fr & 3)) * 2;
                const s16x4 lo = __builtin_bit_cast(s16x4, __builtin_amdgcn_ds_read_tr16_b64_v4i16((LAS s16x4*)vp));
                const s16x4 hi = __builtin_bit_cast(s16x4, __builtin_amdgcn_ds_read_tr16_b64_v4i16((LAS s16x4*)(vp + 4 * KV_PITCH)));
                const bf16x8 vf = (bf16x8){lo[0], lo[1], lo[2], lo[3], hi[0], hi[1], hi[2], hi[3]};
                o[eb] = __builtin_amdgcn_mfma_f32_16x16x32_bf16(vf, pf, o[eb], 0, 0, 0);
            }
        }
        const float il = 1.f / l;
        bf16* op = atto + ((size_t)g * NT + qrow) * 256 + h * 64 + 4 * fq;
#pragma unroll
        for (int eb = 0; eb < 4; ++eb) { const f32x4 v = o[eb] * il; *(v2u*)(op + 16 * eb) = (v2u){pk2(v.x, v.y), pk2(v.z, v.w)}; }
        if (fq == 0) lse[((size_t)g * NT + qrow) * 4 + h] = mx + __builtin_amdgcn_logf(l);
    }
#undef ATT_DECODE
}

__device__ __forceinline__ void combine_phase(Frame& F) {
    const bf16* atto = (const bf16*)(F.ws + WS_ATTO); const float* lse = (const float*)(F.ws + WS_LSE); bf16* mixin = (bf16*)(F.ws + WS_MIXIN);
    for (size_t idx = (size_t)F.bid * NTHREADS + F.tid; idx < (size_t)NT * 32; idx += (size_t)F.G * NTHREADS) {
        const size_t t = idx >> 5; const int pc = (int)(idx & 31), h = pc >> 3;
        const float l0 = lse[(0 * (size_t)NT + t) * 4 + h], l1 = lse[(1 * (size_t)NT + t) * 4 + h], l2 = lse[(2 * (size_t)NT + t) * 4 + h];
        const float m = fmaxf(l0, fmaxf(l1, l2));
        float a0 = __builtin_amdgcn_exp2f(l0 - m), a1 = __builtin_amdgcn_exp2f(l1 - m), a2 = __builtin_amdgcn_exp2f(l2 - m);
        const float inv = 1.f / (a0 + a1 + a2); a0 *= inv; a1 *= inv; a2 *= inv;
        const v4u v0 = *(const v4u*)(atto + (0 * (size_t)NT + t) * 256 + pc * 8), v1 = *(const v4u*)(atto + (1 * (size_t)NT + t) * 256 + pc * 8), v2 = *(const v4u*)(atto + (2 * (size_t)NT + t) * 256 + pc * 8);
        v4u o;
        o.x = pk2(a0 * bflo(v0.x) + a1 * bflo(v1.x) + a2 * bflo(v2.x), a0 * bfhi(v0.x) + a1 * bfhi(v1.x) + a2 * bfhi(v2.x));
        o.y = pk2(a0 * bflo(v0.y) + a1 * bflo(v1.y) + a2 * bflo(v2.y), a0 * bfhi(v0.y) + a1 * bfhi(v1.y) + a2 * bfhi(v2.y));
        o.z = pk2(a0 * bflo(v0.z) + a1 * bflo(v1.z) + a2 * bflo(v2.z), a0 * bfhi(v0.z) + a1 * bfhi(v1.z) + a2 * bfhi(v2.z));
        o.w = pk2(a0 * bflo(v0.w) + a1 * bflo(v1.w) + a2 * bflo(v2.w), a0 * bfhi(v0.w) + a1 * bfhi(v1.w) + a2 * bfhi(v2.w));
        *(v4u*)(mixin + t * NMIX + 256 + pc * 8) = o;
    }
}

#if MK_NAIVE_ATTN
__device__ __forceinline__ void naive_attn_phase(Frame& F) {
    const bf16* proj = (const bf16*)(F.ws + WS_PROJ); bf16* mixin = (bf16*)(F.ws + WS_MIXIN);
    for (size_t idx = (size_t)F.bid * NTHREADS + F.tid; idx < (size_t)NT * 4; idx += (size_t)F.G * NTHREADS) {
        const size_t tg = idx >> 2; const int h = (int)(idx & 3), t = (int)(tg & (SEQ - 1)); const size_t rowb = tg - t;
        float m = -1e30f, l = 0.f, o[64];
        for (int e = 0; e < 64; ++e) o[e] = 0.f;
        for (int g = 0; g < 3; ++g) { const int d = 1 << (2 * g); const int colQ = 256 + g * 256 + h * 64;
            const bf16* q = proj + tg * NPROJ + colQ;
            for (int j = 0; j <= 128; ++j) { const int tk = t - j * d; if (tk < 0) break;
                const bf16* k = proj + (rowb + tk) * NPROJ + colQ + 768; const bf16* v = k + 768;
                float sdot = 0.f; for (int e = 0; e < 64; ++e) sdot += bf2f(q[e]) * bf2f(k[e]);
                sdot *= 0.125f;
                const float mn = fmaxf(m, sdot), corr = __expf(m - mn), p = __expf(sdot - mn);
                l = l * corr + p; for (int e = 0; e < 64; ++e) o[e] = o[e] * corr + p * bf2f(v[e]); m = mn; } }
        const float il = 1.f / l;
        for (int e = 0; e < 64; ++e) mixin[tg * NMIX + 256 + h * 64 + e] = (bf16)f2bf(o[e] * il);
    }
}
#endif

__device__ __forceinline__ void routing_phase(Frame& F, const float* router_bias) {
    const float* L0 = (const float*)(F.ws + WS_LOGIT); const float* L1 = L0 + (size_t)NT * NE;
    float* gatew = (float*)(F.ws + WS_GATEW); unsigned* bucket = (unsigned*)(F.ws + WS_BUCKET); unsigned* gcnt = (unsigned*)(F.ws + WS_CTL) + CW_GCNT;
    LAS unsigned* hist = (LAS unsigned*)F.lds; LAS unsigned* basel = hist + 256; LAS unsigned* asg = hist + 512;
    const int lane = F.lane;
    for (int blk = F.bid; blk < NT / 128; blk += F.G) {
        __syncthreads();
        if (F.tid < 256) hist[F.tid] = 0u;
        __syncthreads();
        const f32x4 bias = *(const f32x4*)(router_bias + 4 * lane);
        for (int tl = 0; tl < 16; ++tl) {
            const int tloc = F.wave * 16 + tl; const size_t t = (size_t)blk * 128 + tloc;
            const f32x4 lg = *(const f32x4*)(L0 + t * NE + 4 * lane) + *(const f32x4*)(L1 + t * NE + 4 * lane);
            float sc[4], cd[4];
#pragma unroll
            for (int i = 0; i < 4; ++i) { sc[i] = 1.f / (1.f + __expf(-lg[i])); cd[i] = sc[i] + bias[i]; }
            float a1 = fmaxf(cd[0], cd[1]), a2 = fminf(cd[0], cd[1]);
#pragma unroll
            for (int i = 2; i < 4; ++i) { const float v = cd[i]; a2 = fmaxf(a2, fminf(a1, v)); a1 = fmaxf(a1, v); }
#pragma unroll
            for (int off = 1; off < 8; off <<= 1) { const float b1 = __shfl_xor(a1, off), b2 = __shfl_xor(a2, off);
                const float n1 = fmaxf(a1, b1), n2 = fmaxf(fminf(a1, b1), fmaxf(a2, b2)); a1 = n1; a2 = n2; }
            const float gs = a1 + a2; const int myg = lane >> 3; int rank = 0;
#pragma unroll
            for (int gg = 0; gg < 8; ++gg) { const float o = __shfl(gs, gg * 8); rank += (o > gs || (o == gs && gg < myg)) ? 1 : 0; }
            if (rank >= 4) {
#pragma unroll
                for (int i = 0; i < 4; ++i) cd[i] = -1e30f; }
            int sel_e = 0; float sel_s = 0.f, ssum = 0.f;
#pragma unroll
            for (int k = 0; k < TOPK; ++k) {
                float bv = cd[0]; int bi = 0;
#pragma unroll
                for (int i = 1; i < 4; ++i) if (cd[i] > bv) { bv = cd[i]; bi = i; }
                int gi = 4 * lane + bi;
#pragma unroll
                for (int off = 32; off >= 1; off >>= 1) { const float ov = __shfl_xor(bv, off); const int oi = __shfl_xor(gi, off);
                    if (ov > bv || (ov == bv && oi < gi)) { bv = ov; gi = oi; } }
                const int own = gi >> 2, wi = gi & 3;
                float myv = sc[0]; myv = wi == 1 ? sc[1] : myv; myv = wi == 2 ? sc[2] : myv; myv = wi == 3 ? sc[3] : myv;
                const float sv = __shfl(myv, own);
                if (lane == own) {
#pragma unroll
                    for (int i = 0; i < 4; ++i) if (wi == i) cd[i] = -1e30f; }
                ssum += sv;
                if (lane == k) { sel_e = gi; sel_s = sv; }
            }
            if (lane < TOPK) {
                const unsigned rk = __hip_atomic_fetch_add(hist + sel_e, 1u, __ATOMIC_RELAXED, __HIP_MEMORY_SCOPE_WORKGROUP);
                asg[tloc * 8 + lane] = (unsigned)sel_e | (rk << 16);
                gatew[t * 8 + lane] = sel_s / ssum * 2.5f;
            }
        }
        __syncthreads();
        if (F.tid < 256) { const unsigned c = hist[F.tid]; basel[F.tid] = c ? atomicAdd(&gcnt[F.tid * 16], c) : 0u; }
        __syncthreads();
        for (int a = F.tid; a < 1024; a += NTHREADS) { const unsigned v = asg[a], e = v & 0xffffu, rk = v >> 16;
            bucket[(size_t)e * CAP + basel[e] + rk] = (unsigned)(blk * 1024 + a); }
    }
}

__device__ __forceinline__ void build_tables(Frame& F, int& nblk_total) {
    const unsigned* gcnt = (const unsigned*)(F.ws + WS_CTL) + CW_GCNT;
    LAS int* prefix = (LAS int*)(F.lds + TAB_OFF); LAS int* cnt = prefix + 260;
    __syncthreads();
    if (F.tid < 256) cnt[F.tid] = (int)__hip_atomic_load(&gcnt[F.tid * 16], __ATOMIC_RELAXED, __HIP_MEMORY_SCOPE_AGENT);
    __syncthreads();
    if (F.tid == 0) { int s = 0; for (int e = 0; e < NE; ++e) { prefix[e] = s; s += (cnt[e] + 255) >> 8; } prefix[NE] = s; }
    __syncthreads();
    if (F.tid < 256) { LAS unsigned char* b2e = (LAS unsigned char*)(cnt + 256); for (int b = prefix[F.tid]; b < prefix[F.tid + 1]; ++b) b2e[b] = (unsigned char)F.tid; }
    __syncthreads();
    nblk_total = prefix[NE];
}

__device__ __forceinline__ void final_phase(Frame& F, const float* X, const float* g_final) {
    const float* mod = (const float*)(F.ws + WS_MOD); const unsigned char* Y = (const unsigned char*)(F.ws + WS_Y);
    const unsigned* pos = (const unsigned*)(F.ws + WS_POS); const float* gatew = (const float*)(F.ws + WS_GATEW);
    constexpr int RW = 1;
    const int c0 = 16 * F.lane;
    for (int blk = F.bid; blk < NT / 128; blk += F.G) {
        const int b = (blk * 128) >> 12; const float* g1 = mod + (size_t)b * 6144 + 2 * D + c0; const float* g2 = mod + (size_t)b * 6144 + 5 * D + c0;
        f32x4 ga[4], gb[4];
#pragma unroll
        for (int j = 0; j < 4; ++j) { ga[j] = *(const f32x4*)(g1 + 4 * j); gb[j] = *(const f32x4*)(g2 + 4 * j); }
        const size_t rowbase = (size_t)blk * 128 + F.wave * 16;
        const unsigned p0 = pos[rowbase * 8 + F.lane], p1 = pos[rowbase * 8 + 64 + F.lane];
        const float w0 = gatew[rowbase * 8 + F.lane] * Y_INV_SCALE, w1 = gatew[rowbase * 8 + 64 + F.lane] * Y_INV_SCALE;
        for (int rr = 0; rr < 16; rr += RW) {
            f32x4 v[RW][4]; v4u dv[RW][2], sv[RW][2], yv[RW][TOPK]; float wk[RW][TOPK];
#pragma unroll
            for (int q = 0; q < RW; ++q) { const size_t row = rowbase + rr + q;
                const f32x4* xr = (const f32x4*)(X + row * D + c0); const v4u* dr = (const v4u*)((const bf16*)F.out + row * (2 * D) + c0);
#pragma unroll
                for (int j = 0; j < 4; ++j) v[q][j] = xr[j];
                dv[q][0] = dr[0]; dv[q][1] = dr[1]; sv[q][0] = dr[128]; sv[q][1] = dr[129];
#pragma unroll
                for (int k = 0; k < TOPK; ++k) { const int idx = (rr + q) * 8 + k;
                    const unsigned pk = (unsigned)__builtin_amdgcn_readlane((int)(idx < 64 ? p0 : p1), idx & 63);
                    wk[q][k] = __builtin_bit_cast(float, __builtin_amdgcn_readlane(__builtin_bit_cast(int, idx < 64 ? w0 : w1), idx & 63));
                    yv[q][k] = *(const v4u*)(Y + (size_t)pk * D + c0); } }
#pragma unroll
            for (int q = 0; q < RW; ++q) { float s = 0.f;
#pragma unroll
                for (int j = 0; j < 4; ++j) {
                    const unsigned sw0 = sv[q][j >> 1][(j & 1) * 2], sw1 = sv[q][j >> 1][(j & 1) * 2 + 1];
                    f32x4 r = (f32x4){bflo(sw0), bfhi(sw0), bflo(sw1), bfhi(sw1)};
#pragma unroll
                    for (int k = 0; k < TOPK; ++k) { const int wd = (int)yv[q][k][j];
                        const auto lo = __builtin_amdgcn_cvt_pk_f32_fp8(wd, false), hi = __builtin_amdgcn_cvt_pk_f32_fp8(wd, true);
                        r += wk[q][k] * (f32x4){lo[0], lo[1], hi[0], hi[1]}; }
                    const unsigned dw0 = dv[q][j >> 1][(j & 1) * 2], dw1 = dv[q][j >> 1][(j & 1) * 2 + 1];
                    v[q][j] = v[q][j] + ga[j] * (f32x4){bflo(dw0), bfhi(dw0), bflo(dw1), bfhi(dw1)} + gb[j] * r;
                    s += (v[q][j].x * v[q][j].x + v[q][j].y * v[q][j].y) + (v[q][j].z * v[q][j].z + v[q][j].w * v[q][j].w); }
                const float rstd = 1.f / sqrtf(wave_sum(s) * (1.f / D) + NORM_EPS);
                f32x4* orow = (f32x4*)(F.out + (rowbase + rr + q) * D + c0);
#pragma unroll
                for (int j = 0; j < 4; ++j) orow[j] = v[q][j] * rstd * *(const f32x4*)(g_final + c0 + 4 * j); }
        }
    }
}

constexpr int N_PHASES = 12;
__global__ void __launch_bounds__(NTHREADS, 2) fwd(Args args) {
    extern __shared__ __attribute__((aligned(16))) unsigned char lds_raw[];
    Frame F;
    F.lds = (LAS unsigned char*)lds_raw;
    F.tid = threadIdx.x; F.lane = F.tid & 63; F.wave = __builtin_amdgcn_readfirstlane(F.tid >> 6); F.G = gridDim.x; F.bid = blockIdx.x;
#define INP(i) ld_ptr(F.lds, (i))
    F.out = args.out; F.ws = args.ws;
    unsigned char* ws = args.ws;
    volatile LAS unsigned* MISC = (volatile LAS unsigned*)(F.lds + MISC_OFF);
    if (F.tid < 16) MISC[F.tid] = 0u;
    if (F.tid == 0) { LAS unsigned long long* pt = (LAS unsigned long long*)(F.lds + PT_OFF);
#pragma unroll
        for (int i = 0; i < 19; ++i) pt[i] = (unsigned long long)args.in[i]; }
    __syncthreads();
    const int lo = args.ph_lo, hi = args.ph_hi;
    XcdBarrier bar; bar.bar = (unsigned*)(ws + WS_CTL) + CW_BAR; bar.x = 0; bar.st = nullptr;
    if (hi - lo > 1) bar = xcd_barrier_post((unsigned*)(ws + WS_CTL) + CW_BAR, MISC + 8);
#ifndef PH_MASK
#define PH_MASK 0xfff
#endif
#define IN(k) (((PH_MASK >> (k)) & 1) && lo <= (k) && (k) < hi)
#define SEAM(k) do { if (IN(k) && IN((k) + 1)) xcd_barrier(bar); { int _t = threadIdx.x; asm volatile("" : "+v"(_t)); F.tid = _t; F.lane = _t & 63; } } while (0)

    const int vcu = (F.G % 8 == 0) ? (F.bid % 8) * (F.G / 8) + F.bid / 8 : F.bid;
    bf16* hbuf = (bf16*)(ws + WS_H); bf16* proj = (bf16*)(ws + WS_PROJ); bf16* mixin = (bf16*)(ws + WS_MIXIN);

    if (IN(0)) { p0_prologue(F); } SEAM(0);
    if (IN(1)) { modnorm_phase<false>(F, INP(0), INP(4), 0, hbuf); } SEAM(1);
    if (IN(2)) {
        typedef DenseSchedT<NT / 256, NPROJ / 256, 1> SchedP2; SchedP2 S; S.init(hbuf, ws + WS_WIN_T, D, D, 0, F.G, F.bid);
        EpiProj E{proj};
        const int ksplit = vcu % 6;
        S.i0 = 0; S.i1 = ksplit;
        gemm_phase<EpiProj, SchedP2>(F.lds, D, D, S, E);
        __syncthreads();
        for (int e = F.bid; e < NE; e += F.G)
            convert_expert<false>(F, INP(12) + (size_t)e * D * FF, INP(13) + (size_t)e * D * FF, (bf16*)(ws + WS_WGU_T) + (size_t)e * 512 * D);
        __syncthreads();
        S.i0 = ksplit; S.i1 = 0x3fffffff;
        gemm_phase<EpiProj, SchedP2>(F.lds, D, D, S, E);
    } SEAM(2);
    if (IN(3)) {
        pool_phase(F, INP(6), INP(7));
#if MK_NAIVE_ATTN
        naive_attn_phase(F);
#else
        attn_phase(F);
#endif
    } SEAM(3);
    if (IN(4)) {
#if !MK_NAIVE_ATTN
        combine_phase(F);
#endif
    } SEAM(4);
    if (IN(5)) {
        typedef DenseSchedT<NT / 256, D / 256, 1> SchedP5; SchedP5 S; S.init(mixin, ws + WS_WOUT_T, NMIX, NMIX, 0, F.G, F.bid);
        EpiOut E{(bf16*)F.out};
        gemm_phase<EpiOut, SchedP5>(F.lds, NMIX, NMIX, S, E);
    } SEAM(5);
    if (IN(6)) { modnorm_phase<true>(F, INP(0), INP(9), 3, hbuf); } SEAM(6);
    if (IN(7)) {
        typedef DenseSchedT<NT / 256, NE / 256, 2> SchedP7; SchedP7 S; S.init(hbuf, ws + WS_WR_T, D, D, 512, F.G, F.bid);
        EpiRouter E{(float*)(ws + WS_LOGIT)};
        gemm_phase<EpiRouter, SchedP7>(F.lds, 512, D, S, E);
    } SEAM(7);
    if (IN(8)) { routing_phase(F, INP(11)); } SEAM(8);
    if (IN(9)) {
        int nblk; build_tables(F, nblk);
        MoeSched<2, false> S; S.prefix = (const LAS int*)(F.lds + TAB_OFF); S.cnt = S.prefix + 260; S.bucket = (const unsigned*)(ws + WS_BUCKET);
        S.Ar = (const char*)hbuf; S.As = (const char*)hbuf; S.Br = (const char*)(ws + WS_WGU_T); S.Bs = (const char*)(ws + WS_WSGU_T);
        S.nRouted = nblk * 2; S.total = S.nRouted + (NT / 256) * 2; S.G = F.G; S.c = vcu;
        EpiGU E{(bf16*)(ws + WS_ACT), (bf16*)(ws + WS_ACTS), (const unsigned*)(ws + WS_BUCKET), (unsigned*)(ws + WS_POS)};
        const int ksplit = vcu % 11;
        S.i0 = 0; S.i1 = ksplit;
        gemm_phase<EpiGU, MoeSched<2, false>>(F.lds, D, D, S, E);
        __syncthreads();
        for (int e = F.bid; e < NE; e += F.G)
            convert_expert<true>(F, INP(14) + (size_t)e * FF * D, nullptr, (bf16*)(ws + WS_WD_T) + (size_t)e * D * FF);
        __syncthreads();
        S.i0 = ksplit; S.i1 = 0x3fffffff;
        gemm_phase<EpiGU, MoeSched<2, false>>(F.lds, D, D, S, E);
    } SEAM(9);
    if (IN(10)) {
        int nblk; build_tables(F, nblk);
        MoeSched<4, true> S; S.prefix = (const LAS int*)(F.lds + TAB_OFF); S.cnt = S.prefix + 260; S.bucket = (const unsigned*)(ws + WS_BUCKET);
        S.Ar = (const char*)(ws + WS_ACT); S.As = (const char*)(ws + WS_ACTS); S.Br = (const char*)(ws + WS_WD_T); S.Bs = (const char*)(ws + WS_WSD_T);
        S.nRouted = nblk * 4; S.total = S.nRouted + (NT / 256) * 4; S.G = F.G; S.c = vcu; S.i0 = 0; S.i1 = 0x3fffffff;
        EpiDown E{(unsigned char*)(ws + WS_Y), (bf16*)F.out};
        gemm_phase<EpiDown, MoeSched<4, true>>(F.lds, FF, FF, S, E);
    } SEAM(10);
    if (IN(11)) { final_phase(F, INP(0), INP(18)); }
#undef IN
#undef SEAM
#undef INP
}

extern "C" void kernel_launch(void* const* d_in, const int* in_sizes, int n_in, void* d_out, int out_size, void* d_ws, size_t ws_size, hipStream_t stream) {
    static int grid = 0;
    if (grid == 0) {
        if (n_in != 19 || out_size != NT * D || ws_size < WS_END) { fprintf(stderr, "kernel_launch: unexpected shapes (n_in %d out %d ws %zu)\n", n_in, out_size, ws_size); grid = -1; return; }
        int dev = 0, cus = 0;
        if (hipGetDevice(&dev) != hipSuccess || hipDeviceGetAttribute(&cus, hipDeviceAttributeMultiprocessorCount, dev) != hipSuccess) { grid = -1; return; }
        if (hipFuncSetAttribute((const void*)fwd, hipFuncAttributeMaxDynamicSharedMemorySize, LDS_BYTES) != hipSuccess) { fprintf(stderr, "kernel_launch: hipFuncSetAttribute failed\n"); grid = -1; return; }
        int per_cu = 0;
        if (hipOccupancyMaxActiveBlocksPerMultiprocessor(&per_cu, (const void*)fwd, NTHREADS, LDS_BYTES) != hipSuccess || per_cu < 1) { fprintf(stderr, "kernel_launch: occupancy query says %d\n", per_cu); }
        (void)hipGetLastError();
        grid = cus;
    }
    if (grid < 0) return;
    (void)hipMemsetAsync((char*)d_ws + WS_CTL, 0, CTL_ZERO_BYTES, stream);
    Args a{};
    for (int i = 0; i < 19; ++i) a.in[i] = (const float*)d_in[i];
    a.out = (float*)d_out; a.ws = (unsigned char*)d_ws;
#if MK_ONE_LAUNCH
    a.ph_lo = 0; a.ph_hi = N_PHASES;
    hipLaunchKernelGGL(fwd, dim3(grid), dim3(NTHREADS), LDS_BYTES, stream, a);
#else
    for (int p = 0; p < N_PHASES; ++p) { a.ph_lo = p; a.ph_hi = p + 1; const int reps = ((MK_REP_MASK >> p) & 1) ? 2 : 1;
        for (int r = 0; r < reps; ++r) hipLaunchKernelGGL(fwd, dim3(grid), dim3(NTHREADS), LDS_BYTES, stream, a); }
#endif
}
```

```cpp
#include <hip/hip_runtime.h>
#include <cstdio>
#include <cstdint>

#ifndef MK_ONE_LAUNCH
#define MK_ONE_LAUNCH 1
#endif
#ifndef MK_FAST_GEMM
#define MK_FAST_GEMM 1
#endif
#ifndef MK_REP_MASK
#define MK_REP_MASK 0x000
#endif
#ifndef MK_MX
#define MK_MX 1
#endif
#ifndef MK_PROBE
#define MK_PROBE 0
#endif
#ifndef MK_PROBE_BLK
#define MK_PROBE_BLK 0
#endif
#ifndef MK_PROBE_WAVE
#define MK_PROBE_WAVE 0
#endif
#ifndef MK_PROBE_MULT
#define MK_PROBE_MULT 4
#endif
#ifndef MK_NAIVE_ATTN
#define MK_NAIVE_ATTN 0
#endif

#define LAS __attribute__((address_space(3)))
#define GAS __attribute__((address_space(1)))
typedef unsigned short bf16;
typedef short bf16x8 __attribute__((ext_vector_type(8)));
typedef short s16x4 __attribute__((ext_vector_type(4)));
typedef float f32x4 __attribute__((ext_vector_type(4)));
typedef float f32x2 __attribute__((ext_vector_type(2)));
typedef long l64x2 __attribute__((ext_vector_type(2)));
typedef int i32x8 __attribute__((ext_vector_type(8)));
typedef int i32x4 __attribute__((ext_vector_type(4)));
typedef unsigned v4u __attribute__((ext_vector_type(4)));
typedef unsigned v2u __attribute__((ext_vector_type(2)));

constexpr int D = 1024, NB = 8, SEQ = 4096, NT = NB * SEQ;
constexpr int NPROJ = 2560, NE = 256, TOPK = 8, FF = 256, NMIX = 512;
constexpr int CAP = NT;
constexpr int MAXBLK = NT * TOPK / 256 + NE;
constexpr float NORM_EPS = 1e-6f;
constexpr int NWAVES = 8, NTHREADS = 512;

constexpr size_t MiB = 1u << 20;
constexpr size_t WS_CTL = 0, CTL_ZERO_BYTES = 1 * MiB;
constexpr size_t WS_MOD = 1 * MiB;
constexpr size_t WS_GATEW = 2 * MiB;
constexpr size_t WS_WIN_T = 4 * MiB;
constexpr size_t WS_WOUT_T = 9 * MiB;
constexpr size_t WS_WR_T = 10 * MiB;
constexpr size_t WS_WSGU_T = 11 * MiB;
constexpr size_t WS_WSD_T = 12 * MiB;
constexpr size_t WS_LSE = 13 * MiB;
constexpr size_t WS_WD_T = 16 * MiB;
constexpr size_t WS_ACT = 144 * MiB;
constexpr size_t WS_ACTS = 304 * MiB;
constexpr size_t WS_BUCKET = 320 * MiB;
constexpr size_t WS_WGU_T = 352 * MiB;
constexpr size_t WS_PROJ = 608 * MiB;
constexpr size_t WS_H = 768 * MiB;
constexpr size_t WS_ATTO = 832 * MiB;
constexpr size_t WS_MIXIN = 880 * MiB;
constexpr size_t WS_LOGIT = 912 * MiB;
constexpr size_t WS_Y = 352 * MiB;
constexpr size_t WS_H2B = 832 * MiB;
constexpr size_t WS_POS = 3 * MiB;
constexpr size_t WS_END = 992 * MiB;
constexpr int CW_BAR = 4096;
constexpr int CW_GCNT = 16384;

constexpr int RING_BYTES = 131072;
constexpr int TAB_OFF = RING_BYTES;
constexpr int MISC_OFF = TAB_OFF + 4096;
constexpr int PT_OFF = MISC_OFF + 256;
constexpr int LDS_BYTES = 147456;

__device__ __forceinline__ unsigned f2bf(float f) { unsigned u = __builtin_bit_cast(unsigned, f); return (u + 0x7fffu + ((u >> 16) & 1u)) >> 16; }
__device__ __forceinline__ unsigned pk2(float lo, float hi) { unsigned r; asm("v_cvt_pk_bf16_f32 %0, %1, %2" : "=v"(r) : "v"(lo), "v"(hi)); return r; }
constexpr float W_SCALE = 64.f, W_INV_SCALE = 1.f / 64.f;
constexpr float ACT_SCALE = 4.f;
__device__ __forceinline__ unsigned pk4_fp8(float a, float b, float c, float d) {
    int w = __builtin_amdgcn_cvt_pk_fp8_f32(a, b, 0, false); w = __builtin_amdgcn_cvt_pk_fp8_f32(c, d, w, true); return (unsigned)w; }
__device__ __forceinline__ float bf2f(unsigned short b) { return __builtin_bit_cast(float, ((unsigned)b) << 16); }
__device__ __forceinline__ float bflo(unsigned u) { return __builtin_bit_cast(float, u << 16); }
__device__ __forceinline__ float bfhi(unsigned u) { return __builtin_bit_cast(float, u & 0xffff0000u); }
__device__ __forceinline__ float wave_sum(float v) {
#pragma unroll
    for (int o = 1; o < 64; o <<= 1) v += __shfl_xor(v, o);
    return v;
}
__device__ __forceinline__ float silu_f(float g) { return g * __builtin_amdgcn_rcpf(1.f + __builtin_amdgcn_exp2f(-1.44269504f * g)); }

__device__ __forceinline__ const float* ld_ptr(LAS unsigned char* lds, int i) {
    const unsigned long long v = ((const LAS unsigned long long*)(lds + PT_OFF))[i];
    const unsigned lo = __builtin_amdgcn_readfirstlane((unsigned)v), hi = __builtin_amdgcn_readfirstlane((unsigned)(v >> 32));
    return (const float*)(((unsigned long long)hi << 32) | lo);
}
#define XB_TMO      128
#define XB_XCNT(j)  (256  + 64 * (j))
#define XB_XSUB(j)  (1280 + 64 * (j))
#define XB_XGEN(j)  (2304 + 64 * (j))
#define XB_TOP      3328
#define XB_TOPGEN   3392
#define XCD_BAR_WORDS 3456
#define XB_SPIN_CAP (1u << 18)
__device__ __forceinline__ unsigned xb_ld(unsigned* p)              { return __hip_atomic_load(p, __ATOMIC_RELAXED, __HIP_MEMORY_SCOPE_AGENT); }
__device__ __forceinline__ unsigned xb_add(unsigned* p, unsigned v) { return __hip_atomic_fetch_add(p, v, __ATOMIC_RELAXED, __HIP_MEMORY_SCOPE_AGENT); }
__device__ __forceinline__ unsigned xb_xcc_id() { return (unsigned)__builtin_amdgcn_s_getreg((3 << 11) | 20) & 0xFu; }
#define XB_SPIN(cond, bar) do { unsigned _sp = 0; while (cond) { __builtin_amdgcn_s_sleep(1); \
    if ((++_sp & 255u) == 0u) { if (xb_ld(&(bar)[XB_TMO])) break; if (_sp > XB_SPIN_CAP) { atomicAdd(&(bar)[XB_TMO], 1u); break; } } } } while (0)
struct XcdBarrier { unsigned* bar; unsigned x; volatile LAS unsigned* st; };
__device__ __forceinline__ XcdBarrier xcd_barrier_post(unsigned* bar, volatile LAS unsigned* st) {
    XcdBarrier b; b.bar = bar; b.x = xb_xcc_id(); b.st = st;
    if (threadIdx.x == 0) (void)xb_add(&bar[XB_XCNT(b.x)], 1u);
    return b;
}
__device__ __forceinline__ void xcd_barrier_complete(unsigned* bar, unsigned x, unsigned& nloc, unsigned& nx) {
    const unsigned G = gridDim.x * gridDim.y * gridDim.z;
    unsigned sum, cnt, mine, sp = 0u;
    for (;;) {
        sum = 0u; cnt = 0u; mine = 0u;
#pragma unroll
        for (unsigned j = 0; j < 16; ++j) { const unsigned c = xb_ld(&bar[XB_XCNT(j)]); sum += c; cnt += (c > 0u) ? 1u : 0u; mine = (j == x) ? c : mine; }
        if (sum == G) break;
        __builtin_amdgcn_s_sleep(1);
        if ((++sp & 255u) == 0u) { if (xb_ld(&bar[XB_TMO])) break; if (sp > XB_SPIN_CAP) { atomicAdd(&bar[XB_TMO], 1u); break; } }
    }
    nloc = mine > 0u ? mine : 1u; nx = cnt > 0u ? cnt : 1u;
}
__device__ __forceinline__ void xcd_barrier(const XcdBarrier& b) {
    asm volatile("s_waitcnt vmcnt(0)" ::: "memory");
    __syncthreads();
    if (threadIdx.x == 0) {
        unsigned* bar = b.bar;
        __builtin_amdgcn_s_waitcnt(0);
        unsigned nloc = b.st[0], nx = b.st[1];
        if (nloc == 0u) { xcd_barrier_complete(bar, b.x, nloc, nx); b.st[0] = nloc; b.st[1] = nx; }
        const unsigned old = xb_add(&bar[XB_XSUB(b.x)], 1u);
        const unsigned gen = old / nloc;
        if (old + 1u == (gen + 1u) * nloc) {
            __builtin_amdgcn_fence(__ATOMIC_RELEASE, "agent");
            asm volatile("s_waitcnt vmcnt(0)" ::: "memory");
            const unsigned og = xb_add(&bar[XB_TOP], 1u);
            const unsigned tg = og / nx;
            if (og + 1u == (tg + 1u) * nx) xb_add(&bar[XB_TOPGEN], 1u);
            else XB_SPIN(xb_ld(&bar[XB_TOPGEN]) == tg, bar);
            __builtin_amdgcn_fence(__ATOMIC_ACQUIRE, "agent");
            xb_add(&bar[XB_XGEN(b.x)], 1u);
            asm volatile("s_waitcnt vmcnt(0)" ::: "memory");
        } else {
            XB_SPIN(xb_ld(&bar[XB_XGEN(b.x)]) == gen, bar);
            __builtin_amdgcn_fence(__ATOMIC_ACQUIRE, "agent");
            asm volatile("s_waitcnt vmcnt(0)" ::: "memory");
        }
    }
    __syncthreads();
}

constexpr int BK = 64, HALF = 128, HTB = HALF * BK * 2;
__device__ __forceinline__ int lds_byte(int r, int c) { const int st = (r >> 4) * 2 + (c >> 5), rr = r & 15, cc = c & 31, ob = rr * 64 + cc * 2; return st * 1024 + (ob ^ (((ob >> 9) & 1) << 5)); }
__device__ __forceinline__ void stage_rc(int b, int& R, int& C) { const int st = b / 1024, sb = b % 1024, swz = sb ^ (((sb >> 9) & 1) << 5); R = (st >> 1) * 16 + swz / 64; C = (st & 1) * 32 + (swz % 64) / 2; }
__device__ __forceinline__ int perm32(int rho) { const int n = rho >> 4, i = rho & 15; return 8 * (i >> 2) + 4 * n + (i & 3); }

template <class Epi, class Sched>
__device__ __forceinline__ void gemm_simple(const int K, const int ldb, const Sched& S, const Epi& E) {
    const int tid = threadIdx.x, wid = __builtin_amdgcn_readfirstlane(tid >> 6), lane = tid & 63, wr = wid >> 2, wc = wid & 3, fr = lane & 15, fq = lane >> 4;
    typename Sched::Unit u;
    for (int ui = 0; S.next(ui, u); ++ui) {
        f32x4 acc[2][2][4][2];
#pragma unroll
        for (int a = 0; a < 2; ++a)
#pragma unroll
            for (int b = 0; b < 2; ++b)
#pragma unroll
                for (int m = 0; m < 4; ++m)
#pragma unroll
                    for (int n = 0; n < 2; ++n) acc[a][b][m][n] = (f32x4){0.f, 0.f, 0.f, 0.f};
        const char* A = S.a_base(u); const char* B = S.b_base(u);
        unsigned aoff[2][4], boff[2][2];
#pragma unroll
        for (int ai = 0; ai < 2; ++ai)
#pragma unroll
            for (int m = 0; m < 4; ++m) aoff[ai][m] = S.a_off(u, 128 * ai + 64 * wr + 16 * m + fr) + fq * 16;
#pragma unroll
        for (int bj = 0; bj < 2; ++bj)
#pragma unroll
            for (int n = 0; n < 2; ++n) { const int row = 128 * bj + 32 * wc + (Epi::PERM ? perm32(16 * n + fr) : 16 * n + fr); boff[bj][n] = (unsigned)(row * ldb) * 2u + fq * 16; }
        for (int k = 0; k < K; k += 32) {
            bf16x8 a[2][4], b[2][2];
#pragma unroll
            for (int ai = 0; ai < 2; ++ai)
#pragma unroll
                for (int m = 0; m < 4; ++m) a[ai][m] = *(const bf16x8*)(A + aoff[ai][m] + k * 2);
#pragma unroll
            for (int bj = 0; bj < 2; ++bj)
#pragma unroll
                for (int n = 0; n < 2; ++n) b[bj][n] = *(const bf16x8*)(B + boff[bj][n] + k * 2);
#pragma unroll
            for (int ai = 0; ai < 2; ++ai)
#pragma unroll
                for (int bj = 0; bj < 2; ++bj)
#pragma unroll
                    for (int m = 0; m < 4; ++m)
#pragma unroll
                        for (int n = 0; n < 2; ++n) acc[ai][bj][m][n] = __builtin_amdgcn_mfma_f32_16x16x32_bf16(b[bj][n], a[ai][m], acc[ai][bj][m][n], 0, 0, 0);
        }
        E(acc, u, wr, wc, fr, fq);
    }
}

template <class Epi, class Sched>
__device__ __forceinline__ void gemm_fast(LAS unsigned char* lds, const int K, const int ldb, const Sched& S, const Epi& E) {
    int tid0 = threadIdx.x; asm volatile("" : "+v"(tid0));
    const int tid = tid0, wid = __builtin_amdgcn_readfirstlane(tid >> 6), lane = tid & 63, wr = wid >> 2, wc = wid & 3, fr = lane & 15, fq = lane >> 4;
    int nt = K / BK; asm volatile("" : "+s"(nt));
    unsigned voffB[2];
#pragma unroll
    for (int i = 0; i < 2; ++i) { int R, C; stage_rc(tid * 16 + i * 8192, R, C); const int Rb = Epi::PERM ? ((R & ~31) + perm32(R & 31)) : R;
        voffB[i] = (unsigned)(Rb * ldb + C) * 2u; }
#define PG8_AOFF(u) do { int _tz = threadIdx.x; asm volatile("" : "+v"(_tz)); _Pragma("unroll") for (int _i = 0; _i < 2; ++_i) { int _R, _C; stage_rc(_tz * 16 + _i * 8192, _R, _C); \
        vA0[_i] = S.a_off(u, _R) + (unsigned)_C * 2u; vA1[_i] = S.a_off(u, HALF + _R) + (unsigned)_C * 2u; } } while (0)
    const size_t kstep = (size_t)(BK * 2);
    const size_t hstepB = (size_t)HALF * ldb * 2;
    const unsigned ldsw = (unsigned)wid * 1024u;
    const int aoff = lds_byte(wr * 64 + fr, fq * 8), boff = lds_byte(wc * 32 + fr, fq * 8);
#if MK_PROBE
#define PRB_NOW() __builtin_amdgcn_s_memrealtime()
#define PRB_ADD(IV, t0, t1) do { if (MK_PROBE == Epi::PID * 10 + (IV) && blockIdx.x == MK_PROBE_BLK && wid == MK_PROBE_WAVE && lane == 0) \
        __hip_atomic_fetch_add((LAS unsigned*)(lds + MISC_OFF + 48), (unsigned)((t1) - (t0)), __ATOMIC_RELAXED, __HIP_MEMORY_SCOPE_WORKGROUP); } while (0)
#else
#define PRB_NOW() 0ull
#define PRB_ADD(IV, t0, t1) do { } while (0)
#endif
#define PG8_SA(b, h) (((b) * 2 + (h)) * HTB)
#define PG8_SB(b, h) ((4 + (b) * 2 + (h)) * HTB)
#define PG8_STAGE(bufoff, gbase, voff) do { _Pragma("unroll") for (int _i = 0; _i < 2; ++_i) \
        __builtin_amdgcn_global_load_lds((const unsigned*)((const char*)(gbase) + (voff)[_i]), (LAS unsigned*)(lds + (bufoff) + ldsw + _i * 8192), 16, 0, 0); } while (0)
#define PG8_LDA(dst, b, h) do { _Pragma("unroll") for (int m = 0; m < 4; ++m) _Pragma("unroll") for (int k = 0; k < 2; ++k) dst[m][k] = *(const LAS bf16x8*)(lds + PG8_SA(b, h) + aoff + m * 2048 + k * 1024); } while (0)
#define PG8_LDB(dst, b, h) do { _Pragma("unroll") for (int n = 0; n < 2; ++n) _Pragma("unroll") for (int k = 0; k < 2; ++k) dst[n][k] = *(const LAS bf16x8*)(lds + PG8_SB(b, h) + boff + n * 2048 + k * 1024); } while (0)
#define PG8_MMA(ai, bj, At, Bt) do { __builtin_amdgcn_s_setprio(1); _Pragma("unroll") for (int m = 0; m < 4; ++m) _Pragma("unroll") for (int n = 0; n < 2; ++n) _Pragma("unroll") for (int k = 0; k < 2; ++k) { \
        if constexpr (Epi::FP8 && MK_MX) { if (k == 0) { \
            const i32x8 _a = __builtin_shufflevector(__builtin_bit_cast(i32x4, At[m][0]), __builtin_bit_cast(i32x4, At[m][1]), 0, 1, 2, 3, 4, 5, 6, 7); \
            const i32x8 _b = __builtin_shufflevector(__builtin_bit_cast(i32x4, Bt[n][0]), __builtin_bit_cast(i32x4, Bt[n][1]), 0, 1, 2, 3, 4, 5, 6, 7); \
            acc[ai][bj][m][n] = __builtin_amdgcn_mfma_scale_f32_16x16x128_f8f6f4(_b, _a, acc[ai][bj][m][n], 0, 0, 0, 0x7F7F7F7F, 0, 0x7F7F7F7F); } } \
        else if constexpr (Epi::FP8) { const l64x2 _a = __builtin_bit_cast(l64x2, At[m][k]), _b = __builtin_bit_cast(l64x2, Bt[n][k]); \
            acc[ai][bj][m][n] = __builtin_amdgcn_mfma_f32_16x16x32_fp8_fp8(_b[0], _a[0], acc[ai][bj][m][n], 0, 0, 0); \
            acc[ai][bj][m][n] = __builtin_amdgcn_mfma_f32_16x16x32_fp8_fp8(_b[1], _a[1], acc[ai][bj][m][n], 0, 0, 0); } \
        else acc[ai][bj][m][n] = __builtin_amdgcn_mfma_f32_16x16x32_bf16(Bt[n][k], At[m][k], acc[ai][bj][m][n], 0, 0, 0); } __builtin_amdgcn_s_setprio(0); } while (0)
#define PG8_WAIT_V(n) asm volatile("s_waitcnt vmcnt(" #n ")" ::: "memory")
#define PG8_WAIT_L(n) asm volatile("s_waitcnt lgkmcnt(" #n ")" ::: "memory")
#define PG8_BAR __builtin_amdgcn_s_barrier()
#define PG8_SCHED __builtin_amdgcn_sched_barrier(0)
    typename Sched::Unit cur, nxt; int ui = 0;
    if (!S.next(0, cur)) return;
    f32x4 acc[2][2][4][2];
#pragma unroll
    for (int a = 0; a < 2; ++a)
#pragma unroll
        for (int b = 0; b < 2; ++b)
#pragma unroll
            for (int m = 0; m < 4; ++m)
#pragma unroll
                for (int n = 0; n < 2; ++n) acc[a][b][m][n] = (f32x4){0.f, 0.f, 0.f, 0.f};
    bf16x8 At[4][2], B0[2][2], B1[2][2];
    const char* cA = S.a_base(cur); const char* cB = S.b_base(cur);
    unsigned vA0[2], vA1[2];
    PG8_AOFF(cur);
    PG8_STAGE(PG8_SB(0, 0), cB, voffB); PG8_STAGE(PG8_SA(0, 0), cA, vA0); PG8_STAGE(PG8_SB(0, 1), cB + hstepB, voffB); PG8_STAGE(PG8_SA(0, 1), cA, vA1);
    if (wr == 1) PG8_BAR;
    PG8_WAIT_V(4); PG8_BAR;
    PG8_STAGE(PG8_SB(1, 0), cB + kstep, voffB); PG8_STAGE(PG8_SA(1, 0), cA + kstep, vA0); PG8_STAGE(PG8_SB(1, 1), cB + hstepB + kstep, voffB);
    PG8_WAIT_V(6); PG8_BAR;
    for (;;) {
        const unsigned long long prb_a = PRB_NOW();
        const bool has_next = S.next(ui + 1, nxt);
        const char* nA = has_next ? S.a_base(nxt) : cA; const char* nB = has_next ? S.b_base(nxt) : cB;
        const unsigned long long prb_b = PRB_NOW(); PRB_ADD(1, prb_a, prb_b);
        for (int t = 0; t < nt; t += 2) {
            const unsigned long long prb_i0 = PRB_NOW();
            const bool last = (t == nt - 2);
            const char* a1 = cA + (size_t)(t + 1) * kstep;
            const char* a2 = last ? nA : cA + (size_t)(t + 2) * kstep; const char* b2 = last ? nB : cB + (size_t)(t + 2) * kstep;
            const char* a3 = a2 + kstep; const char* b3 = b2 + kstep;
            PG8_LDB(B0, 0, 0); PG8_SCHED; PG8_LDA(At, 0, 0); PG8_STAGE(PG8_SA(1, 1), a1, vA1);
            if (last && has_next) PG8_AOFF(nxt);
            PG8_WAIT_L(8); PG8_BAR; PG8_WAIT_L(0); PG8_MMA(0, 0, At, B0); PG8_BAR; PG8_SCHED;
            PG8_LDB(B1, 0, 1); PG8_STAGE(PG8_SB(0, 0), b2, voffB);
            PG8_BAR; PG8_WAIT_L(0); PG8_MMA(0, 1, At, B1); PG8_BAR;
            PG8_LDA(At, 0, 1); PG8_STAGE(PG8_SA(0, 0), a2, vA0);
            PG8_BAR; PG8_WAIT_L(0); PG8_MMA(1, 0, At, B0); PG8_BAR; PG8_SCHED;
            PG8_STAGE(PG8_SB(0, 1), b2 + hstepB, voffB);
            PG8_WAIT_V(6); PG8_BAR; PG8_MMA(1, 1, At, B1); PG8_BAR;
            PG8_LDB(B0, 1, 0); PG8_SCHED; PG8_LDA(At, 1, 0); PG8_STAGE(PG8_SA(0, 1), a2, vA1);
            PG8_WAIT_L(8); PG8_BAR; PG8_WAIT_L(0); PG8_MMA(0, 0, At, B0); PG8_BAR; PG8_SCHED;
            PG8_LDB(B1, 1, 1); PG8_STAGE(PG8_SB(1, 0), b3, voffB);
            PG8_BAR; PG8_WAIT_L(0); PG8_MMA(0, 1, At, B1); PG8_BAR;
            PG8_LDA(At, 1, 1); PG8_STAGE(PG8_SA(1, 0), a3, vA0);
            PG8_BAR; PG8_WAIT_L(0); PG8_MMA(1, 0, At, B0); PG8_BAR; PG8_SCHED;
            PG8_STAGE(PG8_SB(1, 1), b3 + hstepB, voffB);
            PG8_WAIT_V(6); PG8_BAR; PG8_MMA(1, 1, At, B1); PG8_BAR;
            { const unsigned long long prb_i1 = PRB_NOW(); if (t == 0) PRB_ADD(4, prb_i0, prb_i1); if (last) PRB_ADD(5, prb_i0, prb_i1); if (t != 0 && !last) PRB_ADD(6, prb_i0, prb_i1); }
        }
        const unsigned long long prb_c = PRB_NOW(); PRB_ADD(2, prb_b, prb_c);
        { int tz = threadIdx.x; asm volatile("" : "+v"(tz)); const int wz = tz >> 6, lz = tz & 63;
          E(acc, cur, wz >> 2, wz & 3, lz & 15, lz >> 4);
#if defined(MK_EPI_TWICE)
          if (Epi::TWICE) { asm volatile("" ::: "memory"); E(acc, cur, wz >> 2, wz & 3, lz & 15, lz >> 4); }
#endif
          }
        { const unsigned long long prb_d = PRB_NOW(); PRB_ADD(3, prb_c, prb_d); }
        if (!has_next) break;
#pragma unroll
        for (int a = 0; a < 2; ++a)
#pragma unroll
            for (int b = 0; b < 2; ++b)
#pragma unroll
                for (int m = 0; m < 4; ++m)
#pragma unroll
                    for (int n = 0; n < 2; ++n) acc[a][b][m][n] = (f32x4){0.f, 0.f, 0.f, 0.f};
        cur = nxt; cA = nA; cB = nB; ++ui;
    }
    PG8_WAIT_V(0);
    if (wr == 0) PG8_BAR;
    PG8_BAR;
#undef PG8_AOFF
#undef PRB_NOW
#undef PRB_ADD
#undef PG8_SA
#undef PG8_SB
#undef PG8_STAGE
#undef PG8_LDA
#undef PG8_LDB
#undef PG8_MMA
#undef PG8_WAIT_V
#undef PG8_WAIT_L
#undef PG8_BAR
#undef PG8_SCHED
}

template <class Epi, class Sched>
__device__ __forceinline__ void gemm_phase(LAS unsigned char* lds, const int K, const int ldb, const Sched& S, const Epi& E) {
#if MK_FAST_GEMM
    gemm_fast<Epi, Sched>(lds, K, ldb, S, E);
#else
    gemm_simple<Epi, Sched>(K, ldb, S, E);
#endif
}

struct DenseUnit { int pm, pn, ks; };
template <int NM, int NN, int KSPLIT>
struct DenseSchedT {
    typedef DenseUnit Unit;
    const char* A; const char* B; int lda2, ldb2, ksub2, G, c, i0, i1;
    __device__ __forceinline__ void init(const void* A_, const void* B_, int lda, int ldb, int Ksub, int G_, int c_) {
        A = (const char*)A_; B = (const char*)B_; lda2 = lda * 2; ldb2 = ldb * 2; ksub2 = Ksub * 2; G = G_; c = c_; i0 = 0; i1 = 0x3fffffff; }
    __device__ __forceinline__ bool next(int i, Unit& u) const {
        constexpr int nwg = NM * NN, total = nwg * KSPLIT;
        if (i + i0 >= i1) return false;
        const int L = (i + i0) * G + c; if (L >= total) return false;
        int id = L / KSPLIT; u.ks = L - id * KSPLIT;
        { constexpr int q = nwg / 8, r = nwg % 8; const int xcd = id % 8, off = id / 8; id = (xcd < r ? xcd * (q + 1) : r * (q + 1) + (xcd - r) * q) + off; }
        constexpr int nig = 8 * NN; const int gid = id / nig, fm = gid * 8, gsz = (NM - fm) < 8 ? (NM - fm) : 8;
        u.pm = fm + ((id % nig) % gsz); u.pn = (id % nig) / gsz; return true;
    }
    __device__ __forceinline__ const char* a_base(const Unit& u) const { return A + (size_t)u.pm * 256 * lda2 + (size_t)u.ks * ksub2; }
    __device__ __forceinline__ const char* b_base(const Unit& u) const { return B + (size_t)u.pn * 256 * ldb2 + (size_t)u.ks * ksub2; }
    __device__ __forceinline__ unsigned a_off(const Unit&, int r) const { return (unsigned)(r * lda2); }
};

template <int PN, bool DOWN>
struct MoeSched {
    struct Unit { int kind, e, rb, blk, valid, pm, pn; };
    const LAS int* prefix; const LAS int* cnt; const unsigned* bucket;
    const char* Ar; const char* As; const char* Br; const char* Bs;
    int nRouted, total, G, c, i0, i1;
    __device__ __forceinline__ bool next(int i, Unit& u) const {
        if (i + i0 >= i1) return false;
        const int id = (i + i0) * G + c; if (id >= total) return false;
        u.e = 0; u.rb = 0; u.blk = 0; u.pm = 0;
        if (id < nRouted) {
            const int blk = id / PN; u.pn = id % PN;
            const int lo = ((const LAS unsigned char*)(cnt + 256))[blk];
            u.kind = 0; u.e = lo; u.rb = blk - prefix[lo]; u.blk = blk; const int rem = cnt[lo] - u.rb * 256; u.valid = rem < 256 ? rem : 256;
        } else { const int s = id - nRouted; u.kind = 1; u.pm = s / PN; u.pn = s % PN; u.valid = 256; }
        return true;
    }
    __device__ __forceinline__ const char* a_base(const Unit& u) const { return u.kind == 0 ? Ar : As; }
    __device__ __forceinline__ const char* b_base(const Unit& u) const {
        if (!DOWN) return u.kind == 0 ? Br + ((size_t)u.e * 512 + (size_t)u.pn * 256) * D : Bs + (size_t)u.pn * 256 * D;
        else       return u.kind == 0 ? Br + ((size_t)u.e * 1024 + (size_t)u.pn * 256) * FF : Bs + (size_t)u.pn * 256 * FF;
    }
    __device__ __forceinline__ unsigned a_off(const Unit& u, int r) const {
        if (!DOWN) {
            if (u.kind == 0) { const int rr = r < u.valid ? r : u.valid - 1; const unsigned slot = bucket[(size_t)u.e * CAP + u.rb * 256 + rr]; return (slot >> 3) * (unsigned)D; }
            return (unsigned)(u.pm * 256 + r) * (unsigned)D;
        } else {
            return (unsigned)((u.kind == 0 ? u.blk : u.pm) * 256 + r) * (unsigned)FF;
        }
    }
};

struct EpiProj {
    static constexpr int PID = 2;
    static constexpr bool PERM = true, TWICE = false, FP8 = false;
    bf16* O;
    __device__ __forceinline__ void operator()(const f32x4 (&acc)[2][2][4][2], const DenseUnit& u, int wr, int wc, int fr, int fq) const {
        const int row0 = u.pm * 256 + wr * 64 + fr, col0 = u.pn * 256 + wc * 32 + 8 * fq;
#pragma unroll
        for (int ai = 0; ai < 2; ++ai)
#pragma unroll
            for (int m = 0; m < 4; ++m) { bf16* rowp = O + (size_t)(row0 + ai * 128 + m * 16) * NPROJ + col0;
#pragma unroll
                for (int bj = 0; bj < 2; ++bj) { const f32x4 v0 = acc[ai][bj][m][0], v1 = acc[ai][bj][m][1];
                    *(v4u*)(rowp + bj * 128) = (v4u){pk2(v0[0], v0[1]), pk2(v0[2], v0[3]), pk2(v1[0], v1[1]), pk2(v1[2], v1[3])}; } }
    }
};
struct EpiOut {
    static constexpr int PID = 5;
    static constexpr bool PERM = true, TWICE = false, FP8 = false;
    bf16* O;
    __device__ __forceinline__ void operator()(const f32x4 (&acc)[2][2][4][2], const DenseUnit& u, int wr, int wc, int fr, int fq) const {
        const int row0 = u.pm * 256 + wr * 64 + fr, col0 = u.pn * 256 + wc * 32 + 8 * fq;
#pragma unroll
        for (int ai = 0; ai < 2; ++ai)
#pragma unroll
            for (int m = 0; m < 4; ++m) { bf16* rowp = O + (size_t)(row0 + ai * 128 + m * 16) * (2 * D) + col0;
#pragma unroll
                for (int bj = 0; bj < 2; ++bj) { const f32x4 v0 = acc[ai][bj][m][0], v1 = acc[ai][bj][m][1];
                    *(v4u*)(rowp + bj * 128) = (v4u){pk2(v0[0], v0[1]), pk2(v0[2], v0[3]), pk2(v1[0], v1[1]), pk2(v1[2], v1[3])}; } }
    }
};
struct EpiRouter {
    static constexpr int PID = 7;
    static constexpr bool PERM = false, TWICE = false, FP8 = false;
    float* L;
    __device__ __forceinline__ void operator()(const f32x4 (&acc)[2][2][4][2], const DenseUnit& u, int wr, int wc, int fr, int fq) const {
        const int row0 = u.pm * 256 + wr * 64 + fr, col0 = wc * 32 + 4 * fq;
        float* Lp = L + (size_t)u.ks * NT * NE;
#pragma unroll
        for (int ai = 0; ai < 2; ++ai)
#pragma unroll
            for (int m = 0; m < 4; ++m) { const size_t ro = (size_t)(row0 + ai * 128 + m * 16) * NE + col0;
#pragma unroll
                for (int bj = 0; bj < 2; ++bj)
#pragma unroll
                    for (int n = 0; n < 2; ++n) *(f32x4*)(Lp + ro + bj * 128 + n * 16) = acc[ai][bj][m][n]; }
    }
};
struct EpiGU {
    static constexpr int PID = 9;
    static constexpr bool PERM = true, TWICE = false, FP8 = true;
    unsigned char* act; unsigned char* acts; const unsigned* bucket; unsigned* pos;
    __device__ __forceinline__ void operator()(const f32x4 (&acc)[2][2][4][2], const MoeSched<2, false>::Unit& u, int wr, int wc, int fr, int fq) const {
        unsigned char* O = u.kind == 0 ? act : acts;
        const int row0 = (u.kind == 0 ? u.blk : u.pm) * 256 + wr * 64 + fr, col0 = u.pn * 128 + wc * 32 + 8 * fq;
        if (u.kind == 0 && u.pn == 0 && wc == 0 && fq == 0) {
#pragma unroll
            for (int ai = 0; ai < 2; ++ai)
#pragma unroll
                for (int m = 0; m < 4; ++m) { const int r = ai * 128 + wr * 64 + m * 16 + fr;
                    if (r < u.valid) pos[bucket[(size_t)u.e * CAP + u.rb * 256 + r]] = (unsigned)(u.blk * 256 + r); } }
#pragma unroll
        for (int ai = 0; ai < 2; ++ai)
#pragma unroll
            for (int m = 0; m < 4; ++m) {
                const f32x4 g0 = acc[ai][0][m][0], g1 = acc[ai][0][m][1], u0 = acc[ai][1][m][0], u1 = acc[ai][1][m][1];
                float a[8];
#pragma unroll
                for (int j = 0; j < 4; j += 2) {
                    const f32x2 ga = (f32x2){g0[j], g0[j + 1]} * W_INV_SCALE, gb = (f32x2){g1[j], g1[j + 1]} * W_INV_SCALE;
                    const f32x2 ua = (f32x2){u0[j], u0[j + 1]} * (W_INV_SCALE * ACT_SCALE), ub = (f32x2){u1[j], u1[j + 1]} * (W_INV_SCALE * ACT_SCALE);
                    const f32x2 ea = ga * (-1.44269504f), eb = gb * (-1.44269504f);
                    f32x2 da, db; da.x = __builtin_amdgcn_exp2f(ea.x); da.y = __builtin_amdgcn_exp2f(ea.y); db.x = __builtin_amdgcn_exp2f(eb.x); db.y = __builtin_amdgcn_exp2f(eb.y);
                    da = da + 1.0f; db = db + 1.0f;
                    f32x2 ra, rb; ra.x = __builtin_amdgcn_rcpf(da.x); ra.y = __builtin_amdgcn_rcpf(da.y); rb.x = __builtin_amdgcn_rcpf(db.x); rb.y = __builtin_amdgcn_rcpf(db.y);
                    const f32x2 oa = (ga * ua) * ra, ob = (gb * ub) * rb;
                    a[j] = oa.x; a[j + 1] = oa.y; a[4 + j] = ob.x; a[4 + j + 1] = ob.y; }
                *(v2u*)(O + (size_t)(row0 + ai * 128 + m * 16) * FF + col0) = (v2u){pk4_fp8(a[0], a[1], a[2], a[3]), pk4_fp8(a[4], a[5], a[6], a[7])};
                __builtin_amdgcn_sched_barrier(0);
            }
    }
};
constexpr float Y_SCALE = 8.f, Y_INV_SCALE = 0.125f;
struct EpiDown {
    static constexpr int PID = 10;
    static constexpr bool PERM = true, TWICE = false, FP8 = true;
    unsigned char* Y; bf16* O;
    __device__ __forceinline__ void operator()(const f32x4 (&acc)[2][2][4][2], const MoeSched<4, true>::Unit& u, int wr, int wc, int fr, int fq) const {
        const int col0 = u.pn * 256 + wc * 32 + 8 * fq;
        if (u.kind == 0) {
            const int row0 = u.blk * 256 + wr * 64 + fr;
#pragma unroll
            for (int ai = 0; ai < 2; ++ai)
#pragma unroll
                for (int m = 0; m < 4; ++m) { unsigned char* rowp = Y + (size_t)(row0 + ai * 128 + m * 16) * D + col0;
#pragma unroll
                    for (int bj = 0; bj < 2; ++bj) { f32x4 v0 = acc[ai][bj][m][0] * (Y_SCALE * W_INV_SCALE / ACT_SCALE), v1 = acc[ai][bj][m][1] * (Y_SCALE * W_INV_SCALE / ACT_SCALE);
#pragma unroll
                        for (int j = 0; j < 4; ++j) { v0[j] = __builtin_amdgcn_fmed3f(v0[j], -448.f, 448.f); v1[j] = __builtin_amdgcn_fmed3f(v1[j], -448.f, 448.f); }
                        int w0 = __builtin_amdgcn_cvt_pk_fp8_f32(v0[0], v0[1], 0, false); w0 = __builtin_amdgcn_cvt_pk_fp8_f32(v0[2], v0[3], w0, true);
                        int w1 = __builtin_amdgcn_cvt_pk_fp8_f32(v1[0], v1[1], 0, false); w1 = __builtin_amdgcn_cvt_pk_fp8_f32(v1[2], v1[3], w1, true);
                        *(v2u*)(rowp + bj * 128) = (v2u){(unsigned)w0, (unsigned)w1}; } }
        } else {
            const int row0 = u.pm * 256 + wr * 64 + fr;
#pragma unroll
            for (int ai = 0; ai < 2; ++ai)
#pragma unroll
                for (int m = 0; m < 4; ++m) { bf16* rowp = O + (size_t)(row0 + ai * 128 + m * 16) * (2 * D) + D + col0;
#pragma unroll
                    for (int bj = 0; bj < 2; ++bj) { const f32x4 v0 = acc[ai][bj][m][0] * (W_INV_SCALE / ACT_SCALE), v1 = acc[ai][bj][m][1] * (W_INV_SCALE / ACT_SCALE);
                        *(v4u*)(rowp + bj * 128) = (v4u){pk2(v0[0], v0[1]), pk2(v0[2], v0[3]), pk2(v1[0], v1[1]), pk2(v1[2], v1[3])}; } }
        }
    }
};

struct Args { const float* in[19]; float* out; unsigned char* ws; int ph_lo, ph_hi; };

struct Frame {
    LAS unsigned char* lds; int tid, lane, wave, G, bid;
    float* out; unsigned char* ws;
};

__device__ __forceinline__ void titem_load(const float* W, int N, int kb, int nb, int lane, float (&v)[32]) {
    const float* Wu = W + (size_t)(64 * kb) * N + 32 * nb;
    const unsigned loff = (unsigned)((lane >> 5) * N + (lane & 31)) * 4u;
#pragma unroll
    for (int i = 0; i < 32; ++i) v[i] = *(const float*)((const char*)(Wu + (size_t)(2 * i) * N) + loff);
}
template <bool FP8>
__device__ __forceinline__ void titem_store(const float (&v)[32], int K, void* WTv, int kb, int dst_row0, LAS float* scr, int lane) {
    const int k0 = 64 * kb;
#pragma unroll
    for (int i = 0; i < 32; ++i) { const int kk = 2 * i + (lane >> 5); scr[kk * 33 + (lane & 31)] = v[i]; }
    asm volatile("s_waitcnt lgkmcnt(0)" ::: "memory");
    const int c = lane & 7;
#pragma unroll
    for (int j = 0; j < 4; ++j) { const int n = (lane >> 3) + 8 * j; const LAS float* s = scr + (8 * c) * 33 + n;
        if (FP8) { v2u o; o.x = pk4_fp8(s[0 * 33] * W_SCALE, s[1 * 33] * W_SCALE, s[2 * 33] * W_SCALE, s[3 * 33] * W_SCALE);
            o.y = pk4_fp8(s[4 * 33] * W_SCALE, s[5 * 33] * W_SCALE, s[6 * 33] * W_SCALE, s[7 * 33] * W_SCALE);
            *(v2u*)((unsigned char*)WTv + (size_t)(dst_row0 + n) * K + k0 + 8 * c) = o; }
        else { v4u o; o.x = pk2(s[0 * 33], s[1 * 33]); o.y = pk2(s[2 * 33], s[3 * 33]); o.z = pk2(s[4 * 33], s[5 * 33]); o.w = pk2(s[6 * 33], s[7 * 33]);
            *(v4u*)((bf16*)WTv + (size_t)(dst_row0 + n) * K + k0 + 8 * c) = o; } }
    asm volatile("s_waitcnt lgkmcnt(0)" ::: "memory");
}
template <bool FP8>
__device__ __forceinline__ void transpose_item(const float* W, int K, int N, void* WT, int kb, int nb, int dst_row0, LAS float* scr, int lane) {
    float v[32]; titem_load(W, N, kb, nb, lane, v); titem_store<FP8>(v, K, WT, kb, dst_row0, scr, lane);
}
template <bool DOWN>
__device__ __forceinline__ void convert_expert(Frame& F, const float* Wa, const float* Wb, unsigned char* dst) {
    LAS float* scr = (LAS float*)(F.lds + F.wave * 16384);
    constexpr int PER_WAVE = DOWN ? 16 : 32;
    const int base = 0, wv = F.wave;
    auto ld = [&](int i, float (&v)[32]) {
        if (!DOWN) titem_load((i >> 4) ? Wb : Wa, FF, i & 15, wv, F.lane, v);
        else titem_load(Wa, D, i >> 2, wv + 8 * (i & 3), F.lane, v); };
    auto st = [&](int i, const float (&v)[32]) {
        if (!DOWN) { const int n0 = wv * 32; titem_store<true>(v, D, dst, i & 15, (n0 >> 7) * 256 + ((i >> 4) ? 128 : 0) + (n0 & 127), scr, F.lane); }
        else titem_store<true>(v, FF, dst, i >> 2, (wv + 8 * (i & 3)) * 32, scr, F.lane); };
    float v0[32], v1[32], v2[32], v3[32];
    ld(base, v0); ld(base + 1, v1); ld(base + 2, v2);
    for (int i = 0; i < PER_WAVE; i += 4) {
        ld(base + i + 3, v3); st(base + i, v0);
        if (i + 4 < PER_WAVE) ld(base + i + 4, v0);
        st(base + i + 1, v1);
        if (i + 5 < PER_WAVE) ld(base + i + 5, v1);
        st(base + i + 2, v2);
        if (i + 6 < PER_WAVE) ld(base + i + 6, v2);
        st(base + i + 3, v3);
    }
}

__device__ __forceinline__ void p0_prologue(Frame& F) {
#define INP(i) ld_ptr(F.lds, (i))
    if (F.bid < 192) {
        const float* cptr = INP(1); const float* w_ada = INP(2); const float* b_ada = INP(3);
        LAS float* cs = (LAS float*)F.lds;
        LAS float* red = (LAS float*)(F.lds + 32768);
        for (int i = F.tid; i < NB * D; i += NTHREADS) { const float v = cptr[i]; cs[i] = v / (1.f + __expf(-v)); }
        __syncthreads();
        const int col = F.tid & 31, kg = F.tid >> 5, j = F.bid * 32 + col;
        float a[NB];
#pragma unroll
        for (int b = 0; b < NB; ++b) a[b] = 0.f;
#pragma unroll 8
        for (int kk = 0; kk < 64; ++kk) { const int k = kg * 64 + kk; const float w = w_ada[(size_t)k * 6144 + j];
#pragma unroll
            for (int b = 0; b < NB; ++b) a[b] += cs[b * D + k] * w; }
#pragma unroll
        for (int b = 0; b < NB; ++b) red[(kg * NB + b) * 32 + col] = a[b];
        __syncthreads();
        if (F.tid < 256) { const int b = F.tid >> 5, cc = F.tid & 31; float s = 0.f;
#pragma unroll
            for (int g = 0; g < 16; ++g) s += red[(g * NB + b) * 32 + cc];
            ((float*)(F.ws + WS_MOD))[b * 6144 + F.bid * 32 + cc] = s + b_ada[F.bid * 32 + cc]; }
        __syncthreads();
    }
    LAS float* scr = (LAS float*)(F.lds + F.wave * 16384);
    const int gw = F.bid * NWAVES + F.wave, NGW = F.G * NWAVES;
    constexpr int I_IN = 16 * 80, I_OUT = 8 * 32, I_R = 16 * 8, I_G = 16 * 8, I_D = 4 * 32;
    constexpr int I_SMALL = I_IN + I_OUT + I_R + 2 * I_G + I_D, I_EXP = 2 * I_G + I_D;
    constexpr int NITEMS = I_SMALL;
    unsigned char* win_t = F.ws + WS_WIN_T; bf16* wout_t = (bf16*)(F.ws + WS_WOUT_T); bf16* wr_t = (bf16*)(F.ws + WS_WR_T);
    unsigned char* wsgu_t = F.ws + WS_WSGU_T; unsigned char* wsd_t = F.ws + WS_WSD_T; unsigned char* wgu_t = F.ws + WS_WGU_T; unsigned char* wd_t = F.ws + WS_WD_T;
    for (int it = gw; it < NITEMS; it += NGW) {
        int r = it;
        if (r < I_IN) { transpose_item<false>(INP(5), D, NPROJ, win_t, r / 80, r % 80, (r % 80) * 32, scr, F.lane); continue; } r -= I_IN;
        if (r < I_OUT) { transpose_item<false>(INP(8), NMIX, D, wout_t, r / 32, r % 32, (r % 32) * 32, scr, F.lane); continue; } r -= I_OUT;
        if (r < I_R) { transpose_item<false>(INP(10), D, NE, wr_t, r / 8, r % 8, (r % 8) * 32, scr, F.lane); continue; } r -= I_R;
        const float *Wg, *Wu, *Wd; unsigned char *GU, *DN;
        if (r < 2 * I_G + I_D) { Wg = INP(15); Wu = INP(16); Wd = INP(17); GU = wsgu_t; DN = wsd_t; }
        else { r -= 2 * I_G + I_D; const int e = r / I_EXP; r -= e * I_EXP;
            Wg = INP(12) + (size_t)e * D * FF; Wu = INP(13) + (size_t)e * D * FF; Wd = INP(14) + (size_t)e * FF * D;
            GU = wgu_t + (size_t)e * 512 * D; DN = wd_t + (size_t)e * D * FF; }
        if (r < I_G) { const int nb = r % 8, n0 = nb * 32; transpose_item<true>(Wg, D, FF, GU, r / 8, nb, (n0 >> 7) * 256 + (n0 & 127), scr, F.lane); continue; } r -= I_G;
        if (r < I_G) { const int nb = r % 8, n0 = nb * 32; transpose_item<true>(Wu, D, FF, GU, r / 8, nb, (n0 >> 7) * 256 + 128 + (n0 & 127), scr, F.lane); continue; } r -= I_G;
        transpose_item<true>(Wd, FF, D, DN, r / 32, r % 32, (r % 32) * 32, scr, F.lane);
    }
#undef INP
}

template <bool HAS_DX, bool OUT8, bool OUTB>
__device__ __forceinline__ void modnorm_phase(Frame& F, const float* X, const float* g, int shift_chunk, unsigned char* O8, bf16* Ob) {
    const float* mod = (const float*)(F.ws + WS_MOD);
    constexpr int RW = 4;
    const unsigned l16 = (unsigned)F.lane * 16u, l8 = (unsigned)F.lane * 8u, l4 = (unsigned)F.lane * 4u;
    const int wv = __builtin_amdgcn_readfirstlane(F.wave);
    for (int blk = F.bid; blk < NT / 128; blk += F.G) {
        const int b = (blk * 128) >> 12;
        const float* sh = mod + (size_t)b * 6144 + shift_chunk * D; const float* sc = sh + D; const float* g1 = mod + (size_t)b * 6144 + 2 * D;
        f32x4 gg[4], ss[4], ga[4];
#pragma unroll
        for (int j = 0; j < 4; ++j) { const f32x4 gv = *(const f32x4*)((const char*)g + 1024 * j + l16), scv = *(const f32x4*)((const char*)sc + 1024 * j + l16);
            gg[j] = gv * (scv + 1.f); ss[j] = *(const f32x4*)((const char*)sh + 1024 * j + l16); ga[j] = HAS_DX ? *(const f32x4*)((const char*)g1 + 1024 * j + l16) : (f32x4){0.f, 0.f, 0.f, 0.f}; }
#pragma nounroll
        for (int rr = 0; rr < 16; rr += RW) {
            const int row = blk * 128 + wv * 16 + rr;
            f32x4 v[RW][4]; v2u dv[RW][4];
#pragma unroll
            for (int q = 0; q < RW; ++q) { const char* xr = (const char*)(X + (size_t)(row + q) * D);
#pragma unroll
                for (int j = 0; j < 4; ++j) v[q][j] = *(const f32x4*)(xr + 1024 * j + l16);
                if (HAS_DX) { const char* dr = (const char*)F.out + (size_t)(row + q) * (4 * D);
#pragma unroll
                    for (int j = 0; j < 4; ++j) dv[q][j] = *(const v2u*)(dr + 512 * j + l8); } }
#pragma unroll
            for (int q = 0; q < RW; ++q) { float s = 0.f;
#pragma unroll
                for (int j = 0; j < 4; ++j) {
                    if (HAS_DX) v[q][j] = v[q][j] + ga[j] * (f32x4){bflo(dv[q][j].x), bfhi(dv[q][j].x), bflo(dv[q][j].y), bfhi(dv[q][j].y)};
                    s += (v[q][j].x * v[q][j].x + v[q][j].y * v[q][j].y) + (v[q][j].z * v[q][j].z + v[q][j].w * v[q][j].w); }
                const float rstd = 1.f / sqrtf(wave_sum(s) * (1.f / D) + NORM_EPS);
                char* o8 = (char*)O8 + (size_t)(row + q) * D; char* ob = (char*)Ob + (size_t)(row + q) * (2 * D);
#pragma unroll
                for (int j = 0; j < 4; ++j) { const f32x4 y = v[q][j] * rstd * gg[j] + ss[j]; if (OUT8) *(unsigned*)(o8 + 256 * j + l4) = pk4_fp8(y.x, y.y, y.z, y.w);
                    if (OUTB) *(v2u*)(ob + 512 * j + l8) = (v2u){pk2(y.x, y.y), pk2(y.z, y.w)}; } }
        }
    }
}

__device__ __forceinline__ void pool_phase(Frame& F, const float* pool_w, const float* pool_scale) {
    const bf16* proj = (const bf16*)(F.ws + WS_PROJ); bf16* mixin = (bf16*)(F.ws + WS_MIXIN);
    LAS float* us = (LAS float*)F.lds;
    LAS float* pl = (LAS float*)(F.lds + 49152);
    for (int tile = F.bid; tile < NT / 32; tile += F.G) {
        const int row0 = tile * 32, tl0 = row0 & (SEQ - 1);
        __syncthreads();
        for (int p = F.tid; p < 47 * 32; p += NTHREADS) { const int rr = p >> 5, pc = p & 31; const int tl = tl0 - 15 + rr;
            v4u raw = (v4u){0u, 0u, 0u, 0u};
            if (tl >= 0) raw = *(const v4u*)(proj + (size_t)(row0 - 15 + rr) * NPROJ + pc * 8);
            LAS float* d = us + rr * 256 + pc * 8;
            d[0] = bflo(raw.x); d[1] = bfhi(raw.x); d[2] = bflo(raw.y); d[3] = bfhi(raw.y); d[4] = bflo(raw.z); d[5] = bfhi(raw.z); d[6] = bflo(raw.w); d[7] = bfhi(raw.w); }
        __syncthreads();
        { const int ch = F.tid & 255, half = F.tid >> 8, w = 2 << (ch >> 6);
            for (int i = 0; i < 16; ++i) { const int tt = half * 16 + i, tl = tl0 + tt; float s = 0.f;
                for (int k = 0; k < w; ++k) s += us[(15 + tt - k) * 256 + ch];
                const int cnt = (tl + 1) < w ? (tl + 1) : w;
                pl[tt * 256 + ch] = s / (float)cnt - us[(15 + tt) * 256 + ch]; } }
        __syncthreads();
        { const int col = F.tid & 255, half = F.tid >> 8, g = col >> 6, dc = col & 63;
            float acc[16];
#pragma unroll
            for (int i = 0; i < 16; ++i) acc[i] = 0.f;
            const float* pw = pool_w + (size_t)g * 64 * 64 + dc;
            for (int c4 = 0; c4 < 64; c4 += 4) {
                const float w0 = pw[(c4 + 0) * 64], w1 = pw[(c4 + 1) * 64], w2 = pw[(c4 + 2) * 64], w3 = pw[(c4 + 3) * 64];
#pragma unroll
                for (int i = 0; i < 16; ++i) { const f32x4 p = *(const LAS f32x4*)(pl + (half * 16 + i) * 256 + g * 64 + c4);
                    acc[i] += p.x * w0 + p.y * w1 + p.z * w2 + p.w * w3; } }
            const float sc = pool_scale[col];
#pragma unroll
            for (int i = 0; i < 16; ++i) mixin[(size_t)(row0 + half * 16 + i) * NMIX + col] = (bf16)f2bf(acc[i] * sc); }
    }
}

constexpr int KV_PITCH = 144;
__device__ __forceinline__ void attn_phase(Frame& F) {
    const bf16* proj = (const bf16*)(F.ws + WS_PROJ);
    bf16* atto = (bf16*)(F.ws + WS_ATTO); float* lse = (float*)(F.ws + WS_LSE);
    LAS unsigned char* Ks = F.lds; LAS unsigned char* Vs = F.lds + 256 * KV_PITCH;
    const int lane = F.lane, fr = lane & 15, fq = lane >> 4, w = F.wave;
    const int w_i0 = 16 * w, c0 = w >> 1, qi = w_i0 + fr;
#define ATT_DECODE(unit_, rowb_, d_, r_, n_, g_, h_, colQ_) \
        const int rn_##unit_ = (unit_) & 31; const int h_ = ((unit_) >> 5) & 3, g_ = ((unit_) >> 7) % 3; const size_t rowb_ = (size_t)((unit_) / 384) * SEQ; \
        const int d_ = 1 << (2 * g_), nbk_##unit_ = 32 >> (2 * g_), r_ = rn_##unit_ / nbk_##unit_, n_ = rn_##unit_ % nbk_##unit_; const int colQ_ = 256 + g_ * 256 + h_ * 64;
    v4u kreg[4], vreg[4]; bf16x8 qn[2];
    {   const int unit0 = F.bid;
        if (unit0 < NB * 3 * 4 * 32) { ATT_DECODE(unit0, rowb, d, r, n, g, h, colQ)
            const size_t qrow = rowb + (size_t)(n * 128 + qi) * d + r;
#pragma unroll
            for (int ks = 0; ks < 2; ++ks) qn[ks] = *(const bf16x8*)(proj + qrow * NPROJ + colQ + ks * 32 + fq * 8);
#pragma unroll
            for (int cidx = 0; cidx < 4; ++cidx) { const int ch = F.tid + 512 * cidx, j = ch >> 3, pc = ch & 7;
                int p = (n - 1) * 128 + j; p = p < 0 ? 0 : p; const size_t row = rowb + (size_t)p * d + r;
                kreg[cidx] = *(const v4u*)(proj + row * NPROJ + colQ + 768 + pc * 8); vreg[cidx] = *(const v4u*)(proj + row * NPROJ + colQ + 1536 + pc * 8); } } }
    for (int unit = F.bid; unit < NB * 3 * 4 * 32; unit += F.G) {
        ATT_DECODE(unit, rowb, d, r, n, g, h, colQ)
        __syncthreads();
#pragma unroll
        for (int cidx = 0; cidx < 4; ++cidx) { const int ch = F.tid + 512 * cidx, j = ch >> 3, pc = ch & 7;
            *(LAS v4u*)(Ks + j * KV_PITCH + pc * 16) = kreg[cidx]; *(LAS v4u*)(Vs + j * KV_PITCH + pc * 16) = vreg[cidx]; }
        const size_t qrow = rowb + (size_t)(n * 128 + qi) * d + r;
        bf16x8 qf[2]; qf[0] = qn[0]; qf[1] = qn[1];
        __syncthreads();
        {   const int unit2 = unit + F.G;
            if (unit2 < NB * 3 * 4 * 32) { ATT_DECODE(unit2, rowb2, d2, r2, n2, g2, h2, colQ2)
                const size_t qrow2 = rowb2 + (size_t)(n2 * 128 + qi) * d2 + r2;
#pragma unroll
                for (int ks = 0; ks < 2; ++ks) qn[ks] = *(const bf16x8*)(proj + qrow2 * NPROJ + colQ2 + ks * 32 + fq * 8);
#pragma unroll
                for (int cidx = 0; cidx < 4; ++cidx) { const int ch = F.tid + 512 * cidx, j = ch >> 3, pc = ch & 7;
                    int p = (n2 - 1) * 128 + j; p = p < 0 ? 0 : p; const size_t row = rowb2 + (size_t)p * d2 + r2;
                    kreg[cidx] = *(const v4u*)(proj + row * NPROJ + colQ2 + 768 + pc * 8); vreg[cidx] = *(const v4u*)(proj + row * NPROJ + colQ2 + 1536 + pc * 8); } } }
        f32x4 s[5][2];
#pragma unroll
        for (int cc = 0; cc < 5; ++cc)
#pragma unroll
            for (int hh = 0; hh < 2; ++hh) {
                const int j = 32 * (c0 + cc) + 8 * (fr >> 2) + 4 * hh + (fr & 3);
                const bf16x8 k0 = *(const LAS bf16x8*)(Ks + j * KV_PITCH + fq * 16), k1 = *(const LAS bf16x8*)(Ks + j * KV_PITCH + 64 + fq * 16);
                f32x4 a = (f32x4){0.f, 0.f, 0.f, 0.f};
                a = __builtin_amdgcn_mfma_f32_16x16x32_bf16(k0, qf[0], a, 0, 0, 0);
                a = __builtin_amdgcn_mfma_f32_16x16x32_bf16(k1, qf[1], a, 0, 0, 0);
                s[cc][hh] = a;
            }
        float mx = -1e30f;
        int qil = qi; asm volatile("" : "+v"(qil));
#pragma unroll
        for (int cc = 0; cc < 5; ++cc)
#pragma unroll
            for (int hh = 0; hh < 2; ++hh)
#pragma unroll
                for (int rr = 0; rr < 4; ++rr) { const int j = 32 * (c0 + cc) + 8 * fq + 4 * hh + rr; const int dist = 128 + qil - j;
                    const bool valid = (dist >= 0) && (dist <= 128) && (n > 0 || j >= 128);
                    const float v = valid ? s[cc][hh][rr] * 0.18033688f : -1e30f; s[cc][hh][rr] = v; mx = fmaxf(mx, v); }
        mx = fmaxf(mx, __shfl_xor(mx, 16)); mx = fmaxf(mx, __shfl_xor(mx, 32));
        float l = 0.f;
#pragma unroll
        for (int cc = 0; cc < 5; ++cc)
#pragma unroll
            for (int hh = 0; hh < 2; ++hh)
#pragma unroll
                for (int rr = 0; rr < 4; ++rr) { const float p = __builtin_amdgcn_exp2f(s[cc][hh][rr] - mx); s[cc][hh][rr] = p; l += p; }
        l += __shfl_xor(l, 16); l += __shfl_xor(l, 32);
        f32x4 o[4];
#pragma unroll
        for (int eb = 0; eb < 4; ++eb) o[eb] = (f32x4){0.f, 0.f, 0.f, 0.f};
#pragma unroll
        for (int cc = 0; cc < 5; ++cc) {
            const v4u pu = (v4u){pk2(s[cc][0][0], s[cc][0][1]), pk2(s[cc][0][2], s[cc][0][3]), pk2(s[cc][1][0], s[cc][1][1]), pk2(s[cc][1][2], s[cc][1][3])};
            const bf16x8 pf = __builtin_bit_cast(bf16x8, pu);
            const int key0 = 32 * (c0 + cc) + 8 * fq + (fr >> 2);
#pragma unroll
            for (int eb = 0; eb < 4; ++eb) {
                const LAS unsigned char* vp = Vs + key0 * KV_PITCH + (16 * eb + 4 * (fr & 3)) * 2;
                const s16x4 lo = __builtin_bit_cast(s16x4, __builtin_amdgcn_ds_read_tr16_b64_v4i16((LAS s16x4*)vp));
                const s16x4 hi = __builtin_bit_cast(s16x4, __builtin_amdgcn_ds_read_tr16_b64_v4i16((LAS s16x4*)(vp + 4 * KV_PITCH)));
                const bf16x8 vf = (bf16x8){lo[0], lo[1], lo[2], lo[3], hi[0], hi[1], hi[2], hi[3]};
                o[eb] = __builtin_amdgcn_mfma_f32_16x16x32_bf16(vf, pf, o[eb], 0, 0, 0);
            }
        }
        const float il = 1.f / l;
        bf16* op = atto + ((size_t)g * NT + qrow) * 256 + h * 64 + 4 * fq;
#pragma unroll
        for (int eb = 0; eb < 4; ++eb) { const f32x4 v = o[eb] * il; *(v2u*)(op + 16 * eb) = (v2u){pk2(v.x, v.y), pk2(v.z, v.w)}; }
        if (fq == 0) lse[((size_t)g * NT + qrow) * 4 + h] = mx + __builtin_amdgcn_logf(l);
    }
#undef ATT_DECODE
}

__device__ __forceinline__ void combine_phase(Frame& F) {
    const bf16* atto = (const bf16*)(F.ws + WS_ATTO); const float* lse = (const float*)(F.ws + WS_LSE); bf16* mixin = (bf16*)(F.ws + WS_MIXIN);
    for (size_t idx = (size_t)F.bid * NTHREADS + F.tid; idx < (size_t)NT * 32; idx += (size_t)F.G * NTHREADS) {
        const size_t t = idx >> 5; const int pc = (int)(idx & 31), h = pc >> 3;
        const float l0 = lse[(0 * (size_t)NT + t) * 4 + h], l1 = lse[(1 * (size_t)NT + t) * 4 + h], l2 = lse[(2 * (size_t)NT + t) * 4 + h];
        const float m = fmaxf(l0, fmaxf(l1, l2));
        float a0 = __builtin_amdgcn_exp2f(l0 - m), a1 = __builtin_amdgcn_exp2f(l1 - m), a2 = __builtin_amdgcn_exp2f(l2 - m);
        const float inv = 1.f / (a0 + a1 + a2); a0 *= inv; a1 *= inv; a2 *= inv;
        const v4u v0 = *(const v4u*)(atto + (0 * (size_t)NT + t) * 256 + pc * 8), v1 = *(const v4u*)(atto + (1 * (size_t)NT + t) * 256 + pc * 8), v2 = *(const v4u*)(atto + (2 * (size_t)NT + t) * 256 + pc * 8);
        v4u o;
        o.x = pk2(a0 * bflo(v0.x) + a1 * bflo(v1.x) + a2 * bflo(v2.x), a0 * bfhi(v0.x) + a1 * bfhi(v1.x) + a2 * bfhi(v2.x));
        o.y = pk2(a0 * bflo(v0.y) + a1 * bflo(v1.y) + a2 * bflo(v2.y), a0 * bfhi(v0.y) + a1 * bfhi(v1.y) + a2 * bfhi(v2.y));
        o.z = pk2(a0 * bflo(v0.z) + a1 * bflo(v1.z) + a2 * bflo(v2.z), a0 * bfhi(v0.z) + a1 * bfhi(v1.z) + a2 * bfhi(v2.z));
        o.w = pk2(a0 * bflo(v0.w) + a1 * bflo(v1.w) + a2 * bflo(v2.w), a0 * bfhi(v0.w) + a1 * bfhi(v1.w) + a2 * bfhi(v2.w));
        *(v4u*)(mixin + t * NMIX + 256 + pc * 8) = o;
    }
}

#if MK_NAIVE_ATTN
__device__ __forceinline__ void naive_attn_phase(Frame& F) {
    const bf16* proj = (const bf16*)(F.ws + WS_PROJ); bf16* mixin = (bf16*)(F.ws + WS_MIXIN);
    for (size_t idx = (size_t)F.bid * NTHREADS + F.tid; idx < (size_t)NT * 4; idx += (size_t)F.G * NTHREADS) {
        const size_t tg = idx >> 2; const int h = (int)(idx & 3), t = (int)(tg & (SEQ - 1)); const size_t rowb = tg - t;
        float m = -1e30f, l = 0.f, o[64];
        for (int e = 0; e < 64; ++e) o[e] = 0.f;
        for (int g = 0; g < 3; ++g) { const int d = 1 << (2 * g); const int colQ = 256 + g * 256 + h * 64;
            const bf16* q = proj + tg * NPROJ + colQ;
            for (int j = 0; j <= 128; ++j) { const int tk = t - j * d; if (tk < 0) break;
                const bf16* k = proj + (rowb + tk) * NPROJ + colQ + 768; const bf16* v = k + 768;
                float sdot = 0.f; for (int e = 0; e < 64; ++e) sdot += bf2f(q[e]) * bf2f(k[e]);
                sdot *= 0.125f;
                const float mn = fmaxf(m, sdot), corr = __expf(m - mn), p = __expf(sdot - mn);
                l = l * corr + p; for (int e = 0; e < 64; ++e) o[e] = o[e] * corr + p * bf2f(v[e]); m = mn; } }
        const float il = 1.f / l;
        for (int e = 0; e < 64; ++e) mixin[tg * NMIX + 256 + h * 64 + e] = (bf16)f2bf(o[e] * il);
    }
}
#endif

__device__ __forceinline__ void routing_phase(Frame& F, const float* router_bias) {
    const float* L0 = (const float*)(F.ws + WS_LOGIT); const float* L1 = L0 + (size_t)NT * NE;
    float* gatew = (float*)(F.ws + WS_GATEW); unsigned* bucket = (unsigned*)(F.ws + WS_BUCKET); unsigned* gcnt = (unsigned*)(F.ws + WS_CTL) + CW_GCNT;
    LAS unsigned* hist = (LAS unsigned*)F.lds; LAS unsigned* basel = hist + 256; LAS unsigned* asg = hist + 512;
    const int lane = F.lane;
    for (int blk = F.bid; blk < NT / 128; blk += F.G) {
        __syncthreads();
        if (F.tid < 256) hist[F.tid] = 0u;
        __syncthreads();
        const f32x4 bias = *(const f32x4*)(router_bias + 4 * lane);
        for (int tl = 0; tl < 16; ++tl) {
            const int tloc = F.wave * 16 + tl; const size_t t = (size_t)blk * 128 + tloc;
            const f32x4 lg = *(const f32x4*)(L0 + t * NE + 4 * lane) + *(const f32x4*)(L1 + t * NE + 4 * lane);
            float sc[4], cd[4];
#pragma unroll
            for (int i = 0; i < 4; ++i) { sc[i] = 1.f / (1.f + __expf(-lg[i])); cd[i] = sc[i] + bias[i]; }
            float a1 = fmaxf(cd[0], cd[1]), a2 = fminf(cd[0], cd[1]);
#pragma unroll
            for (int i = 2; i < 4; ++i) { const float v = cd[i]; a2 = fmaxf(a2, fminf(a1, v)); a1 = fmaxf(a1, v); }
#pragma unroll
            for (int off = 1; off < 8; off <<= 1) { const float b1 = __shfl_xor(a1, off), b2 = __shfl_xor(a2, off);
                const float n1 = fmaxf(a1, b1), n2 = fmaxf(fminf(a1, b1), fmaxf(a2, b2)); a1 = n1; a2 = n2; }
            const float gs = a1 + a2; const int myg = lane >> 3; int rank = 0;
#pragma unroll
            for (int gg = 0; gg < 8; ++gg) { const float o = __shfl(gs, gg * 8); rank += (o > gs || (o == gs && gg < myg)) ? 1 : 0; }
            if (rank >= 4) {
#pragma unroll
                for (int i = 0; i < 4; ++i) cd[i] = -1e30f; }
            int sel_e = 0; float sel_s = 0.f, ssum = 0.f;
#pragma unroll
            for (int k = 0; k < TOPK; ++k) {
                float bv = cd[0]; int bi = 0;
#pragma unroll
                for (int i = 1; i < 4; ++i) if (cd[i] > bv) { bv = cd[i]; bi = i; }
                int gi = 4 * lane + bi;
#pragma unroll
                for (int off = 32; off >= 1; off >>= 1) { const float ov = __shfl_xor(bv, off); const int oi = __shfl_xor(gi, off);
                    if (ov > bv || (ov == bv && oi < gi)) { bv = ov; gi = oi; } }
                const int own = gi >> 2, wi = gi & 3;
                float myv = sc[0]; myv = wi == 1 ? sc[1] : myv; myv = wi == 2 ? sc[2] : myv; myv = wi == 3 ? sc[3] : myv;
                const float sv = __shfl(myv, own);
                if (lane == own) {
#pragma unroll
                    for (int i = 0; i < 4; ++i) if (wi == i) cd[i] = -1e30f; }
                ssum += sv;
                if (lane == k) { sel_e = gi; sel_s = sv; }
            }
            if (lane < TOPK) {
                const unsigned rk = __hip_atomic_fetch_add(hist + sel_e, 1u, __ATOMIC_RELAXED, __HIP_MEMORY_SCOPE_WORKGROUP);
                asg[tloc * 8 + lane] = (unsigned)sel_e | (rk << 16);
                gatew[t * 8 + lane] = sel_s / ssum * 2.5f;
            }
        }
        __syncthreads();
        if (F.tid < 256) { const unsigned c = hist[F.tid]; basel[F.tid] = c ? atomicAdd(&gcnt[F.tid * 16], c) : 0u; }
        __syncthreads();
        for (int a = F.tid; a < 1024; a += NTHREADS) { const unsigned v = asg[a], e = v & 0xffffu, rk = v >> 16;
            bucket[(size_t)e * CAP + basel[e] + rk] = (unsigned)(blk * 1024 + a); }
    }
}

__device__ __forceinline__ void build_tables(Frame& F, int& nblk_total) {
    const unsigned* gcnt = (const unsigned*)(F.ws + WS_CTL) + CW_GCNT;
    LAS int* prefix = (LAS int*)(F.lds + TAB_OFF); LAS int* cnt = prefix + 260;
    __syncthreads();
    if (F.tid < 256) cnt[F.tid] = (int)__hip_atomic_load(&gcnt[F.tid * 16], __ATOMIC_RELAXED, __HIP_MEMORY_SCOPE_AGENT);
    __syncthreads();
    if (F.tid == 0) { int s = 0; for (int e = 0; e < NE; ++e) { prefix[e] = s; s += (cnt[e] + 255) >> 8; } prefix[NE] = s; }
    __syncthreads();
    if (F.tid < 256) { LAS unsigned char* b2e = (LAS unsigned char*)(cnt + 256); for (int b = prefix[F.tid]; b < prefix[F.tid + 1]; ++b) b2e[b] = (unsigned char)F.tid; }
    __syncthreads();
    nblk_total = prefix[NE];
}

__device__ __forceinline__ void final_phase(Frame& F, const float* X, const float* g_final) {
    const float* mod = (const float*)(F.ws + WS_MOD); const unsigned char* Y = (const unsigned char*)(F.ws + WS_Y);
    const unsigned* pos = (const unsigned*)(F.ws + WS_POS); const float* gatew = (const float*)(F.ws + WS_GATEW);
    constexpr int RW = 1;
    const int c0 = 16 * F.lane;
    for (int blk = F.bid; blk < NT / 128; blk += F.G) {
        const int b = (blk * 128) >> 12; const float* g1 = mod + (size_t)b * 6144 + 2 * D + c0; const float* g2 = mod + (size_t)b * 6144 + 5 * D + c0;
        f32x4 ga[4], gb[4];
#pragma unroll
        for (int j = 0; j < 4; ++j) { ga[j] = *(const f32x4*)(g1 + 4 * j); gb[j] = *(const f32x4*)(g2 + 4 * j); }
        const size_t rowbase = (size_t)blk * 128 + F.wave * 16;
        const unsigned p0 = pos[rowbase * 8 + F.lane], p1 = pos[rowbase * 8 + 64 + F.lane];
        const float w0 = gatew[rowbase * 8 + F.lane] * Y_INV_SCALE, w1 = gatew[rowbase * 8 + 64 + F.lane] * Y_INV_SCALE;
        for (int rr = 0; rr < 16; rr += RW) {
            f32x4 v[RW][4]; v4u dv[RW][2], sv[RW][2], yv[RW][TOPK]; float wk[RW][TOPK];
#pragma unroll
            for (int q = 0; q < RW; ++q) { const size_t row = rowbase + rr + q;
                const f32x4* xr = (const f32x4*)(X + row * D + c0); const v4u* dr = (const v4u*)((const bf16*)F.out + row * (2 * D) + c0);
#pragma unroll
                for (int j = 0; j < 4; ++j) v[q][j] = xr[j];
                dv[q][0] = dr[0]; dv[q][1] = dr[1]; sv[q][0] = dr[128]; sv[q][1] = dr[129];
#pragma unroll
                for (int k = 0; k < TOPK; ++k) { const int idx = (rr + q) * 8 + k;
                    const unsigned pk = (unsigned)__builtin_amdgcn_readlane((int)(idx < 64 ? p0 : p1), idx & 63);
                    wk[q][k] = __builtin_bit_cast(float, __builtin_amdgcn_readlane(__builtin_bit_cast(int, idx < 64 ? w0 : w1), idx & 63));
                    yv[q][k] = *(const v4u*)(Y + (size_t)pk * D + c0); } }
#pragma unroll
            for (int q = 0; q < RW; ++q) { float s = 0.f;
#pragma unroll
                for (int j = 0; j < 4; ++j) {
                    const unsigned sw0 = sv[q][j >> 1][(j & 1) * 2], sw1 = sv[q][j >> 1][(j & 1) * 2 + 1];
                    f32x4 r = (f32x4){bflo(sw0), bfhi(sw0), bflo(sw1), bfhi(sw1)};
#pragma unroll
                    for (int k = 0; k < TOPK; ++k) { const int wd = (int)yv[q][k][j];
                        const auto lo = __builtin_amdgcn_cvt_pk_f32_fp8(wd, false), hi = __builtin_amdgcn_cvt_pk_f32_fp8(wd, true);
                        r += wk[q][k] * (f32x4){lo[0], lo[1], hi[0], hi[1]}; }
                    const unsigned dw0 = dv[q][j >> 1][(j & 1) * 2], dw1 = dv[q][j >> 1][(j & 1) * 2 + 1];
                    v[q][j] = v[q][j] + ga[j] * (f32x4){bflo(dw0), bfhi(dw0), bflo(dw1), bfhi(dw1)} + gb[j] * r;
                    s += (v[q][j].x * v[q][j].x + v[q][j].y * v[q][j].y) + (v[q][j].z * v[q][j].z + v[q][j].w * v[q][j].w); }
                const float rstd = 1.f / sqrtf(wave_sum(s) * (1.f / D) + NORM_EPS);
                f32x4* orow = (f32x4*)(F.out + (rowbase + rr + q) * D + c0);
#pragma unroll
                for (int j = 0; j < 4; ++j) orow[j] = v[q][j] * rstd * *(const f32x4*)(g_final + c0 + 4 * j); }
        }
    }
}

constexpr int N_PHASES = 12;
__global__ void __launch_bounds__(NTHREADS, 2) fwd(Args args) {
    extern __shared__ __attribute__((aligned(16))) unsigned char lds_raw[];
    Frame F;
    F.lds = (LAS unsigned char*)lds_raw;
    F.tid = threadIdx.x; F.lane = F.tid & 63; F.wave = __builtin_amdgcn_readfirstlane(F.tid >> 6); F.G = gridDim.x; F.bid = blockIdx.x;
#define INP(i) ld_ptr(F.lds, (i))
    F.out = args.out; F.ws = args.ws;
    unsigned char* ws = args.ws;
    volatile LAS unsigned* MISC = (volatile LAS unsigned*)(F.lds + MISC_OFF);
    if (F.tid < 16) MISC[F.tid] = 0u;
    if (F.tid == 0) { LAS unsigned long long* pt = (LAS unsigned long long*)(F.lds + PT_OFF);
#pragma unroll
        for (int i = 0; i < 19; ++i) pt[i] = (unsigned long long)args.in[i]; }
    __syncthreads();
    const int lo = args.ph_lo, hi = args.ph_hi;
    XcdBarrier bar; bar.bar = (unsigned*)(ws + WS_CTL) + CW_BAR; bar.x = 0; bar.st = nullptr;
    if (hi - lo > 1) bar = xcd_barrier_post((unsigned*)(ws + WS_CTL) + CW_BAR, MISC + 8);
#ifndef PH_MASK
#define PH_MASK 0xfff
#endif
#define IN(k) (((PH_MASK >> (k)) & 1) && lo <= (k) && (k) < hi)
#define SEAM(k) do { if (IN(k) && IN((k) + 1)) xcd_barrier(bar); { int _t = threadIdx.x; asm volatile("" : "+v"(_t)); F.tid = _t; F.lane = _t & 63; } } while (0)

    const int vcu = (F.G % 8 == 0) ? (F.bid % 8) * (F.G / 8) + F.bid / 8 : F.bid;
    unsigned char* h8 = ws + WS_H;
    bf16* h2b = (bf16*)(ws + WS_H2B); bf16* proj = (bf16*)(ws + WS_PROJ); bf16* mixin = (bf16*)(ws + WS_MIXIN);

    if (IN(0)) { p0_prologue(F); } SEAM(0);
    if (IN(1)) { modnorm_phase<false, false, true>(F, INP(0), INP(4), 0, nullptr, (bf16*)h8); } SEAM(1);
    if (IN(2)) {
        typedef DenseSchedT<NT / 256, NPROJ / 256, 1> SchedP2; SchedP2 S; S.init(h8, ws + WS_WIN_T, D, D, 0, F.G, F.bid);
        EpiProj E{proj};
        const int ksplit = vcu % 6;
        S.i0 = 0; S.i1 = ksplit;
        gemm_phase<EpiProj, SchedP2>(F.lds, D, D, S, E);
        __syncthreads();
        for (int e = F.bid; e < NE; e += F.G)
            convert_expert<false>(F, INP(12) + (size_t)e * D * FF, INP(13) + (size_t)e * D * FF, ws + WS_WGU_T + (size_t)e * 512 * D);
        __syncthreads();
        S.i0 = ksplit; S.i1 = 0x3fffffff;
        gemm_phase<EpiProj, SchedP2>(F.lds, D, D, S, E);
    } SEAM(2);
    if (IN(3)) {
        pool_phase(F, INP(6), INP(7));
#if MK_NAIVE_ATTN
        naive_attn_phase(F);
#else
        attn_phase(F);
#endif
    } SEAM(3);
    if (IN(4)) {
#if !MK_NAIVE_ATTN
        combine_phase(F);
#endif
    } SEAM(4);
    if (IN(5)) {
        typedef DenseSchedT<NT / 256, D / 256, 1> SchedP5; SchedP5 S; S.init(mixin, ws + WS_WOUT_T, NMIX, NMIX, 0, F.G, F.bid);
        EpiOut E{(bf16*)F.out};
        gemm_phase<EpiOut, SchedP5>(F.lds, NMIX, NMIX, S, E);
    } SEAM(5);
    if (IN(6)) { modnorm_phase<true, true, true>(F, INP(0), INP(9), 3, h8, h2b); } SEAM(6);
    if (IN(7)) {
        typedef DenseSchedT<NT / 256, NE / 256, 2> SchedP7; SchedP7 S; S.init(h2b, ws + WS_WR_T, D, D, 512, F.G, F.bid);
        EpiRouter E{(float*)(ws + WS_LOGIT)};
        gemm_phase<EpiRouter, SchedP7>(F.lds, 512, D, S, E);
    } SEAM(7);
    if (IN(8)) { routing_phase(F, INP(11)); } SEAM(8);
    if (IN(9)) {
        int nblk; build_tables(F, nblk);
        MoeSched<2, false> S; S.prefix = (const LAS int*)(F.lds + TAB_OFF); S.cnt = S.prefix + 260; S.bucket = (const unsigned*)(ws + WS_BUCKET);
        S.Ar = (const char*)h8; S.As = (const char*)h8; S.Br = (const char*)(ws + WS_WGU_T); S.Bs = (const char*)(ws + WS_WSGU_T);
        S.nRouted = nblk * 2; S.total = S.nRouted + (NT / 256) * 2; S.G = F.G; S.c = vcu;
        EpiGU E{ws + WS_ACT, ws + WS_ACTS, (const unsigned*)(ws + WS_BUCKET), (unsigned*)(ws + WS_POS)};
        const int ksplit = vcu % 11;
        S.i0 = 0; S.i1 = ksplit;
        gemm_phase<EpiGU, MoeSched<2, false>>(F.lds, D / 2, D / 2, S, E);
        __syncthreads();
        for (int e = F.bid; e < NE; e += F.G)
            convert_expert<true>(F, INP(14) + (size_t)e * FF * D, nullptr, ws + WS_WD_T + (size_t)e * D * FF);
        __syncthreads();
        S.i0 = ksplit; S.i1 = 0x3fffffff;
        gemm_phase<EpiGU, MoeSched<2, false>>(F.lds, D / 2, D / 2, S, E);
    } SEAM(9);
    if (IN(10)) {
        int nblk; build_tables(F, nblk);
        MoeSched<4, true> S; S.prefix = (const LAS int*)(F.lds + TAB_OFF); S.cnt = S.prefix + 260; S.bucket = (const unsigned*)(ws + WS_BUCKET);
        S.Ar = (const char*)(ws + WS_ACT); S.As = (const char*)(ws + WS_ACTS); S.Br = (const char*)(ws + WS_WD_T); S.Bs = (const char*)(ws + WS_WSD_T);
        S.nRouted = nblk * 4; S.total = S.nRouted + (NT / 256) * 4; S.G = F.G; S.c = vcu; S.i0 = 0; S.i1 = 0x3fffffff;
        EpiDown E{(unsigned char*)(ws + WS_Y), (bf16*)F.out};
        gemm_phase<EpiDown, MoeSched<4, true>>(F.lds, FF / 2, FF / 2, S, E);
    } SEAM(10);
    if (IN(11)) { final_phase(F, INP(0), INP(18)); }
#if MK_PROBE
    if (blockIdx.x == MK_PROBE_BLK) { __syncthreads();
        if (F.tid == 0) { const unsigned long long span = (unsigned long long)MISC[12] * MK_PROBE_MULT, t0 = __builtin_amdgcn_s_memrealtime();
            while (__builtin_amdgcn_s_memrealtime() - t0 < span) __builtin_amdgcn_s_sleep(16); } }
#endif
#undef IN
#undef SEAM
#undef INP
}

extern "C" void kernel_launch(void* const* d_in, const int* in_sizes, int n_in, void* d_out, int out_size, void* d_ws, size_t ws_size, hipStream_t stream) {
    static int grid = 0;
    if (grid == 0) {
        if (n_in != 19 || out_size != NT * D || ws_size < WS_END) { fprintf(stderr, "kernel_launch: unexpected shapes (n_in %d out %d ws %zu)\n", n_in, out_size, ws_size); grid = -1; return; }
        int dev = 0, cus = 0;
        if (hipGetDevice(&dev) != hipSuccess || hipDeviceGetAttribute(&cus, hipDeviceAttributeMultiprocessorCount, dev) != hipSuccess) { grid = -1; return; }
        if (hipFuncSetAttribute((const void*)fwd, hipFuncAttributeMaxDynamicSharedMemorySize, LDS_BYTES) != hipSuccess) { fprintf(stderr, "kernel_launch: hipFuncSetAttribute failed\n"); grid = -1; return; }
        int per_cu = 0;
        if (hipOccupancyMaxActiveBlocksPerMultiprocessor(&per_cu, (const void*)fwd, NTHREADS, LDS_BYTES) != hipSuccess || per_cu < 1) { fprintf(stderr, "kernel_launch: occupancy query says %d\n", per_cu); }
        (void)hipGetLastError();
        grid = cus;
    }
    if (grid < 0) return;
    (void)hipMemsetAsync((char*)d_ws + WS_CTL, 0, CTL_ZERO_BYTES, stream);
    Args a{};
    for (int i = 0; i < 19; ++i) a.in[i] = (const float*)d_in[i];
    a.out = (float*)d_out; a.ws = (unsigned char*)d_ws;
#if MK_ONE_LAUNCH
    a.ph_lo = 0; a.ph_hi = N_PHASES;
    hipLaunchKernelGGL(fwd, dim3(grid), dim3(NTHREADS), LDS_BYTES, stream, a);
#else
    for (int p = 0; p < N_PHASES; ++p) { a.ph_lo = p; a.ph_hi = p + 1; const int reps = ((MK_REP_MASK >> p) & 1) ? 2 : 1;
        for (int r = 0; r < reps; ++r) hipLaunchKernelGGL(fwd, dim3(grid), dim3(NTHREADS), LDS_BYTES, stream, a); }
#endif
}
```

```cpp
#include <hip/hip_runtime.h>
#include <cstdio>
#include <cstdint>

#ifndef MK_ONE_LAUNCH
#define MK_ONE_LAUNCH 1
#endif
#ifndef MK_FAST_GEMM
#define MK_FAST_GEMM 1
#endif
#ifndef MK_REP_MASK
#define MK_REP_MASK 0x000
#endif
#ifndef MK_MX
#define MK_MX 1
#endif
#ifndef MK_PROBE
#define MK_PROBE 0
#endif
#ifndef MK_PROBE_BLK
#define MK_PROBE_BLK 0
#endif
#ifndef MK_PROBE_WAVE
#define MK_PROBE_WAVE 0
#endif
#ifndef MK_PROBE_MULT
#define MK_PROBE_MULT 4
#endif
#ifndef MK_NAIVE_ATTN
#define MK_NAIVE_ATTN 0
#endif

#define LAS __attribute__((address_space(3)))
#define GAS __attribute__((address_space(1)))
typedef unsigned short bf16;
typedef short bf16x8 __attribute__((ext_vector_type(8)));
typedef short s16x4 __attribute__((ext_vector_type(4)));
typedef float f32x4 __attribute__((ext_vector_type(4)));
typedef float f32x2 __attribute__((ext_vector_type(2)));
typedef long l64x2 __attribute__((ext_vector_type(2)));
typedef int i32x8 __attribute__((ext_vector_type(8)));
typedef int i32x4 __attribute__((ext_vector_type(4)));
typedef unsigned v4u __attribute__((ext_vector_type(4)));
typedef unsigned v2u __attribute__((ext_vector_type(2)));

constexpr int D = 1024, NB = 8, SEQ = 4096, NT = NB * SEQ;
constexpr int NPROJ = 2560, NE = 256, TOPK = 8, FF = 256, NMIX = 512;
constexpr int CAP = NT;
constexpr int MAXBLK = NT * TOPK / 256 + NE;
constexpr float NORM_EPS = 1e-6f;
constexpr int NWAVES = 8, NTHREADS = 512;

constexpr size_t MiB = 1u << 20;
constexpr size_t WS_CTL = 0, CTL_ZERO_BYTES = 1 * MiB;
constexpr size_t WS_MOD = 1 * MiB;
constexpr size_t WS_GATEW = 2 * MiB;
constexpr size_t WS_WIN_T = 4 * MiB;
constexpr size_t WS_WOUT_T = 9 * MiB;
constexpr size_t WS_WR_T = 10 * MiB;
constexpr size_t WS_WSGU_T = 11 * MiB;
constexpr size_t WS_WSD_T = 12 * MiB;
constexpr size_t WS_LSE = 13 * MiB;
constexpr size_t WS_WD_T = 16 * MiB;
constexpr size_t WS_ACT = 144 * MiB;
constexpr size_t WS_ACTS = 304 * MiB;
constexpr size_t WS_BUCKET = 320 * MiB;
constexpr size_t WS_WGU_T = 352 * MiB;
constexpr size_t WS_PROJ = 608 * MiB;
constexpr size_t WS_H = 768 * MiB;
constexpr size_t WS_ATTO = 832 * MiB;
constexpr size_t WS_MIXIN = 880 * MiB;
constexpr size_t WS_LOGIT = 912 * MiB;
constexpr size_t WS_Y = 352 * MiB;
constexpr size_t WS_H2B = 832 * MiB;
constexpr size_t WS_POS = 3 * MiB;
constexpr size_t WS_END = 992 * MiB;
constexpr int CW_BAR = 4096;
constexpr int CW_GCNT = 16384;

constexpr int RING_BYTES = 131072;
constexpr int TAB_OFF = RING_BYTES;
constexpr int MISC_OFF = TAB_OFF + 4096;
constexpr int PT_OFF = MISC_OFF + 256;
constexpr int LDS_BYTES = 147456;

__device__ __forceinline__ unsigned f2bf(float f) { unsigned u = __builtin_bit_cast(unsigned, f); return (u + 0x7fffu + ((u >> 16) & 1u)) >> 16; }
__device__ __forceinline__ unsigned pk2(float lo, float hi) { unsigned r; asm("v_cvt_pk_bf16_f32 %0, %1, %2" : "=v"(r) : "v"(lo), "v"(hi)); return r; }
constexpr float W_SCALE = 64.f, W_INV_SCALE = 1.f / 64.f;
constexpr float ACT_SCALE = 4.f;
__device__ __forceinline__ unsigned pk4_fp8(float a, float b, float c, float d) {
    int w = __builtin_amdgcn_cvt_pk_fp8_f32(a, b, 0, false); w = __builtin_amdgcn_cvt_pk_fp8_f32(c, d, w, true); return (unsigned)w; }
__device__ __forceinline__ float bf2f(unsigned short b) { return __builtin_bit_cast(float, ((unsigned)b) << 16); }
__device__ __forceinline__ float bflo(unsigned u) { return __builtin_bit_cast(float, u << 16); }
__device__ __forceinline__ float bfhi(unsigned u) { return __builtin_bit_cast(float, u & 0xffff0000u); }
template <int CTRL> __device__ __forceinline__ float dppf(float v) {
    return __builtin_bit_cast(float, __builtin_amdgcn_update_dpp(0, __builtin_bit_cast(int, v), CTRL, 0xF, 0xF, true)); }
__device__ __forceinline__ float wave_sum(float v) {
    v += dppf<0xB1>(v); v += dppf<0x4E>(v); v += dppf<0x141>(v); v += dppf<0x140>(v);
    const float r0 = __builtin_bit_cast(float, __builtin_amdgcn_readlane(__builtin_bit_cast(int, v), 0)), r1 = __builtin_bit_cast(float, __builtin_amdgcn_readlane(__builtin_bit_cast(int, v), 16));
    const float r2 = __builtin_bit_cast(float, __builtin_amdgcn_readlane(__builtin_bit_cast(int, v), 32)), r3 = __builtin_bit_cast(float, __builtin_amdgcn_readlane(__builtin_bit_cast(int, v), 48));
    return (r0 + r1) + (r2 + r3);
}
__device__ __forceinline__ float silu_f(float g) { return g * __builtin_amdgcn_rcpf(1.f + __builtin_amdgcn_exp2f(-1.44269504f * g)); }

__device__ __forceinline__ const float* ld_ptr(LAS unsigned char* lds, int i) {
    const unsigned long long v = ((const LAS unsigned long long*)(lds + PT_OFF))[i];
    const unsigned lo = __builtin_amdgcn_readfirstlane((unsigned)v), hi = __builtin_amdgcn_readfirstlane((unsigned)(v >> 32));
    return (const float*)(((unsigned long long)hi << 32) | lo);
}
#define XB_TMO      128
#define XB_XCNT(j)  (256  + 64 * (j))
#define XB_XSUB(j)  (1280 + 64 * (j))
#define XB_XGEN(j)  (2304 + 64 * (j))
#define XB_TOP      3328
#define XB_TOPGEN   3392
#define XCD_BAR_WORDS 3456
#define XB_SPIN_CAP (1u << 18)
__device__ __forceinline__ unsigned xb_ld(unsigned* p)              { return __hip_atomic_load(p, __ATOMIC_RELAXED, __HIP_MEMORY_SCOPE_AGENT); }
__device__ __forceinline__ unsigned xb_add(unsigned* p, unsigned v) { return __hip_atomic_fetch_add(p, v, __ATOMIC_RELAXED, __HIP_MEMORY_SCOPE_AGENT); }
__device__ __forceinline__ unsigned xb_xcc_id() { return (unsigned)__builtin_amdgcn_s_getreg((3 << 11) | 20) & 0xFu; }
#define XB_SPIN(cond, bar) do { unsigned _sp = 0; while (cond) { __builtin_amdgcn_s_sleep(1); \
    if ((++_sp & 255u) == 0u) { if (xb_ld(&(bar)[XB_TMO])) break; if (_sp > XB_SPIN_CAP) { atomicAdd(&(bar)[XB_TMO], 1u); break; } } } } while (0)
struct XcdBarrier { unsigned* bar; unsigned x; volatile LAS unsigned* st; };
__device__ __forceinline__ XcdBarrier xcd_barrier_post(unsigned* bar, volatile LAS unsigned* st) {
    XcdBarrier b; b.bar = bar; b.x = xb_xcc_id(); b.st = st;
    if (threadIdx.x == 0) (void)xb_add(&bar[XB_XCNT(b.x)], 1u);
    return b;
}
__device__ __forceinline__ void xcd_barrier_complete(unsigned* bar, unsigned x, unsigned& nloc, unsigned& nx) {
    const unsigned G = gridDim.x * gridDim.y * gridDim.z;
    unsigned sum, cnt, mine, sp = 0u;
    for (;;) {
        sum = 0u; cnt = 0u; mine = 0u;
#pragma unroll
        for (unsigned j = 0; j < 16; ++j) { const unsigned c = xb_ld(&bar[XB_XCNT(j)]); sum += c; cnt += (c > 0u) ? 1u : 0u; mine = (j == x) ? c : mine; }
        if (sum == G) break;
        __builtin_amdgcn_s_sleep(1);
        if ((++sp & 255u) == 0u) { if (xb_ld(&bar[XB_TMO])) break; if (sp > XB_SPIN_CAP) { atomicAdd(&bar[XB_TMO], 1u); break; } }
    }
    nloc = mine > 0u ? mine : 1u; nx = cnt > 0u ? cnt : 1u;
}
__device__ __forceinline__ void xcd_barrier(const XcdBarrier& b) {
    asm volatile("s_waitcnt vmcnt(0)" ::: "memory");
    __syncthreads();
    if (threadIdx.x == 0) {
        unsigned* bar = b.bar;
        __builtin_amdgcn_s_waitcnt(0);
        unsigned nloc = b.st[0], nx = b.st[1];
        if (nloc == 0u) { xcd_barrier_complete(bar, b.x, nloc, nx); b.st[0] = nloc; b.st[1] = nx; }
        const unsigned old = xb_add(&bar[XB_XSUB(b.x)], 1u);
        const unsigned gen = old / nloc;
        if (old + 1u == (gen + 1u) * nloc) {
            __builtin_amdgcn_fence(__ATOMIC_RELEASE, "agent");
            asm volatile("s_waitcnt vmcnt(0)" ::: "memory");
            const unsigned og = xb_add(&bar[XB_TOP], 1u);
            const unsigned tg = og / nx;
            if (og + 1u == (tg + 1u) * nx) xb_add(&bar[XB_TOPGEN], 1u);
            else XB_SPIN(xb_ld(&bar[XB_TOPGEN]) == tg, bar);
            __builtin_amdgcn_fence(__ATOMIC_ACQUIRE, "agent");
            xb_add(&bar[XB_XGEN(b.x)], 1u);
            asm volatile("s_waitcnt vmcnt(0)" ::: "memory");
        } else {
            XB_SPIN(xb_ld(&bar[XB_XGEN(b.x)]) == gen, bar);
            __builtin_amdgcn_fence(__ATOMIC_ACQUIRE, "agent");
            asm volatile("s_waitcnt vmcnt(0)" ::: "memory");
        }
    }
    __syncthreads();
}

constexpr int BK = 64, HALF = 128, HTB = HALF * BK * 2;
__device__ __forceinline__ int lds_byte(int r, int c) { const int st = (r >> 4) * 2 + (c >> 5), rr = r & 15, cc = c & 31, ob = rr * 64 + cc * 2; return st * 1024 + (ob ^ (((ob >> 9) & 1) << 5)); }
__device__ __forceinline__ void stage_rc(int b, int& R, int& C) { const int st = b / 1024, sb = b % 1024, swz = sb ^ (((sb >> 9) & 1) << 5); R = (st >> 1) * 16 + swz / 64; C = (st & 1) * 32 + (swz % 64) / 2; }
__device__ __forceinline__ int perm32(int rho) { const int n = rho >> 4, i = rho & 15; return 8 * (i >> 2) + 4 * n + (i & 3); }

template <class Epi, class Sched>
__device__ __forceinline__ void gemm_simple(const int K, const int ldb, const Sched& S, const Epi& E) {
    const int tid = threadIdx.x, wid = __builtin_amdgcn_readfirstlane(tid >> 6), lane = tid & 63, wr = wid >> 2, wc = wid & 3, fr = lane & 15, fq = lane >> 4;
    typename Sched::Unit u;
    for (int ui = 0; S.next(ui, u); ++ui) {
        f32x4 acc[2][2][4][2];
#pragma unroll
        for (int a = 0; a < 2; ++a)
#pragma unroll
            for (int b = 0; b < 2; ++b)
#pragma unroll
                for (int m = 0; m < 4; ++m)
#pragma unroll
                    for (int n = 0; n < 2; ++n) acc[a][b][m][n] = (f32x4){0.f, 0.f, 0.f, 0.f};
        const char* A = S.a_base(u); const char* B = S.b_base(u);
        unsigned aoff[2][4], boff[2][2];
#pragma unroll
        for (int ai = 0; ai < 2; ++ai)
#pragma unroll
            for (int m = 0; m < 4; ++m) aoff[ai][m] = S.a_off(u, 128 * ai + 64 * wr + 16 * m + fr) + fq * 16;
#pragma unroll
        for (int bj = 0; bj < 2; ++bj)
#pragma unroll
            for (int n = 0; n < 2; ++n) { const int row = Epi::PERM == 2 ? 64 * wc + 16 * (fr >> 2) + 8 * bj + 4 * n + (fr & 3) : 128 * bj + 32 * wc + (Epi::PERM == 1 ? perm32(16 * n + fr) : 16 * n + fr); boff[bj][n] = (unsigned)(row * ldb) * 2u + fq * 16; }
        for (int k = 0; k < K; k += 32) {
            bf16x8 a[2][4], b[2][2];
#pragma unroll
            for (int ai = 0; ai < 2; ++ai)
#pragma unroll
                for (int m = 0; m < 4; ++m) a[ai][m] = *(const bf16x8*)(A + aoff[ai][m] + k * 2);
#pragma unroll
            for (int bj = 0; bj < 2; ++bj)
#pragma unroll
                for (int n = 0; n < 2; ++n) b[bj][n] = *(const bf16x8*)(B + boff[bj][n] + k * 2);
#pragma unroll
            for (int ai = 0; ai < 2; ++ai)
#pragma unroll
                for (int bj = 0; bj < 2; ++bj)
#pragma unroll
                    for (int m = 0; m < 4; ++m)
#pragma unroll
                        for (int n = 0; n < 2; ++n) acc[ai][bj][m][n] = __builtin_amdgcn_mfma_f32_16x16x32_bf16(b[bj][n], a[ai][m], acc[ai][bj][m][n], 0, 0, 0);
        }
        E(acc, u, wr, wc, fr, fq);
    }
}

template <class Epi, class Sched>
__device__ __forceinline__ void gemm_fast(LAS unsigned char* lds, const int K, const int ldb, const Sched& S, const Epi& E) {
    int tid0 = threadIdx.x; asm volatile("" : "+v"(tid0));
    const int tid = tid0, wid = __builtin_amdgcn_readfirstlane(tid >> 6), lane = tid & 63, wr = wid >> 2, wc = wid & 3, fr = lane & 15, fq = lane >> 4;
    int nt = K / BK; asm volatile("" : "+s"(nt));
    unsigned voffB0[2], voffB1[2];
#pragma unroll
    for (int i = 0; i < 2; ++i) { int R, C; stage_rc(tid * 16 + i * 8192, R, C);
        if (Epi::PERM == 2) { const int cb = 64 * (R >> 5) + 16 * ((R & 15) >> 2) + 4 * ((R >> 4) & 1) + (R & 3);
            voffB0[i] = (unsigned)(cb * ldb + C) * 2u; voffB1[i] = (unsigned)((cb + 8) * ldb + C) * 2u; }
        else { const int Rb = Epi::PERM == 1 ? ((R & ~31) + perm32(R & 31)) : R;
            voffB0[i] = (unsigned)(Rb * ldb + C) * 2u; voffB1[i] = (unsigned)((Rb + HALF) * ldb + C) * 2u; } }
#define PG8_AOFF(u) do { int _tz = threadIdx.x; asm volatile("" : "+v"(_tz)); _Pragma("unroll") for (int _i = 0; _i < 2; ++_i) { int _R, _C; stage_rc(_tz * 16 + _i * 8192, _R, _C); \
        vA0[_i] = S.a_off(u, _R) + (unsigned)_C * 2u; vA1[_i] = S.a_off(u, HALF + _R) + (unsigned)_C * 2u; } } while (0)
    const size_t kstep = (size_t)(BK * 2);
    const unsigned ldsw = (unsigned)wid * 1024u;
    const int aoff = lds_byte(wr * 64 + fr, fq * 8), boff = lds_byte(wc * 32 + fr, fq * 8);
#if MK_PROBE
#define PRB_NOW() __builtin_amdgcn_s_memrealtime()
#define PRB_ADD(IV, t0, t1) do { if (MK_PROBE == Epi::PID * 10 + (IV) && blockIdx.x == MK_PROBE_BLK && wid == MK_PROBE_WAVE && lane == 0) \
        __hip_atomic_fetch_add((LAS unsigned*)(lds + MISC_OFF + 48), (unsigned)((t1) - (t0)), __ATOMIC_RELAXED, __HIP_MEMORY_SCOPE_WORKGROUP); } while (0)
#else
#define PRB_NOW() 0ull
#define PRB_ADD(IV, t0, t1) do { } while (0)
#endif
#define PG8_SA(b, h) (((b) * 2 + (h)) * HTB)
#define PG8_SB(b, h) ((4 + (b) * 2 + (h)) * HTB)
#define PG8_STAGE(bufoff, gbase, voff) do { _Pragma("unroll") for (int _i = 0; _i < 2; ++_i) \
        __builtin_amdgcn_global_load_lds((const unsigned*)((const char*)(gbase) + (voff)[_i]), (LAS unsigned*)(lds + (bufoff) + ldsw + _i * 8192), 16, 0, 0); } while (0)
#define PG8_LDA(dst, b, h) do { _Pragma("unroll") for (int m = 0; m < 4; ++m) _Pragma("unroll") for (int k = 0; k < 2; ++k) dst[m][k] = *(const LAS bf16x8*)(lds + PG8_SA(b, h) + aoff + m * 2048 + k * 1024); } while (0)
#define PG8_LDB(dst, b, h) do { _Pragma("unroll") for (int n = 0; n < 2; ++n) _Pragma("unroll") for (int k = 0; k < 2; ++k) dst[n][k] = *(const LAS bf16x8*)(lds + PG8_SB(b, h) + boff + n * 2048 + k * 1024); } while (0)
#define PG8_MMA(ai, bj, At, Bt) do { __builtin_amdgcn_s_setprio(1); _Pragma("unroll") for (int m = 0; m < 4; ++m) _Pragma("unroll") for (int n = 0; n < 2; ++n) _Pragma("unroll") for (int k = 0; k < 2; ++k) { \
        if constexpr (Epi::FP8 && MK_MX) { if (k == 0) { \
            const i32x8 _a = __builtin_shufflevector(__builtin_bit_cast(i32x4, At[m][0]), __builtin_bit_cast(i32x4, At[m][1]), 0, 1, 2, 3, 4, 5, 6, 7); \
            const i32x8 _b = __builtin_shufflevector(__builtin_bit_cast(i32x4, Bt[n][0]), __builtin_bit_cast(i32x4, Bt[n][1]), 0, 1, 2, 3, 4, 5, 6, 7); \
            acc[ai][bj][m][n] = __builtin_amdgcn_mfma_scale_f32_16x16x128_f8f6f4(_b, _a, acc[ai][bj][m][n], 0, 0, 0, 0x7F7F7F7F, 0, 0x7F7F7F7F); } } \
        else if constexpr (Epi::FP8) { const l64x2 _a = __builtin_bit_cast(l64x2, At[m][k]), _b = __builtin_bit_cast(l64x2, Bt[n][k]); \
            acc[ai][bj][m][n] = __builtin_amdgcn_mfma_f32_16x16x32_fp8_fp8(_b[0], _a[0], acc[ai][bj][m][n], 0, 0, 0); \
            acc[ai][bj][m][n] = __builtin_amdgcn_mfma_f32_16x16x32_fp8_fp8(_b[1], _a[1], acc[ai][bj][m][n], 0, 0, 0); } \
        else acc[ai][bj][m][n] = __builtin_amdgcn_mfma_f32_16x16x32_bf16(Bt[n][k], At[m][k], acc[ai][bj][m][n], 0, 0, 0); } __builtin_amdgcn_s_setprio(0); } while (0)
#define PG8_WAIT_V(n) asm volatile("s_waitcnt vmcnt(" #n ")" ::: "memory")
#define PG8_WAIT_L(n) asm volatile("s_waitcnt lgkmcnt(" #n ")" ::: "memory")
#define PG8_BAR __builtin_amdgcn_s_barrier()
#define PG8_SCHED __builtin_amdgcn_sched_barrier(0)
    typename Sched::Unit cur, nxt; int ui = 0;
    if (!S.next(0, cur)) return;
    f32x4 acc[2][2][4][2];
#pragma unroll
    for (int a = 0; a < 2; ++a)
#pragma unroll
        for (int b = 0; b < 2; ++b)
#pragma unroll
            for (int m = 0; m < 4; ++m)
#pragma unroll
                for (int n = 0; n < 2; ++n) acc[a][b][m][n] = (f32x4){0.f, 0.f, 0.f, 0.f};
    bf16x8 At[4][2], B0[2][2], B1[2][2];
    const char* cA = S.a_base(cur); const char* cB = S.b_base(cur);
    unsigned vA0[2], vA1[2];
    PG8_AOFF(cur);
    PG8_STAGE(PG8_SB(0, 0), cB, voffB0); PG8_STAGE(PG8_SA(0, 0), cA, vA0); PG8_STAGE(PG8_SB(0, 1), cB, voffB1); PG8_STAGE(PG8_SA(0, 1), cA, vA1);
    if (wr == 1) PG8_BAR;
    PG8_WAIT_V(4); PG8_BAR;
    PG8_STAGE(PG8_SB(1, 0), cB + kstep, voffB0); PG8_STAGE(PG8_SA(1, 0), cA + kstep, vA0); PG8_STAGE(PG8_SB(1, 1), cB + kstep, voffB1);
    PG8_WAIT_V(6); PG8_BAR;
    for (;;) {
        const unsigned long long prb_a = PRB_NOW();
        const bool has_next = S.next(ui + 1, nxt);
        const char* nA = has_next ? S.a_base(nxt) : cA; const char* nB = has_next ? S.b_base(nxt) : cB;
        const unsigned long long prb_b = PRB_NOW(); PRB_ADD(1, prb_a, prb_b);
        for (int t = 0; t < nt; t += 2) {
            const unsigned long long prb_i0 = PRB_NOW();
            const bool last = (t == nt - 2);
            const char* a1 = cA + (size_t)(t + 1) * kstep;
            const char* a2 = last ? nA : cA + (size_t)(t + 2) * kstep; const char* b2 = last ? nB : cB + (size_t)(t + 2) * kstep;
            const char* a3 = a2 + kstep; const char* b3 = b2 + kstep;
            PG8_LDB(B0, 0, 0); PG8_SCHED; PG8_LDA(At, 0, 0); PG8_STAGE(PG8_SA(1, 1), a1, vA1);
            if (last && has_next) PG8_AOFF(nxt);
            PG8_WAIT_L(8); PG8_BAR; PG8_WAIT_L(0); PG8_MMA(0, 0, At, B0); PG8_BAR; PG8_SCHED;
            PG8_LDB(B1, 0, 1); PG8_STAGE(PG8_SB(0, 0), b2, voffB0);
            PG8_BAR; PG8_WAIT_L(0); PG8_MMA(0, 1, At, B1); PG8_BAR;
            PG8_LDA(At, 0, 1); PG8_STAGE(PG8_SA(0, 0), a2, vA0);
            PG8_BAR; PG8_WAIT_L(0); PG8_MMA(1, 0, At, B0); PG8_BAR; PG8_SCHED;
            PG8_STAGE(PG8_SB(0, 1), b2, voffB1);
            PG8_WAIT_V(6); PG8_BAR; PG8_MMA(1, 1, At, B1); PG8_BAR;
            PG8_LDB(B0, 1, 0); PG8_SCHED; PG8_LDA(At, 1, 0); PG8_STAGE(PG8_SA(0, 1), a2, vA1);
            PG8_WAIT_L(8); PG8_BAR; PG8_WAIT_L(0); PG8_MMA(0, 0, At, B0); PG8_BAR; PG8_SCHED;
            PG8_LDB(B1, 1, 1); PG8_STAGE(PG8_SB(1, 0), b3, voffB0);
            PG8_BAR; PG8_WAIT_L(0); PG8_MMA(0, 1, At, B1); PG8_BAR;
            PG8_LDA(At, 1, 1); PG8_STAGE(PG8_SA(1, 0), a3, vA0);
            PG8_BAR; PG8_WAIT_L(0); PG8_MMA(1, 0, At, B0); PG8_BAR; PG8_SCHED;
            PG8_STAGE(PG8_SB(1, 1), b3, voffB1);
            PG8_WAIT_V(6); PG8_BAR; PG8_MMA(1, 1, At, B1); PG8_BAR;
            { const unsigned long long prb_i1 = PRB_NOW(); if (t == 0) PRB_ADD(4, prb_i0, prb_i1); if (last) PRB_ADD(5, prb_i0, prb_i1); if (t != 0 && !last) PRB_ADD(6, prb_i0, prb_i1); }
        }
        const unsigned long long prb_c = PRB_NOW(); PRB_ADD(2, prb_b, prb_c);
        { int tz = threadIdx.x; asm volatile("" : "+v"(tz)); const int wz = tz >> 6, lz = tz & 63;
          E(acc, cur, wz >> 2, wz & 3, lz & 15, lz >> 4);
#if defined(MK_EPI_TWICE)
          if (Epi::TWICE) { asm volatile("" ::: "memory"); E(acc, cur, wz >> 2, wz & 3, lz & 15, lz >> 4); }
#endif
          }
        { const unsigned long long prb_d = PRB_NOW(); PRB_ADD(3, prb_c, prb_d); }
        if (!has_next) break;
#pragma unroll
        for (int a = 0; a < 2; ++a)
#pragma unroll
            for (int b = 0; b < 2; ++b)
#pragma unroll
                for (int m = 0; m < 4; ++m)
#pragma unroll
                    for (int n = 0; n < 2; ++n) acc[a][b][m][n] = (f32x4){0.f, 0.f, 0.f, 0.f};
        cur = nxt; cA = nA; cB = nB; ++ui;
    }
    PG8_WAIT_V(0);
    if (wr == 0) PG8_BAR;
    PG8_BAR;
#undef PG8_AOFF
#undef PRB_NOW
#undef PRB_ADD
#undef PG8_SA
#undef PG8_SB
#undef PG8_STAGE
#undef PG8_LDA
#undef PG8_LDB
#undef PG8_MMA
#undef PG8_WAIT_V
#undef PG8_WAIT_L
#undef PG8_BAR
#undef PG8_SCHED
}

template <class Epi, class Sched>
__device__ __forceinline__ void gemm_phase(LAS unsigned char* lds, const int K, const int ldb, const Sched& S, const Epi& E) {
#if MK_FAST_GEMM
    gemm_fast<Epi, Sched>(lds, K, ldb, S, E);
#else
    gemm_simple<Epi, Sched>(K, ldb, S, E);
#endif
}

struct DenseUnit { int pm, pn, ks; };
template <int NM, int NN, int KSPLIT>
struct DenseSchedT {
    typedef DenseUnit Unit;
    const char* A; const char* B; int lda2, ldb2, ksub2, G, c, i0, i1;
    __device__ __forceinline__ void init(const void* A_, const void* B_, int lda, int ldb, int Ksub, int G_, int c_) {
        A = (const char*)A_; B = (const char*)B_; lda2 = lda * 2; ldb2 = ldb * 2; ksub2 = Ksub * 2; G = G_; c = c_; i0 = 0; i1 = 0x3fffffff; }
    __device__ __forceinline__ bool next(int i, Unit& u) const {
        constexpr int nwg = NM * NN, total = nwg * KSPLIT;
        if (i + i0 >= i1) return false;
        const int L = (i + i0) * G + c; if (L >= total) return false;
        int id = L / KSPLIT; u.ks = L - id * KSPLIT;
        { constexpr int q = nwg / 8, r = nwg % 8; const int xcd = id % 8, off = id / 8; id = (xcd < r ? xcd * (q + 1) : r * (q + 1) + (xcd - r) * q) + off; }
        constexpr int nig = 8 * NN; const int gid = id / nig, fm = gid * 8, gsz = (NM - fm) < 8 ? (NM - fm) : 8;
        u.pm = fm + ((id % nig) % gsz); u.pn = (id % nig) / gsz; return true;
    }
    __device__ __forceinline__ const char* a_base(const Unit& u) const { return A + (size_t)u.pm * 256 * lda2 + (size_t)u.ks * ksub2; }
    __device__ __forceinline__ const char* b_base(const Unit& u) const { return B + (size_t)u.pn * 256 * ldb2 + (size_t)u.ks * ksub2; }
    __device__ __forceinline__ unsigned a_off(const Unit&, int r) const { return (unsigned)(r * lda2); }
};

template <int PN, bool DOWN>
struct MoeSched {
    struct Unit { int kind, e, rb, blk, valid, pm, pn; };
    const LAS int* prefix; const LAS int* cnt; const unsigned* bucket;
    const char* Ar; const char* As; const char* Br; const char* Bs;
    int nRouted, total, G, c, i0, i1;
    __device__ __forceinline__ bool next(int i, Unit& u) const {
        if (i + i0 >= i1) return false;
        const int id = (i + i0) * G + c; if (id >= total) return false;
        u.e = 0; u.rb = 0; u.blk = 0; u.pm = 0;
        if (id < nRouted) {
            const int blk = id / PN; u.pn = id % PN;
            const int lo = ((const LAS unsigned char*)(cnt + 256))[blk];
            u.kind = 0; u.e = lo; u.rb = blk - prefix[lo]; u.blk = blk; const int rem = cnt[lo] - u.rb * 256; u.valid = rem < 256 ? rem : 256;
        } else { const int s = id - nRouted; u.kind = 1; u.pm = s / PN; u.pn = s % PN; u.valid = 256; }
        return true;
    }
    __device__ __forceinline__ const char* a_base(const Unit& u) const { return u.kind == 0 ? Ar : As; }
    __device__ __forceinline__ const char* b_base(const Unit& u) const {
        if (!DOWN) return u.kind == 0 ? Br + ((size_t)u.e * 512 + (size_t)u.pn * 256) * D : Bs + (size_t)u.pn * 256 * D;
        else       return u.kind == 0 ? Br + ((size_t)u.e * 1024 + (size_t)u.pn * 256) * FF : Bs + (size_t)u.pn * 256 * FF;
    }
    __device__ __forceinline__ unsigned a_off(const Unit& u, int r) const {
        if (!DOWN) {
            if (u.kind == 0) { const int rr = r < u.valid ? r : u.valid - 1; const unsigned slot = bucket[(size_t)u.e * CAP + u.rb * 256 + rr]; return (slot >> 3) * (unsigned)D; }
            return (unsigned)(u.pm * 256 + r) * (unsigned)D;
        } else {
            return (unsigned)((u.kind == 0 ? u.blk : u.pm) * 256 + r) * (unsigned)FF;
        }
    }
};

struct EpiProj {
    static constexpr int PID = 2, PERM = 2;
    static constexpr bool TWICE = false, FP8 = false;
    bf16* O;
    __device__ __forceinline__ void operator()(const f32x4 (&acc)[2][2][4][2], const DenseUnit& u, int wr, int wc, int fr, int fq) const {
        const int row0 = u.pm * 256 + wr * 64 + fr, col0 = u.pn * 256 + wc * 64 + 16 * fq;
#pragma unroll
        for (int ai = 0; ai < 2; ++ai)
#pragma unroll
            for (int m = 0; m < 4; ++m) { bf16* rowp = O + (size_t)(row0 + ai * 128 + m * 16) * NPROJ + col0;
#pragma unroll
                for (int bj = 0; bj < 2; ++bj) { const f32x4 v0 = acc[ai][bj][m][0], v1 = acc[ai][bj][m][1];
                    *(v4u*)(rowp + bj * 8) = (v4u){pk2(v0[0], v0[1]), pk2(v0[2], v0[3]), pk2(v1[0], v1[1]), pk2(v1[2], v1[3])}; } }
    }
};
struct EpiOut {
    static constexpr int PID = 5, PERM = 2;
    static constexpr bool TWICE = false, FP8 = false;
    bf16* O;
    __device__ __forceinline__ void operator()(const f32x4 (&acc)[2][2][4][2], const DenseUnit& u, int wr, int wc, int fr, int fq) const {
        const int row0 = u.pm * 256 + wr * 64 + fr, col0 = u.pn * 256 + wc * 64 + 16 * fq;
#pragma unroll
        for (int ai = 0; ai < 2; ++ai)
#pragma unroll
            for (int m = 0; m < 4; ++m) { bf16* rowp = O + (size_t)(row0 + ai * 128 + m * 16) * (2 * D) + col0;
#pragma unroll
                for (int bj = 0; bj < 2; ++bj) { const f32x4 v0 = acc[ai][bj][m][0], v1 = acc[ai][bj][m][1];
                    *(v4u*)(rowp + bj * 8) = (v4u){pk2(v0[0], v0[1]), pk2(v0[2], v0[3]), pk2(v1[0], v1[1]), pk2(v1[2], v1[3])}; } }
    }
};
struct EpiRouter {
    static constexpr int PID = 7, PERM = 0;
    static constexpr bool TWICE = false, FP8 = false;
    float* L;
    __device__ __forceinline__ void operator()(const f32x4 (&acc)[2][2][4][2], const DenseUnit& u, int wr, int wc, int fr, int fq) const {
        const int row0 = u.pm * 256 + wr * 64 + fr, col0 = wc * 32 + 4 * fq;
        float* Lp = L + (size_t)u.ks * NT * NE;
#pragma unroll
        for (int ai = 0; ai < 2; ++ai)
#pragma unroll
            for (int m = 0; m < 4; ++m) { const size_t ro = (size_t)(row0 + ai * 128 + m * 16) * NE + col0;
#pragma unroll
                for (int bj = 0; bj < 2; ++bj)
#pragma unroll
                    for (int n = 0; n < 2; ++n) *(f32x4*)(Lp + ro + bj * 128 + n * 16) = acc[ai][bj][m][n]; }
    }
};
struct EpiGU {
    static constexpr int PID = 9, PERM = 1;
    static constexpr bool TWICE = false, FP8 = true;
    unsigned char* act; unsigned char* acts; const unsigned* bucket; unsigned* pos;
    __device__ __forceinline__ void operator()(const f32x4 (&acc)[2][2][4][2], const MoeSched<2, false>::Unit& u, int wr, int wc, int fr, int fq) const {
        unsigned char* O = u.kind == 0 ? act : acts;
        const int row0 = (u.kind == 0 ? u.blk : u.pm) * 256 + wr * 64 + fr, col0 = u.pn * 128 + wc * 32 + 8 * fq;
        if (u.kind == 0 && u.pn == 0 && wc == 0 && fq == 0) {
#pragma unroll
            for (int ai = 0; ai < 2; ++ai)
#pragma unroll
                for (int m = 0; m < 4; ++m) { const int r = ai * 128 + wr * 64 + m * 16 + fr;
                    if (r < u.valid) pos[bucket[(size_t)u.e * CAP + u.rb * 256 + r]] = (unsigned)(u.blk * 256 + r); } }
#pragma unroll
        for (int ai = 0; ai < 2; ++ai)
#pragma unroll
            for (int m = 0; m < 4; ++m) {
                const f32x4 g0 = acc[ai][0][m][0], g1 = acc[ai][0][m][1], u0 = acc[ai][1][m][0], u1 = acc[ai][1][m][1];
                float a[8];
#pragma unroll
                for (int j = 0; j < 4; j += 2) {
                    const f32x2 ga = (f32x2){g0[j], g0[j + 1]} * W_INV_SCALE, gb = (f32x2){g1[j], g1[j + 1]} * W_INV_SCALE;
                    const f32x2 ua = (f32x2){u0[j], u0[j + 1]} * (W_INV_SCALE * ACT_SCALE), ub = (f32x2){u1[j], u1[j + 1]} * (W_INV_SCALE * ACT_SCALE);
                    const f32x2 ea = ga * (-1.44269504f), eb = gb * (-1.44269504f);
                    f32x2 da, db; da.x = __builtin_amdgcn_exp2f(ea.x); da.y = __builtin_amdgcn_exp2f(ea.y); db.x = __builtin_amdgcn_exp2f(eb.x); db.y = __builtin_amdgcn_exp2f(eb.y);
                    da = da + 1.0f; db = db + 1.0f;
                    f32x2 ra, rb; ra.x = __builtin_amdgcn_rcpf(da.x); ra.y = __builtin_amdgcn_rcpf(da.y); rb.x = __builtin_amdgcn_rcpf(db.x); rb.y = __builtin_amdgcn_rcpf(db.y);
                    const f32x2 oa = (ga * ua) * ra, ob = (gb * ub) * rb;
                    a[j] = oa.x; a[j + 1] = oa.y; a[4 + j] = ob.x; a[4 + j + 1] = ob.y; }
                *(v2u*)(O + (size_t)(row0 + ai * 128 + m * 16) * FF + col0) = (v2u){pk4_fp8(a[0], a[1], a[2], a[3]), pk4_fp8(a[4], a[5], a[6], a[7])};
                __builtin_amdgcn_sched_barrier(0);
            }
    }
};
constexpr float Y_SCALE = 8.f, Y_INV_SCALE = 0.125f;
struct EpiDown {
    static constexpr int PID = 10, PERM = 2;
    static constexpr bool TWICE = false, FP8 = true;
    unsigned char* Y; bf16* O;
    __device__ __forceinline__ void operator()(const f32x4 (&acc)[2][2][4][2], const MoeSched<4, true>::Unit& u, int wr, int wc, int fr, int fq) const {
        const int col0 = u.pn * 256 + wc * 64 + 16 * fq;
        if (u.kind == 0) {
            const int row0 = u.blk * 256 + wr * 64 + fr;
            constexpr float sc = Y_SCALE * W_INV_SCALE / ACT_SCALE;
#pragma unroll
            for (int ai = 0; ai < 2; ++ai)
#pragma unroll
                for (int m = 0; m < 4; ++m) { unsigned char* rowp = Y + (size_t)(row0 + ai * 128 + m * 16) * D + col0;
                    unsigned w[4];
#pragma unroll
                    for (int bj = 0; bj < 2; ++bj)
#pragma unroll
                        for (int n = 0; n < 2; ++n) { f32x4 v = acc[ai][bj][m][n] * sc;
#pragma unroll
                            for (int j = 0; j < 4; ++j) v[j] = __builtin_amdgcn_fmed3f(v[j], -448.f, 448.f);
                            w[bj * 2 + n] = pk4_fp8(v[0], v[1], v[2], v[3]); }
                    *(v4u*)rowp = (v4u){w[0], w[1], w[2], w[3]}; }
        } else {
            const int row0 = u.pm * 256 + wr * 64 + fr;
#pragma unroll
            for (int ai = 0; ai < 2; ++ai)
#pragma unroll
                for (int m = 0; m < 4; ++m) { bf16* rowp = O + (size_t)(row0 + ai * 128 + m * 16) * (2 * D) + D + col0;
#pragma unroll
                    for (int bj = 0; bj < 2; ++bj) { const f32x4 v0 = acc[ai][bj][m][0] * (W_INV_SCALE / ACT_SCALE), v1 = acc[ai][bj][m][1] * (W_INV_SCALE / ACT_SCALE);
                        *(v4u*)(rowp + bj * 8) = (v4u){pk2(v0[0], v0[1]), pk2(v0[2], v0[3]), pk2(v1[0], v1[1]), pk2(v1[2], v1[3])}; } }
        }
    }
};

struct Args { const float* in[19]; float* out; unsigned char* ws; int ph_lo, ph_hi; };

struct Frame {
    LAS unsigned char* lds; int tid, lane, wave, G, bid;
    float* out; unsigned char* ws;
};

__device__ __forceinline__ void titem_load(const float* W, int N, int kb, int nb, int lane, float (&v)[32]) {
    const float* Wu = W + (size_t)(64 * kb) * N + 32 * nb;
    const unsigned loff = (unsigned)((lane >> 5) * N + (lane & 31)) * 4u;
#pragma unroll
    for (int i = 0; i < 32; ++i) v[i] = *(const float*)((const char*)(Wu + (size_t)(2 * i) * N) + loff);
}
template <bool FP8>
__device__ __forceinline__ void titem_store(const float (&v)[32], int K, void* WTv, int kb, int dst_row0, LAS float* scr, int lane) {
    const int k0 = 64 * kb;
#pragma unroll
    for (int i = 0; i < 32; ++i) { const int kk = 2 * i + (lane >> 5); scr[kk * 33 + (lane & 31)] = v[i]; }
    asm volatile("s_waitcnt lgkmcnt(0)" ::: "memory");
    const int c = lane & 7;
#pragma unroll
    for (int j = 0; j < 4; ++j) { const int n = (lane >> 3) + 8 * j; const LAS float* s = scr + (8 * c) * 33 + n;
        if (FP8) { v2u o; o.x = pk4_fp8(s[0 * 33] * W_SCALE, s[1 * 33] * W_SCALE, s[2 * 33] * W_SCALE, s[3 * 33] * W_SCALE);
            o.y = pk4_fp8(s[4 * 33] * W_SCALE, s[5 * 33] * W_SCALE, s[6 * 33] * W_SCALE, s[7 * 33] * W_SCALE);
            *(v2u*)((unsigned char*)WTv + (size_t)(dst_row0 + n) * K + k0 + 8 * c) = o; }
        else { v4u o; o.x = pk2(s[0 * 33], s[1 * 33]); o.y = pk2(s[2 * 33], s[3 * 33]); o.z = pk2(s[4 * 33], s[5 * 33]); o.w = pk2(s[6 * 33], s[7 * 33]);
            *(v4u*)((bf16*)WTv + (size_t)(dst_row0 + n) * K + k0 + 8 * c) = o; } }
    asm volatile("s_waitcnt lgkmcnt(0)" ::: "memory");
}
template <bool FP8>
__device__ __forceinline__ void transpose_item(const float* W, int K, int N, void* WT, int kb, int nb, int dst_row0, LAS float* scr, int lane) {
    float v[32]; titem_load(W, N, kb, nb, lane, v); titem_store<FP8>(v, K, WT, kb, dst_row0, scr, lane);
}
template <bool DOWN>
__device__ __forceinline__ void convert_expert(Frame& F, const float* Wa, const float* Wb, unsigned char* dst) {
    LAS float* scr = (LAS float*)(F.lds + F.wave * 16384);
    constexpr int PER_WAVE = DOWN ? 16 : 32;
    const int base = 0, wv = F.wave;
    auto ld = [&](int i, float (&v)[32]) {
        if (!DOWN) titem_load((i >> 4) ? Wb : Wa, FF, i & 15, wv, F.lane, v);
        else titem_load(Wa, D, i >> 2, wv + 8 * (i & 3), F.lane, v); };
    auto st = [&](int i, const float (&v)[32]) {
        if (!DOWN) { const int n0 = wv * 32; titem_store<true>(v, D, dst, i & 15, (n0 >> 7) * 256 + ((i >> 4) ? 128 : 0) + (n0 & 127), scr, F.lane); }
        else titem_store<true>(v, FF, dst, i >> 2, (wv + 8 * (i & 3)) * 32, scr, F.lane); };
    float v0[32], v1[32], v2[32], v3[32];
    ld(base, v0); ld(base + 1, v1); ld(base + 2, v2);
    for (int i = 0; i < PER_WAVE; i += 4) {
        ld(base + i + 3, v3); st(base + i, v0);
        if (i + 4 < PER_WAVE) ld(base + i + 4, v0);
        st(base + i + 1, v1);
        if (i + 5 < PER_WAVE) ld(base + i + 5, v1);
        st(base + i + 2, v2);
        if (i + 6 < PER_WAVE) ld(base + i + 6, v2);
        st(base + i + 3, v3);
    }
}

__device__ __forceinline__ void p0_prologue(Frame& F) {
#define INP(i) ld_ptr(F.lds, (i))
    if (F.bid < 192) {
        const float* cptr = INP(1); const float* w_ada = INP(2); const float* b_ada = INP(3);
        LAS float* cs = (LAS float*)F.lds;
        LAS float* red = (LAS float*)(F.lds + 32768);
        for (int i = F.tid; i < NB * D; i += NTHREADS) { const float v = cptr[i]; cs[i] = v / (1.f + __expf(-v)); }
        __syncthreads();
        const int col = F.tid & 31, kg = F.tid >> 5, j = F.bid * 32 + col;
        float a[NB];
#pragma unroll
        for (int b = 0; b < NB; ++b) a[b] = 0.f;
#pragma unroll 8
        for (int kk = 0; kk < 64; ++kk) { const int k = kg * 64 + kk; const float w = w_ada[(size_t)k * 6144 + j];
#pragma unroll
            for (int b = 0; b < NB; ++b) a[b] += cs[b * D + k] * w; }
#pragma unroll
        for (int b = 0; b < NB; ++b) red[(kg * NB + b) * 32 + col] = a[b];
        __syncthreads();
        if (F.tid < 256) { const int b = F.tid >> 5, cc = F.tid & 31; float s = 0.f;
#pragma unroll
            for (int g = 0; g < 16; ++g) s += red[(g * NB + b) * 32 + cc];
            ((float*)(F.ws + WS_MOD))[b * 6144 + F.bid * 32 + cc] = s + b_ada[F.bid * 32 + cc]; }
        __syncthreads();
    }
    LAS float* scr = (LAS float*)(F.lds + F.wave * 16384);
    const int gw = F.bid * NWAVES + F.wave, NGW = F.G * NWAVES;
    constexpr int I_IN = 16 * 80, I_OUT = 8 * 32, I_R = 16 * 8, I_G = 16 * 8, I_D = 4 * 32;
    constexpr int I_SMALL = I_IN + I_OUT + I_R + 2 * I_G + I_D, I_EXP = 2 * I_G + I_D;
    constexpr int NITEMS = I_SMALL;
    unsigned char* win_t = F.ws + WS_WIN_T; bf16* wout_t = (bf16*)(F.ws + WS_WOUT_T); bf16* wr_t = (bf16*)(F.ws + WS_WR_T);
    unsigned char* wsgu_t = F.ws + WS_WSGU_T; unsigned char* wsd_t = F.ws + WS_WSD_T; unsigned char* wgu_t = F.ws + WS_WGU_T; unsigned char* wd_t = F.ws + WS_WD_T;
    for (int it = gw; it < NITEMS; it += NGW) {
        int r = it;
        if (r < I_IN) { transpose_item<false>(INP(5), D, NPROJ, win_t, r / 80, r % 80, (r % 80) * 32, scr, F.lane); continue; } r -= I_IN;
        if (r < I_OUT) { transpose_item<false>(INP(8), NMIX, D, wout_t, r / 32, r % 32, (r % 32) * 32, scr, F.lane); continue; } r -= I_OUT;
        if (r < I_R) { transpose_item<false>(INP(10), D, NE, wr_t, r / 8, r % 8, (r % 8) * 32, scr, F.lane); continue; } r -= I_R;
        const float *Wg, *Wu, *Wd; unsigned char *GU, *DN;
        if (r < 2 * I_G + I_D) { Wg = INP(15); Wu = INP(16); Wd = INP(17); GU = wsgu_t; DN = wsd_t; }
        else { r -= 2 * I_G + I_D; const int e = r / I_EXP; r -= e * I_EXP;
            Wg = INP(12) + (size_t)e * D * FF; Wu = INP(13) + (size_t)e * D * FF; Wd = INP(14) + (size_t)e * FF * D;
            GU = wgu_t + (size_t)e * 512 * D; DN = wd_t + (size_t)e * D * FF; }
        if (r < I_G) { const int nb = r % 8, n0 = nb * 32; transpose_item<true>(Wg, D, FF, GU, r / 8, nb, (n0 >> 7) * 256 + (n0 & 127), scr, F.lane); continue; } r -= I_G;
        if (r < I_G) { const int nb = r % 8, n0 = nb * 32; transpose_item<true>(Wu, D, FF, GU, r / 8, nb, (n0 >> 7) * 256 + 128 + (n0 & 127), scr, F.lane); continue; } r -= I_G;
        transpose_item<true>(Wd, FF, D, DN, r / 32, r % 32, (r % 32) * 32, scr, F.lane);
    }
#undef INP
}

template <bool HAS_DX, bool OUT8, bool OUTB>
__device__ __forceinline__ void modnorm_phase(Frame& F, const float* X, const float* g, int shift_chunk, unsigned char* O8, bf16* Ob) {
    const float* mod = (const float*)(F.ws + WS_MOD);
    constexpr int RW = 4;
    const unsigned l16 = (unsigned)F.lane * 16u, l8 = (unsigned)F.lane * 8u, l4 = (unsigned)F.lane * 4u;
    const int wv = __builtin_amdgcn_readfirstlane(F.wave);
    for (int blk = F.bid; blk < NT / 128; blk += F.G) {
        const int b = (blk * 128) >> 12;
        const float* sh = mod + (size_t)b * 6144 + shift_chunk * D; const float* sc = sh + D; const float* g1 = mod + (size_t)b * 6144 + 2 * D;
        f32x4 gg[4], ss[4], ga[4];
#pragma unroll
        for (int j = 0; j < 4; ++j) { const f32x4 gv = *(const f32x4*)((const char*)g + 1024 * j + l16), scv = *(const f32x4*)((const char*)sc + 1024 * j + l16);
            gg[j] = gv * (scv + 1.f); ss[j] = *(const f32x4*)((const char*)sh + 1024 * j + l16); ga[j] = HAS_DX ? *(const f32x4*)((const char*)g1 + 1024 * j + l16) : (f32x4){0.f, 0.f, 0.f, 0.f}; }
#pragma nounroll
        for (int rr = 0; rr < 16; rr += RW) {
            const int row = blk * 128 + wv * 16 + rr;
            f32x4 v[RW][4]; v2u dv[RW][4];
#pragma unroll
            for (int q = 0; q < RW; ++q) { const char* xr = (const char*)(X + (size_t)(row + q) * D);
#pragma unroll
                for (int j = 0; j < 4; ++j) v[q][j] = *(const f32x4*)(xr + 1024 * j + l16);
                if (HAS_DX) { const char* dr = (const char*)F.out + (size_t)(row + q) * (4 * D);
#pragma unroll
                    for (int j = 0; j < 4; ++j) dv[q][j] = *(const v2u*)(dr + 512 * j + l8); } }
#pragma unroll
            for (int q = 0; q < RW; ++q) { float s = 0.f;
#pragma unroll
                for (int j = 0; j < 4; ++j) {
                    if (HAS_DX) v[q][j] = v[q][j] + ga[j] * (f32x4){bflo(dv[q][j].x), bfhi(dv[q][j].x), bflo(dv[q][j].y), bfhi(dv[q][j].y)};
                    s += (v[q][j].x * v[q][j].x + v[q][j].y * v[q][j].y) + (v[q][j].z * v[q][j].z + v[q][j].w * v[q][j].w); }
                const float rstd = 1.f / sqrtf(wave_sum(s) * (1.f / D) + NORM_EPS);
                char* o8 = (char*)O8 + (size_t)(row + q) * D; char* ob = (char*)Ob + (size_t)(row + q) * (2 * D);
#pragma unroll
                for (int j = 0; j < 4; ++j) { const f32x4 y = v[q][j] * rstd * gg[j] + ss[j]; if (OUT8) *(unsigned*)(o8 + 256 * j + l4) = pk4_fp8(y.x, y.y, y.z, y.w);
                    if (OUTB) *(v2u*)(ob + 512 * j + l8) = (v2u){pk2(y.x, y.y), pk2(y.z, y.w)}; }
                __builtin_amdgcn_sched_barrier(0); }
        }
    }
}

__device__ __forceinline__ void pool_phase(Frame& F, const float* pool_w, const float* pool_scale) {
    const bf16* proj = (const bf16*)(F.ws + WS_PROJ); bf16* mixin = (bf16*)(F.ws + WS_MIXIN);
    LAS float* us = (LAS float*)F.lds;
    LAS float* pl = (LAS float*)(F.lds + 49152);
    for (int tile = F.bid; tile < NT / 32; tile += F.G) {
        const int row0 = tile * 32, tl0 = row0 & (SEQ - 1);
        __syncthreads();
        for (int p = F.tid; p < 47 * 32; p += NTHREADS) { const int rr = p >> 5, pc = p & 31; const int tl = tl0 - 15 + rr;
            v4u raw = (v4u){0u, 0u, 0u, 0u};
            if (tl >= 0) raw = *(const v4u*)(proj + (size_t)(row0 - 15 + rr) * NPROJ + pc * 8);
            LAS float* d = us + rr * 256 + pc * 8;
            d[0] = bflo(raw.x); d[1] = bfhi(raw.x); d[2] = bflo(raw.y); d[3] = bfhi(raw.y); d[4] = bflo(raw.z); d[5] = bfhi(raw.z); d[6] = bflo(raw.w); d[7] = bfhi(raw.w); }
        __syncthreads();
        { const int ch = F.tid & 255, half = F.tid >> 8, w = 2 << (ch >> 6);
            for (int i = 0; i < 16; ++i) { const int tt = half * 16 + i, tl = tl0 + tt; float s = 0.f;
                for (int k = 0; k < w; ++k) s += us[(15 + tt - k) * 256 + ch];
                const int cnt = (tl + 1) < w ? (tl + 1) : w;
                pl[tt * 256 + ch] = s / (float)cnt - us[(15 + tt) * 256 + ch]; } }
        __syncthreads();
        { const int col = F.tid & 255, half = F.tid >> 8, g = col >> 6, dc = col & 63;
            float acc[16];
#pragma unroll
            for (int i = 0; i < 16; ++i) acc[i] = 0.f;
            const float* pw = pool_w + (size_t)g * 64 * 64 + dc;
            for (int c4 = 0; c4 < 64; c4 += 4) {
                const float w0 = pw[(c4 + 0) * 64], w1 = pw[(c4 + 1) * 64], w2 = pw[(c4 + 2) * 64], w3 = pw[(c4 + 3) * 64];
#pragma unroll
                for (int i = 0; i < 16; ++i) { const f32x4 p = *(const LAS f32x4*)(pl + (half * 16 + i) * 256 + g * 64 + c4);
                    acc[i] += p.x * w0 + p.y * w1 + p.z * w2 + p.w * w3; } }
            const float sc = pool_scale[col];
#pragma unroll
            for (int i = 0; i < 16; ++i) mixin[(size_t)(row0 + half * 16 + i) * NMIX + col] = (bf16)f2bf(acc[i] * sc); }
    }
}

constexpr int KV_PITCH = 144;
__device__ __forceinline__ void attn_phase(Frame& F) {
    const bf16* proj = (const bf16*)(F.ws + WS_PROJ);
    bf16* atto = (bf16*)(F.ws + WS_ATTO); float* lse = (float*)(F.ws + WS_LSE);
    LAS unsigned char* Ks = F.lds; LAS unsigned char* Vs = F.lds + 256 * KV_PITCH;
    const int lane = F.lane, fr = lane & 15, fq = lane >> 4, w = F.wave;
    const int w_i0 = 16 * w, c0 = w >> 1, qi = w_i0 + fr;
#define ATT_DECODE(unit_, rowb_, d_, r_, n_, g_, h_, colQ_) \
        const int rn_##unit_ = (unit_) & 31; const int h_ = ((unit_) >> 5) & 3, g_ = ((unit_) >> 7) % 3; const size_t rowb_ = (size_t)((unit_) / 384) * SEQ; \
        const int d_ = 1 << (2 * g_), nbk_##unit_ = 32 >> (2 * g_), r_ = rn_##unit_ / nbk_##unit_, n_ = rn_##unit_ % nbk_##unit_; const int colQ_ = 256 + g_ * 256 + h_ * 64;
    v4u kreg[4], vreg[4]; bf16x8 qn[2];
    {   const int unit0 = F.bid;
        if (unit0 < NB * 3 * 4 * 32) { ATT_DECODE(unit0, rowb, d, r, n, g, h, colQ)
            const size_t qrow = rowb + (size_t)(n * 128 + qi) * d + r;
#pragma unroll
            for (int ks = 0; ks < 2; ++ks) qn[ks] = *(const bf16x8*)(proj + qrow * NPROJ + colQ + ks * 32 + fq * 8);
#pragma unroll
            for (int cidx = 0; cidx < 4; ++cidx) { const int ch = F.tid + 512 * cidx, j = ch >> 3, pc = ch & 7;
                int p = (n - 1) * 128 + j; p = p < 0 ? 0 : p; const size_t row = rowb + (size_t)p * d + r;
                kreg[cidx] = *(const v4u*)(proj + row * NPROJ + colQ + 768 + pc * 8); vreg[cidx] = *(const v4u*)(proj + row * NPROJ + colQ + 1536 + pc * 8); } } }
    for (int unit = F.bid; unit < NB * 3 * 4 * 32; unit += F.G) {
        ATT_DECODE(unit, rowb, d, r, n, g, h, colQ)
        __syncthreads();
#pragma unroll
        for (int cidx = 0; cidx < 4; ++cidx) { const int ch = F.tid + 512 * cidx, j = ch >> 3, pc = ch & 7;
            *(LAS v4u*)(Ks + j * KV_PITCH + pc * 16) = kreg[cidx]; *(LAS v4u*)(Vs + j * KV_PITCH + pc * 16) = vreg[cidx]; }
        const size_t qrow = rowb + (size_t)(n * 128 + qi) * d + r;
        bf16x8 qf[2]; qf[0] = qn[0]; qf[1] = qn[1];
        __syncthreads();
        {   const int unit2 = unit + F.G;
            if (unit2 < NB * 3 * 4 * 32) { ATT_DECODE(unit2, rowb2, d2, r2, n2, g2, h2, colQ2)
                const size_t qrow2 = rowb2 + (size_t)(n2 * 128 + qi) * d2 + r2;
#pragma unroll
                for (int ks = 0; ks < 2; ++ks) qn[ks] = *(const bf16x8*)(proj + qrow2 * NPROJ + colQ2 + ks * 32 + fq * 8);
#pragma unroll
                for (int cidx = 0; cidx < 4; ++cidx) { const int ch = F.tid + 512 * cidx, j = ch >> 3, pc = ch & 7;
                    int p = (n2 - 1) * 128 + j; p = p < 0 ? 0 : p; const size_t row = rowb2 + (size_t)p * d2 + r2;
                    kreg[cidx] = *(const v4u*)(proj + row * NPROJ + colQ2 + 768 + pc * 8); vreg[cidx] = *(const v4u*)(proj + row * NPROJ + colQ2 + 1536 + pc * 8); } } }
        f32x4 s[5][2];
#pragma unroll
        for (int cc = 0; cc < 5; ++cc)
#pragma unroll
            for (int hh = 0; hh < 2; ++hh) {
                const int j = 32 * (c0 + cc) + 8 * (fr >> 2) + 4 * hh + (fr & 3);
                const bf16x8 k0 = *(const LAS bf16x8*)(Ks + j * KV_PITCH + fq * 16), k1 = *(const LAS bf16x8*)(Ks + j * KV_PITCH + 64 + fq * 16);
                f32x4 a = (f32x4){0.f, 0.f, 0.f, 0.f};
                a = __builtin_amdgcn_mfma_f32_16x16x32_bf16(k0, qf[0], a, 0, 0, 0);
                a = __builtin_amdgcn_mfma_f32_16x16x32_bf16(k1, qf[1], a, 0, 0, 0);
                s[cc][hh] = a;
            }
        float mx = -1e30f;
        int qil = qi; asm volatile("" : "+v"(qil));
#pragma unroll
        for (int cc = 0; cc < 5; ++cc)
#pragma unroll
            for (int hh = 0; hh < 2; ++hh)
#pragma unroll
                for (int rr = 0; rr < 4; ++rr) { const int j = 32 * (c0 + cc) + 8 * fq + 4 * hh + rr; const int dist = 128 + qil - j;
                    const bool valid = (dist >= 0) && (dist <= 128) && (n > 0 || j >= 128);
                    const float v = valid ? s[cc][hh][rr] * 0.18033688f : -1e30f; s[cc][hh][rr] = v; mx = fmaxf(mx, v); }
        mx = fmaxf(mx, __shfl_xor(mx, 16)); mx = fmaxf(mx, __shfl_xor(mx, 32));
        float l = 0.f;
#pragma unroll
        for (int cc = 0; cc < 5; ++cc)
#pragma unroll
            for (int hh = 0; hh < 2; ++hh)
#pragma unroll
                for (int rr = 0; rr < 4; ++rr) { const float p = __builtin_amdgcn_exp2f(s[cc][hh][rr] - mx); s[cc][hh][rr] = p; l += p; }
        l += __shfl_xor(l, 16); l += __shfl_xor(l, 32);
        f32x4 o[4];
#pragma unroll
        for (int eb = 0; eb < 4; ++eb) o[eb] = (f32x4){0.f, 0.f, 0.f, 0.f};
#pragma unroll
        for (int cc = 0; cc < 5; ++cc) {
            const v4u pu = (v4u){pk2(s[cc][0][0], s[cc][0][1]), pk2(s[cc][0][2], s[cc][0][3]), pk2(s[cc][1][0], s[cc][1][1]), pk2(s[cc][1][2], s[cc][1][3])};
            const bf16x8 pf = __builtin_bit_cast(bf16x8, pu);
            const int key0 = 32 * (c0 + cc) + 8 * fq + (fr >> 2);
#pragma unroll
            for (int eb = 0; eb < 4; ++eb) {
                const LAS unsigned char* vp = Vs + key0 * KV_PITCH + (16 * eb + 4 * (fr & 3)) * 2;
                const s16x4 lo = __builtin_bit_cast(s16x4, __builtin_amdgcn_ds_read_tr16_b64_v4i16((LAS s16x4*)vp));
                const s16x4 hi = __builtin_bit_cast(s16x4, __builtin_amdgcn_ds_read_tr16_b64_v4i16((LAS s16x4*)(vp + 4 * KV_PITCH)));
                const bf16x8 vf = (bf16x8){lo[0], lo[1], lo[2], lo[3], hi[0], hi[1], hi[2], hi[3]};
                o[eb] = __builtin_amdgcn_mfma_f32_16x16x32_bf16(vf, pf, o[eb], 0, 0, 0);
            }
        }
        const float il = 1.f / l;
        bf16* op = atto + ((size_t)g * NT + qrow) * 256 + h * 64 + 4 * fq;
#pragma unroll
        for (int eb = 0; eb < 4; ++eb) { const f32x4 v = o[eb] * il; *(v2u*)(op + 16 * eb) = (v2u){pk2(v.x, v.y), pk2(v.z, v.w)}; }
        if (fq == 0) lse[((size_t)g * NT + qrow) * 4 + h] = mx + __builtin_amdgcn_logf(l);
    }
#undef ATT_DECODE
}

__device__ __forceinline__ void combine_phase(Frame& F) {
    const bf16* atto = (const bf16*)(F.ws + WS_ATTO); const float* lse = (const float*)(F.ws + WS_LSE); bf16* mixin = (bf16*)(F.ws + WS_MIXIN);
    for (size_t idx = (size_t)F.bid * NTHREADS + F.tid; idx < (size_t)NT * 32; idx += (size_t)F.G * NTHREADS) {
        const size_t t = idx >> 5; const int pc = (int)(idx & 31), h = pc >> 3;
        const float l0 = lse[(0 * (size_t)NT + t) * 4 + h], l1 = lse[(1 * (size_t)NT + t) * 4 + h], l2 = lse[(2 * (size_t)NT + t) * 4 + h];
        const float m = fmaxf(l0, fmaxf(l1, l2));
        float a0 = __builtin_amdgcn_exp2f(l0 - m), a1 = __builtin_amdgcn_exp2f(l1 - m), a2 = __builtin_amdgcn_exp2f(l2 - m);
        const float inv = 1.f / (a0 + a1 + a2); a0 *= inv; a1 *= inv; a2 *= inv;
        const v4u v0 = *(const v4u*)(atto + (0 * (size_t)NT + t) * 256 + pc * 8), v1 = *(const v4u*)(atto + (1 * (size_t)NT + t) * 256 + pc * 8), v2 = *(const v4u*)(atto + (2 * (size_t)NT + t) * 256 + pc * 8);
        v4u o;
        o.x = pk2(a0 * bflo(v0.x) + a1 * bflo(v1.x) + a2 * bflo(v2.x), a0 * bfhi(v0.x) + a1 * bfhi(v1.x) + a2 * bfhi(v2.x));
        o.y = pk2(a0 * bflo(v0.y) + a1 * bflo(v1.y) + a2 * bflo(v2.y), a0 * bfhi(v0.y) + a1 * bfhi(v1.y) + a2 * bfhi(v2.y));
        o.z = pk2(a0 * bflo(v0.z) + a1 * bflo(v1.z) + a2 * bflo(v2.z), a0 * bfhi(v0.z) + a1 * bfhi(v1.z) + a2 * bfhi(v2.z));
        o.w = pk2(a0 * bflo(v0.w) + a1 * bflo(v1.w) + a2 * bflo(v2.w), a0 * bfhi(v0.w) + a1 * bfhi(v1.w) + a2 * bfhi(v2.w));
        *(v4u*)(mixin + t * NMIX + 256 + pc * 8) = o;
    }
}

#if MK_NAIVE_ATTN
__device__ __forceinline__ void naive_attn_phase(Frame& F) {
    const bf16* proj = (const bf16*)(F.ws + WS_PROJ); bf16* mixin = (bf16*)(F.ws + WS_MIXIN);
    for (size_t idx = (size_t)F.bid * NTHREADS + F.tid; idx < (size_t)NT * 4; idx += (size_t)F.G * NTHREADS) {
        const size_t tg = idx >> 2; const int h = (int)(idx & 3), t = (int)(tg & (SEQ - 1)); const size_t rowb = tg - t;
        float m = -1e30f, l = 0.f, o[64];
        for (int e = 0; e < 64; ++e) o[e] = 0.f;
        for (int g = 0; g < 3; ++g) { const int d = 1 << (2 * g); const int colQ = 256 + g * 256 + h * 64;
            const bf16* q = proj + tg * NPROJ + colQ;
            for (int j = 0; j <= 128; ++j) { const int tk = t - j * d; if (tk < 0) break;
                const bf16* k = proj + (rowb + tk) * NPROJ + colQ + 768; const bf16* v = k + 768;
                float sdot = 0.f; for (int e = 0; e < 64; ++e) sdot += bf2f(q[e]) * bf2f(k[e]);
                sdot *= 0.125f;
                const float mn = fmaxf(m, sdot), corr = __expf(m - mn), p = __expf(sdot - mn);
                l = l * corr + p; for (int e = 0; e < 64; ++e) o[e] = o[e] * corr + p * bf2f(v[e]); m = mn; } }
        const float il = 1.f / l;
        for (int e = 0; e < 64; ++e) mixin[tg * NMIX + 256 + h * 64 + e] = (bf16)f2bf(o[e] * il);
    }
}
#endif

__device__ __forceinline__ void routing_phase(Frame& F, const float* router_bias) {
    const float* L0 = (const float*)(F.ws + WS_LOGIT); const float* L1 = L0 + (size_t)NT * NE;
    float* gatew = (float*)(F.ws + WS_GATEW); unsigned* bucket = (unsigned*)(F.ws + WS_BUCKET); unsigned* gcnt = (unsigned*)(F.ws + WS_CTL) + CW_GCNT;
    LAS unsigned* hist = (LAS unsigned*)F.lds; LAS unsigned* basel = hist + 256; LAS unsigned* asg = hist + 512;
    const int lane = F.lane;
    for (int blk = F.bid; blk < NT / 128; blk += F.G) {
        __syncthreads();
        if (F.tid < 256) hist[F.tid] = 0u;
        __syncthreads();
        const f32x4 bias = *(const f32x4*)(router_bias + 4 * lane);
        f32x4 lgn; { const size_t t0 = (size_t)blk * 128 + F.wave * 16; lgn = *(const f32x4*)(L0 + t0 * NE + 4 * lane) + *(const f32x4*)(L1 + t0 * NE + 4 * lane); }
#pragma nounroll
        for (int tl = 0; tl < 16; ++tl) {
            const int tloc = F.wave * 16 + tl; const size_t t = (size_t)blk * 128 + tloc;
            const f32x4 lg = lgn;
            if (tl + 1 < 16) lgn = *(const f32x4*)(L0 + (t + 1) * NE + 4 * lane) + *(const f32x4*)(L1 + (t + 1) * NE + 4 * lane);
            float sc[4], cd[4];
#pragma unroll
            for (int i = 0; i < 4; ++i) { sc[i] = 1.f / (1.f + __expf(-lg[i])); cd[i] = sc[i] + bias[i]; }
            float a1 = fmaxf(cd[0], cd[1]), a2 = fminf(cd[0], cd[1]);
#pragma unroll
            for (int i = 2; i < 4; ++i) { const float v = cd[i]; a2 = fmaxf(a2, fminf(a1, v)); a1 = fmaxf(a1, v); }
            { float b1 = dppf<0xB1>(a1), b2 = dppf<0xB1>(a2); float n1 = fmaxf(a1, b1), n2 = fmaxf(fminf(a1, b1), fmaxf(a2, b2)); a1 = n1; a2 = n2;
              b1 = dppf<0x4E>(a1); b2 = dppf<0x4E>(a2); n1 = fmaxf(a1, b1); n2 = fmaxf(fminf(a1, b1), fmaxf(a2, b2)); a1 = n1; a2 = n2;
              b1 = dppf<0x141>(a1); b2 = dppf<0x141>(a2); n1 = fmaxf(a1, b1); n2 = fmaxf(fminf(a1, b1), fmaxf(a2, b2)); a1 = n1; a2 = n2; }
            const float gs = a1 + a2; const int myg = lane >> 3; int rank = 0;
#pragma unroll
            for (int gg = 0; gg < 8; ++gg) { const float o = __builtin_bit_cast(float, __builtin_amdgcn_readlane(__builtin_bit_cast(int, gs), gg * 8)); rank += (o > gs || (o == gs && gg < myg)) ? 1 : 0; }
            if (rank >= 4) {
#pragma unroll
                for (int i = 0; i < 4; ++i) cd[i] = -1e30f; }
            int sel_e = 0; float sel_s = 0.f, ssum = 0.f;
#pragma unroll
            for (int k = 0; k < TOPK; ++k) {
                const float lm = fmaxf(fmaxf(cd[0], cd[1]), fmaxf(cd[2], cd[3]));
                float v = fmaxf(lm, dppf<0xB1>(lm)); v = fmaxf(v, dppf<0x4E>(v)); v = fmaxf(v, dppf<0x141>(v)); v = fmaxf(v, dppf<0x140>(v));
                const float r0 = __builtin_bit_cast(float, __builtin_amdgcn_readlane(__builtin_bit_cast(int, v), 0)), r1 = __builtin_bit_cast(float, __builtin_amdgcn_readlane(__builtin_bit_cast(int, v), 16));
                const float r2 = __builtin_bit_cast(float, __builtin_amdgcn_readlane(__builtin_bit_cast(int, v), 32)), r3 = __builtin_bit_cast(float, __builtin_amdgcn_readlane(__builtin_bit_cast(int, v), 48));
                const float mx = fmaxf(fmaxf(r0, r1), fmaxf(r2, r3));
                const unsigned long long msk = __ballot(lm == mx);
                const int own = __builtin_ffsll((long long)msk) - 1;
                const int bi = cd[0] == mx ? 0 : (cd[1] == mx ? 1 : (cd[2] == mx ? 2 : 3));
                float myv = sc[0]; myv = bi == 1 ? sc[1] : myv; myv = bi == 2 ? sc[2] : myv; myv = bi == 3 ? sc[3] : myv;
                const int wi = __builtin_amdgcn_readlane(bi, own);
                const float sv = __builtin_bit_cast(float, __builtin_amdgcn_readlane(__builtin_bit_cast(int, myv), own));
                if (lane == own) {
#pragma unroll
                    for (int i = 0; i < 4; ++i) if (wi == i) cd[i] = -1e30f; }
                ssum += sv;
                if (lane == k) { sel_e = 4 * own + wi; sel_s = sv; }
            }
            if (lane < TOPK) {
                const unsigned rk = __hip_atomic_fetch_add(hist + sel_e, 1u, __ATOMIC_RELAXED, __HIP_MEMORY_SCOPE_WORKGROUP);
                asg[tloc * 8 + lane] = (unsigned)sel_e | (rk << 16);
                gatew[t * 8 + lane] = sel_s / ssum * 2.5f;
            }
        }
        __syncthreads();
        if (F.tid < 256) { const unsigned c = hist[F.tid]; basel[F.tid] = c ? atomicAdd(&gcnt[F.tid * 16], c) : 0u; }
        __syncthreads();
        for (int a = F.tid; a < 1024; a += NTHREADS) { const unsigned v = asg[a], e = v & 0xffffu, rk = v >> 16;
            bucket[(size_t)e * CAP + basel[e] + rk] = (unsigned)(blk * 1024 + a); }
    }
}

__device__ __forceinline__ void build_tables(Frame& F, int& nblk_total) {
    const unsigned* gcnt = (const unsigned*)(F.ws + WS_CTL) + CW_GCNT;
    LAS int* prefix = (LAS int*)(F.lds + TAB_OFF); LAS int* cnt = prefix + 260;
    __syncthreads();
    if (F.tid < 256) cnt[F.tid] = (int)__hip_atomic_load(&gcnt[F.tid * 16], __ATOMIC_RELAXED, __HIP_MEMORY_SCOPE_AGENT);
    __syncthreads();
    if (F.tid < 64) {
        int nb[4], sm = 0;
#pragma unroll
        for (int i = 0; i < 4; ++i) { nb[i] = (cnt[4 * F.tid + i] + 255) >> 8; sm += nb[i]; }
        int inc = sm;
#pragma unroll
        for (int o = 1; o < 64; o <<= 1) { const int t = __shfl_up(inc, o); if (F.tid >= o) inc += t; }
        int ex = inc - sm;
#pragma unroll
        for (int i = 0; i < 4; ++i) { prefix[4 * F.tid + i] = ex; ex += nb[i]; }
        if (F.tid == 63) prefix[NE] = inc;
    }
    __syncthreads();
    if (F.tid < 256) { LAS unsigned char* b2e = (LAS unsigned char*)(cnt + 256); for (int b = prefix[F.tid]; b < prefix[F.tid + 1]; ++b) b2e[b] = (unsigned char)F.tid; }
    __syncthreads();
    nblk_total = prefix[NE];
}

__device__ __forceinline__ void final_phase(Frame& F, const float* X, const float* g_final) {
    const float* mod = (const float*)(F.ws + WS_MOD); const unsigned char* Y = (const unsigned char*)(F.ws + WS_Y);
    const unsigned* pos = (const unsigned*)(F.ws + WS_POS); const float* gatew = (const float*)(F.ws + WS_GATEW);
    constexpr int RW = 1;
    const int c0 = 16 * F.lane;
    for (int blk = F.bid; blk < NT / 128; blk += F.G) {
        const int b = (blk * 128) >> 12; const float* g1 = mod + (size_t)b * 6144 + 2 * D + c0; const float* g2 = mod + (size_t)b * 6144 + 5 * D + c0;
        f32x4 ga[4], gb[4];
#pragma unroll
        for (int j = 0; j < 4; ++j) { ga[j] = *(const f32x4*)(g1 + 4 * j); gb[j] = *(const f32x4*)(g2 + 4 * j); }
        const size_t rowbase = (size_t)blk * 128 + F.wave * 16;
        const unsigned p0 = pos[rowbase * 8 + F.lane], p1 = pos[rowbase * 8 + 64 + F.lane];
        const float w0 = gatew[rowbase * 8 + F.lane] * Y_INV_SCALE, w1 = gatew[rowbase * 8 + 64 + F.lane] * Y_INV_SCALE;
        for (int rr = 0; rr < 16; rr += RW) {
            f32x4 v[RW][4]; v4u dv[RW][2], sv[RW][2], yv[RW][TOPK]; float wk[RW][TOPK];
#pragma unroll
            for (int q = 0; q < RW; ++q) { const size_t row = rowbase + rr + q;
                const f32x4* xr = (const f32x4*)(X + row * D + c0); const v4u* dr = (const v4u*)((const bf16*)F.out + row * (2 * D) + c0);
#pragma unroll
                for (int j = 0; j < 4; ++j) v[q][j] = xr[j];
                dv[q][0] = dr[0]; dv[q][1] = dr[1]; sv[q][0] = dr[128]; sv[q][1] = dr[129];
#pragma unroll
                for (int k = 0; k < TOPK; ++k) { const int idx = (rr + q) * 8 + k;
                    const unsigned pk = (unsigned)__builtin_amdgcn_readlane((int)(idx < 64 ? p0 : p1), idx & 63);
                    wk[q][k] = __builtin_bit_cast(float, __builtin_amdgcn_readlane(__builtin_bit_cast(int, idx < 64 ? w0 : w1), idx & 63));
                    yv[q][k] = *(const v4u*)(Y + (size_t)pk * D + c0); } }
#pragma unroll
            for (int q = 0; q < RW; ++q) { float s = 0.f;
#pragma unroll
                for (int j = 0; j < 4; ++j) {
                    const unsigned sw0 = sv[q][j >> 1][(j & 1) * 2], sw1 = sv[q][j >> 1][(j & 1) * 2 + 1];
                    f32x4 r = (f32x4){bflo(sw0), bfhi(sw0), bflo(sw1), bfhi(sw1)};
#pragma unroll
                    for (int k = 0; k < TOPK; ++k) { const int wd = (int)yv[q][k][j];
                        const auto lo = __builtin_amdgcn_cvt_pk_f32_fp8(wd, false), hi = __builtin_amdgcn_cvt_pk_f32_fp8(wd, true);
                        r += wk[q][k] * (f32x4){lo[0], lo[1], hi[0], hi[1]}; }
                    const unsigned dw0 = dv[q][j >> 1][(j & 1) * 2], dw1 = dv[q][j >> 1][(j & 1) * 2 + 1];
                    v[q][j] = v[q][j] + ga[j] * (f32x4){bflo(dw0), bfhi(dw0), bflo(dw1), bfhi(dw1)} + gb[j] * r;
                    s += (v[q][j].x * v[q][j].x + v[q][j].y * v[q][j].y) + (v[q][j].z * v[q][j].z + v[q][j].w * v[q][j].w); }
                const float rstd = 1.f / sqrtf(wave_sum(s) * (1.f / D) + NORM_EPS);
                f32x4* orow = (f32x4*)(F.out + (rowbase + rr + q) * D + c0);
#pragma unroll
                for (int j = 0; j < 4; ++j) orow[j] = v[q][j] * rstd * *(const f32x4*)(g_final + c0 + 4 * j); }
        }
    }
}

constexpr int N_PHASES = 12;
__global__ void __launch_bounds__(NTHREADS, 2) fwd(Args args) {
    extern __shared__ __attribute__((aligned(16))) unsigned char lds_raw[];
    Frame F;
    F.lds = (LAS unsigned char*)lds_raw;
    F.tid = threadIdx.x; F.lane = F.tid & 63; F.wave = __builtin_amdgcn_readfirstlane(F.tid >> 6); F.G = gridDim.x; F.bid = blockIdx.x;
#define INP(i) ld_ptr(F.lds, (i))
    F.out = args.out; F.ws = args.ws;
    unsigned char* ws = args.ws;
    volatile LAS unsigned* MISC = (volatile LAS unsigned*)(F.lds + MISC_OFF);
    if (F.tid < 16) MISC[F.tid] = 0u;
    if (F.tid == 0) { LAS unsigned long long* pt = (LAS unsigned long long*)(F.lds + PT_OFF);
#pragma unroll
        for (int i = 0; i < 19; ++i) pt[i] = (unsigned long long)args.in[i]; }
    __syncthreads();
    const int lo = args.ph_lo, hi = args.ph_hi;
    XcdBarrier bar; bar.bar = (unsigned*)(ws + WS_CTL) + CW_BAR; bar.x = 0; bar.st = nullptr;
    if (hi - lo > 1) bar = xcd_barrier_post((unsigned*)(ws + WS_CTL) + CW_BAR, MISC + 8);
#ifndef PH_MASK
#define PH_MASK 0xfff
#endif
#define IN(k) (((PH_MASK >> (k)) & 1) && lo <= (k) && (k) < hi)
#if MK_PROBE >= 1000
#define PH_T0(k) unsigned long long _pt##k = 0; if (MK_PROBE == 1000 + (k)) _pt##k = __builtin_amdgcn_s_memrealtime();
#define PH_T1(k) if (MK_PROBE == 1000 + (k) && blockIdx.x == MK_PROBE_BLK && F.tid == 0) MISC[12] += (unsigned)(__builtin_amdgcn_s_memrealtime() - _pt##k);
#else
#define PH_T0(k)
#define PH_T1(k)
#endif
#if MK_PROBE >= 2000
#define SEAM_T0() const unsigned long long _st0 = __builtin_amdgcn_s_memrealtime();
#define SEAM_T1(k) if ((MK_PROBE == 2000 || MK_PROBE == 2001 + (k)) && blockIdx.x == MK_PROBE_BLK && F.tid == 0) MISC[12] += (unsigned)(__builtin_amdgcn_s_memrealtime() - _st0);
#else
#define SEAM_T0()
#define SEAM_T1(k)
#endif
#define SEAM(k) do { SEAM_T0() if (IN(k) && IN((k) + 1)) xcd_barrier(bar); SEAM_T1(k) { int _t = threadIdx.x; asm volatile("" : "+v"(_t)); F.tid = _t; F.lane = _t & 63; } } while (0)

    const int vcu = (F.G % 8 == 0) ? (F.bid % 8) * (F.G / 8) + F.bid / 8 : F.bid;
    unsigned char* h8 = ws + WS_H;
    bf16* h2b = (bf16*)(ws + WS_H2B); bf16* proj = (bf16*)(ws + WS_PROJ); bf16* mixin = (bf16*)(ws + WS_MIXIN);

    PH_T0(0) if (IN(0)) { p0_prologue(F); } PH_T1(0) SEAM(0);
    PH_T0(1) if (IN(1)) { modnorm_phase<false, false, true>(F, INP(0), INP(4), 0, nullptr, (bf16*)h8); } PH_T1(1) SEAM(1);
    PH_T0(2) if (IN(2)) {
        typedef DenseSchedT<NT / 256, NPROJ / 256, 1> SchedP2; SchedP2 S; S.init(h8, ws + WS_WIN_T, D, D, 0, F.G, F.bid);
        EpiProj E{proj};
        const int ksplit = vcu % 6;
        S.i0 = 0; S.i1 = ksplit;
        gemm_phase<EpiProj, SchedP2>(F.lds, D, D, S, E);
        __syncthreads();
        for (int e = F.bid; e < NE; e += F.G)
            convert_expert<false>(F, INP(12) + (size_t)e * D * FF, INP(13) + (size_t)e * D * FF, ws + WS_WGU_T + (size_t)e * 512 * D);
        __syncthreads();
        S.i0 = ksplit; S.i1 = 0x3fffffff;
        gemm_phase<EpiProj, SchedP2>(F.lds, D, D, S, E);
    } PH_T1(2) SEAM(2);
    PH_T0(3) if (IN(3)) {
        pool_phase(F, INP(6), INP(7));
#if MK_NAIVE_ATTN
        naive_attn_phase(F);
#else
        attn_phase(F);
#endif
    } PH_T1(3) SEAM(3);
    PH_T0(4) if (IN(4)) {
#if !MK_NAIVE_ATTN
        combine_phase(F);
#endif
    } PH_T1(4) SEAM(4);
    PH_T0(5) if (IN(5)) {
        typedef DenseSchedT<NT / 256, D / 256, 1> SchedP5; SchedP5 S; S.init(mixin, ws + WS_WOUT_T, NMIX, NMIX, 0, F.G, F.bid);
        EpiOut E{(bf16*)F.out};
        gemm_phase<EpiOut, SchedP5>(F.lds, NMIX, NMIX, S, E);
    } PH_T1(5) SEAM(5);
    PH_T0(6) if (IN(6)) { modnorm_phase<true, true, true>(F, INP(0), INP(9), 3, h8, h2b); } PH_T1(6) SEAM(6);
    PH_T0(7) if (IN(7)) {
        typedef DenseSchedT<NT / 256, NE / 256, 2> SchedP7; SchedP7 S; S.init(h2b, ws + WS_WR_T, D, D, 512, F.G, F.bid);
        EpiRouter E{(float*)(ws + WS_LOGIT)};
        gemm_phase<EpiRouter, SchedP7>(F.lds, 512, D, S, E);
    } PH_T1(7) SEAM(7);
    PH_T0(8) if (IN(8)) { routing_phase(F, INP(11)); } PH_T1(8) SEAM(8);
    PH_T0(9) if (IN(9)) {
        int nblk; build_tables(F, nblk);
        MoeSched<2, false> S; S.prefix = (const LAS int*)(F.lds + TAB_OFF); S.cnt = S.prefix + 260; S.bucket = (const unsigned*)(ws + WS_BUCKET);
        S.Ar = (const char*)h8; S.As = (const char*)h8; S.Br = (const char*)(ws + WS_WGU_T); S.Bs = (const char*)(ws + WS_WSGU_T);
        S.nRouted = nblk * 2; S.total = S.nRouted + (NT / 256) * 2; S.G = F.G; S.c = vcu;
        EpiGU E{ws + WS_ACT, ws + WS_ACTS, (const unsigned*)(ws + WS_BUCKET), (unsigned*)(ws + WS_POS)};
        const int ksplit = vcu % 11;
        S.i0 = 0; S.i1 = ksplit;
        gemm_phase<EpiGU, MoeSched<2, false>>(F.lds, D / 2, D / 2, S, E);
        __syncthreads();
        for (int e = F.bid; e < NE; e += F.G)
            convert_expert<true>(F, INP(14) + (size_t)e * FF * D, nullptr, ws + WS_WD_T + (size_t)e * D * FF);
        __syncthreads();
        S.i0 = ksplit; S.i1 = 0x3fffffff;
        gemm_phase<EpiGU, MoeSched<2, false>>(F.lds, D / 2, D / 2, S, E);
    } PH_T1(9) SEAM(9);
    PH_T0(10) if (IN(10)) {
        int nblk; build_tables(F, nblk);
        MoeSched<4, true> S; S.prefix = (const LAS int*)(F.lds + TAB_OFF); S.cnt = S.prefix + 260; S.bucket = (const unsigned*)(ws + WS_BUCKET);
        S.Ar = (const char*)(ws + WS_ACT); S.As = (const char*)(ws + WS_ACTS); S.Br = (const char*)(ws + WS_WD_T); S.Bs = (const char*)(ws + WS_WSD_T);
        S.nRouted = nblk * 4; S.total = S.nRouted + (NT / 256) * 4; S.G = F.G; S.c = vcu; S.i0 = 0; S.i1 = 0x3fffffff;
        EpiDown E{(unsigned char*)(ws + WS_Y), (bf16*)F.out};
        gemm_phase<EpiDown, MoeSched<4, true>>(F.lds, FF / 2, FF / 2, S, E);
    } PH_T1(10) SEAM(10);
    PH_T0(11) if (IN(11)) { final_phase(F, INP(0), INP(18)); } PH_T1(11)
#if MK_PROBE
    if (blockIdx.x == MK_PROBE_BLK) { __syncthreads();
        if (F.tid == 0) { const unsigned long long span = (unsigned long long)MISC[12] * MK_PROBE_MULT, t0 = __builtin_amdgcn_s_memrealtime();
            while (__builtin_amdgcn_s_memrealtime() - t0 < span) __builtin_amdgcn_s_sleep(16); } }
#endif
#undef IN
#undef SEAM
#undef INP
}

extern "C" void kernel_launch(void* const* d_in, const int* in_sizes, int n_in, void* d_out, int out_size, void* d_ws, size_t ws_size, hipStream_t stream) {
    static int grid = 0;
    if (grid == 0) {
        if (n_in != 19 || out_size != NT * D || ws_size < WS_END) { fprintf(stderr, "kernel_launch: unexpected shapes (n_in %d out %d ws %zu)\n", n_in, out_size, ws_size); grid = -1; return; }
        int dev = 0, cus = 0;
        if (hipGetDevice(&dev) != hipSuccess || hipDeviceGetAttribute(&cus, hipDeviceAttributeMultiprocessorCount, dev) != hipSuccess) { grid = -1; return; }
        if (hipFuncSetAttribute((const void*)fwd, hipFuncAttributeMaxDynamicSharedMemorySize, LDS_BYTES) != hipSuccess) { fprintf(stderr, "kernel_launch: hipFuncSetAttribute failed\n"); grid = -1; return; }
        int per_cu = 0;
        if (hipOccupancyMaxActiveBlocksPerMultiprocessor(&per_cu, (const void*)fwd, NTHREADS, LDS_BYTES) != hipSuccess || per_cu < 1) { fprintf(stderr, "kernel_launch: occupancy query says %d\n", per_cu); }
        (void)hipGetLastError();
        grid = cus;
    }
    if (grid < 0) return;
    (void)hipMemsetAsync((char*)d_ws + WS_CTL, 0, CTL_ZERO_BYTES, stream);
    Args a{};
    for (int i = 0; i < 19; ++i) a.in[i] = (const float*)d_in[i];
    a.out = (float*)d_out; a.ws = (unsigned char*)d_ws;
#if MK_ONE_LAUNCH
    a.ph_lo = 0; a.ph_hi = N_PHASES;
    hipLaunchKernelGGL(fwd, dim3(grid), dim3(NTHREADS), LDS_BYTES, stream, a);
#else
    for (int p = 0; p < N_PHASES; ++p) { a.ph_lo = p; a.ph_hi = p + 1; const int reps = ((MK_REP_MASK >> p) & 1) ? 2 : 1;
        for (int r = 0; r < reps; ++r) hipLaunchKernelGGL(fwd, dim3(grid), dim3(NTHREADS), LDS_BYTES, stream, a); }
#endif
}
```

```cpp
#include <hip/hip_runtime.h>
#include <cstdio>
#include <cstdint>

#ifndef MK_ONE_LAUNCH
#define MK_ONE_LAUNCH 1
#endif
#ifndef MK_FAST_GEMM
#define MK_FAST_GEMM 1
#endif
#ifndef MK_REP_MASK
#define MK_REP_MASK 0x000
#endif
#ifndef MK_MX
#define MK_MX 1
#endif
#ifndef MK_PROBE
#define MK_PROBE 0
#endif
#ifndef MK_PROBE_BLK
#define MK_PROBE_BLK 0
#endif
#ifndef MK_PROBE_WAVE
#define MK_PROBE_WAVE 0
#endif
#ifndef MK_PROBE_MULT
#define MK_PROBE_MULT 4
#endif
#ifndef MK_NAIVE_ATTN
#define MK_NAIVE_ATTN 0
#endif

#define LAS __attribute__((address_space(3)))
#define GAS __attribute__((address_space(1)))
typedef unsigned short bf16;
typedef short bf16x8 __attribute__((ext_vector_type(8)));
typedef short s16x4 __attribute__((ext_vector_type(4)));
typedef float f32x4 __attribute__((ext_vector_type(4)));
typedef float f32x2 __attribute__((ext_vector_type(2)));
typedef long l64x2 __attribute__((ext_vector_type(2)));
typedef int i32x8 __attribute__((ext_vector_type(8)));
typedef int i32x4 __attribute__((ext_vector_type(4)));
typedef unsigned v4u __attribute__((ext_vector_type(4)));
typedef unsigned v2u __attribute__((ext_vector_type(2)));

constexpr int D = 1024, NB = 8, SEQ = 4096, NT = NB * SEQ;
constexpr int NPROJ = 2560, NE = 256, TOPK = 8, FF = 256, NMIX = 512;
constexpr int CAP = NT;
constexpr int MAXBLK = NT * TOPK / 256 + NE;
constexpr float NORM_EPS = 1e-6f;
constexpr int NWAVES = 8, NTHREADS = 512;

constexpr size_t MiB = 1u << 20;
constexpr size_t WS_CTL = 0, CTL_ZERO_BYTES = 1 * MiB;
constexpr size_t WS_MOD = 1 * MiB;
constexpr size_t WS_GATEW = 2 * MiB;
constexpr size_t WS_WIN_T = 4 * MiB;
constexpr size_t WS_WOUT_T = 9 * MiB;
constexpr size_t WS_WR_T = 10 * MiB;
constexpr size_t WS_WSGU_T = 11 * MiB;
constexpr size_t WS_WSD_T = 12 * MiB;
constexpr size_t WS_LSE = 13 * MiB;
constexpr size_t WS_WD_T = 16 * MiB;
constexpr size_t WS_ACT = 144 * MiB;
constexpr size_t WS_ACTS = 304 * MiB;
constexpr size_t WS_BUCKET = 320 * MiB;
constexpr size_t WS_WGU_T = 352 * MiB;
constexpr size_t WS_PROJ = 608 * MiB;
constexpr size_t WS_H = 768 * MiB;
constexpr size_t WS_ATTO = 832 * MiB;
constexpr size_t WS_MIXIN = 880 * MiB;
constexpr size_t WS_LOGIT = 912 * MiB;
constexpr size_t WS_Y = 352 * MiB;
constexpr size_t WS_H2B = 832 * MiB;
constexpr size_t WS_PWT = 15 * MiB;
constexpr size_t WS_POS = 3 * MiB;
constexpr size_t WS_END = 992 * MiB;
constexpr int CW_BAR = 4096;
constexpr int CW_GCNT = 16384;

constexpr int RING_BYTES = 131072;
constexpr int TAB_OFF = RING_BYTES;
constexpr int MISC_OFF = TAB_OFF + 4096;
constexpr int PT_OFF = MISC_OFF + 256;
constexpr int LDS_BYTES = 147456;

__device__ __forceinline__ unsigned f2bf(float f) { unsigned u = __builtin_bit_cast(unsigned, f); return (u + 0x7fffu + ((u >> 16) & 1u)) >> 16; }
__device__ __forceinline__ unsigned pk2(float lo, float hi) { unsigned r; asm("v_cvt_pk_bf16_f32 %0, %1, %2" : "=v"(r) : "v"(lo), "v"(hi)); return r; }
constexpr float W_SCALE = 64.f, W_INV_SCALE = 1.f / 64.f;
constexpr float WD_SCALE = 4.f;
constexpr float ACT_SCALE = 4.f;
__device__ __forceinline__ unsigned pk4_fp8(float a, float b, float c, float d) {
    int w = __builtin_amdgcn_cvt_pk_fp8_f32(a, b, 0, false); w = __builtin_amdgcn_cvt_pk_fp8_f32(c, d, w, true); return (unsigned)w; }
__device__ __forceinline__ float bf2f(unsigned short b) { return __builtin_bit_cast(float, ((unsigned)b) << 16); }
__device__ __forceinline__ float bflo(unsigned u) { return __builtin_bit_cast(float, u << 16); }
__device__ __forceinline__ float bfhi(unsigned u) { return __builtin_bit_cast(float, u & 0xffff0000u); }
template <int CTRL> __device__ __forceinline__ float dppf(float v) {
    return __builtin_bit_cast(float, __builtin_amdgcn_update_dpp(0, __builtin_bit_cast(int, v), CTRL, 0xF, 0xF, true)); }
__device__ __forceinline__ float wave_sum(float v) {
    v += dppf<0xB1>(v); v += dppf<0x4E>(v); v += dppf<0x141>(v); v += dppf<0x140>(v);
    const float r0 = __builtin_bit_cast(float, __builtin_amdgcn_readlane(__builtin_bit_cast(int, v), 0)), r1 = __builtin_bit_cast(float, __builtin_amdgcn_readlane(__builtin_bit_cast(int, v), 16));
    const float r2 = __builtin_bit_cast(float, __builtin_amdgcn_readlane(__builtin_bit_cast(int, v), 32)), r3 = __builtin_bit_cast(float, __builtin_amdgcn_readlane(__builtin_bit_cast(int, v), 48));
    return (r0 + r1) + (r2 + r3);
}
__device__ __forceinline__ float silu_f(float g) { return g * __builtin_amdgcn_rcpf(1.f + __builtin_amdgcn_exp2f(-1.44269504f * g)); }

__device__ __forceinline__ const float* ld_ptr(LAS unsigned char* lds, int i) {
    const unsigned long long v = ((const LAS unsigned long long*)(lds + PT_OFF))[i];
    const unsigned lo = __builtin_amdgcn_readfirstlane((unsigned)v), hi = __builtin_amdgcn_readfirstlane((unsigned)(v >> 32));
    return (const float*)(((unsigned long long)hi << 32) | lo);
}
#define XB_TMO      128
#define XB_XCNT(j)  (256  + 64 * (j))
#define XB_XSUB(j)  (1280 + 64 * (j))
#define XB_XGEN(j)  (2304 + 64 * (j))
#define XB_TOP      3328
#define XB_TOPGEN   3392
#define XCD_BAR_WORDS 3456
#define XB_SPIN_CAP (1u << 18)
__device__ __forceinline__ unsigned xb_ld(unsigned* p)              { return __hip_atomic_load(p, __ATOMIC_RELAXED, __HIP_MEMORY_SCOPE_AGENT); }
__device__ __forceinline__ unsigned xb_add(unsigned* p, unsigned v) { return __hip_atomic_fetch_add(p, v, __ATOMIC_RELAXED, __HIP_MEMORY_SCOPE_AGENT); }
__device__ __forceinline__ unsigned xb_xcc_id() { return (unsigned)__builtin_amdgcn_s_getreg((3 << 11) | 20) & 0xFu; }
#define XB_SPIN(cond, bar) do { unsigned _sp = 0; while (cond) { __builtin_amdgcn_s_sleep(1); \
    if ((++_sp & 255u) == 0u) { if (xb_ld(&(bar)[XB_TMO])) break; if (_sp > XB_SPIN_CAP) { atomicAdd(&(bar)[XB_TMO], 1u); break; } } } } while (0)
struct XcdBarrier { unsigned* bar; unsigned x; volatile LAS unsigned* st; };
__device__ __forceinline__ XcdBarrier xcd_barrier_post(unsigned* bar, volatile LAS unsigned* st) {
    XcdBarrier b; b.bar = bar; b.x = xb_xcc_id(); b.st = st;
    if (threadIdx.x == 0) (void)xb_add(&bar[XB_XCNT(b.x)], 1u);
    return b;
}
__device__ __forceinline__ void xcd_barrier_complete(unsigned* bar, unsigned x, unsigned& nloc, unsigned& nx) {
    const unsigned G = gridDim.x * gridDim.y * gridDim.z;
    unsigned sum, cnt, mine, sp = 0u;
    for (;;) {
        sum = 0u; cnt = 0u; mine = 0u;
#pragma unroll
        for (unsigned j = 0; j < 16; ++j) { const unsigned c = xb_ld(&bar[XB_XCNT(j)]); sum += c; cnt += (c > 0u) ? 1u : 0u; mine = (j == x) ? c : mine; }
        if (sum == G) break;
        __builtin_amdgcn_s_sleep(1);
        if ((++sp & 255u) == 0u) { if (xb_ld(&bar[XB_TMO])) break; if (sp > XB_SPIN_CAP) { atomicAdd(&bar[XB_TMO], 1u); break; } }
    }
    nloc = mine > 0u ? mine : 1u; nx = cnt > 0u ? cnt : 1u;
}
__device__ __forceinline__ void xcd_barrier(const XcdBarrier& b) {
    asm volatile("s_waitcnt vmcnt(0)" ::: "memory");
    __syncthreads();
    if (threadIdx.x == 0) {
        unsigned* bar = b.bar;
        __builtin_amdgcn_s_waitcnt(0);
        unsigned nloc = b.st[0], nx = b.st[1];
        if (nloc == 0u) { xcd_barrier_complete(bar, b.x, nloc, nx); b.st[0] = nloc; b.st[1] = nx; }
        const unsigned old = xb_add(&bar[XB_XSUB(b.x)], 1u);
        const unsigned gen = old / nloc;
        if (old + 1u == (gen + 1u) * nloc) {
            __builtin_amdgcn_fence(__ATOMIC_RELEASE, "agent");
            asm volatile("s_waitcnt vmcnt(0)" ::: "memory");
            const unsigned og = xb_add(&bar[XB_TOP], 1u);
            const unsigned tg = og / nx;
            if (og + 1u == (tg + 1u) * nx) xb_add(&bar[XB_TOPGEN], 1u);
            else XB_SPIN(xb_ld(&bar[XB_TOPGEN]) == tg, bar);
            __builtin_amdgcn_fence(__ATOMIC_ACQUIRE, "agent");
            xb_add(&bar[XB_XGEN(b.x)], 1u);
            asm volatile("s_waitcnt vmcnt(0)" ::: "memory");
        } else {
            XB_SPIN(xb_ld(&bar[XB_XGEN(b.x)]) == gen, bar);
            __builtin_amdgcn_fence(__ATOMIC_ACQUIRE, "agent");
            asm volatile("s_waitcnt vmcnt(0)" ::: "memory");
        }
    }
    __syncthreads();
}

constexpr int BK = 64, HALF = 128, HTB = HALF * BK * 2;
__device__ __forceinline__ int lds_byte(int r, int c) { const int st = (r >> 4) * 2 + (c >> 5), rr = r & 15, cc = c & 31, ob = rr * 64 + cc * 2; return st * 1024 + (ob ^ (((ob >> 9) & 1) << 5)); }
__device__ __forceinline__ void stage_rc(int b, int& R, int& C) { const int st = b / 1024, sb = b % 1024, swz = sb ^ (((sb >> 9) & 1) << 5); R = (st >> 1) * 16 + swz / 64; C = (st & 1) * 32 + (swz % 64) / 2; }
__device__ __forceinline__ int perm32(int rho) { const int n = rho >> 4, i = rho & 15; return 8 * (i >> 2) + 4 * n + (i & 3); }

template <class Epi, class Sched>
__device__ __forceinline__ void gemm_simple(const int K, const int ldb, const Sched& S, const Epi& E) {
    const int tid = threadIdx.x, wid = __builtin_amdgcn_readfirstlane(tid >> 6), lane = tid & 63, wr = wid >> 2, wc = wid & 3, fr = lane & 15, fq = lane >> 4;
    typename Sched::Unit u;
    for (int ui = 0; S.next(ui, u); ++ui) {
        f32x4 acc[2][2][4][2];
#pragma unroll
        for (int a = 0; a < 2; ++a)
#pragma unroll
            for (int b = 0; b < 2; ++b)
#pragma unroll
                for (int m = 0; m < 4; ++m)
#pragma unroll
                    for (int n = 0; n < 2; ++n) acc[a][b][m][n] = (f32x4){0.f, 0.f, 0.f, 0.f};
        const char* A = S.a_base(u); const char* B = S.b_base(u);
        unsigned aoff[2][4], boff[2][2];
#pragma unroll
        for (int ai = 0; ai < 2; ++ai)
#pragma unroll
            for (int m = 0; m < 4; ++m) aoff[ai][m] = S.a_off(u, 128 * ai + 64 * wr + 16 * m + fr) + fq * 16;
#pragma unroll
        for (int bj = 0; bj < 2; ++bj)
#pragma unroll
            for (int n = 0; n < 2; ++n) { const int row = Epi::PERM == 2 ? 64 * wc + 16 * (fr >> 2) + 8 * bj + 4 * n + (fr & 3) : 128 * bj + 32 * wc + (Epi::PERM == 1 ? perm32(16 * n + fr) : 16 * n + fr); boff[bj][n] = (unsigned)(row * ldb) * 2u + fq * 16; }
        for (int k = 0; k < K; k += 32) {
            bf16x8 a[2][4], b[2][2];
#pragma unroll
            for (int ai = 0; ai < 2; ++ai)
#pragma unroll
                for (int m = 0; m < 4; ++m) a[ai][m] = *(const bf16x8*)(A + aoff[ai][m] + k * 2);
#pragma unroll
            for (int bj = 0; bj < 2; ++bj)
#pragma unroll
                for (int n = 0; n < 2; ++n) b[bj][n] = *(const bf16x8*)(B + boff[bj][n] + k * 2);
#pragma unroll
            for (int ai = 0; ai < 2; ++ai)
#pragma unroll
                for (int bj = 0; bj < 2; ++bj)
#pragma unroll
                    for (int m = 0; m < 4; ++m)
#pragma unroll
                        for (int n = 0; n < 2; ++n) acc[ai][bj][m][n] = __builtin_amdgcn_mfma_f32_16x16x32_bf16(b[bj][n], a[ai][m], acc[ai][bj][m][n], 0, 0, 0);
        }
        E(acc, u, wr, wc, fr, fq);
    }
}

template <class Epi, class Sched>
__device__ __forceinline__ void gemm_fast(LAS unsigned char* lds, const int K, const int ldb, const Sched& S, const Epi& E) {
    int tid0 = threadIdx.x; asm volatile("" : "+v"(tid0));
    const int tid = tid0, wid = __builtin_amdgcn_readfirstlane(tid >> 6), lane = tid & 63, wr = wid >> 2, wc = wid & 3, fr = lane & 15, fq = lane >> 4;
    int nt = K / BK; asm volatile("" : "+s"(nt));
    unsigned voffB0[2], voffB1[2];
#pragma unroll
    for (int i = 0; i < 2; ++i) { int R, C; stage_rc(tid * 16 + i * 8192, R, C);
        if (Epi::PERM == 2) { const int cb = 64 * (R >> 5) + 16 * ((R & 15) >> 2) + 4 * ((R >> 4) & 1) + (R & 3);
            voffB0[i] = (unsigned)(cb * ldb + C) * 2u; voffB1[i] = (unsigned)((cb + 8) * ldb + C) * 2u; }
        else { const int Rb = Epi::PERM == 1 ? ((R & ~31) + perm32(R & 31)) : R;
            voffB0[i] = (unsigned)(Rb * ldb + C) * 2u; voffB1[i] = (unsigned)((Rb + HALF) * ldb + C) * 2u; } }
#define PG8_AOFF(u) do { int _tz = threadIdx.x; asm volatile("" : "+v"(_tz)); _Pragma("unroll") for (int _i = 0; _i < 2; ++_i) { int _R, _C; stage_rc(_tz * 16 + _i * 8192, _R, _C); \
        vA0[_i] = S.a_off(u, _R) + (unsigned)_C * 2u; vA1[_i] = S.a_off(u, HALF + _R) + (unsigned)_C * 2u; } } while (0)
    const size_t kstep = (size_t)(BK * 2);
    const unsigned ldsw = (unsigned)wid * 1024u;
    const int aoff = lds_byte(wr * 64 + fr, fq * 8), boff = lds_byte(wc * 32 + fr, fq * 8);
#if MK_PROBE
#define PRB_NOW() __builtin_amdgcn_s_memrealtime()
#define PRB_ADD(IV, t0, t1) do { if (MK_PROBE == Epi::PID * 10 + (IV) && blockIdx.x == MK_PROBE_BLK && wid == MK_PROBE_WAVE && lane == 0) \
        __hip_atomic_fetch_add((LAS unsigned*)(lds + MISC_OFF + 48), (unsigned)((t1) - (t0)), __ATOMIC_RELAXED, __HIP_MEMORY_SCOPE_WORKGROUP); } while (0)
#else
#define PRB_NOW() 0ull
#define PRB_ADD(IV, t0, t1) do { } while (0)
#endif
#define PG8_SA(b, h) (((b) * 2 + (h)) * HTB)
#define PG8_SB(b, h) ((4 + (b) * 2 + (h)) * HTB)
#define PG8_STAGE(bufoff, gbase, voff) do { _Pragma("unroll") for (int _i = 0; _i < 2; ++_i) \
        __builtin_amdgcn_global_load_lds((const unsigned*)((const char*)(gbase) + (voff)[_i]), (LAS unsigned*)(lds + (bufoff) + ldsw + _i * 8192), 16, 0, 0); } while (0)
#define PG8_LDA(dst, b, h) do { _Pragma("unroll") for (int m = 0; m < 4; ++m) _Pragma("unroll") for (int k = 0; k < 2; ++k) dst[m][k] = *(const LAS bf16x8*)(lds + PG8_SA(b, h) + aoff + m * 2048 + k * 1024); } while (0)
#define PG8_LDB(dst, b, h) do { _Pragma("unroll") for (int n = 0; n < 2; ++n) _Pragma("unroll") for (int k = 0; k < 2; ++k) dst[n][k] = *(const LAS bf16x8*)(lds + PG8_SB(b, h) + boff + n * 2048 + k * 1024); } while (0)
#define PG8_MMA(ai, bj, At, Bt) do { __builtin_amdgcn_s_setprio(1); _Pragma("unroll") for (int m = 0; m < 4; ++m) _Pragma("unroll") for (int n = 0; n < 2; ++n) _Pragma("unroll") for (int k = 0; k < 2; ++k) { \
        if constexpr (Epi::FP8 && MK_MX) { if (k == 0) { \
            const i32x8 _a = __builtin_shufflevector(__builtin_bit_cast(i32x4, At[m][0]), __builtin_bit_cast(i32x4, At[m][1]), 0, 1, 2, 3, 4, 5, 6, 7); \
            const i32x8 _b = __builtin_shufflevector(__builtin_bit_cast(i32x4, Bt[n][0]), __builtin_bit_cast(i32x4, Bt[n][1]), 0, 1, 2, 3, 4, 5, 6, 7); \
            acc[ai][bj][m][n] = __builtin_amdgcn_mfma_scale_f32_16x16x128_f8f6f4(_b, _a, acc[ai][bj][m][n], 0, 0, 0, 0x7F7F7F7F, 0, 0x7F7F7F7F); } } \
        else if constexpr (Epi::FP8) { const l64x2 _a = __builtin_bit_cast(l64x2, At[m][k]), _b = __builtin_bit_cast(l64x2, Bt[n][k]); \
            acc[ai][bj][m][n] = __builtin_amdgcn_mfma_f32_16x16x32_fp8_fp8(_b[0], _a[0], acc[ai][bj][m][n], 0, 0, 0); \
            acc[ai][bj][m][n] = __builtin_amdgcn_mfma_f32_16x16x32_fp8_fp8(_b[1], _a[1], acc[ai][bj][m][n], 0, 0, 0); } \
        else acc[ai][bj][m][n] = __builtin_amdgcn_mfma_f32_16x16x32_bf16(Bt[n][k], At[m][k], acc[ai][bj][m][n], 0, 0, 0); } __builtin_amdgcn_s_setprio(0); } while (0)
#define PG8_WAIT_V(n) asm volatile("s_waitcnt vmcnt(" #n ")" ::: "memory")
#define PG8_WAIT_L(n) asm volatile("s_waitcnt lgkmcnt(" #n ")" ::: "memory")
#define PG8_BAR __builtin_amdgcn_s_barrier()
#define PG8_SCHED __builtin_amdgcn_sched_barrier(0)
    typename Sched::Unit cur, nxt; int ui = 0;
    if (!S.next(0, cur)) return;
    f32x4 acc[2][2][4][2];
#pragma unroll
    for (int a = 0; a < 2; ++a)
#pragma unroll
        for (int b = 0; b < 2; ++b)
#pragma unroll
            for (int m = 0; m < 4; ++m)
#pragma unroll
                for (int n = 0; n < 2; ++n) acc[a][b][m][n] = (f32x4){0.f, 0.f, 0.f, 0.f};
    bf16x8 At[4][2], B0[2][2], B1[2][2];
    const char* cA = S.a_base(cur); const char* cB = S.b_base(cur);
    unsigned vA0[2], vA1[2];
    PG8_AOFF(cur);
    PG8_STAGE(PG8_SB(0, 0), cB, voffB0); PG8_STAGE(PG8_SA(0, 0), cA, vA0); PG8_STAGE(PG8_SB(0, 1), cB, voffB1); PG8_STAGE(PG8_SA(0, 1), cA, vA1);
    if (wr == 1) PG8_BAR;
    PG8_WAIT_V(4); PG8_BAR;
    PG8_STAGE(PG8_SB(1, 0), cB + kstep, voffB0); PG8_STAGE(PG8_SA(1, 0), cA + kstep, vA0); PG8_STAGE(PG8_SB(1, 1), cB + kstep, voffB1);
    PG8_WAIT_V(6); PG8_BAR;
    for (;;) {
        const unsigned long long prb_a = PRB_NOW();
        const bool has_next = S.next(ui + 1, nxt);
        const char* nA = has_next ? S.a_base(nxt) : cA; const char* nB = has_next ? S.b_base(nxt) : cB;
        const unsigned long long prb_b = PRB_NOW(); PRB_ADD(1, prb_a, prb_b);
        for (int t = 0; t < nt; t += 2) {
            const unsigned long long prb_i0 = PRB_NOW();
            const bool last = (t == nt - 2);
            const char* a1 = cA + (size_t)(t + 1) * kstep;
            const char* a2 = last ? nA : cA + (size_t)(t + 2) * kstep; const char* b2 = last ? nB : cB + (size_t)(t + 2) * kstep;
            const char* a3 = a2 + kstep; const char* b3 = b2 + kstep;
            PG8_LDB(B0, 0, 0); PG8_SCHED; PG8_LDA(At, 0, 0); PG8_STAGE(PG8_SA(1, 1), a1, vA1);
            if (last && has_next) PG8_AOFF(nxt);
            PG8_WAIT_L(8); PG8_BAR; PG8_WAIT_L(0); PG8_MMA(0, 0, At, B0); PG8_BAR; PG8_SCHED;
            PG8_LDB(B1, 0, 1); PG8_STAGE(PG8_SB(0, 0), b2, voffB0);
            PG8_BAR; PG8_WAIT_L(0); PG8_MMA(0, 1, At, B1); PG8_BAR;
            PG8_LDA(At, 0, 1); PG8_STAGE(PG8_SA(0, 0), a2, vA0);
            PG8_BAR; PG8_WAIT_L(0); PG8_MMA(1, 0, At, B0); PG8_BAR; PG8_SCHED;
            PG8_STAGE(PG8_SB(0, 1), b2, voffB1);
            PG8_WAIT_V(6); PG8_BAR; PG8_MMA(1, 1, At, B1); PG8_BAR;
            PG8_LDB(B0, 1, 0); PG8_SCHED; PG8_LDA(At, 1, 0); PG8_STAGE(PG8_SA(0, 1), a2, vA1);
            PG8_WAIT_L(8); PG8_BAR; PG8_WAIT_L(0); PG8_MMA(0, 0, At, B0); PG8_BAR; PG8_SCHED;
            PG8_LDB(B1, 1, 1); PG8_STAGE(PG8_SB(1, 0), b3, voffB0);
            PG8_BAR; PG8_WAIT_L(0); PG8_MMA(0, 1, At, B1); PG8_BAR;
            PG8_LDA(At, 1, 1); PG8_STAGE(PG8_SA(1, 0), a3, vA0);
            PG8_BAR; PG8_WAIT_L(0); PG8_MMA(1, 0, At, B0); PG8_BAR; PG8_SCHED;
            PG8_STAGE(PG8_SB(1, 1), b3, voffB1);
            PG8_WAIT_V(6); PG8_BAR; PG8_MMA(1, 1, At, B1); PG8_BAR;
            { const unsigned long long prb_i1 = PRB_NOW(); if (t == 0) PRB_ADD(4, prb_i0, prb_i1); if (last) PRB_ADD(5, prb_i0, prb_i1); if (t != 0 && !last) PRB_ADD(6, prb_i0, prb_i1); }
        }
        const unsigned long long prb_c = PRB_NOW(); PRB_ADD(2, prb_b, prb_c);
        { int tz = threadIdx.x; asm volatile("" : "+v"(tz)); const int wz = tz >> 6, lz = tz & 63;
          E(acc, cur, wz >> 2, wz & 3, lz & 15, lz >> 4);
#if defined(MK_EPI_TWICE)
          if (Epi::TWICE) { asm volatile("" ::: "memory"); E(acc, cur, wz >> 2, wz & 3, lz & 15, lz >> 4); }
#endif
          }
        { const unsigned long long prb_d = PRB_NOW(); PRB_ADD(3, prb_c, prb_d); }
        if (!has_next) break;
#pragma unroll
        for (int a = 0; a < 2; ++a)
#pragma unroll
            for (int b = 0; b < 2; ++b)
#pragma unroll
                for (int m = 0; m < 4; ++m)
#pragma unroll
                    for (int n = 0; n < 2; ++n) acc[a][b][m][n] = (f32x4){0.f, 0.f, 0.f, 0.f};
        cur = nxt; cA = nA; cB = nB; ++ui;
    }
    PG8_WAIT_V(0);
    if (wr == 0) PG8_BAR;
    PG8_BAR;
#undef PG8_AOFF
#undef PRB_NOW
#undef PRB_ADD
#undef PG8_SA
#undef PG8_SB
#undef PG8_STAGE
#undef PG8_LDA
#undef PG8_LDB
#undef PG8_MMA
#undef PG8_WAIT_V
#undef PG8_WAIT_L
#undef PG8_BAR
#undef PG8_SCHED
}

template <class Epi, class Sched>
__device__ __forceinline__ void gemm_phase(LAS unsigned char* lds, const int K, const int ldb, const Sched& S, const Epi& E) {
#if MK_FAST_GEMM
    gemm_fast<Epi, Sched>(lds, K, ldb, S, E);
#else
    gemm_simple<Epi, Sched>(K, ldb, S, E);
#endif
}

struct DenseUnit { int pm, pn, ks; };
template <int NM, int NN, int KSPLIT>
struct DenseSchedT {
    typedef DenseUnit Unit;
    const char* A; const char* B; int lda2, ldb2, ksub2, G, c, i0, i1;
    __device__ __forceinline__ void init(const void* A_, const void* B_, int lda, int ldb, int Ksub, int G_, int c_) {
        A = (const char*)A_; B = (const char*)B_; lda2 = lda * 2; ldb2 = ldb * 2; ksub2 = Ksub * 2; G = G_; c = c_; i0 = 0; i1 = 0x3fffffff; }
    __device__ __forceinline__ bool next(int i, Unit& u) const {
        constexpr int nwg = NM * NN, total = nwg * KSPLIT;
        if (i + i0 >= i1) return false;
        const int L = (i + i0) * G + c; if (L >= total) return false;
        int id = L / KSPLIT; u.ks = L - id * KSPLIT;
        { constexpr int q = nwg / 8, r = nwg % 8; const int xcd = id % 8, off = id / 8; id = (xcd < r ? xcd * (q + 1) : r * (q + 1) + (xcd - r) * q) + off; }
        constexpr int nig = 8 * NN; const int gid = id / nig, fm = gid * 8, gsz = (NM - fm) < 8 ? (NM - fm) : 8;
        u.pm = fm + ((id % nig) % gsz); u.pn = (id % nig) / gsz; return true;
    }
    __device__ __forceinline__ const char* a_base(const Unit& u) const { return A + (size_t)u.pm * 256 * lda2 + (size_t)u.ks * ksub2; }
    __device__ __forceinline__ const char* b_base(const Unit& u) const { return B + (size_t)u.pn * 256 * ldb2 + (size_t)u.ks * ksub2; }
    __device__ __forceinline__ unsigned a_off(const Unit&, int r) const { return (unsigned)(r * lda2); }
};

template <int PN, bool DOWN>
struct MoeSched {
    struct Unit { int kind, e, rb, blk, valid, pm, pn; };
    const LAS int* prefix; const LAS int* cnt; const unsigned* bucket;
    const char* Ar; const char* As; const char* Br; const char* Bs;
    int nRouted, total, G, c, i0, i1;
    __device__ __forceinline__ bool next(int i, Unit& u) const {
        if (i + i0 >= i1) return false;
        const int id = (i + i0) * G + c; if (id >= total) return false;
        u.e = 0; u.rb = 0; u.blk = 0; u.pm = 0;
        if (id < nRouted) {
            const int blk = id / PN; u.pn = id % PN;
            const int lo = ((const LAS unsigned char*)(cnt + 256))[blk];
            u.kind = 0; u.e = lo; u.rb = blk - prefix[lo]; u.blk = blk; const int rem = cnt[lo] - u.rb * 256; u.valid = rem < 256 ? rem : 256;
        } else { const int s = id - nRouted; u.kind = 1; u.pm = s / PN; u.pn = s % PN; u.valid = 256; }
        return true;
    }
    __device__ __forceinline__ const char* a_base(const Unit& u) const { return u.kind == 0 ? Ar : As; }
    __device__ __forceinline__ const char* b_base(const Unit& u) const {
        if (!DOWN) return u.kind == 0 ? Br + ((size_t)u.e * 512 + (size_t)u.pn * 256) * D : Bs + (size_t)u.pn * 256 * D;
        else       return u.kind == 0 ? Br + ((size_t)u.e * 1024 + (size_t)u.pn * 256) * FF : Bs + (size_t)u.pn * 256 * FF;
    }
    __device__ __forceinline__ unsigned a_off(const Unit& u, int r) const {
        if (!DOWN) {
            if (u.kind == 0) { const int rr = r < u.valid ? r : u.valid - 1; const unsigned slot = bucket[(size_t)u.e * CAP + u.rb * 256 + rr]; return (slot >> 3) * (unsigned)D; }
            return (unsigned)(u.pm * 256 + r) * (unsigned)D;
        } else {
            return (unsigned)((u.kind == 0 ? u.blk : u.pm) * 256 + r) * (unsigned)FF;
        }
    }
};

struct EpiProj {
    static constexpr int PID = 2, PERM = 2;
    static constexpr bool TWICE = false, FP8 = false;
    bf16* O;
    __device__ __forceinline__ void operator()(const f32x4 (&acc)[2][2][4][2], const DenseUnit& u, int wr, int wc, int fr, int fq) const {
        const int row0 = u.pm * 256 + wr * 64 + fr, col0 = u.pn * 256 + wc * 64 + 16 * fq;
#pragma unroll
        for (int ai = 0; ai < 2; ++ai)
#pragma unroll
            for (int m = 0; m < 4; ++m) { bf16* rowp = O + (size_t)(row0 + ai * 128 + m * 16) * NPROJ + col0;
#pragma unroll
                for (int bj = 0; bj < 2; ++bj) { const f32x4 v0 = acc[ai][bj][m][0], v1 = acc[ai][bj][m][1];
                    *(v4u*)(rowp + bj * 8) = (v4u){pk2(v0[0], v0[1]), pk2(v0[2], v0[3]), pk2(v1[0], v1[1]), pk2(v1[2], v1[3])}; } }
    }
};
struct EpiOut {
    static constexpr int PID = 5, PERM = 2;
    static constexpr bool TWICE = false, FP8 = false;
    bf16* O;
    __device__ __forceinline__ void operator()(const f32x4 (&acc)[2][2][4][2], const DenseUnit& u, int wr, int wc, int fr, int fq) const {
        const int row0 = u.pm * 256 + wr * 64 + fr, col0 = u.pn * 256 + wc * 64 + 16 * fq;
#pragma unroll
        for (int ai = 0; ai < 2; ++ai)
#pragma unroll
            for (int m = 0; m < 4; ++m) { bf16* rowp = O + (size_t)(row0 + ai * 128 + m * 16) * (2 * D) + col0;
#pragma unroll
                for (int bj = 0; bj < 2; ++bj) { const f32x4 v0 = acc[ai][bj][m][0], v1 = acc[ai][bj][m][1];
                    *(v4u*)(rowp + bj * 8) = (v4u){pk2(v0[0], v0[1]), pk2(v0[2], v0[3]), pk2(v1[0], v1[1]), pk2(v1[2], v1[3])}; } }
    }
};
struct EpiRouter {
    static constexpr int PID = 7, PERM = 0;
    static constexpr bool TWICE = false, FP8 = false;
    float* L;
    __device__ __forceinline__ void operator()(const f32x4 (&acc)[2][2][4][2], const DenseUnit& u, int wr, int wc, int fr, int fq) const {
        const int row0 = u.pm * 256 + wr * 64 + fr, col0 = wc * 32 + 4 * fq;
        float* Lp = L + (size_t)u.ks * NT * NE;
#pragma unroll
        for (int ai = 0; ai < 2; ++ai)
#pragma unroll
            for (int m = 0; m < 4; ++m) { const size_t ro = (size_t)(row0 + ai * 128 + m * 16) * NE + col0;
#pragma unroll
                for (int bj = 0; bj < 2; ++bj)
#pragma unroll
                    for (int n = 0; n < 2; ++n) *(f32x4*)(Lp + ro + bj * 128 + n * 16) = acc[ai][bj][m][n]; }
    }
};
struct EpiGU {
    static constexpr int PID = 9, PERM = 1;
    static constexpr bool TWICE = false, FP8 = true;
    unsigned char* act; unsigned char* acts; const unsigned* bucket; unsigned* pos;
    __device__ __forceinline__ void operator()(const f32x4 (&acc)[2][2][4][2], const MoeSched<2, false>::Unit& u, int wr, int wc, int fr, int fq) const {
        unsigned char* O = u.kind == 0 ? act : acts;
        const int row0 = (u.kind == 0 ? u.blk : u.pm) * 256 + wr * 64 + fr, col0 = u.pn * 128 + wc * 32 + 8 * fq;
        if (u.kind == 0 && u.pn == 0 && wc == 0 && fq == 0) {
#pragma unroll
            for (int ai = 0; ai < 2; ++ai)
#pragma unroll
                for (int m = 0; m < 4; ++m) { const int r = ai * 128 + wr * 64 + m * 16 + fr;
                    if (r < u.valid) pos[bucket[(size_t)u.e * CAP + u.rb * 256 + r]] = (unsigned)(u.blk * 256 + r); } }
#pragma unroll
        for (int ai = 0; ai < 2; ++ai)
#pragma unroll
            for (int m = 0; m < 4; ++m) {
                const f32x4 g0 = acc[ai][0][m][0], g1 = acc[ai][0][m][1], u0 = acc[ai][1][m][0], u1 = acc[ai][1][m][1];
                float a[8];
#pragma unroll
                for (int j = 0; j < 4; j += 2) {
                    const f32x2 ga = (f32x2){g0[j], g0[j + 1]} * W_INV_SCALE, gb = (f32x2){g1[j], g1[j + 1]} * W_INV_SCALE;
                    const f32x2 ua = (f32x2){u0[j], u0[j + 1]} * (W_INV_SCALE * ACT_SCALE), ub = (f32x2){u1[j], u1[j + 1]} * (W_INV_SCALE * ACT_SCALE);
                    const f32x2 ea = ga * (-1.44269504f), eb = gb * (-1.44269504f);
                    f32x2 da, db; da.x = __builtin_amdgcn_exp2f(ea.x); da.y = __builtin_amdgcn_exp2f(ea.y); db.x = __builtin_amdgcn_exp2f(eb.x); db.y = __builtin_amdgcn_exp2f(eb.y);
                    da = da + 1.0f; db = db + 1.0f;
                    f32x2 ra, rb; ra.x = __builtin_amdgcn_rcpf(da.x); ra.y = __builtin_amdgcn_rcpf(da.y); rb.x = __builtin_amdgcn_rcpf(db.x); rb.y = __builtin_amdgcn_rcpf(db.y);
                    const f32x2 oa = (ga * ua) * ra, ob = (gb * ub) * rb;
                    a[j] = oa.x; a[j + 1] = oa.y; a[4 + j] = ob.x; a[4 + j + 1] = ob.y; }
                *(v2u*)(O + (size_t)(row0 + ai * 128 + m * 16) * FF + col0) = (v2u){pk4_fp8(a[0], a[1], a[2], a[3]), pk4_fp8(a[4], a[5], a[6], a[7])};
                __builtin_amdgcn_sched_barrier(0);
            }
    }
};
constexpr float Y_SCALE = ACT_SCALE * WD_SCALE, Y_INV_SCALE = 1.f / Y_SCALE;
struct EpiDown {
    static constexpr int PID = 10, PERM = 2;
    static constexpr bool TWICE = false, FP8 = true;
    unsigned char* Y; bf16* O;
    __device__ __forceinline__ void operator()(const f32x4 (&acc)[2][2][4][2], const MoeSched<4, true>::Unit& u, int wr, int wc, int fr, int fq) const {
        const int col0 = u.pn * 256 + wc * 64 + 16 * fq;
        if (u.kind == 0) {
            const int row0 = u.blk * 256 + wr * 64 + fr;
#pragma unroll
            for (int ai = 0; ai < 2; ++ai)
#pragma unroll
                for (int m = 0; m < 4; ++m) { unsigned char* rowp = Y + (size_t)(row0 + ai * 128 + m * 16) * D + col0;
                    unsigned w[4];
#pragma unroll
                    for (int bj = 0; bj < 2; ++bj)
#pragma unroll
                        for (int n = 0; n < 2; ++n) { f32x4 v = acc[ai][bj][m][n];
#pragma unroll
                            for (int j = 0; j < 4; ++j) v[j] = __builtin_amdgcn_fmed3f(v[j], -448.f, 448.f);
                            w[bj * 2 + n] = pk4_fp8(v[0], v[1], v[2], v[3]); }
                    *(v4u*)rowp = (v4u){w[0], w[1], w[2], w[3]}; }
        } else {
            const int row0 = u.pm * 256 + wr * 64 + fr;
#pragma unroll
            for (int ai = 0; ai < 2; ++ai)
#pragma unroll
                for (int m = 0; m < 4; ++m) { bf16* rowp = O + (size_t)(row0 + ai * 128 + m * 16) * (2 * D) + D + col0;
#pragma unroll
                    for (int bj = 0; bj < 2; ++bj) { const f32x4 v0 = acc[ai][bj][m][0] * Y_INV_SCALE, v1 = acc[ai][bj][m][1] * Y_INV_SCALE;
                        *(v4u*)(rowp + bj * 8) = (v4u){pk2(v0[0], v0[1]), pk2(v0[2], v0[3]), pk2(v1[0], v1[1]), pk2(v1[2], v1[3])}; } }
        }
    }
};

struct Args { const float* in[19]; float* out; unsigned char* ws; int ph_lo, ph_hi; };

struct Frame {
    LAS unsigned char* lds; int tid, lane, wave, G, bid;
    float* out; unsigned char* ws;
};

__device__ __forceinline__ void titem_load(const float* W, int N, int kb, int nb, int lane, float (&v)[32]) {
    const float* Wu = W + (size_t)(64 * kb) * N + 32 * nb;
    const unsigned loff = (unsigned)((lane >> 5) * N + (lane & 31)) * 4u;
#pragma unroll
    for (int i = 0; i < 32; ++i) v[i] = *(const float*)((const char*)(Wu + (size_t)(2 * i) * N) + loff);
}
template <bool FP8>
__device__ __forceinline__ void titem_store(const float (&v)[32], int K, void* WTv, int kb, int dst_row0, LAS float* scr, int lane, float wsc = W_SCALE) {
    const int k0 = 64 * kb;
#pragma unroll
    for (int i = 0; i < 32; ++i) { const int kk = 2 * i + (lane >> 5); scr[kk * 33 + (lane & 31)] = v[i]; }
    asm volatile("s_waitcnt lgkmcnt(0)" ::: "memory");
    const int c = lane & 7;
#pragma unroll
    for (int j = 0; j < 4; ++j) { const int n = (lane >> 3) + 8 * j; const LAS float* s = scr + (8 * c) * 33 + n;
        if (FP8) { v2u o; o.x = pk4_fp8(s[0 * 33] * wsc, s[1 * 33] * wsc, s[2 * 33] * wsc, s[3 * 33] * wsc);
            o.y = pk4_fp8(s[4 * 33] * wsc, s[5 * 33] * wsc, s[6 * 33] * wsc, s[7 * 33] * wsc);
            *(v2u*)((unsigned char*)WTv + (size_t)(dst_row0 + n) * K + k0 + 8 * c) = o; }
        else { v4u o; o.x = pk2(s[0 * 33], s[1 * 33]); o.y = pk2(s[2 * 33], s[3 * 33]); o.z = pk2(s[4 * 33], s[5 * 33]); o.w = pk2(s[6 * 33], s[7 * 33]);
            *(v4u*)((bf16*)WTv + (size_t)(dst_row0 + n) * K + k0 + 8 * c) = o; } }
    asm volatile("s_waitcnt lgkmcnt(0)" ::: "memory");
}
template <bool FP8>
__device__ __forceinline__ void transpose_item(const float* W, int K, int N, void* WT, int kb, int nb, int dst_row0, LAS float* scr, int lane, float wsc = W_SCALE) {
    float v[32]; titem_load(W, N, kb, nb, lane, v); titem_store<FP8>(v, K, WT, kb, dst_row0, scr, lane, wsc);
}
template <bool DOWN>
__device__ __forceinline__ void convert_expert(Frame& F, const float* Wa, const float* Wb, unsigned char* dst) {
    LAS float* scr = (LAS float*)(F.lds + F.wave * 16384);
    constexpr int PER_WAVE = DOWN ? 16 : 32;
    const int base = 0, wv = F.wave;
    auto ld = [&](int i, float (&v)[32]) {
        if (!DOWN) titem_load((i >> 4) ? Wb : Wa, FF, i & 15, wv, F.lane, v);
        else titem_load(Wa, D, i >> 2, wv + 8 * (i & 3), F.lane, v); };
    auto st = [&](int i, const float (&v)[32]) {
        if (!DOWN) { const int n0 = wv * 32; titem_store<true>(v, D, dst, i & 15, (n0 >> 7) * 256 + ((i >> 4) ? 128 : 0) + (n0 & 127), scr, F.lane); }
        else titem_store<true>(v, FF, dst, i >> 2, (wv + 8 * (i & 3)) * 32, scr, F.lane, WD_SCALE); };
    float v0[32], v1[32], v2[32], v3[32];
    ld(base, v0); ld(base + 1, v1); ld(base + 2, v2);
    for (int i = 0; i < PER_WAVE; i += 4) {
        ld(base + i + 3, v3); st(base + i, v0);
        if (i + 4 < PER_WAVE) ld(base + i + 4, v0);
        st(base + i + 1, v1);
        if (i + 5 < PER_WAVE) ld(base + i + 5, v1);
        st(base + i + 2, v2);
        if (i + 6 < PER_WAVE) ld(base + i + 6, v2);
        st(base + i + 3, v3);
    }
}

__device__ __forceinline__ void p0_prologue(Frame& F) {
#define INP(i) ld_ptr(F.lds, (i))
    if (F.bid < 192) {
        const float* cptr = INP(1); const float* w_ada = INP(2); const float* b_ada = INP(3);
        LAS float* cs = (LAS float*)F.lds;
        LAS float* red = (LAS float*)(F.lds + 32768);
        for (int i = F.tid; i < NB * D; i += NTHREADS) { const float v = cptr[i]; cs[i] = v / (1.f + __expf(-v)); }
        __syncthreads();
        const int col = F.tid & 31, kg = F.tid >> 5, j = F.bid * 32 + col;
        float a[NB];
#pragma unroll
        for (int b = 0; b < NB; ++b) a[b] = 0.f;
#pragma unroll 8
        for (int kk = 0; kk < 64; ++kk) { const int k = kg * 64 + kk; const float w = w_ada[(size_t)k * 6144 + j];
#pragma unroll
            for (int b = 0; b < NB; ++b) a[b] += cs[b * D + k] * w; }
#pragma unroll
        for (int b = 0; b < NB; ++b) red[(kg * NB + b) * 32 + col] = a[b];
        __syncthreads();
        if (F.tid < 256) { const int b = F.tid >> 5, cc = F.tid & 31; float s = 0.f;
#pragma unroll
            for (int g = 0; g < 16; ++g) s += red[(g * NB + b) * 32 + cc];
            ((float*)(F.ws + WS_MOD))[b * 6144 + F.bid * 32 + cc] = s + b_ada[F.bid * 32 + cc]; }
        __syncthreads();
    }
    if (F.bid == F.G - 1) { const float* pw = INP(6); bf16* pwt = (bf16*)(F.ws + WS_PWT);
        for (int i = F.tid; i < 4 * 64 * 64; i += NTHREADS) { const int g = i >> 12, d = (i >> 6) & 63, c = i & 63; pwt[i] = (bf16)f2bf(pw[(g * 64 + c) * 64 + d]); } }
    LAS float* scr = (LAS float*)(F.lds + F.wave * 16384);
    const int gw = F.bid * NWAVES + F.wave, NGW = F.G * NWAVES;
    constexpr int I_IN = 16 * 80, I_OUT = 8 * 32, I_R = 16 * 8, I_G = 16 * 8, I_D = 4 * 32;
    constexpr int I_SMALL = I_IN + I_OUT + I_R + 2 * I_G + I_D, I_EXP = 2 * I_G + I_D;
    constexpr int NITEMS = I_SMALL;
    unsigned char* win_t = F.ws + WS_WIN_T; bf16* wout_t = (bf16*)(F.ws + WS_WOUT_T); bf16* wr_t = (bf16*)(F.ws + WS_WR_T);
    unsigned char* wsgu_t = F.ws + WS_WSGU_T; unsigned char* wsd_t = F.ws + WS_WSD_T; unsigned char* wgu_t = F.ws + WS_WGU_T; unsigned char* wd_t = F.ws + WS_WD_T;
    for (int it = gw; it < NITEMS; it += NGW) {
        int r = it;
        if (r < I_IN) { transpose_item<false>(INP(5), D, NPROJ, win_t, r / 80, r % 80, (r % 80) * 32, scr, F.lane); continue; } r -= I_IN;
        if (r < I_OUT) { transpose_item<false>(INP(8), NMIX, D, wout_t, r / 32, r % 32, (r % 32) * 32, scr, F.lane); continue; } r -= I_OUT;
        if (r < I_R) { transpose_item<false>(INP(10), D, NE, wr_t, r / 8, r % 8, (r % 8) * 32, scr, F.lane); continue; } r -= I_R;
        const float *Wg, *Wu, *Wd; unsigned char *GU, *DN;
        if (r < 2 * I_G + I_D) { Wg = INP(15); Wu = INP(16); Wd = INP(17); GU = wsgu_t; DN = wsd_t; }
        else { r -= 2 * I_G + I_D; const int e = r / I_EXP; r -= e * I_EXP;
            Wg = INP(12) + (size_t)e * D * FF; Wu = INP(13) + (size_t)e * D * FF; Wd = INP(14) + (size_t)e * FF * D;
            GU = wgu_t + (size_t)e * 512 * D; DN = wd_t + (size_t)e * D * FF; }
        if (r < I_G) { const int nb = r % 8, n0 = nb * 32; transpose_item<true>(Wg, D, FF, GU, r / 8, nb, (n0 >> 7) * 256 + (n0 & 127), scr, F.lane); continue; } r -= I_G;
        if (r < I_G) { const int nb = r % 8, n0 = nb * 32; transpose_item<true>(Wu, D, FF, GU, r / 8, nb, (n0 >> 7) * 256 + 128 + (n0 & 127), scr, F.lane); continue; } r -= I_G;
        transpose_item<true>(Wd, FF, D, DN, r / 32, r % 32, (r % 32) * 32, scr, F.lane, WD_SCALE);
    }
#undef INP
}

template <bool HAS_DX, bool OUT8, bool OUTB>
__device__ __forceinline__ void modnorm_phase(Frame& F, const float* X, const float* g, int shift_chunk, unsigned char* O8, bf16* Ob) {
    const float* mod = (const float*)(F.ws + WS_MOD);
    constexpr int RW = 4;
    const unsigned l16 = (unsigned)F.lane * 16u, l8 = (unsigned)F.lane * 8u, l4 = (unsigned)F.lane * 4u;
    const int wv = __builtin_amdgcn_readfirstlane(F.wave);
    for (int blk = F.bid; blk < NT / 128; blk += F.G) {
        const int b = (blk * 128) >> 12;
        const float* sh = mod + (size_t)b * 6144 + shift_chunk * D; const float* sc = sh + D; const float* g1 = mod + (size_t)b * 6144 + 2 * D;
        f32x4 gg[4], ss[4], ga[4];
#pragma unroll
        for (int j = 0; j < 4; ++j) { const f32x4 gv = *(const f32x4*)((const char*)g + 1024 * j + l16), scv = *(const f32x4*)((const char*)sc + 1024 * j + l16);
            gg[j] = gv * (scv + 1.f); ss[j] = *(const f32x4*)((const char*)sh + 1024 * j + l16); ga[j] = HAS_DX ? *(const f32x4*)((const char*)g1 + 1024 * j + l16) : (f32x4){0.f, 0.f, 0.f, 0.f}; }
#pragma nounroll
        for (int rr = 0; rr < 16; rr += RW) {
            const int row = blk * 128 + wv * 16 + rr;
            f32x4 v[RW][4]; v2u dv[RW][4];
#pragma unroll
            for (int q = 0; q < RW; ++q) { const char* xr = (const char*)(X + (size_t)(row + q) * D);
#pragma unroll
                for (int j = 0; j < 4; ++j) v[q][j] = *(const f32x4*)(xr + 1024 * j + l16);
                if (HAS_DX) { const char* dr = (const char*)F.out + (size_t)(row + q) * (4 * D);
#pragma unroll
                    for (int j = 0; j < 4; ++j) dv[q][j] = *(const v2u*)(dr + 512 * j + l8); } }
#pragma unroll
            for (int q = 0; q < RW; ++q) { float s = 0.f;
#pragma unroll
                for (int j = 0; j < 4; ++j) {
                    if (HAS_DX) v[q][j] = v[q][j] + ga[j] * (f32x4){bflo(dv[q][j].x), bfhi(dv[q][j].x), bflo(dv[q][j].y), bfhi(dv[q][j].y)};
                    s += (v[q][j].x * v[q][j].x + v[q][j].y * v[q][j].y) + (v[q][j].z * v[q][j].z + v[q][j].w * v[q][j].w); }
                const float rstd = 1.f / sqrtf(wave_sum(s) * (1.f / D) + NORM_EPS);
                if (HAS_DX) { char* xo = (char*)F.out + (size_t)(row + q) * (4 * D);
#pragma unroll
                    for (int j = 0; j < 4; ++j) *(v2u*)(xo + 512 * j + l8) = (v2u){pk2(v[q][j].x, v[q][j].y), pk2(v[q][j].z, v[q][j].w)}; }
                char* o8 = (char*)O8 + (size_t)(row + q) * D; char* ob = (char*)Ob + (size_t)(row + q) * (2 * D);
#pragma unroll
                for (int j = 0; j < 4; ++j) { const f32x4 y = v[q][j] * rstd * gg[j] + ss[j]; if (OUT8) *(unsigned*)(o8 + 256 * j + l4) = pk4_fp8(y.x, y.y, y.z, y.w);
                    if (OUTB) *(v2u*)(ob + 512 * j + l8) = (v2u){pk2(y.x, y.y), pk2(y.z, y.w)}; }
                __builtin_amdgcn_sched_barrier(0); }
        }
    }
}

constexpr int POOL_T = 64, POOL_PITCH = 528;
__device__ __forceinline__ void pool_phase(Frame& F, const float* pool_scale) {
    const bf16* proj = (const bf16*)(F.ws + WS_PROJ); bf16* mixin = (bf16*)(F.ws + WS_MIXIN); const bf16* pwt = (const bf16*)(F.ws + WS_PWT);
    LAS unsigned char* us = F.lds;
    LAS unsigned char* pl = F.lds + 80 * POOL_PITCH;
    const int lane = F.lane, fr = lane & 15, fq = lane >> 4;
    for (int tile = F.bid; tile < NT / POOL_T; tile += F.G) {
        const int row0 = tile * POOL_T, tl0 = row0 & (SEQ - 1);
        __syncthreads();
        for (int p = F.tid; p < (POOL_T + 15) * 32; p += NTHREADS) { const int rr = p >> 5, pc = p & 31; const int tl = tl0 - 15 + rr;
            v4u raw = (v4u){0u, 0u, 0u, 0u};
            if (tl >= 0) raw = *(const v4u*)(proj + (size_t)(row0 - 15 + rr) * NPROJ + pc * 8);
            *(LAS v4u*)(us + rr * POOL_PITCH + pc * 16) = raw; }
        __syncthreads();
        {
            const int c8 = F.tid & 31, q = F.tid >> 5, w = 2 << (c8 >> 3);
            float sm[8];
#pragma unroll
            for (int e = 0; e < 8; ++e) sm[e] = 0.f;
            const int i0 = 15 + q * 4;
            for (int k = 0; k < w; ++k) { const v4u r = *(const LAS v4u*)(us + (i0 - k) * POOL_PITCH + c8 * 16);
                sm[0] += bflo(r.x); sm[1] += bfhi(r.x); sm[2] += bflo(r.y); sm[3] += bfhi(r.y); sm[4] += bflo(r.z); sm[5] += bfhi(r.z); sm[6] += bflo(r.w); sm[7] += bfhi(r.w); }
#pragma unroll
            for (int i = 0; i < 4; ++i) { const int tt = q * 4 + i, tl = tl0 + tt;
                const v4u cur = *(const LAS v4u*)(us + (15 + tt) * POOL_PITCH + c8 * 16);
                if (i > 0) { const v4u old = *(const LAS v4u*)(us + (15 + tt - w) * POOL_PITCH + c8 * 16);
                    sm[0] += bflo(cur.x) - bflo(old.x); sm[1] += bfhi(cur.x) - bfhi(old.x); sm[2] += bflo(cur.y) - bflo(old.y); sm[3] += bfhi(cur.y) - bfhi(old.y);
                    sm[4] += bflo(cur.z) - bflo(old.z); sm[5] += bfhi(cur.z) - bfhi(old.z); sm[6] += bflo(cur.w) - bflo(old.w); sm[7] += bfhi(cur.w) - bfhi(old.w); }
                const float ic = 1.f / (float)((tl + 1) < w ? (tl + 1) : w);
                v4u o; o.x = pk2(sm[0] * ic - bflo(cur.x), sm[1] * ic - bfhi(cur.x)); o.y = pk2(sm[2] * ic - bflo(cur.y), sm[3] * ic - bfhi(cur.y));
                o.z = pk2(sm[4] * ic - bflo(cur.z), sm[5] * ic - bfhi(cur.z)); o.w = pk2(sm[6] * ic - bflo(cur.w), sm[7] * ic - bfhi(cur.w));
                *(LAS v4u*)(pl + tt * POOL_PITCH + c8 * 16) = o; }
        }
        __syncthreads();
        {
            const int g = F.wave >> 1, mh = F.wave & 1;
            bf16x8 af[2][2], bfr[4][2];
#pragma unroll
            for (int mt = 0; mt < 2; ++mt)
#pragma unroll
                for (int k = 0; k < 2; ++k) af[mt][k] = *(const LAS bf16x8*)(pl + (32 * mh + 16 * mt + fr) * POOL_PITCH + (g * 64 + k * 32 + fq * 8) * 2);
#pragma unroll
            for (int nt = 0; nt < 4; ++nt)
#pragma unroll
                for (int k = 0; k < 2; ++k) bfr[nt][k] = *(const bf16x8*)(pwt + ((size_t)(g * 64 + nt * 16 + fr) * 64 + k * 32 + fq * 8));
#pragma unroll
            for (int mt = 0; mt < 2; ++mt)
#pragma unroll
                for (int nt = 0; nt < 4; ++nt) { f32x4 acc = (f32x4){0.f, 0.f, 0.f, 0.f};
                    acc = __builtin_amdgcn_mfma_f32_16x16x32_bf16(bfr[nt][0], af[mt][0], acc, 0, 0, 0);
                    acc = __builtin_amdgcn_mfma_f32_16x16x32_bf16(bfr[nt][1], af[mt][1], acc, 0, 0, 0);
                    const int col = g * 64 + nt * 16 + 4 * fq; const f32x4 sc = *(const f32x4*)(pool_scale + col);
                    const f32x4 o = acc * sc;
                    *(v2u*)(mixin + (size_t)(row0 + 32 * mh + 16 * mt + fr) * NMIX + col) = (v2u){pk2(o.x, o.y), pk2(o.z, o.w)}; }
        }
    }
}

constexpr int KV_PITCH = 144;
__device__ __forceinline__ void attn_phase(Frame& F) {
    const bf16* proj = (const bf16*)(F.ws + WS_PROJ);
    bf16* atto = (bf16*)(F.ws + WS_ATTO); float* lse = (float*)(F.ws + WS_LSE);
    LAS unsigned char* Ks = F.lds; LAS unsigned char* Vs = F.lds + 256 * KV_PITCH;
    const int lane = F.lane, fr = lane & 15, fq = lane >> 4, w = F.wave;
    const int w_i0 = 16 * w, c0 = w >> 1, qi = w_i0 + fr;
#define ATT_DECODE(unit_, rowb_, d_, r_, n_, g_, h_, colQ_) \
        const int rn_##unit_ = (unit_) & 31; const int h_ = ((unit_) >> 5) & 3, g_ = ((unit_) >> 7) % 3; const size_t rowb_ = (size_t)((unit_) / 384) * SEQ; \
        const int d_ = 1 << (2 * g_), nbk_##unit_ = 32 >> (2 * g_), r_ = rn_##unit_ / nbk_##unit_, n_ = rn_##unit_ % nbk_##unit_; const int colQ_ = 256 + g_ * 256 + h_ * 64;
    v4u kreg[4], vreg[4]; bf16x8 qn[2];
    {   const int unit0 = F.bid;
        if (unit0 < NB * 3 * 4 * 32) { ATT_DECODE(unit0, rowb, d, r, n, g, h, colQ)
            const size_t qrow = rowb + (size_t)(n * 128 + qi) * d + r;
#pragma unroll
            for (int ks = 0; ks < 2; ++ks) qn[ks] = *(const bf16x8*)(proj + qrow * NPROJ + colQ + ks * 32 + fq * 8);
#pragma unroll
            for (int cidx = 0; cidx < 4; ++cidx) { const int ch = F.tid + 512 * cidx, j = ch >> 3, pc = ch & 7;
                int p = (n - 1) * 128 + j; p = p < 0 ? 0 : p; const size_t row = rowb + (size_t)p * d + r;
                kreg[cidx] = *(const v4u*)(proj + row * NPROJ + colQ + 768 + pc * 8); vreg[cidx] = *(const v4u*)(proj + row * NPROJ + colQ + 1536 + pc * 8); } } }
    for (int unit = F.bid; unit < NB * 3 * 4 * 32; unit += F.G) {
        ATT_DECODE(unit, rowb, d, r, n, g, h, colQ)
        __syncthreads();
#pragma unroll
        for (int cidx = 0; cidx < 4; ++cidx) { const int ch = F.tid + 512 * cidx, j = ch >> 3, pc = ch & 7;
            *(LAS v4u*)(Ks + j * KV_PITCH + pc * 16) = kreg[cidx]; *(LAS v4u*)(Vs + j * KV_PITCH + pc * 16) = vreg[cidx]; }
        const size_t qrow = rowb + (size_t)(n * 128 + qi) * d + r;
        bf16x8 qf[2]; qf[0] = qn[0]; qf[1] = qn[1];
        __syncthreads();
        {   const int unit2 = unit + F.G;
            if (unit2 < NB * 3 * 4 * 32) { ATT_DECODE(unit2, rowb2, d2, r2, n2, g2, h2, colQ2)
                const size_t qrow2 = rowb2 + (size_t)(n2 * 128 + qi) * d2 + r2;
#pragma unroll
                for (int ks = 0; ks < 2; ++ks) qn[ks] = *(const bf16x8*)(proj + qrow2 * NPROJ + colQ2 + ks * 32 + fq * 8);
#pragma unroll
                for (int cidx = 0; cidx < 4; ++cidx) { const int ch = F.tid + 512 * cidx, j = ch >> 3, pc = ch & 7;
                    int p = (n2 - 1) * 128 + j; p = p < 0 ? 0 : p; const size_t row = rowb2 + (size_t)p * d2 + r2;
                    kreg[cidx] = *(const v4u*)(proj + row * NPROJ + colQ2 + 768 + pc * 8); vreg[cidx] = *(const v4u*)(proj + row * NPROJ + colQ2 + 1536 + pc * 8); } } }
        f32x4 s[5][2];
#pragma unroll
        for (int cc = 0; cc < 5; ++cc)
#pragma unroll
            for (int hh = 0; hh < 2; ++hh) {
                const int j = 32 * (c0 + cc) + 8 * (fr >> 2) + 4 * hh + (fr & 3);
                const bf16x8 k0 = *(const LAS bf16x8*)(Ks + j * KV_PITCH + fq * 16), k1 = *(const LAS bf16x8*)(Ks + j * KV_PITCH + 64 + fq * 16);
                f32x4 a = (f32x4){0.f, 0.f, 0.f, 0.f};
                a = __builtin_amdgcn_mfma_f32_16x16x32_bf16(k0, qf[0], a, 0, 0, 0);
                a = __builtin_amdgcn_mfma_f32_16x16x32_bf16(k1, qf[1], a, 0, 0, 0);
                s[cc][hh] = a;
            }
        float mx = -1e30f;
        int qil = qi; asm volatile("" : "+v"(qil));
#pragma unroll
        for (int cc = 0; cc < 5; ++cc)
#pragma unroll
            for (int hh = 0; hh < 2; ++hh)
#pragma unroll
                for (int rr = 0; rr < 4; ++rr) { const int j = 32 * (c0 + cc) + 8 * fq + 4 * hh + rr; const int dist = 128 + qil - j;
                    const bool valid = (dist >= 0) && (dist <= 128) && (n > 0 || j >= 128);
                    const float v = valid ? s[cc][hh][rr] * 0.18033688f : -1e30f; s[cc][hh][rr] = v; mx = fmaxf(mx, v); }
        mx = fmaxf(mx, __shfl_xor(mx, 16)); mx = fmaxf(mx, __shfl_xor(mx, 32));
        float l = 0.f;
#pragma unroll
        for (int cc = 0; cc < 5; ++cc)
#pragma unroll
            for (int hh = 0; hh < 2; ++hh)
#pragma unroll
                for (int rr = 0; rr < 4; ++rr) { const float p = __builtin_amdgcn_exp2f(s[cc][hh][rr] - mx); s[cc][hh][rr] = p; l += p; }
        l += __shfl_xor(l, 16); l += __shfl_xor(l, 32);
        f32x4 o[4];
#pragma unroll
        for (int eb = 0; eb < 4; ++eb) o[eb] = (f32x4){0.f, 0.f, 0.f, 0.f};
#pragma unroll
        for (int cc = 0; cc < 5; ++cc) {
            const v4u pu = (v4u){pk2(s[cc][0][0], s[cc][0][1]), pk2(s[cc][0][2], s[cc][0][3]), pk2(s[cc][1][0], s[cc][1][1]), pk2(s[cc][1][2], s[cc][1][3])};
            const bf16x8 pf = __builtin_bit_cast(bf16x8, pu);
            const int key0 = 32 * (c0 + cc) + 8 * fq + (fr >> 2);
#pragma unroll
            for (int eb = 0; eb < 4; ++eb) {
                const LAS unsigned char* vp = Vs + key0 * KV_PITCH + (16 * eb + 4 * (fr & 3)) * 2;
                const s16x4 lo = __builtin_bit_cast(s16x4, __builtin_amdgcn_ds_read_tr16_b64_v4i16((LAS s16x4*)vp));
                const s16x4 hi = __builtin_bit_cast(s16x4, __builtin_amdgcn_ds_read_tr16_b64_v4i16((LAS s16x4*)(vp + 4 * KV_PITCH)));
                const bf16x8 vf = (bf16x8){lo[0], lo[1], lo[2], lo[3], hi[0], hi[1], hi[2], hi[3]};
                o[eb] = __builtin_amdgcn_mfma_f32_16x16x32_bf16(vf, pf, o[eb], 0, 0, 0);
            }
        }
        const float il = 1.f / l;
        bf16* op = atto + ((size_t)g * NT + qrow) * 256 + h * 64 + 4 * fq;
#pragma unroll
        for (int eb = 0; eb < 4; ++eb) { const f32x4 v = o[eb] * il; *(v2u*)(op + 16 * eb) = (v2u){pk2(v.x, v.y), pk2(v.z, v.w)}; }
        if (fq == 0) lse[((size_t)g * NT + qrow) * 4 + h] = mx + __builtin_amdgcn_logf(l);
    }
#undef ATT_DECODE
}

__device__ __forceinline__ void combine_phase(Frame& F) {
    const bf16* atto = (const bf16*)(F.ws + WS_ATTO); const float* lse = (const float*)(F.ws + WS_LSE); bf16* mixin = (bf16*)(F.ws + WS_MIXIN);
    for (size_t idx = (size_t)F.bid * NTHREADS + F.tid; idx < (size_t)NT * 32; idx += (size_t)F.G * NTHREADS) {
        const size_t t = idx >> 5; const int pc = (int)(idx & 31), h = pc >> 3;
        const float l0 = lse[(0 * (size_t)NT + t) * 4 + h], l1 = lse[(1 * (size_t)NT + t) * 4 + h], l2 = lse[(2 * (size_t)NT + t) * 4 + h];
        const float m = fmaxf(l0, fmaxf(l1, l2));
        float a0 = __builtin_amdgcn_exp2f(l0 - m), a1 = __builtin_amdgcn_exp2f(l1 - m), a2 = __builtin_amdgcn_exp2f(l2 - m);
        const float inv = 1.f / (a0 + a1 + a2); a0 *= inv; a1 *= inv; a2 *= inv;
        const v4u v0 = *(const v4u*)(atto + (0 * (size_t)NT + t) * 256 + pc * 8), v1 = *(const v4u*)(atto + (1 * (size_t)NT + t) * 256 + pc * 8), v2 = *(const v4u*)(atto + (2 * (size_t)NT + t) * 256 + pc * 8);
        v4u o;
        o.x = pk2(a0 * bflo(v0.x) + a1 * bflo(v1.x) + a2 * bflo(v2.x), a0 * bfhi(v0.x) + a1 * bfhi(v1.x) + a2 * bfhi(v2.x));
        o.y = pk2(a0 * bflo(v0.y) + a1 * bflo(v1.y) + a2 * bflo(v2.y), a0 * bfhi(v0.y) + a1 * bfhi(v1.y) + a2 * bfhi(v2.y));
        o.z = pk2(a0 * bflo(v0.z) + a1 * bflo(v1.z) + a2 * bflo(v2.z), a0 * bfhi(v0.z) + a1 * bfhi(v1.z) + a2 * bfhi(v2.z));
        o.w = pk2(a0 * bflo(v0.w) + a1 * bflo(v1.w) + a2 * bflo(v2.w), a0 * bfhi(v0.w) + a1 * bfhi(v1.w) + a2 * bfhi(v2.w));
        *(v4u*)(mixin + t * NMIX + 256 + pc * 8) = o;
    }
}

#if MK_NAIVE_ATTN
__device__ __forceinline__ void naive_attn_phase(Frame& F) {
    const bf16* proj = (const bf16*)(F.ws + WS_PROJ); bf16* mixin = (bf16*)(F.ws + WS_MIXIN);
    for (size_t idx = (size_t)F.bid * NTHREADS + F.tid; idx < (size_t)NT * 4; idx += (size_t)F.G * NTHREADS) {
        const size_t tg = idx >> 2; const int h = (int)(idx & 3), t = (int)(tg & (SEQ - 1)); const size_t rowb = tg - t;
        float m = -1e30f, l = 0.f, o[64];
        for (int e = 0; e < 64; ++e) o[e] = 0.f;
        for (int g = 0; g < 3; ++g) { const int d = 1 << (2 * g); const int colQ = 256 + g * 256 + h * 64;
            const bf16* q = proj + tg * NPROJ + colQ;
            for (int j = 0; j <= 128; ++j) { const int tk = t - j * d; if (tk < 0) break;
                const bf16* k = proj + (rowb + tk) * NPROJ + colQ + 768; const bf16* v = k + 768;
                float sdot = 0.f; for (int e = 0; e < 64; ++e) sdot += bf2f(q[e]) * bf2f(k[e]);
                sdot *= 0.125f;
                const float mn = fmaxf(m, sdot), corr = __expf(m - mn), p = __expf(sdot - mn);
                l = l * corr + p; for (int e = 0; e < 64; ++e) o[e] = o[e] * corr + p * bf2f(v[e]); m = mn; } }
        const float il = 1.f / l;
        for (int e = 0; e < 64; ++e) mixin[tg * NMIX + 256 + h * 64 + e] = (bf16)f2bf(o[e] * il);
    }
}
#endif

__device__ __forceinline__ void routing_phase(Frame& F, const float* router_bias) {
    const float* L0 = (const float*)(F.ws + WS_LOGIT); const float* L1 = L0 + (size_t)NT * NE;
    float* gatew = (float*)(F.ws + WS_GATEW); unsigned* bucket = (unsigned*)(F.ws + WS_BUCKET); unsigned* gcnt = (unsigned*)(F.ws + WS_CTL) + CW_GCNT;
    LAS unsigned* hist = (LAS unsigned*)F.lds; LAS unsigned* basel = hist + 256; LAS unsigned* asg = hist + 512;
    const int lane = F.lane;
    for (int blk = F.bid; blk < NT / 128; blk += F.G) {
        __syncthreads();
        if (F.tid < 256) hist[F.tid] = 0u;
        __syncthreads();
        const f32x4 bias = *(const f32x4*)(router_bias + 4 * lane);
        f32x4 lgn; { const size_t t0 = (size_t)blk * 128 + F.wave * 16; lgn = *(const f32x4*)(L0 + t0 * NE + 4 * lane) + *(const f32x4*)(L1 + t0 * NE + 4 * lane); }
#pragma nounroll
        for (int tl = 0; tl < 16; ++tl) {
            const int tloc = F.wave * 16 + tl; const size_t t = (size_t)blk * 128 + tloc;
            const f32x4 lg = lgn;
            if (tl + 1 < 16) lgn = *(const f32x4*)(L0 + (t + 1) * NE + 4 * lane) + *(const f32x4*)(L1 + (t + 1) * NE + 4 * lane);
            float sc[4], cd[4];
#pragma unroll
            for (int i = 0; i < 4; ++i) { sc[i] = 1.f / (1.f + __expf(-lg[i])); cd[i] = sc[i] + bias[i]; }
            float a1 = fmaxf(cd[0], cd[1]), a2 = fminf(cd[0], cd[1]);
#pragma unroll
            for (int i = 2; i < 4; ++i) { const float v = cd[i]; a2 = fmaxf(a2, fminf(a1, v)); a1 = fmaxf(a1, v); }
            { float b1 = dppf<0xB1>(a1), b2 = dppf<0xB1>(a2); float n1 = fmaxf(a1, b1), n2 = fmaxf(fminf(a1, b1), fmaxf(a2, b2)); a1 = n1; a2 = n2;
              b1 = dppf<0x4E>(a1); b2 = dppf<0x4E>(a2); n1 = fmaxf(a1, b1); n2 = fmaxf(fminf(a1, b1), fmaxf(a2, b2)); a1 = n1; a2 = n2;
              b1 = dppf<0x141>(a1); b2 = dppf<0x141>(a2); n1 = fmaxf(a1, b1); n2 = fmaxf(fminf(a1, b1), fmaxf(a2, b2)); a1 = n1; a2 = n2; }
            const float gs = a1 + a2; const int myg = lane >> 3; int rank = 0;
#pragma unroll
            for (int gg = 0; gg < 8; ++gg) { const float o = __builtin_bit_cast(float, __builtin_amdgcn_readlane(__builtin_bit_cast(int, gs), gg * 8)); rank += (o > gs || (o == gs && gg < myg)) ? 1 : 0; }
            if (rank >= 4) {
#pragma unroll
                for (int i = 0; i < 4; ++i) cd[i] = -1e30f; }
            int sel_e = 0; float sel_s = 0.f, ssum = 0.f;
#pragma unroll
            for (int k = 0; k < TOPK; ++k) {
                const float lm = fmaxf(fmaxf(cd[0], cd[1]), fmaxf(cd[2], cd[3]));
                float v = fmaxf(lm, dppf<0xB1>(lm)); v = fmaxf(v, dppf<0x4E>(v)); v = fmaxf(v, dppf<0x141>(v)); v = fmaxf(v, dppf<0x140>(v));
                const float r0 = __builtin_bit_cast(float, __builtin_amdgcn_readlane(__builtin_bit_cast(int, v), 0)), r1 = __builtin_bit_cast(float, __builtin_amdgcn_readlane(__builtin_bit_cast(int, v), 16));
                const float r2 = __builtin_bit_cast(float, __builtin_amdgcn_readlane(__builtin_bit_cast(int, v), 32)), r3 = __builtin_bit_cast(float, __builtin_amdgcn_readlane(__builtin_bit_cast(int, v), 48));
                const float mx = fmaxf(fmaxf(r0, r1), fmaxf(r2, r3));
                const unsigned long long msk = __ballot(lm == mx);
                const int own = __builtin_ffsll((long long)msk) - 1;
                const int bi = cd[0] == mx ? 0 : (cd[1] == mx ? 1 : (cd[2] == mx ? 2 : 3));
                float myv = sc[0]; myv = bi == 1 ? sc[1] : myv; myv = bi == 2 ? sc[2] : myv; myv = bi == 3 ? sc[3] : myv;
                const int wi = __builtin_amdgcn_readlane(bi, own);
                const float sv = __builtin_bit_cast(float, __builtin_amdgcn_readlane(__builtin_bit_cast(int, myv), own));
                if (lane == own) {
#pragma unroll
                    for (int i = 0; i < 4; ++i) if (wi == i) cd[i] = -1e30f; }
                ssum += sv;
                if (lane == k) { sel_e = 4 * own + wi; sel_s = sv; }
            }
            if (lane < TOPK) {
                const unsigned rk = __hip_atomic_fetch_add(hist + sel_e, 1u, __ATOMIC_RELAXED, __HIP_MEMORY_SCOPE_WORKGROUP);
                asg[tloc * 8 + lane] = (unsigned)sel_e | (rk << 16);
                gatew[t * 8 + lane] = sel_s / ssum * 2.5f;
            }
        }
        __syncthreads();
        if (F.tid < 256) { const unsigned c = hist[F.tid]; basel[F.tid] = c ? atomicAdd(&gcnt[F.tid * 16], c) : 0u; }
        __syncthreads();
        for (int a = F.tid; a < 1024; a += NTHREADS) { const unsigned v = asg[a], e = v & 0xffffu, rk = v >> 16;
            bucket[(size_t)e * CAP + basel[e] + rk] = (unsigned)(blk * 1024 + a); }
    }
}

__device__ __forceinline__ void build_tables(Frame& F, int& nblk_total) {
    const unsigned* gcnt = (const unsigned*)(F.ws + WS_CTL) + CW_GCNT;
    LAS int* prefix = (LAS int*)(F.lds + TAB_OFF); LAS int* cnt = prefix + 260;
    __syncthreads();
    if (F.tid < 256) cnt[F.tid] = (int)__hip_atomic_load(&gcnt[F.tid * 16], __ATOMIC_RELAXED, __HIP_MEMORY_SCOPE_AGENT);
    __syncthreads();
    if (F.tid < 64) {
        int nb[4], sm = 0;
#pragma unroll
        for (int i = 0; i < 4; ++i) { nb[i] = (cnt[4 * F.tid + i] + 255) >> 8; sm += nb[i]; }
        int inc = sm;
#pragma unroll
        for (int o = 1; o < 64; o <<= 1) { const int t = __shfl_up(inc, o); if (F.tid >= o) inc += t; }
        int ex = inc - sm;
#pragma unroll
        for (int i = 0; i < 4; ++i) { prefix[4 * F.tid + i] = ex; ex += nb[i]; }
        if (F.tid == 63) prefix[NE] = inc;
    }
    __syncthreads();
    if (F.tid < 256) { LAS unsigned char* b2e = (LAS unsigned char*)(cnt + 256); for (int b = prefix[F.tid]; b < prefix[F.tid + 1]; ++b) b2e[b] = (unsigned char)F.tid; }
    __syncthreads();
    nblk_total = prefix[NE];
}

__device__ __forceinline__ void final_phase(Frame& F, const float* g_final) {
    const float* mod = (const float*)(F.ws + WS_MOD); const unsigned char* Y = (const unsigned char*)(F.ws + WS_Y);
    const unsigned* pos = (const unsigned*)(F.ws + WS_POS); const float* gatew = (const float*)(F.ws + WS_GATEW);
    const int c0 = 16 * F.lane;
    for (int blk = F.bid; blk < NT / 128; blk += F.G) {
        const int b = (blk * 128) >> 12; const float* g2 = mod + (size_t)b * 6144 + 5 * D + c0;
        f32x4 gb[4];
#pragma unroll
        for (int j = 0; j < 4; ++j) gb[j] = *(const f32x4*)(g2 + 4 * j);
        const size_t rowbase = (size_t)blk * 128 + F.wave * 16;
        const unsigned p0 = pos[rowbase * 8 + F.lane], p1 = pos[rowbase * 8 + 64 + F.lane];
        const float w0 = gatew[rowbase * 8 + F.lane] * Y_INV_SCALE, w1 = gatew[rowbase * 8 + 64 + F.lane] * Y_INV_SCALE;
#pragma nounroll
        for (int rr = 0; rr < 16; ++rr) {
            const size_t row = rowbase + rr;
            const v4u* dr = (const v4u*)((const bf16*)F.out + row * (2 * D) + c0);
            v4u xv[2], sv[2], yv[TOPK]; float wk[TOPK];
            xv[0] = dr[0]; xv[1] = dr[1]; sv[0] = dr[128]; sv[1] = dr[129];
#pragma unroll
            for (int k = 0; k < TOPK; ++k) { const int idx = rr * 8 + k;
                const unsigned pk = (unsigned)__builtin_amdgcn_readlane((int)(idx < 64 ? p0 : p1), idx & 63);
                wk[k] = __builtin_bit_cast(float, __builtin_amdgcn_readlane(__builtin_bit_cast(int, idx < 64 ? w0 : w1), idx & 63));
                yv[k] = *(const v4u*)(Y + (size_t)pk * D + c0); }
            f32x4 v[4]; float s = 0.f;
#pragma unroll
            for (int j = 0; j < 4; ++j) {
                const unsigned sw0 = sv[j >> 1][(j & 1) * 2], sw1 = sv[j >> 1][(j & 1) * 2 + 1];
                f32x4 r = (f32x4){bflo(sw0), bfhi(sw0), bflo(sw1), bfhi(sw1)};
#pragma unroll
                for (int k = 0; k < TOPK; ++k) { const int wd = (int)yv[k][j];
                    const auto lo = __builtin_amdgcn_cvt_pk_f32_fp8(wd, false), hi = __builtin_amdgcn_cvt_pk_f32_fp8(wd, true);
                    r += wk[k] * (f32x4){lo[0], lo[1], hi[0], hi[1]}; }
                const unsigned xw0 = xv[j >> 1][(j & 1) * 2], xw1 = xv[j >> 1][(j & 1) * 2 + 1];
                v[j] = (f32x4){bflo(xw0), bfhi(xw0), bflo(xw1), bfhi(xw1)} + gb[j] * r;
                s += (v[j].x * v[j].x + v[j].y * v[j].y) + (v[j].z * v[j].z + v[j].w * v[j].w); }
            const float rstd = 1.f / sqrtf(wave_sum(s) * (1.f / D) + NORM_EPS);
            f32x4* orow = (f32x4*)(F.out + row * D + c0);
#pragma unroll
            for (int j = 0; j < 4; ++j) orow[j] = v[j] * rstd * *(const f32x4*)(g_final + c0 + 4 * j);
        }
    }
}

constexpr int N_PHASES = 12;
__global__ void __launch_bounds__(NTHREADS, 2) fwd(Args args) {
    extern __shared__ __attribute__((aligned(16))) unsigned char lds_raw[];
    Frame F;
    F.lds = (LAS unsigned char*)lds_raw;
    F.tid = threadIdx.x; F.lane = F.tid & 63; F.wave = __builtin_amdgcn_readfirstlane(F.tid >> 6); F.G = gridDim.x; F.bid = blockIdx.x;
#define INP(i) ld_ptr(F.lds, (i))
    F.out = args.out; F.ws = args.ws;
    unsigned char* ws = args.ws;
    volatile LAS unsigned* MISC = (volatile LAS unsigned*)(F.lds + MISC_OFF);
    if (F.tid < 16) MISC[F.tid] = 0u;
    if (F.tid == 0) { LAS unsigned long long* pt = (LAS unsigned long long*)(F.lds + PT_OFF);
#pragma unroll
        for (int i = 0; i < 19; ++i) pt[i] = (unsigned long long)args.in[i]; }
    __syncthreads();
    const int lo = args.ph_lo, hi = args.ph_hi;
    XcdBarrier bar; bar.bar = (unsigned*)(ws + WS_CTL) + CW_BAR; bar.x = 0; bar.st = nullptr;
    if (hi - lo > 1) bar = xcd_barrier_post((unsigned*)(ws + WS_CTL) + CW_BAR, MISC + 8);
#ifndef PH_MASK
#define PH_MASK 0xfff
#endif
#define IN(k) (((PH_MASK >> (k)) & 1) && lo <= (k) && (k) < hi)
#if MK_PROBE >= 1000
#define PH_T0(k) unsigned long long _pt##k = 0; if (MK_PROBE == 1000 + (k)) _pt##k = __builtin_amdgcn_s_memrealtime();
#define PH_T1(k) if (MK_PROBE == 1000 + (k) && blockIdx.x == MK_PROBE_BLK && F.tid == 0) MISC[12] += (unsigned)(__builtin_amdgcn_s_memrealtime() - _pt##k);
#else
#define PH_T0(k)
#define PH_T1(k)
#endif
#if MK_PROBE >= 2000
#define SEAM_T0() const unsigned long long _st0 = __builtin_amdgcn_s_memrealtime();
#define SEAM_T1(k) if ((MK_PROBE == 2000 || MK_PROBE == 2001 + (k)) && blockIdx.x == MK_PROBE_BLK && F.tid == 0) MISC[12] += (unsigned)(__builtin_amdgcn_s_memrealtime() - _st0);
#else
#define SEAM_T0()
#define SEAM_T1(k)
#endif
#define SEAM(k) do { SEAM_T0() if (IN(k) && IN((k) + 1)) xcd_barrier(bar); SEAM_T1(k) { int _t = threadIdx.x; asm volatile("" : "+v"(_t)); F.tid = _t; F.lane = _t & 63; } } while (0)

    const int vcu = (F.G % 8 == 0) ? (F.bid % 8) * (F.G / 8) + F.bid / 8 : F.bid;
    unsigned char* h8 = ws + WS_H;
    bf16* h2b = (bf16*)(ws + WS_H2B); bf16* proj = (bf16*)(ws + WS_PROJ); bf16* mixin = (bf16*)(ws + WS_MIXIN);

    PH_T0(0) if (IN(0)) { p0_prologue(F); } PH_T1(0) SEAM(0);
    PH_T0(1) if (IN(1)) { modnorm_phase<false, false, true>(F, INP(0), INP(4), 0, nullptr, (bf16*)h8); } PH_T1(1) SEAM(1);
    PH_T0(2) if (IN(2)) {
        typedef DenseSchedT<NT / 256, NPROJ / 256, 1> SchedP2; SchedP2 S; S.init(h8, ws + WS_WIN_T, D, D, 0, F.G, F.bid);
        EpiProj E{proj};
        const int ksplit = vcu % 6;
        S.i0 = 0; S.i1 = ksplit;
        gemm_phase<EpiProj, SchedP2>(F.lds, D, D, S, E);
        __syncthreads();
        for (int e = F.bid; e < NE; e += F.G)
            convert_expert<false>(F, INP(12) + (size_t)e * D * FF, INP(13) + (size_t)e * D * FF, ws + WS_WGU_T + (size_t)e * 512 * D);
        __syncthreads();
        S.i0 = ksplit; S.i1 = 0x3fffffff;
        gemm_phase<EpiProj, SchedP2>(F.lds, D, D, S, E);
    } PH_T1(2) SEAM(2);
    PH_T0(3) if (IN(3)) {
#if MK_PROBE == 1103
        const unsigned long long _pp0 = __builtin_amdgcn_s_memrealtime();
#endif
        pool_phase(F, INP(7));
#if MK_PROBE == 1103
        if (blockIdx.x == MK_PROBE_BLK && F.tid == 0) MISC[12] += (unsigned)(__builtin_amdgcn_s_memrealtime() - _pp0);
#endif
#if MK_NAIVE_ATTN
        naive_attn_phase(F);
#else
        attn_phase(F);
#endif
    } PH_T1(3) SEAM(3);
    PH_T0(4) if (IN(4)) {
#if !MK_NAIVE_ATTN
        combine_phase(F);
#endif
    } PH_T1(4) SEAM(4);
    PH_T0(5) if (IN(5)) {
        typedef DenseSchedT<NT / 256, D / 256, 1> SchedP5; SchedP5 S; S.init(mixin, ws + WS_WOUT_T, NMIX, NMIX, 0, F.G, F.bid);
        EpiOut E{(bf16*)F.out};
        gemm_phase<EpiOut, SchedP5>(F.lds, NMIX, NMIX, S, E);
    } PH_T1(5) SEAM(5);
    PH_T0(6) if (IN(6)) { modnorm_phase<true, true, true>(F, INP(0), INP(9), 3, h8, h2b); } PH_T1(6) SEAM(6);
    PH_T0(7) if (IN(7)) {
        typedef DenseSchedT<NT / 256, NE / 256, 2> SchedP7; SchedP7 S; S.init(h2b, ws + WS_WR_T, D, D, 512, F.G, F.bid);
        EpiRouter E{(float*)(ws + WS_LOGIT)};
        gemm_phase<EpiRouter, SchedP7>(F.lds, 512, D, S, E);
    } PH_T1(7) SEAM(7);
    PH_T0(8) if (IN(8)) { routing_phase(F, INP(11)); } PH_T1(8) SEAM(8);
    PH_T0(9) if (IN(9)) {
        int nblk; build_tables(F, nblk);
        MoeSched<2, false> S; S.prefix = (const LAS int*)(F.lds + TAB_OFF); S.cnt = S.prefix + 260; S.bucket = (const unsigned*)(ws + WS_BUCKET);
        S.Ar = (const char*)h8; S.As = (const char*)h8; S.Br = (const char*)(ws + WS_WGU_T); S.Bs = (const char*)(ws + WS_WSGU_T);
        S.nRouted = nblk * 2; S.total = S.nRouted + (NT / 256) * 2; S.G = F.G; S.c = vcu;
        EpiGU E{ws + WS_ACT, ws + WS_ACTS, (const unsigned*)(ws + WS_BUCKET), (unsigned*)(ws + WS_POS)};
        const int ksplit = vcu % 11;
        S.i0 = 0; S.i1 = ksplit;
        gemm_phase<EpiGU, MoeSched<2, false>>(F.lds, D / 2, D / 2, S, E);
        __syncthreads();
        for (int e = F.bid; e < NE; e += F.G)
            convert_expert<true>(F, INP(14) + (size_t)e * FF * D, nullptr, ws + WS_WD_T + (size_t)e * D * FF);
        __syncthreads();
        S.i0 = ksplit; S.i1 = 0x3fffffff;
        gemm_phase<EpiGU, MoeSched<2, false>>(F.lds, D / 2, D / 2, S, E);
    } PH_T1(9) SEAM(9);
    PH_T0(10) if (IN(10)) {
        int nblk; build_tables(F, nblk);
        MoeSched<4, true> S; S.prefix = (const LAS int*)(F.lds + TAB_OFF); S.cnt = S.prefix + 260; S.bucket = (const unsigned*)(ws + WS_BUCKET);
        S.Ar = (const char*)(ws + WS_ACT); S.As = (const char*)(ws + WS_ACTS); S.Br = (const char*)(ws + WS_WD_T); S.Bs = (const char*)(ws + WS_WSD_T);
        S.nRouted = nblk * 4; S.total = S.nRouted + (NT / 256) * 4; S.G = F.G; S.c = vcu; S.i0 = 0; S.i1 = 0x3fffffff;
        EpiDown E{(unsigned char*)(ws + WS_Y), (bf16*)F.out};
        gemm_phase<EpiDown, MoeSched<4, true>>(F.lds, FF / 2, FF / 2, S, E);
    } PH_T1(10) SEAM(10);
    PH_T0(11) if (IN(11)) { final_phase(F, INP(18)); } PH_T1(11)
#if MK_PROBE
    if (blockIdx.x == MK_PROBE_BLK) { __syncthreads();
        if (F.tid == 0) { const unsigned long long span = (unsigned long long)MISC[12] * MK_PROBE_MULT, t0 = __builtin_amdgcn_s_memrealtime();
            while (__builtin_amdgcn_s_memrealtime() - t0 < span) __builtin_amdgcn_s_sleep(16); } }
#endif
#undef IN
#undef SEAM
#undef INP
}

extern "C" void kernel_launch(void* const* d_in, const int* in_sizes, int n_in, void* d_out, int out_size, void* d_ws, size_t ws_size, hipStream_t stream) {
    static int grid = 0;
    if (grid == 0) {
        if (n_in != 19 || out_size != NT * D || ws_size < WS_END) { fprintf(stderr, "kernel_launch: unexpected shapes (n_in %d out %d ws %zu)\n", n_in, out_size, ws_size); grid = -1; return; }
        int dev = 0, cus = 0;
        if (hipGetDevice(&dev) != hipSuccess || hipDeviceGetAttribute(&cus, hipDeviceAttributeMultiprocessorCount, dev) != hipSuccess) { grid = -1; return; }
        if (hipFuncSetAttribute((const void*)fwd, hipFuncAttributeMaxDynamicSharedMemorySize, LDS_BYTES) != hipSuccess) { fprintf(stderr, "kernel_launch: hipFuncSetAttribute failed\n"); grid = -1; return; }
        int per_cu = 0;
        if (hipOccupancyMaxActiveBlocksPerMultiprocessor(&per_cu, (const void*)fwd, NTHREADS, LDS_BYTES) != hipSuccess || per_cu < 1) { fprintf(stderr, "kernel_launch: occupancy query says %d\n", per_cu); }
        (void)hipGetLastError();
        grid = cus;
    }
    if (grid < 0) return;
    (void)hipMemsetAsync((char*)d_ws + WS_CTL, 0, CTL_ZERO_BYTES, stream);
    Args a{};
    for (int i = 0; i < 19; ++i) a.in[i] = (const float*)d_in[i];
    a.out = (float*)d_out; a.ws = (unsigned char*)d_ws;
#if MK_ONE_LAUNCH
    a.ph_lo = 0; a.ph_hi = N_PHASES;
    hipLaunchKernelGGL(fwd, dim3(grid), dim3(NTHREADS), LDS_BYTES, stream, a);
#else
    for (int p = 0; p < N_PHASES; ++p) { a.ph_lo = p; a.ph_hi = p + 1; const int reps = ((MK_REP_MASK >> p) & 1) ? 2 : 1;
        for (int r = 0; r < reps; ++r) hipLaunchKernelGGL(fwd, dim3(grid), dim3(NTHREADS), LDS_BYTES, stream, a); }
#endif
}
```

```cpp
#include <hip/hip_runtime.h>
#include <cstdio>
#include <cstdint>

#ifndef MK_ONE_LAUNCH
#define MK_ONE_LAUNCH 1
#endif
#ifndef MK_FAST_GEMM
#define MK_FAST_GEMM 1
#endif
#ifndef MK_REP_MASK
#define MK_REP_MASK 0x000
#endif
#ifndef MK_MX
#define MK_MX 1
#endif
#ifndef MK_PROBE
#define MK_PROBE 0
#endif
#ifndef MK_PROBE_BLK
#define MK_PROBE_BLK 0
#endif
#ifndef MK_PROBE_WAVE
#define MK_PROBE_WAVE 0
#endif
#ifndef MK_PROBE_MULT
#define MK_PROBE_MULT 4
#endif
#ifndef MK_NAIVE_ATTN
#define MK_NAIVE_ATTN 0
#endif

#define LAS __attribute__((address_space(3)))
#define GAS __attribute__((address_space(1)))
typedef unsigned short bf16;
typedef short bf16x8 __attribute__((ext_vector_type(8)));
typedef short s16x4 __attribute__((ext_vector_type(4)));
typedef float f32x4 __attribute__((ext_vector_type(4)));
typedef float f32x2 __attribute__((ext_vector_type(2)));
typedef long l64x2 __attribute__((ext_vector_type(2)));
typedef int i32x8 __attribute__((ext_vector_type(8)));
typedef int i32x4 __attribute__((ext_vector_type(4)));
typedef unsigned v4u __attribute__((ext_vector_type(4)));
typedef unsigned v2u __attribute__((ext_vector_type(2)));

constexpr int D = 1024, NB = 8, SEQ = 4096, NT = NB * SEQ;
constexpr int NPROJ = 2560, NE = 256, TOPK = 8, FF = 256, NMIX = 512;
constexpr int CAP = NT;
constexpr int MAXBLK = NT * TOPK / 256 + NE;
constexpr float NORM_EPS = 1e-6f;
constexpr int NWAVES = 8, NTHREADS = 512;

constexpr size_t MiB = 1u << 20;
constexpr size_t WS_CTL = 0, CTL_ZERO_BYTES = 1 * MiB;
constexpr size_t WS_MOD = 1 * MiB;
constexpr size_t WS_GATEW = 2 * MiB;
constexpr size_t WS_WIN_T = 4 * MiB;
constexpr size_t WS_WOUT_T = 9 * MiB;
constexpr size_t WS_WR_T = 10 * MiB;
constexpr size_t WS_WSGU_T = 11 * MiB;
constexpr size_t WS_WSD_T = 12 * MiB;
constexpr size_t WS_LSE = 13 * MiB;
constexpr size_t WS_WD_T = 16 * MiB;
constexpr size_t WS_ACT = 144 * MiB;
constexpr size_t WS_ACTS = 304 * MiB;
constexpr size_t WS_BUCKET = 320 * MiB;
constexpr size_t WS_WGU_T = 352 * MiB;
constexpr size_t WS_PROJ = 608 * MiB;
constexpr size_t WS_H = 768 * MiB;
constexpr size_t WS_ATTO = 832 * MiB;
constexpr size_t WS_MIXIN = 880 * MiB;
constexpr size_t WS_LOGIT = 912 * MiB;
constexpr size_t WS_Y = 352 * MiB;
constexpr size_t WS_H2B = 832 * MiB;
constexpr size_t WS_PWT = 15 * MiB;
constexpr size_t WS_POS = 3 * MiB;
constexpr size_t WS_END = 992 * MiB;
constexpr int CW_BAR = 4096;
constexpr int CW_GCNT = 16384;
constexpr int CW_QD = 24576;
constexpr unsigned QG_CHUNKS = NE * 32, QD_CHUNKS = QG_CHUNKS + NE * 16;

constexpr int RING_BYTES = 131072;
constexpr int TAB_OFF = RING_BYTES;
constexpr int MISC_OFF = TAB_OFF + 4096;
constexpr int PT_OFF = MISC_OFF + 256;
constexpr int LDS_BYTES = 147456;

__device__ __forceinline__ unsigned f2bf(float f) { unsigned u = __builtin_bit_cast(unsigned, f); return (u + 0x7fffu + ((u >> 16) & 1u)) >> 16; }
__device__ __forceinline__ unsigned pk2(float lo, float hi) { unsigned r; asm("v_cvt_pk_bf16_f32 %0, %1, %2" : "=v"(r) : "v"(lo), "v"(hi)); return r; }
constexpr float W_SCALE = 64.f, W_INV_SCALE = 1.f / 64.f;
constexpr float WD_SCALE = 4.f;
constexpr float ACT_SCALE = 4.f;
__device__ __forceinline__ unsigned pk4_fp8(float a, float b, float c, float d) {
    int w = __builtin_amdgcn_cvt_pk_fp8_f32(a, b, 0, false); w = __builtin_amdgcn_cvt_pk_fp8_f32(c, d, w, true); return (unsigned)w; }
__device__ __forceinline__ float bf2f(unsigned short b) { return __builtin_bit_cast(float, ((unsigned)b) << 16); }
__device__ __forceinline__ float bflo(unsigned u) { return __builtin_bit_cast(float, u << 16); }
__device__ __forceinline__ float bfhi(unsigned u) { return __builtin_bit_cast(float, u & 0xffff0000u); }
template <int CTRL> __device__ __forceinline__ float dppf(float v) {
    return __builtin_bit_cast(float, __builtin_amdgcn_update_dpp(0, __builtin_bit_cast(int, v), CTRL, 0xF, 0xF, true)); }
__device__ __forceinline__ float wave_sum(float v) {
    v += dppf<0xB1>(v); v += dppf<0x4E>(v); v += dppf<0x141>(v); v += dppf<0x140>(v);
    const float r0 = __builtin_bit_cast(float, __builtin_amdgcn_readlane(__builtin_bit_cast(int, v), 0)), r1 = __builtin_bit_cast(float, __builtin_amdgcn_readlane(__builtin_bit_cast(int, v), 16));
    const float r2 = __builtin_bit_cast(float, __builtin_amdgcn_readlane(__builtin_bit_cast(int, v), 32)), r3 = __builtin_bit_cast(float, __builtin_amdgcn_readlane(__builtin_bit_cast(int, v), 48));
    return (r0 + r1) + (r2 + r3);
}
__device__ __forceinline__ float silu_f(float g) { return g * __builtin_amdgcn_rcpf(1.f + __builtin_amdgcn_exp2f(-1.44269504f * g)); }

__device__ __forceinline__ const float* ld_ptr(LAS unsigned char* lds, int i) {
    const unsigned long long v = ((const LAS unsigned long long*)(lds + PT_OFF))[i];
    const unsigned lo = __builtin_amdgcn_readfirstlane((unsigned)v), hi = __builtin_amdgcn_readfirstlane((unsigned)(v >> 32));
    return (const float*)(((unsigned long long)hi << 32) | lo);
}
#define XB_TMO      128
#define XB_XCNT(j)  (256  + 64 * (j))
#define XB_XSUB(j)  (1280 + 64 * (j))
#define XB_XGEN(j)  (2304 + 64 * (j))
#define XB_TOP      3328
#define XB_TOPGEN   3392
#define XCD_BAR_WORDS 3456
#define XB_SPIN_CAP (1u << 18)
__device__ __forceinline__ unsigned xb_ld(unsigned* p)              { return __hip_atomic_load(p, __ATOMIC_RELAXED, __HIP_MEMORY_SCOPE_AGENT); }
__device__ __forceinline__ unsigned xb_add(unsigned* p, unsigned v) { return __hip_atomic_fetch_add(p, v, __ATOMIC_RELAXED, __HIP_MEMORY_SCOPE_AGENT); }
__device__ __forceinline__ unsigned xb_xcc_id() { return (unsigned)__builtin_amdgcn_s_getreg((3 << 11) | 20) & 0xFu; }
#define XB_SPIN(cond, bar) do { unsigned _sp = 0; while (cond) { __builtin_amdgcn_s_sleep(1); \
    if ((++_sp & 255u) == 0u) { if (xb_ld(&(bar)[XB_TMO])) break; if (_sp > XB_SPIN_CAP) { atomicAdd(&(bar)[XB_TMO], 1u); break; } } } } while (0)
struct XcdBarrier { unsigned* bar; unsigned x; volatile LAS unsigned* st; };
__device__ __forceinline__ XcdBarrier xcd_barrier_post(unsigned* bar, volatile LAS unsigned* st) {
    XcdBarrier b; b.bar = bar; b.x = xb_xcc_id(); b.st = st;
    if (threadIdx.x == 0) (void)xb_add(&bar[XB_XCNT(b.x)], 1u);
    return b;
}
__device__ __forceinline__ void xcd_barrier_complete(unsigned* bar, unsigned x, unsigned& nloc, unsigned& nx) {
    const unsigned G = gridDim.x * gridDim.y * gridDim.z;
    unsigned sum, cnt, mine, sp = 0u;
    for (;;) {
        sum = 0u; cnt = 0u; mine = 0u;
#pragma unroll
        for (unsigned j = 0; j < 16; ++j) { const unsigned c = xb_ld(&bar[XB_XCNT(j)]); sum += c; cnt += (c > 0u) ? 1u : 0u; mine = (j == x) ? c : mine; }
        if (sum == G) break;
        __builtin_amdgcn_s_sleep(1);
        if ((++sp & 255u) == 0u) { if (xb_ld(&bar[XB_TMO])) break; if (sp > XB_SPIN_CAP) { atomicAdd(&bar[XB_TMO], 1u); break; } }
    }
    nloc = mine > 0u ? mine : 1u; nx = cnt > 0u ? cnt : 1u;
}
__device__ __forceinline__ void xcd_barrier(const XcdBarrier& b) {
    asm volatile("s_waitcnt vmcnt(0)" ::: "memory");
    __syncthreads();
    if (threadIdx.x == 0) {
        unsigned* bar = b.bar;
        __builtin_amdgcn_s_waitcnt(0);
        unsigned nloc = b.st[0], nx = b.st[1];
        if (nloc == 0u) { xcd_barrier_complete(bar, b.x, nloc, nx); b.st[0] = nloc; b.st[1] = nx; }
        const unsigned old = xb_add(&bar[XB_XSUB(b.x)], 1u);
        const unsigned gen = old / nloc;
        if (old + 1u == (gen + 1u) * nloc) {
            __builtin_amdgcn_fence(__ATOMIC_RELEASE, "agent");
            asm volatile("s_waitcnt vmcnt(0)" ::: "memory");
            const unsigned og = xb_add(&bar[XB_TOP], 1u);
            const unsigned tg = og / nx;
            if (og + 1u == (tg + 1u) * nx) xb_add(&bar[XB_TOPGEN], 1u);
            else XB_SPIN(xb_ld(&bar[XB_TOPGEN]) == tg, bar);
            __builtin_amdgcn_fence(__ATOMIC_ACQUIRE, "agent");
            xb_add(&bar[XB_XGEN(b.x)], 1u);
            asm volatile("s_waitcnt vmcnt(0)" ::: "memory");
        } else {
            XB_SPIN(xb_ld(&bar[XB_XGEN(b.x)]) == gen, bar);
            __builtin_amdgcn_fence(__ATOMIC_ACQUIRE, "agent");
            asm volatile("s_waitcnt vmcnt(0)" ::: "memory");
        }
    }
    __syncthreads();
}

constexpr int BK = 64, HALF = 128, HTB = HALF * BK * 2;
__device__ __forceinline__ int lds_byte(int r, int c) { const int st = (r >> 4) * 2 + (c >> 5), rr = r & 15, cc = c & 31, ob = rr * 64 + cc * 2; return st * 1024 + (ob ^ (((ob >> 9) & 1) << 5)); }
__device__ __forceinline__ void stage_rc(int b, int& R, int& C) { const int st = b / 1024, sb = b % 1024, swz = sb ^ (((sb >> 9) & 1) << 5); R = (st >> 1) * 16 + swz / 64; C = (st & 1) * 32 + (swz % 64) / 2; }
__device__ __forceinline__ int perm32(int rho) { const int n = rho >> 4, i = rho & 15; return 8 * (i >> 2) + 4 * n + (i & 3); }

template <class Epi, class Sched>
__device__ __forceinline__ void gemm_simple(const int K, const int ldb, const Sched& S, const Epi& E) {
    const int tid = threadIdx.x, wid = __builtin_amdgcn_readfirstlane(tid >> 6), lane = tid & 63, wr = wid >> 2, wc = wid & 3, fr = lane & 15, fq = lane >> 4;
    typename Sched::Unit u;
    for (int ui = 0; S.next(ui, u); ++ui) {
        f32x4 acc[2][2][4][2];
#pragma unroll
        for (int a = 0; a < 2; ++a)
#pragma unroll
            for (int b = 0; b < 2; ++b)
#pragma unroll
                for (int m = 0; m < 4; ++m)
#pragma unroll
                    for (int n = 0; n < 2; ++n) acc[a][b][m][n] = (f32x4){0.f, 0.f, 0.f, 0.f};
        const char* A = S.a_base(u); const char* B = S.b_base(u);
        unsigned aoff[2][4], boff[2][2];
#pragma unroll
        for (int ai = 0; ai < 2; ++ai)
#pragma unroll
            for (int m = 0; m < 4; ++m) aoff[ai][m] = S.a_off(u, 128 * ai + 64 * wr + 16 * m + fr) + fq * 16;
#pragma unroll
        for (int bj = 0; bj < 2; ++bj)
#pragma unroll
            for (int n = 0; n < 2; ++n) { const int row = Epi::PERM == 2 ? 64 * wc + 16 * (fr >> 2) + 8 * bj + 4 * n + (fr & 3) : 128 * bj + 32 * wc + (Epi::PERM == 1 ? perm32(16 * n + fr) : 16 * n + fr); boff[bj][n] = (unsigned)(row * ldb) * 2u + fq * 16; }
        for (int k = 0; k < K; k += 32) {
            bf16x8 a[2][4], b[2][2];
#pragma unroll
            for (int ai = 0; ai < 2; ++ai)
#pragma unroll
                for (int m = 0; m < 4; ++m) a[ai][m] = *(const bf16x8*)(A + aoff[ai][m] + k * 2);
#pragma unroll
            for (int bj = 0; bj < 2; ++bj)
#pragma unroll
                for (int n = 0; n < 2; ++n) b[bj][n] = *(const bf16x8*)(B + boff[bj][n] + k * 2);
#pragma unroll
            for (int ai = 0; ai < 2; ++ai)
#pragma unroll
                for (int bj = 0; bj < 2; ++bj)
#pragma unroll
                    for (int m = 0; m < 4; ++m)
#pragma unroll
                        for (int n = 0; n < 2; ++n) acc[ai][bj][m][n] = __builtin_amdgcn_mfma_f32_16x16x32_bf16(b[bj][n], a[ai][m], acc[ai][bj][m][n], 0, 0, 0);
        }
        E(acc, u, wr, wc, fr, fq);
    }
}

template <class Epi, class Sched>
__device__ __forceinline__ void gemm_fast(LAS unsigned char* lds, const int K, const int ldb, const Sched& S, const Epi& E) {
    int tid0 = threadIdx.x; asm volatile("" : "+v"(tid0));
    const int tid = tid0, wid = __builtin_amdgcn_readfirstlane(tid >> 6), lane = tid & 63, wr = wid >> 2, wc = wid & 3, fr = lane & 15, fq = lane >> 4;
    int nt = K / BK; asm volatile("" : "+s"(nt));
    unsigned voffB0[2], voffB1[2];
#pragma unroll
    for (int i = 0; i < 2; ++i) { int R, C; stage_rc(tid * 16 + i * 8192, R, C);
        if (Epi::PERM == 2) { const int cb = 64 * (R >> 5) + 16 * ((R & 15) >> 2) + 4 * ((R >> 4) & 1) + (R & 3);
            voffB0[i] = (unsigned)(cb * ldb + C) * 2u; voffB1[i] = (unsigned)((cb + 8) * ldb + C) * 2u; }
        else { const int Rb = Epi::PERM == 1 ? ((R & ~31) + perm32(R & 31)) : R;
            voffB0[i] = (unsigned)(Rb * ldb + C) * 2u; voffB1[i] = (unsigned)((Rb + HALF) * ldb + C) * 2u; } }
#define PG8_AOFF(u) do { int _tz = threadIdx.x; asm volatile("" : "+v"(_tz)); _Pragma("unroll") for (int _i = 0; _i < 2; ++_i) { int _R, _C; stage_rc(_tz * 16 + _i * 8192, _R, _C); \
        vA0[_i] = S.a_off(u, _R) + (unsigned)_C * 2u; vA1[_i] = S.a_off(u, HALF + _R) + (unsigned)_C * 2u; } } while (0)
    const size_t kstep = (size_t)(BK * 2);
    const unsigned ldsw = (unsigned)wid * 1024u;
    const int aoff = lds_byte(wr * 64 + fr, fq * 8), boff = lds_byte(wc * 32 + fr, fq * 8);
#if MK_PROBE
#define PRB_NOW() __builtin_amdgcn_s_memrealtime()
#define PRB_ADD(IV, t0, t1) do { if (MK_PROBE == Epi::PID * 10 + (IV) && blockIdx.x == MK_PROBE_BLK && wid == MK_PROBE_WAVE && lane == 0) \
        __hip_atomic_fetch_add((LAS unsigned*)(lds + MISC_OFF + 48), (unsigned)((t1) - (t0)), __ATOMIC_RELAXED, __HIP_MEMORY_SCOPE_WORKGROUP); } while (0)
#else
#define PRB_NOW() 0ull
#define PRB_ADD(IV, t0, t1) do { } while (0)
#endif
#define PG8_SA(b, h) (((b) * 2 + (h)) * HTB)
#define PG8_SB(b, h) ((4 + (b) * 2 + (h)) * HTB)
#define PG8_STAGE(bufoff, gbase, voff) do { _Pragma("unroll") for (int _i = 0; _i < 2; ++_i) \
        __builtin_amdgcn_global_load_lds((const unsigned*)((const char*)(gbase) + (voff)[_i]), (LAS unsigned*)(lds + (bufoff) + ldsw + _i * 8192), 16, 0, 0); } while (0)
#define PG8_LDA(dst, b, h) do { _Pragma("unroll") for (int m = 0; m < 4; ++m) _Pragma("unroll") for (int k = 0; k < 2; ++k) dst[m][k] = *(const LAS bf16x8*)(lds + PG8_SA(b, h) + aoff + m * 2048 + k * 1024); } while (0)
#define PG8_LDB(dst, b, h) do { _Pragma("unroll") for (int n = 0; n < 2; ++n) _Pragma("unroll") for (int k = 0; k < 2; ++k) dst[n][k] = *(const LAS bf16x8*)(lds + PG8_SB(b, h) + boff + n * 2048 + k * 1024); } while (0)
#define PG8_MMA(ai, bj, At, Bt) do { __builtin_amdgcn_s_setprio(1); _Pragma("unroll") for (int m = 0; m < 4; ++m) _Pragma("unroll") for (int n = 0; n < 2; ++n) _Pragma("unroll") for (int k = 0; k < 2; ++k) { \
        if constexpr (Epi::FP8 && MK_MX) { if (k == 0) { \
            const i32x8 _a = __builtin_shufflevector(__builtin_bit_cast(i32x4, At[m][0]), __builtin_bit_cast(i32x4, At[m][1]), 0, 1, 2, 3, 4, 5, 6, 7); \
            const i32x8 _b = __builtin_shufflevector(__builtin_bit_cast(i32x4, Bt[n][0]), __builtin_bit_cast(i32x4, Bt[n][1]), 0, 1, 2, 3, 4, 5, 6, 7); \
            acc[ai][bj][m][n] = __builtin_amdgcn_mfma_scale_f32_16x16x128_f8f6f4(_b, _a, acc[ai][bj][m][n], 0, 0, 0, 0x7F7F7F7F, 0, 0x7F7F7F7F); } } \
        else if constexpr (Epi::FP8) { const l64x2 _a = __builtin_bit_cast(l64x2, At[m][k]), _b = __builtin_bit_cast(l64x2, Bt[n][k]); \
            acc[ai][bj][m][n] = __builtin_amdgcn_mfma_f32_16x16x32_fp8_fp8(_b[0], _a[0], acc[ai][bj][m][n], 0, 0, 0); \
            acc[ai][bj][m][n] = __builtin_amdgcn_mfma_f32_16x16x32_fp8_fp8(_b[1], _a[1], acc[ai][bj][m][n], 0, 0, 0); } \
        else acc[ai][bj][m][n] = __builtin_amdgcn_mfma_f32_16x16x32_bf16(Bt[n][k], At[m][k], acc[ai][bj][m][n], 0, 0, 0); } __builtin_amdgcn_s_setprio(0); } while (0)
#define PG8_WAIT_V(n) asm volatile("s_waitcnt vmcnt(" #n ")" ::: "memory")
#define PG8_WAIT_L(n) asm volatile("s_waitcnt lgkmcnt(" #n ")" ::: "memory")
#define PG8_BAR __builtin_amdgcn_s_barrier()
#define PG8_SCHED __builtin_amdgcn_sched_barrier(0)
    typename Sched::Unit cur, nxt; int ui = 0;
    if (!S.next(0, cur)) return;
    f32x4 acc[2][2][4][2];
#pragma unroll
    for (int a = 0; a < 2; ++a)
#pragma unroll
        for (int b = 0; b < 2; ++b)
#pragma unroll
            for (int m = 0; m < 4; ++m)
#pragma unroll
                for (int n = 0; n < 2; ++n) acc[a][b][m][n] = (f32x4){0.f, 0.f, 0.f, 0.f};
    bf16x8 At[4][2], B0[2][2], B1[2][2];
    const char* cA = S.a_base(cur); const char* cB = S.b_base(cur);
    unsigned vA0[2], vA1[2];
    PG8_AOFF(cur);
    PG8_STAGE(PG8_SB(0, 0), cB, voffB0); PG8_STAGE(PG8_SA(0, 0), cA, vA0); PG8_STAGE(PG8_SB(0, 1), cB, voffB1); PG8_STAGE(PG8_SA(0, 1), cA, vA1);
    if (wr == 1) PG8_BAR;
    PG8_WAIT_V(4); PG8_BAR;
    PG8_STAGE(PG8_SB(1, 0), cB + kstep, voffB0); PG8_STAGE(PG8_SA(1, 0), cA + kstep, vA0); PG8_STAGE(PG8_SB(1, 1), cB + kstep, voffB1);
    PG8_WAIT_V(6); PG8_BAR;
    for (;;) {
        const unsigned long long prb_a = PRB_NOW();
        const bool has_next = S.next(ui + 1, nxt);
        const char* nA = has_next ? S.a_base(nxt) : cA; const char* nB = has_next ? S.b_base(nxt) : cB;
        const unsigned long long prb_b = PRB_NOW(); PRB_ADD(1, prb_a, prb_b);
        for (int t = 0; t < nt; t += 2) {
            const unsigned long long prb_i0 = PRB_NOW();
            const bool last = (t == nt - 2);
            const char* a1 = cA + (size_t)(t + 1) * kstep;
            const char* a2 = last ? nA : cA + (size_t)(t + 2) * kstep; const char* b2 = last ? nB : cB + (size_t)(t + 2) * kstep;
            const char* a3 = a2 + kstep; const char* b3 = b2 + kstep;
            PG8_LDB(B0, 0, 0); PG8_SCHED; PG8_LDA(At, 0, 0); PG8_STAGE(PG8_SA(1, 1), a1, vA1);
            if (last && has_next) PG8_AOFF(nxt);
            PG8_WAIT_L(8); PG8_BAR; PG8_WAIT_L(0); PG8_MMA(0, 0, At, B0); PG8_BAR; PG8_SCHED;
            PG8_LDB(B1, 0, 1); PG8_STAGE(PG8_SB(0, 0), b2, voffB0);
            PG8_BAR; PG8_WAIT_L(0); PG8_MMA(0, 1, At, B1); PG8_BAR;
            PG8_LDA(At, 0, 1); PG8_STAGE(PG8_SA(0, 0), a2, vA0);
            PG8_BAR; PG8_WAIT_L(0); PG8_MMA(1, 0, At, B0); PG8_BAR; PG8_SCHED;
            PG8_STAGE(PG8_SB(0, 1), b2, voffB1);
            PG8_WAIT_V(6); PG8_BAR; PG8_MMA(1, 1, At, B1); PG8_BAR;
            PG8_LDB(B0, 1, 0); PG8_SCHED; PG8_LDA(At, 1, 0); PG8_STAGE(PG8_SA(0, 1), a2, vA1);
            PG8_WAIT_L(8); PG8_BAR; PG8_WAIT_L(0); PG8_MMA(0, 0, At, B0); PG8_BAR; PG8_SCHED;
            PG8_LDB(B1, 1, 1); PG8_STAGE(PG8_SB(1, 0), b3, voffB0);
            PG8_BAR; PG8_WAIT_L(0); PG8_MMA(0, 1, At, B1); PG8_BAR;
            PG8_LDA(At, 1, 1); PG8_STAGE(PG8_SA(1, 0), a3, vA0);
            PG8_BAR; PG8_WAIT_L(0); PG8_MMA(1, 0, At, B0); PG8_BAR; PG8_SCHED;
            PG8_STAGE(PG8_SB(1, 1), b3, voffB1);
            PG8_WAIT_V(6); PG8_BAR; PG8_MMA(1, 1, At, B1); PG8_BAR;
            { const unsigned long long prb_i1 = PRB_NOW(); if (t == 0) PRB_ADD(4, prb_i0, prb_i1); if (last) PRB_ADD(5, prb_i0, prb_i1); if (t != 0 && !last) PRB_ADD(6, prb_i0, prb_i1); }
        }
        const unsigned long long prb_c = PRB_NOW(); PRB_ADD(2, prb_b, prb_c);
        { int tz = threadIdx.x; asm volatile("" : "+v"(tz)); const int wz = tz >> 6, lz = tz & 63;
          E(acc, cur, wz >> 2, wz & 3, lz & 15, lz >> 4);
#if defined(MK_EPI_TWICE)
          if (Epi::TWICE) { asm volatile("" ::: "memory"); E(acc, cur, wz >> 2, wz & 3, lz & 15, lz >> 4); }
#endif
          }
        { const unsigned long long prb_d = PRB_NOW(); PRB_ADD(3, prb_c, prb_d); }
        if (!has_next) break;
#pragma unroll
        for (int a = 0; a < 2; ++a)
#pragma unroll
            for (int b = 0; b < 2; ++b)
#pragma unroll
                for (int m = 0; m < 4; ++m)
#pragma unroll
                    for (int n = 0; n < 2; ++n) acc[a][b][m][n] = (f32x4){0.f, 0.f, 0.f, 0.f};
        cur = nxt; cA = nA; cB = nB; ++ui;
    }
    PG8_WAIT_V(0);
    if (wr == 0) PG8_BAR;
    PG8_BAR;
#undef PG8_AOFF
#undef PRB_NOW
#undef PRB_ADD
#undef PG8_SA
#undef PG8_SB
#undef PG8_STAGE
#undef PG8_LDA
#undef PG8_LDB
#undef PG8_MMA
#undef PG8_WAIT_V
#undef PG8_WAIT_L
#undef PG8_BAR
#undef PG8_SCHED
}

template <class Epi, class Sched>
__device__ __forceinline__ void gemm_phase(LAS unsigned char* lds, const int K, const int ldb, const Sched& S, const Epi& E) {
#if MK_FAST_GEMM
    gemm_fast<Epi, Sched>(lds, K, ldb, S, E);
#else
    gemm_simple<Epi, Sched>(K, ldb, S, E);
#endif
}

struct DenseUnit { int pm, pn, ks; };
template <int NM, int NN, int KSPLIT>
struct DenseSchedT {
    typedef DenseUnit Unit;
    const char* A; const char* B; int lda2, ldb2, ksub2, G, c, i0, i1;
    __device__ __forceinline__ void init(const void* A_, const void* B_, int lda, int ldb, int Ksub, int G_, int c_) {
        A = (const char*)A_; B = (const char*)B_; lda2 = lda * 2; ldb2 = ldb * 2; ksub2 = Ksub * 2; G = G_; c = c_; i0 = 0; i1 = 0x3fffffff; }
    __device__ __forceinline__ bool next(int i, Unit& u) const {
        constexpr int nwg = NM * NN, total = nwg * KSPLIT;
        if (i + i0 >= i1) return false;
        const int L = (i + i0) * G + c; if (L >= total) return false;
        int id = L / KSPLIT; u.ks = L - id * KSPLIT;
        { constexpr int q = nwg / 8, r = nwg % 8; const int xcd = id % 8, off = id / 8; id = (xcd < r ? xcd * (q + 1) : r * (q + 1) + (xcd - r) * q) + off; }
        constexpr int nig = 8 * NN; const int gid = id / nig, fm = gid * 8, gsz = (NM - fm) < 8 ? (NM - fm) : 8;
        u.pm = fm + ((id % nig) % gsz); u.pn = (id % nig) / gsz; return true;
    }
    __device__ __forceinline__ const char* a_base(const Unit& u) const { return A + (size_t)u.pm * 256 * lda2 + (size_t)u.ks * ksub2; }
    __device__ __forceinline__ const char* b_base(const Unit& u) const { return B + (size_t)u.pn * 256 * ldb2 + (size_t)u.ks * ksub2; }
    __device__ __forceinline__ unsigned a_off(const Unit&, int r) const { return (unsigned)(r * lda2); }
};

template <int PN, bool DOWN>
struct MoeSched {
    struct Unit { int kind, e, rb, blk, valid, pm, pn; };
    const LAS int* prefix; const LAS int* cnt; const unsigned* bucket;
    const char* Ar; const char* As; const char* Br; const char* Bs;
    int nRouted, total, G, c, i0, i1;
    __device__ __forceinline__ bool next(int i, Unit& u) const {
        if (i + i0 >= i1) return false;
        const int id = (i + i0) * G + c; if (id >= total) return false;
        u.e = 0; u.rb = 0; u.blk = 0; u.pm = 0;
        if (id < nRouted) {
            const int blk = id / PN; u.pn = id % PN;
            const int lo = ((const LAS unsigned char*)(cnt + 256))[blk];
            u.kind = 0; u.e = lo; u.rb = blk - prefix[lo]; u.blk = blk; const int rem = cnt[lo] - u.rb * 256; u.valid = rem < 256 ? rem : 256;
        } else { const int s = id - nRouted; u.kind = 1; u.pm = s / PN; u.pn = s % PN; u.valid = 256; }
        return true;
    }
    __device__ __forceinline__ const char* a_base(const Unit& u) const { return u.kind == 0 ? Ar : As; }
    __device__ __forceinline__ const char* b_base(const Unit& u) const {
        if (!DOWN) return u.kind == 0 ? Br + ((size_t)u.e * 512 + (size_t)u.pn * 256) * D : Bs + (size_t)u.pn * 256 * D;
        else       return u.kind == 0 ? Br + ((size_t)u.e * 1024 + (size_t)u.pn * 256) * FF : Bs + (size_t)u.pn * 256 * FF;
    }
    __device__ __forceinline__ unsigned a_off(const Unit& u, int r) const {
        if (!DOWN) {
            if (u.kind == 0) { const int rr = r < u.valid ? r : u.valid - 1; const unsigned slot = bucket[(size_t)u.e * CAP + u.rb * 256 + rr]; return (slot >> 3) * (unsigned)D; }
            return (unsigned)(u.pm * 256 + r) * (unsigned)D;
        } else {
            return (unsigned)((u.kind == 0 ? u.blk : u.pm) * 256 + r) * (unsigned)FF;
        }
    }
};

struct EpiProj {
    static constexpr int PID = 2, PERM = 2;
    static constexpr bool TWICE = false, FP8 = false;
    bf16* O;
    __device__ __forceinline__ void operator()(const f32x4 (&acc)[2][2][4][2], const DenseUnit& u, int wr, int wc, int fr, int fq) const {
        const int row0 = u.pm * 256 + wr * 64 + fr, col0 = u.pn * 256 + wc * 64 + 16 * fq;
#pragma unroll
        for (int ai = 0; ai < 2; ++ai)
#pragma unroll
            for (int m = 0; m < 4; ++m) { bf16* rowp = O + (size_t)(row0 + ai * 128 + m * 16) * NPROJ + col0;
#pragma unroll
                for (int bj = 0; bj < 2; ++bj) { const f32x4 v0 = acc[ai][bj][m][0], v1 = acc[ai][bj][m][1];
                    *(v4u*)(rowp + bj * 8) = (v4u){pk2(v0[0], v0[1]), pk2(v0[2], v0[3]), pk2(v1[0], v1[1]), pk2(v1[2], v1[3])}; } }
    }
};
struct EpiOut {
    static constexpr int PID = 5, PERM = 2;
    static constexpr bool TWICE = false, FP8 = false;
    bf16* O;
    __device__ __forceinline__ void operator()(const f32x4 (&acc)[2][2][4][2], const DenseUnit& u, int wr, int wc, int fr, int fq) const {
        const int row0 = u.pm * 256 + wr * 64 + fr, col0 = u.pn * 256 + wc * 64 + 16 * fq;
#pragma unroll
        for (int ai = 0; ai < 2; ++ai)
#pragma unroll
            for (int m = 0; m < 4; ++m) { bf16* rowp = O + (size_t)(row0 + ai * 128 + m * 16) * (2 * D) + col0;
#pragma unroll
                for (int bj = 0; bj < 2; ++bj) { const f32x4 v0 = acc[ai][bj][m][0], v1 = acc[ai][bj][m][1];
                    *(v4u*)(rowp + bj * 8) = (v4u){pk2(v0[0], v0[1]), pk2(v0[2], v0[3]), pk2(v1[0], v1[1]), pk2(v1[2], v1[3])}; } }
    }
};
struct EpiRouter {
    static constexpr int PID = 7, PERM = 0;
    static constexpr bool TWICE = false, FP8 = false;
    float* L;
    __device__ __forceinline__ void operator()(const f32x4 (&acc)[2][2][4][2], const DenseUnit& u, int wr, int wc, int fr, int fq) const {
        const int row0 = u.pm * 256 + wr * 64 + fr, col0 = wc * 32 + 4 * fq;
        float* Lp = L + (size_t)u.ks * NT * NE;
#pragma unroll
        for (int ai = 0; ai < 2; ++ai)
#pragma unroll
            for (int m = 0; m < 4; ++m) { const size_t ro = (size_t)(row0 + ai * 128 + m * 16) * NE + col0;
#pragma unroll
                for (int bj = 0; bj < 2; ++bj)
#pragma unroll
                    for (int n = 0; n < 2; ++n) *(f32x4*)(Lp + ro + bj * 128 + n * 16) = acc[ai][bj][m][n]; }
    }
};
struct EpiGU {
    static constexpr int PID = 9, PERM = 1;
    static constexpr bool TWICE = false, FP8 = true;
    unsigned char* act; unsigned char* acts; const unsigned* bucket; unsigned* pos;
    __device__ __forceinline__ void operator()(const f32x4 (&acc)[2][2][4][2], const MoeSched<2, false>::Unit& u, int wr, int wc, int fr, int fq) const {
        unsigned char* O = u.kind == 0 ? act : acts;
        const int row0 = (u.kind == 0 ? u.blk : u.pm) * 256 + wr * 64 + fr, col0 = u.pn * 128 + wc * 32 + 8 * fq;
        if (u.kind == 0 && u.pn == 0 && wc == 0 && fq == 0) {
#pragma unroll
            for (int ai = 0; ai < 2; ++ai)
#pragma unroll
                for (int m = 0; m < 4; ++m) { const int r = ai * 128 + wr * 64 + m * 16 + fr;
                    if (r < u.valid) pos[bucket[(size_t)u.e * CAP + u.rb * 256 + r]] = (unsigned)(u.blk * 256 + r); } }
#pragma unroll
        for (int ai = 0; ai < 2; ++ai)
#pragma unroll
            for (int m = 0; m < 4; ++m) {
                const f32x4 g0 = acc[ai][0][m][0], g1 = acc[ai][0][m][1], u0 = acc[ai][1][m][0], u1 = acc[ai][1][m][1];
                float a[8];
#pragma unroll
                for (int j = 0; j < 4; j += 2) {
                    const f32x2 ga = (f32x2){g0[j], g0[j + 1]} * W_INV_SCALE, gb = (f32x2){g1[j], g1[j + 1]} * W_INV_SCALE;
                    const f32x2 ua = (f32x2){u0[j], u0[j + 1]} * (W_INV_SCALE * ACT_SCALE), ub = (f32x2){u1[j], u1[j + 1]} * (W_INV_SCALE * ACT_SCALE);
                    const f32x2 ea = ga * (-1.44269504f), eb = gb * (-1.44269504f);
                    f32x2 da, db; da.x = __builtin_amdgcn_exp2f(ea.x); da.y = __builtin_amdgcn_exp2f(ea.y); db.x = __builtin_amdgcn_exp2f(eb.x); db.y = __builtin_amdgcn_exp2f(eb.y);
                    da = da + 1.0f; db = db + 1.0f;
                    f32x2 ra, rb; ra.x = __builtin_amdgcn_rcpf(da.x); ra.y = __builtin_amdgcn_rcpf(da.y); rb.x = __builtin_amdgcn_rcpf(db.x); rb.y = __builtin_amdgcn_rcpf(db.y);
                    const f32x2 oa = (ga * ua) * ra, ob = (gb * ub) * rb;
                    a[j] = oa.x; a[j + 1] = oa.y; a[4 + j] = ob.x; a[4 + j + 1] = ob.y; }
                *(v2u*)(O + (size_t)(row0 + ai * 128 + m * 16) * FF + col0) = (v2u){pk4_fp8(a[0], a[1], a[2], a[3]), pk4_fp8(a[4], a[5], a[6], a[7])};
                __builtin_amdgcn_sched_barrier(0);
            }
    }
};
constexpr float Y_SCALE = ACT_SCALE * WD_SCALE, Y_INV_SCALE = 1.f / Y_SCALE;
struct EpiDown {
    static constexpr int PID = 10, PERM = 2;
    static constexpr bool TWICE = false, FP8 = true;
    unsigned char* Y; bf16* O;
    __device__ __forceinline__ void operator()(const f32x4 (&acc)[2][2][4][2], const MoeSched<4, true>::Unit& u, int wr, int wc, int fr, int fq) const {
        const int col0 = u.pn * 256 + wc * 64 + 16 * fq;
        if (u.kind == 0) {
            const int row0 = u.blk * 256 + wr * 64 + fr;
#pragma unroll
            for (int ai = 0; ai < 2; ++ai)
#pragma unroll
                for (int m = 0; m < 4; ++m) { unsigned char* rowp = Y + (size_t)(row0 + ai * 128 + m * 16) * D + col0;
                    unsigned w[4];
#pragma unroll
                    for (int bj = 0; bj < 2; ++bj)
#pragma unroll
                        for (int n = 0; n < 2; ++n) { f32x4 v = acc[ai][bj][m][n];
#pragma unroll
                            for (int j = 0; j < 4; ++j) v[j] = __builtin_amdgcn_fmed3f(v[j], -448.f, 448.f);
                            w[bj * 2 + n] = pk4_fp8(v[0], v[1], v[2], v[3]); }
                    *(v4u*)rowp = (v4u){w[0], w[1], w[2], w[3]}; }
        } else {
            const int row0 = u.pm * 256 + wr * 64 + fr;
#pragma unroll
            for (int ai = 0; ai < 2; ++ai)
#pragma unroll
                for (int m = 0; m < 4; ++m) { bf16* rowp = O + (size_t)(row0 + ai * 128 + m * 16) * (2 * D) + D + col0;
#pragma unroll
                    for (int bj = 0; bj < 2; ++bj) { const f32x4 v0 = acc[ai][bj][m][0] * Y_INV_SCALE, v1 = acc[ai][bj][m][1] * Y_INV_SCALE;
                        *(v4u*)(rowp + bj * 8) = (v4u){pk2(v0[0], v0[1]), pk2(v0[2], v0[3]), pk2(v1[0], v1[1]), pk2(v1[2], v1[3])}; } }
        }
    }
};

struct Args { const float* in[19]; float* out; unsigned char* ws; int ph_lo, ph_hi; };

struct Frame {
    LAS unsigned char* lds; int tid, lane, wave, G, bid;
    float* out; unsigned char* ws;
};

__device__ __forceinline__ void titem_load(const float* W, int N, int kb, int nb, int lane, float (&v)[32]) {
    const float* Wu = W + (size_t)(64 * kb) * N + 32 * nb;
    const unsigned loff = (unsigned)((lane >> 5) * N + (lane & 31)) * 4u;
#pragma unroll
    for (int i = 0; i < 32; ++i) v[i] = *(const float*)((const char*)(Wu + (size_t)(2 * i) * N) + loff);
}
template <bool FP8>
__device__ __forceinline__ void titem_store(const float (&v)[32], int K, void* WTv, int kb, int dst_row0, LAS float* scr, int lane, float wsc = W_SCALE) {
    const int k0 = 64 * kb;
#pragma unroll
    for (int i = 0; i < 32; ++i) { const int kk = 2 * i + (lane >> 5); scr[kk * 33 + (lane & 31)] = v[i]; }
    asm volatile("s_waitcnt lgkmcnt(0)" ::: "memory");
    const int c = lane & 7;
#pragma unroll
    for (int j = 0; j < 4; ++j) { const int n = (lane >> 3) + 8 * j; const LAS float* s = scr + (8 * c) * 33 + n;
        if (FP8) { v2u o; o.x = pk4_fp8(s[0 * 33] * wsc, s[1 * 33] * wsc, s[2 * 33] * wsc, s[3 * 33] * wsc);
            o.y = pk4_fp8(s[4 * 33] * wsc, s[5 * 33] * wsc, s[6 * 33] * wsc, s[7 * 33] * wsc);
            *(v2u*)((unsigned char*)WTv + (size_t)(dst_row0 + n) * K + k0 + 8 * c) = o; }
        else { v4u o; o.x = pk2(s[0 * 33], s[1 * 33]); o.y = pk2(s[2 * 33], s[3 * 33]); o.z = pk2(s[4 * 33], s[5 * 33]); o.w = pk2(s[6 * 33], s[7 * 33]);
            *(v4u*)((bf16*)WTv + (size_t)(dst_row0 + n) * K + k0 + 8 * c) = o; } }
    asm volatile("s_waitcnt lgkmcnt(0)" ::: "memory");
}
template <bool FP8>
__device__ __forceinline__ void transpose_item(const float* W, int K, int N, void* WT, int kb, int nb, int dst_row0, LAS float* scr, int lane, float wsc = W_SCALE) {
    float v[32]; titem_load(W, N, kb, nb, lane, v); titem_store<FP8>(v, K, WT, kb, dst_row0, scr, lane, wsc);
}
template <bool DOWN>
__device__ __forceinline__ void convert_expert(Frame& F, const float* Wa, const float* Wb, unsigned char* dst) {
    LAS float* scr = (LAS float*)(F.lds + F.wave * 16384);
    constexpr int PER_WAVE = DOWN ? 16 : 32;
    const int base = 0, wv = F.wave;
    auto ld = [&](int i, float (&v)[32]) {
        if (!DOWN) titem_load((i >> 4) ? Wb : Wa, FF, i & 15, wv, F.lane, v);
        else titem_load(Wa, D, i >> 2, wv + 8 * (i & 3), F.lane, v); };
    auto st = [&](int i, const float (&v)[32]) {
        if (!DOWN) { const int n0 = wv * 32; titem_store<true>(v, D, dst, i & 15, (n0 >> 7) * 256 + ((i >> 4) ? 128 : 0) + (n0 & 127), scr, F.lane); }
        else titem_store<true>(v, FF, dst, i >> 2, (wv + 8 * (i & 3)) * 32, scr, F.lane, WD_SCALE); };
    float v0[32], v1[32], v2[32], v3[32];
    ld(base, v0); ld(base + 1, v1); ld(base + 2, v2);
    for (int i = 0; i < PER_WAVE; i += 4) {
        ld(base + i + 3, v3); st(base + i, v0);
        if (i + 4 < PER_WAVE) ld(base + i + 4, v0);
        st(base + i + 1, v1);
        if (i + 5 < PER_WAVE) ld(base + i + 5, v1);
        st(base + i + 2, v2);
        if (i + 6 < PER_WAVE) ld(base + i + 6, v2);
        st(base + i + 3, v3);
    }
}

__device__ __forceinline__ void chunk_load(Frame& F, unsigned ch, int wv, float (&v)[32]) {
    if (ch < QG_CHUNKS) { const int e = (int)(ch >> 5), i = (int)(ch & 31); titem_load(ld_ptr(F.lds, (i >> 4) ? 13 : 12) + (size_t)e * D * FF, FF, i & 15, wv, F.lane, v); }
    else { const unsigned c2 = ch - QG_CHUNKS; const int e = (int)(c2 >> 4), i = (int)(c2 & 15); titem_load(ld_ptr(F.lds, 14) + (size_t)e * FF * D, D, i >> 2, wv + 8 * (i & 3), F.lane, v); }
}
__device__ __forceinline__ void chunk_store(Frame& F, unsigned ch, int wv, const float (&v)[32], LAS float* scr) {
    if (ch < QG_CHUNKS) { const int e = (int)(ch >> 5), i = (int)(ch & 31), n0 = wv * 32;
        titem_store<true>(v, D, F.ws + WS_WGU_T + (size_t)e * 512 * D, i & 15, (n0 >> 7) * 256 + ((i >> 4) ? 128 : 0) + (n0 & 127), scr, F.lane, W_SCALE); }
    else { const unsigned c2 = ch - QG_CHUNKS; const int e = (int)(c2 >> 4), i = (int)(c2 & 15);
        titem_store<true>(v, FF, F.ws + WS_WD_T + (size_t)e * D * FF, i >> 2, (wv + 8 * (i & 3)) * 32, scr, F.lane, WD_SCALE); }
}
__device__ __forceinline__ void convert_chunk(Frame& F, unsigned ch) {
    const int wv = __builtin_amdgcn_readfirstlane(F.wave);
    LAS float* scr = (LAS float*)(F.lds + wv * 16384);
    float va[32], vb[32];
    chunk_load(F, ch, wv, va); chunk_load(F, ch + 1, wv, vb);
    chunk_store(F, ch, wv, va, scr); chunk_store(F, ch + 1, wv, vb, scr);
}
__device__ __forceinline__ void xcd_barrier_work(const XcdBarrier& b, Frame& F, unsigned chunk_end) {
    asm volatile("s_waitcnt vmcnt(0)" ::: "memory");
    __syncthreads();
    volatile LAS unsigned* st = b.st;
    unsigned* bar = b.bar; unsigned* qd = (unsigned*)(F.ws + WS_CTL) + CW_QD;
    if (threadIdx.x == 0) {
        __builtin_amdgcn_s_waitcnt(0);
        unsigned nloc = st[0], nx = st[1];
        if (nloc == 0u) { xcd_barrier_complete(bar, b.x, nloc, nx); st[0] = nloc; st[1] = nx; }
        const unsigned old = xb_add(&bar[XB_XSUB(b.x)], 1u);
        const unsigned gen = old / nloc;
        if (old + 1u == (gen + 1u) * nloc) {
            __builtin_amdgcn_fence(__ATOMIC_RELEASE, "agent");
            asm volatile("s_waitcnt vmcnt(0)" ::: "memory");
            const unsigned og = xb_add(&bar[XB_TOP], 1u);
            const unsigned tg = og / nx;
            if (og + 1u == (tg + 1u) * nx) xb_add(&bar[XB_TOPGEN], 1u);
            else XB_SPIN(xb_ld(&bar[XB_TOPGEN]) == tg, bar);
            __builtin_amdgcn_fence(__ATOMIC_ACQUIRE, "agent");
            xb_add(&bar[XB_XGEN(b.x)], 1u);
            asm volatile("s_waitcnt vmcnt(0)" ::: "memory");
            st[3] = 1u; st[6] = 1u;
        } else { st[2] = gen; st[3] = 0u; st[6] = 0u; }
    }
    __syncthreads();
    unsigned spins = 0;
    while (st[3] == 0u) {
        if (threadIdx.x == 0) {
            if (xb_ld(&bar[XB_XGEN(b.x)]) != st[2]) st[3] = 1u;
            else { if (st[5] < chunk_end) st[5] = xb_add(qd, 2u);
                if ((++spins & 1023u) == 0u) { if (xb_ld(&bar[XB_TMO])) st[3] = 1u; else if (spins > XB_SPIN_CAP) { atomicAdd(&bar[XB_TMO], 1u); st[3] = 1u; } } }
        }
        __syncthreads();
        if (st[3] != 0u) break;
        const unsigned ch = st[5];
        if (ch < QD_CHUNKS) convert_chunk(F, ch); else __builtin_amdgcn_s_sleep(8);
        __syncthreads();
    }
    if (threadIdx.x == 0 && st[6] == 0u) { __builtin_amdgcn_fence(__ATOMIC_ACQUIRE, "agent"); asm volatile("s_waitcnt vmcnt(0)" ::: "memory"); }
    __syncthreads();
}
__device__ __forceinline__ void drain_queue(Frame& F, unsigned limit) {
    volatile LAS unsigned* MISC = (volatile LAS unsigned*)(F.lds + MISC_OFF); unsigned* qd = (unsigned*)(F.ws + WS_CTL) + CW_QD;
    for (;;) {
        __syncthreads();
        if (threadIdx.x == 0) { const bool more = MISC[13] < limit; MISC[15] = more ? 1u : 0u; if (more) MISC[13] = xb_add(qd, 2u); }
        __syncthreads();
        if (MISC[15] == 0u) break;
        const unsigned ch = MISC[13];
        if (ch < QD_CHUNKS) convert_chunk(F, ch);
        if (ch >= limit) break;
    }
    __syncthreads();
}

__device__ __forceinline__ void p0_prologue(Frame& F) {
#define INP(i) ld_ptr(F.lds, (i))
    if (F.bid < 192) {
        const float* cptr = INP(1); const float* w_ada = INP(2); const float* b_ada = INP(3);
        LAS float* cs = (LAS float*)F.lds;
        LAS float* red = (LAS float*)(F.lds + 32768);
        for (int i = F.tid; i < NB * D; i += NTHREADS) { const float v = cptr[i]; cs[i] = v / (1.f + __expf(-v)); }
        __syncthreads();
        const int col = F.tid & 31, kg = F.tid >> 5, j = F.bid * 32 + col;
        float a[NB];
#pragma unroll
        for (int b = 0; b < NB; ++b) a[b] = 0.f;
#pragma unroll 8
        for (int kk = 0; kk < 64; ++kk) { const int k = kg * 64 + kk; const float w = w_ada[(size_t)k * 6144 + j];
#pragma unroll
            for (int b = 0; b < NB; ++b) a[b] += cs[b * D + k] * w; }
#pragma unroll
        for (int b = 0; b < NB; ++b) red[(kg * NB + b) * 32 + col] = a[b];
        __syncthreads();
        if (F.tid < 256) { const int b = F.tid >> 5, cc = F.tid & 31; float s = 0.f;
#pragma unroll
            for (int g = 0; g < 16; ++g) s += red[(g * NB + b) * 32 + cc];
            ((float*)(F.ws + WS_MOD))[b * 6144 + F.bid * 32 + cc] = s + b_ada[F.bid * 32 + cc]; }
        __syncthreads();
    }
    if (F.bid == F.G - 1) { const float* pw = INP(6); bf16* pwt = (bf16*)(F.ws + WS_PWT);
        for (int i = F.tid; i < 4 * 64 * 64; i += NTHREADS) { const int g = i >> 12, d = (i >> 6) & 63, c = i & 63; pwt[i] = (bf16)f2bf(pw[(g * 64 + c) * 64 + d]); } }
    LAS float* scr = (LAS float*)(F.lds + F.wave * 16384);
    const int gw = F.bid * NWAVES + F.wave, NGW = F.G * NWAVES;
    constexpr int I_IN = 16 * 80, I_OUT = 8 * 32, I_R = 16 * 8, I_G = 16 * 8, I_D = 4 * 32;
    constexpr int I_SMALL = I_IN + I_OUT + I_R + 2 * I_G + I_D, I_EXP = 2 * I_G + I_D;
    constexpr int NITEMS = I_SMALL;
    unsigned char* win_t = F.ws + WS_WIN_T; bf16* wout_t = (bf16*)(F.ws + WS_WOUT_T); bf16* wr_t = (bf16*)(F.ws + WS_WR_T);
    unsigned char* wsgu_t = F.ws + WS_WSGU_T; unsigned char* wsd_t = F.ws + WS_WSD_T; unsigned char* wgu_t = F.ws + WS_WGU_T; unsigned char* wd_t = F.ws + WS_WD_T;
    for (int it = gw; it < NITEMS; it += NGW) {
        int r = it;
        if (r < I_IN) { transpose_item<false>(INP(5), D, NPROJ, win_t, r / 80, r % 80, (r % 80) * 32, scr, F.lane); continue; } r -= I_IN;
        if (r < I_OUT) { transpose_item<false>(INP(8), NMIX, D, wout_t, r / 32, r % 32, (r % 32) * 32, scr, F.lane); continue; } r -= I_OUT;
        if (r < I_R) { transpose_item<false>(INP(10), D, NE, wr_t, r / 8, r % 8, (r % 8) * 32, scr, F.lane); continue; } r -= I_R;
        const float *Wg, *Wu, *Wd; unsigned char *GU, *DN;
        if (r < 2 * I_G + I_D) { Wg = INP(15); Wu = INP(16); Wd = INP(17); GU = wsgu_t; DN = wsd_t; }
        else { r -= 2 * I_G + I_D; const int e = r / I_EXP; r -= e * I_EXP;
            Wg = INP(12) + (size_t)e * D * FF; Wu = INP(13) + (size_t)e * D * FF; Wd = INP(14) + (size_t)e * FF * D;
            GU = wgu_t + (size_t)e * 512 * D; DN = wd_t + (size_t)e * D * FF; }
        if (r < I_G) { const int nb = r % 8, n0 = nb * 32; transpose_item<true>(Wg, D, FF, GU, r / 8, nb, (n0 >> 7) * 256 + (n0 & 127), scr, F.lane); continue; } r -= I_G;
        if (r < I_G) { const int nb = r % 8, n0 = nb * 32; transpose_item<true>(Wu, D, FF, GU, r / 8, nb, (n0 >> 7) * 256 + 128 + (n0 & 127), scr, F.lane); continue; } r -= I_G;
        transpose_item<true>(Wd, FF, D, DN, r / 32, r % 32, (r % 32) * 32, scr, F.lane, WD_SCALE);
    }
#undef INP
}

template <bool HAS_DX, bool OUT8, bool OUTB>
__device__ __forceinline__ void modnorm_phase(Frame& F, const float* X, const float* g, int shift_chunk, unsigned char* O8, bf16* Ob) {
    const float* mod = (const float*)(F.ws + WS_MOD);
    constexpr int RW = 4;
    const unsigned l16 = (unsigned)F.lane * 16u, l8 = (unsigned)F.lane * 8u, l4 = (unsigned)F.lane * 4u;
    const int wv = __builtin_amdgcn_readfirstlane(F.wave);
    for (int blk = F.bid; blk < NT / 128; blk += F.G) {
        const int b = (blk * 128) >> 12;
        const float* sh = mod + (size_t)b * 6144 + shift_chunk * D; const float* sc = sh + D; const float* g1 = mod + (size_t)b * 6144 + 2 * D;
        f32x4 gg[4], ss[4], ga[4];
#pragma unroll
        for (int j = 0; j < 4; ++j) { const f32x4 gv = *(const f32x4*)((const char*)g + 1024 * j + l16), scv = *(const f32x4*)((const char*)sc + 1024 * j + l16);
            gg[j] = gv * (scv + 1.f); ss[j] = *(const f32x4*)((const char*)sh + 1024 * j + l16); ga[j] = HAS_DX ? *(const f32x4*)((const char*)g1 + 1024 * j + l16) : (f32x4){0.f, 0.f, 0.f, 0.f}; }
#pragma nounroll
        for (int rr = 0; rr < 16; rr += RW) {
            const int row = blk * 128 + wv * 16 + rr;
            f32x4 v[RW][4]; v2u dv[RW][4];
#pragma unroll
            for (int q = 0; q < RW; ++q) { const char* xr = (const char*)(X + (size_t)(row + q) * D);
#pragma unroll
                for (int j = 0; j < 4; ++j) v[q][j] = *(const f32x4*)(xr + 1024 * j + l16);
                if (HAS_DX) { const char* dr = (const char*)F.out + (size_t)(row + q) * (4 * D);
#pragma unroll
                    for (int j = 0; j < 4; ++j) dv[q][j] = *(const v2u*)(dr + 512 * j + l8); } }
#pragma unroll
            for (int q = 0; q < RW; ++q) { float s = 0.f;
#pragma unroll
                for (int j = 0; j < 4; ++j) {
                    if (HAS_DX) v[q][j] = v[q][j] + ga[j] * (f32x4){bflo(dv[q][j].x), bfhi(dv[q][j].x), bflo(dv[q][j].y), bfhi(dv[q][j].y)};
                    s += (v[q][j].x * v[q][j].x + v[q][j].y * v[q][j].y) + (v[q][j].z * v[q][j].z + v[q][j].w * v[q][j].w); }
                const float rstd = 1.f / sqrtf(wave_sum(s) * (1.f / D) + NORM_EPS);
                if (HAS_DX) { char* xo = (char*)F.out + (size_t)(row + q) * (4 * D);
#pragma unroll
                    for (int j = 0; j < 4; ++j) *(v2u*)(xo + 512 * j + l8) = (v2u){pk2(v[q][j].x, v[q][j].y), pk2(v[q][j].z, v[q][j].w)}; }
                char* o8 = (char*)O8 + (size_t)(row + q) * D; char* ob = (char*)Ob + (size_t)(row + q) * (2 * D);
#pragma unroll
                for (int j = 0; j < 4; ++j) { const f32x4 y = v[q][j] * rstd * gg[j] + ss[j]; if (OUT8) *(unsigned*)(o8 + 256 * j + l4) = pk4_fp8(y.x, y.y, y.z, y.w);
                    if (OUTB) *(v2u*)(ob + 512 * j + l8) = (v2u){pk2(y.x, y.y), pk2(y.z, y.w)}; }
                __builtin_amdgcn_sched_barrier(0); }
        }
    }
}

constexpr int POOL_T = 64, POOL_PITCH = 528;
__device__ __forceinline__ void pool_phase(Frame& F, const float* pool_scale) {
    const bf16* proj = (const bf16*)(F.ws + WS_PROJ); bf16* mixin = (bf16*)(F.ws + WS_MIXIN); const bf16* pwt = (const bf16*)(F.ws + WS_PWT);
    LAS unsigned char* us = F.lds;
    LAS unsigned char* pl = F.lds + 80 * POOL_PITCH;
    const int lane = F.lane, fr = lane & 15, fq = lane >> 4;
    for (int tile = F.bid; tile < NT / POOL_T; tile += F.G) {
        const int row0 = tile * POOL_T, tl0 = row0 & (SEQ - 1);
        __syncthreads();
        for (int p = F.tid; p < (POOL_T + 15) * 32; p += NTHREADS) { const int rr = p >> 5, pc = p & 31; const int tl = tl0 - 15 + rr;
            v4u raw = (v4u){0u, 0u, 0u, 0u};
            if (tl >= 0) raw = *(const v4u*)(proj + (size_t)(row0 - 15 + rr) * NPROJ + pc * 8);
            *(LAS v4u*)(us + rr * POOL_PITCH + pc * 16) = raw; }
        __syncthreads();
        {
            const int c8 = F.tid & 31, q = F.tid >> 5, w = 2 << (c8 >> 3);
            float sm[8];
#pragma unroll
            for (int e = 0; e < 8; ++e) sm[e] = 0.f;
            const int i0 = 15 + q * 4;
            for (int k = 0; k < w; ++k) { const v4u r = *(const LAS v4u*)(us + (i0 - k) * POOL_PITCH + c8 * 16);
                sm[0] += bflo(r.x); sm[1] += bfhi(r.x); sm[2] += bflo(r.y); sm[3] += bfhi(r.y); sm[4] += bflo(r.z); sm[5] += bfhi(r.z); sm[6] += bflo(r.w); sm[7] += bfhi(r.w); }
#pragma unroll
            for (int i = 0; i < 4; ++i) { const int tt = q * 4 + i, tl = tl0 + tt;
                const v4u cur = *(const LAS v4u*)(us + (15 + tt) * POOL_PITCH + c8 * 16);
                if (i > 0) { const v4u old = *(const LAS v4u*)(us + (15 + tt - w) * POOL_PITCH + c8 * 16);
                    sm[0] += bflo(cur.x) - bflo(old.x); sm[1] += bfhi(cur.x) - bfhi(old.x); sm[2] += bflo(cur.y) - bflo(old.y); sm[3] += bfhi(cur.y) - bfhi(old.y);
                    sm[4] += bflo(cur.z) - bflo(old.z); sm[5] += bfhi(cur.z) - bfhi(old.z); sm[6] += bflo(cur.w) - bflo(old.w); sm[7] += bfhi(cur.w) - bfhi(old.w); }
                const float ic = 1.f / (float)((tl + 1) < w ? (tl + 1) : w);
                v4u o; o.x = pk2(sm[0] * ic - bflo(cur.x), sm[1] * ic - bfhi(cur.x)); o.y = pk2(sm[2] * ic - bflo(cur.y), sm[3] * ic - bfhi(cur.y));
                o.z = pk2(sm[4] * ic - bflo(cur.z), sm[5] * ic - bfhi(cur.z)); o.w = pk2(sm[6] * ic - bflo(cur.w), sm[7] * ic - bfhi(cur.w));
                *(LAS v4u*)(pl + tt * POOL_PITCH + c8 * 16) = o; }
        }
        __syncthreads();
        {
            const int g = F.wave >> 1, mh = F.wave & 1;
            bf16x8 af[2][2], bfr[4][2];
#pragma unroll
            for (int mt = 0; mt < 2; ++mt)
#pragma unroll
                for (int k = 0; k < 2; ++k) af[mt][k] = *(const LAS bf16x8*)(pl + (32 * mh + 16 * mt + fr) * POOL_PITCH + (g * 64 + k * 32 + fq * 8) * 2);
#pragma unroll
            for (int nt = 0; nt < 4; ++nt)
#pragma unroll
                for (int k = 0; k < 2; ++k) bfr[nt][k] = *(const bf16x8*)(pwt + ((size_t)(g * 64 + nt * 16 + fr) * 64 + k * 32 + fq * 8));
#pragma unroll
            for (int mt = 0; mt < 2; ++mt)
#pragma unroll
                for (int nt = 0; nt < 4; ++nt) { f32x4 acc = (f32x4){0.f, 0.f, 0.f, 0.f};
                    acc = __builtin_amdgcn_mfma_f32_16x16x32_bf16(bfr[nt][0], af[mt][0], acc, 0, 0, 0);
                    acc = __builtin_amdgcn_mfma_f32_16x16x32_bf16(bfr[nt][1], af[mt][1], acc, 0, 0, 0);
                    const int col = g * 64 + nt * 16 + 4 * fq; const f32x4 sc = *(const f32x4*)(pool_scale + col);
                    const f32x4 o = acc * sc;
                    *(v2u*)(mixin + (size_t)(row0 + 32 * mh + 16 * mt + fr) * NMIX + col) = (v2u){pk2(o.x, o.y), pk2(o.z, o.w)}; }
        }
    }
}

constexpr int KV_PITCH = 144;
__device__ __forceinline__ void attn_phase(Frame& F) {
    const bf16* proj = (const bf16*)(F.ws + WS_PROJ);
    bf16* atto = (bf16*)(F.ws + WS_ATTO); float* lse = (float*)(F.ws + WS_LSE);
    LAS unsigned char* Ks = F.lds; LAS unsigned char* Vs = F.lds + 256 * KV_PITCH;
    const int lane = F.lane, fr = lane & 15, fq = lane >> 4, w = F.wave;
    const int w_i0 = 16 * w, c0 = w >> 1, qi = w_i0 + fr;
#define ATT_DECODE(unit_, rowb_, d_, r_, n_, g_, h_, colQ_) \
        const int rn_##unit_ = (unit_) & 31; const int h_ = ((unit_) >> 5) & 3, g_ = ((unit_) >> 7) % 3; const size_t rowb_ = (size_t)((unit_) / 384) * SEQ; \
        const int d_ = 1 << (2 * g_), nbk_##unit_ = 32 >> (2 * g_), r_ = rn_##unit_ / nbk_##unit_, n_ = rn_##unit_ % nbk_##unit_; const int colQ_ = 256 + g_ * 256 + h_ * 64;
    v4u kreg[4], vreg[4]; bf16x8 qn[2];
    {   const int unit0 = F.bid;
        if (unit0 < NB * 3 * 4 * 32) { ATT_DECODE(unit0, rowb, d, r, n, g, h, colQ)
            const size_t qrow = rowb + (size_t)(n * 128 + qi) * d + r;
#pragma unroll
            for (int ks = 0; ks < 2; ++ks) qn[ks] = *(const bf16x8*)(proj + qrow * NPROJ + colQ + ks * 32 + fq * 8);
#pragma unroll
            for (int cidx = 0; cidx < 4; ++cidx) { const int ch = F.tid + 512 * cidx, j = ch >> 3, pc = ch & 7;
                int p = (n - 1) * 128 + j; p = p < 0 ? 0 : p; const size_t row = rowb + (size_t)p * d + r;
                kreg[cidx] = *(const v4u*)(proj + row * NPROJ + colQ + 768 + pc * 8); vreg[cidx] = *(const v4u*)(proj + row * NPROJ + colQ + 1536 + pc * 8); } } }
    for (int unit = F.bid; unit < NB * 3 * 4 * 32; unit += F.G) {
        ATT_DECODE(unit, rowb, d, r, n, g, h, colQ)
        __syncthreads();
#pragma unroll
        for (int cidx = 0; cidx < 4; ++cidx) { const int ch = F.tid + 512 * cidx, j = ch >> 3, pc = ch & 7;
            *(LAS v4u*)(Ks + j * KV_PITCH + pc * 16) = kreg[cidx]; *(LAS v4u*)(Vs + j * KV_PITCH + pc * 16) = vreg[cidx]; }
        const size_t qrow = rowb + (size_t)(n * 128 + qi) * d + r;
        bf16x8 qf[2]; qf[0] = qn[0]; qf[1] = qn[1];
        __syncthreads();
        {   const int unit2 = unit + F.G;
            if (unit2 < NB * 3 * 4 * 32) { ATT_DECODE(unit2, rowb2, d2, r2, n2, g2, h2, colQ2)
                const size_t qrow2 = rowb2 + (size_t)(n2 * 128 + qi) * d2 + r2;
#pragma unroll
                for (int ks = 0; ks < 2; ++ks) qn[ks] = *(const bf16x8*)(proj + qrow2 * NPROJ + colQ2 + ks * 32 + fq * 8);
#pragma unroll
                for (int cidx = 0; cidx < 4; ++cidx) { const int ch = F.tid + 512 * cidx, j = ch >> 3, pc = ch & 7;
                    int p = (n2 - 1) * 128 + j; p = p < 0 ? 0 : p; const size_t row = rowb2 + (size_t)p * d2 + r2;
                    kreg[cidx] = *(const v4u*)(proj + row * NPROJ + colQ2 + 768 + pc * 8); vreg[cidx] = *(const v4u*)(proj + row * NPROJ + colQ2 + 1536 + pc * 8); } } }
        f32x4 s[5][2];
#pragma unroll
        for (int cc = 0; cc < 5; ++cc)
#pragma unroll
            for (int hh = 0; hh < 2; ++hh) {
                const int j = 32 * (c0 + cc) + 8 * (fr >> 2) + 4 * hh + (fr & 3);
                const bf16x8 k0 = *(const LAS bf16x8*)(Ks + j * KV_PITCH + fq * 16), k1 = *(const LAS bf16x8*)(Ks + j * KV_PITCH + 64 + fq * 16);
                f32x4 a = (f32x4){0.f, 0.f, 0.f, 0.f};
                a = __builtin_amdgcn_mfma_f32_16x16x32_bf16(k0, qf[0], a, 0, 0, 0);
                a = __builtin_amdgcn_mfma_f32_16x16x32_bf16(k1, qf[1], a, 0, 0, 0);
                s[cc][hh] = a;
            }
        float mx = -1e30f;
        int qil = qi; asm volatile("" : "+v"(qil));
#pragma unroll
        for (int cc = 0; cc < 5; ++cc)
#pragma unroll
            for (int hh = 0; hh < 2; ++hh)
#pragma unroll
                for (int rr = 0; rr < 4; ++rr) { const int j = 32 * (c0 + cc) + 8 * fq + 4 * hh + rr; const int dist = 128 + qil - j;
                    const bool valid = (dist >= 0) && (dist <= 128) && (n > 0 || j >= 128);
                    const float v = valid ? s[cc][hh][rr] * 0.18033688f : -1e30f; s[cc][hh][rr] = v; mx = fmaxf(mx, v); }
        mx = fmaxf(mx, __shfl_xor(mx, 16)); mx = fmaxf(mx, __shfl_xor(mx, 32));
        float l = 0.f;
#pragma unroll
        for (int cc = 0; cc < 5; ++cc)
#pragma unroll
            for (int hh = 0; hh < 2; ++hh)
#pragma unroll
                for (int rr = 0; rr < 4; ++rr) { const float p = __builtin_amdgcn_exp2f(s[cc][hh][rr] - mx); s[cc][hh][rr] = p; l += p; }
        l += __shfl_xor(l, 16); l += __shfl_xor(l, 32);
        f32x4 o[4];
#pragma unroll
        for (int eb = 0; eb < 4; ++eb) o[eb] = (f32x4){0.f, 0.f, 0.f, 0.f};
#pragma unroll
        for (int cc = 0; cc < 5; ++cc) {
            const v4u pu = (v4u){pk2(s[cc][0][0], s[cc][0][1]), pk2(s[cc][0][2], s[cc][0][3]), pk2(s[cc][1][0], s[cc][1][1]), pk2(s[cc][1][2], s[cc][1][3])};
            const bf16x8 pf = __builtin_bit_cast(bf16x8, pu);
            const int key0 = 32 * (c0 + cc) + 8 * fq + (fr >> 2);
#pragma unroll
            for (int eb = 0; eb < 4; ++eb) {
                const LAS unsigned char* vp = Vs + key0 * KV_PITCH + (16 * eb + 4 * (fr & 3)) * 2;
                const s16x4 lo = __builtin_bit_cast(s16x4, __builtin_amdgcn_ds_read_tr16_b64_v4i16((LAS s16x4*)vp));
                const s16x4 hi = __builtin_bit_cast(s16x4, __builtin_amdgcn_ds_read_tr16_b64_v4i16((LAS s16x4*)(vp + 4 * KV_PITCH)));
                const bf16x8 vf = (bf16x8){lo[0], lo[1], lo[2], lo[3], hi[0], hi[1], hi[2], hi[3]};
                o[eb] = __builtin_amdgcn_mfma_f32_16x16x32_bf16(vf, pf, o[eb], 0, 0, 0);
            }
        }
        const float il = 1.f / l;
        bf16* op = atto + ((size_t)g * NT + qrow) * 256 + h * 64 + 4 * fq;
#pragma unroll
        for (int eb = 0; eb < 4; ++eb) { const f32x4 v = o[eb] * il; *(v2u*)(op + 16 * eb) = (v2u){pk2(v.x, v.y), pk2(v.z, v.w)}; }
        if (fq == 0) lse[((size_t)g * NT + qrow) * 4 + h] = mx + __builtin_amdgcn_logf(l);
    }
#undef ATT_DECODE
}

__device__ __forceinline__ void combine_phase(Frame& F) {
    const bf16* atto = (const bf16*)(F.ws + WS_ATTO); const float* lse = (const float*)(F.ws + WS_LSE); bf16* mixin = (bf16*)(F.ws + WS_MIXIN);
    for (size_t idx = (size_t)F.bid * NTHREADS + F.tid; idx < (size_t)NT * 32; idx += (size_t)F.G * NTHREADS) {
        const size_t t = idx >> 5; const int pc = (int)(idx & 31), h = pc >> 3;
        const float l0 = lse[(0 * (size_t)NT + t) * 4 + h], l1 = lse[(1 * (size_t)NT + t) * 4 + h], l2 = lse[(2 * (size_t)NT + t) * 4 + h];
        const float m = fmaxf(l0, fmaxf(l1, l2));
        float a0 = __builtin_amdgcn_exp2f(l0 - m), a1 = __builtin_amdgcn_exp2f(l1 - m), a2 = __builtin_amdgcn_exp2f(l2 - m);
        const float inv = 1.f / (a0 + a1 + a2); a0 *= inv; a1 *= inv; a2 *= inv;
        const v4u v0 = *(const v4u*)(atto + (0 * (size_t)NT + t) * 256 + pc * 8), v1 = *(const v4u*)(atto + (1 * (size_t)NT + t) * 256 + pc * 8), v2 = *(const v4u*)(atto + (2 * (size_t)NT + t) * 256 + pc * 8);
        v4u o;
        o.x = pk2(a0 * bflo(v0.x) + a1 * bflo(v1.x) + a2 * bflo(v2.x), a0 * bfhi(v0.x) + a1 * bfhi(v1.x) + a2 * bfhi(v2.x));
        o.y = pk2(a0 * bflo(v0.y) + a1 * bflo(v1.y) + a2 * bflo(v2.y), a0 * bfhi(v0.y) + a1 * bfhi(v1.y) + a2 * bfhi(v2.y));
        o.z = pk2(a0 * bflo(v0.z) + a1 * bflo(v1.z) + a2 * bflo(v2.z), a0 * bfhi(v0.z) + a1 * bfhi(v1.z) + a2 * bfhi(v2.z));
        o.w = pk2(a0 * bflo(v0.w) + a1 * bflo(v1.w) + a2 * bflo(v2.w), a0 * bfhi(v0.w) + a1 * bfhi(v1.w) + a2 * bfhi(v2.w));
        *(v4u*)(mixin + t * NMIX + 256 + pc * 8) = o;
    }
}

#if MK_NAIVE_ATTN
__device__ __forceinline__ void naive_attn_phase(Frame& F) {
    const bf16* proj = (const bf16*)(F.ws + WS_PROJ); bf16* mixin = (bf16*)(F.ws + WS_MIXIN);
    for (size_t idx = (size_t)F.bid * NTHREADS + F.tid; idx < (size_t)NT * 4; idx += (size_t)F.G * NTHREADS) {
        const size_t tg = idx >> 2; const int h = (int)(idx & 3), t = (int)(tg & (SEQ - 1)); const size_t rowb = tg - t;
        float m = -1e30f, l = 0.f, o[64];
        for (int e = 0; e < 64; ++e) o[e] = 0.f;
        for (int g = 0; g < 3; ++g) { const int d = 1 << (2 * g); const int colQ = 256 + g * 256 + h * 64;
            const bf16* q = proj + tg * NPROJ + colQ;
            for (int j = 0; j <= 128; ++j) { const int tk = t - j * d; if (tk < 0) break;
                const bf16* k = proj + (rowb + tk) * NPROJ + colQ + 768; const bf16* v = k + 768;
                float sdot = 0.f; for (int e = 0; e < 64; ++e) sdot += bf2f(q[e]) * bf2f(k[e]);
                sdot *= 0.125f;
                const float mn = fmaxf(m, sdot), corr = __expf(m - mn), p = __expf(sdot - mn);
                l = l * corr + p; for (int e = 0; e < 64; ++e) o[e] = o[e] * corr + p * bf2f(v[e]); m = mn; } }
        const float il = 1.f / l;
        for (int e = 0; e < 64; ++e) mixin[tg * NMIX + 256 + h * 64 + e] = (bf16)f2bf(o[e] * il);
    }
}
#endif

__device__ __forceinline__ void routing_phase(Frame& F, const float* router_bias) {
    const float* L0 = (const float*)(F.ws + WS_LOGIT); const float* L1 = L0 + (size_t)NT * NE;
    float* gatew = (float*)(F.ws + WS_GATEW); unsigned* bucket = (unsigned*)(F.ws + WS_BUCKET); unsigned* gcnt = (unsigned*)(F.ws + WS_CTL) + CW_GCNT;
    LAS unsigned* hist = (LAS unsigned*)F.lds; LAS unsigned* basel = hist + 256; LAS unsigned* asg = hist + 512;
    const int lane = F.lane;
    for (int blk = F.bid; blk < NT / 128; blk += F.G) {
        __syncthreads();
        if (F.tid < 256) hist[F.tid] = 0u;
        __syncthreads();
        const f32x4 bias = *(const f32x4*)(router_bias + 4 * lane);
        f32x4 lgn; { const size_t t0 = (size_t)blk * 128 + F.wave * 16; lgn = *(const f32x4*)(L0 + t0 * NE + 4 * lane) + *(const f32x4*)(L1 + t0 * NE + 4 * lane); }
#pragma nounroll
        for (int tl = 0; tl < 16; ++tl) {
            const int tloc = F.wave * 16 + tl; const size_t t = (size_t)blk * 128 + tloc;
            const f32x4 lg = lgn;
            if (tl + 1 < 16) lgn = *(const f32x4*)(L0 + (t + 1) * NE + 4 * lane) + *(const f32x4*)(L1 + (t + 1) * NE + 4 * lane);
            float sc[4], cd[4];
#pragma unroll
            for (int i = 0; i < 4; ++i) { sc[i] = 1.f / (1.f + __expf(-lg[i])); cd[i] = sc[i] + bias[i]; }
            float a1 = fmaxf(cd[0], cd[1]), a2 = fminf(cd[0], cd[1]);
#pragma unroll
            for (int i = 2; i < 4; ++i) { const float v = cd[i]; a2 = fmaxf(a2, fminf(a1, v)); a1 = fmaxf(a1, v); }
            { float b1 = dppf<0xB1>(a1), b2 = dppf<0xB1>(a2); float n1 = fmaxf(a1, b1), n2 = fmaxf(fminf(a1, b1), fmaxf(a2, b2)); a1 = n1; a2 = n2;
              b1 = dppf<0x4E>(a1); b2 = dppf<0x4E>(a2); n1 = fmaxf(a1, b1); n2 = fmaxf(fminf(a1, b1), fmaxf(a2, b2)); a1 = n1; a2 = n2;
              b1 = dppf<0x141>(a1); b2 = dppf<0x141>(a2); n1 = fmaxf(a1, b1); n2 = fmaxf(fminf(a1, b1), fmaxf(a2, b2)); a1 = n1; a2 = n2; }
            const float gs = a1 + a2; const int myg = lane >> 3; int rank = 0;
#pragma unroll
            for (int gg = 0; gg < 8; ++gg) { const float o = __builtin_bit_cast(float, __builtin_amdgcn_readlane(__builtin_bit_cast(int, gs), gg * 8)); rank += (o > gs || (o == gs && gg < myg)) ? 1 : 0; }
            if (rank >= 4) {
#pragma unroll
                for (int i = 0; i < 4; ++i) cd[i] = -1e30f; }
            int sel_e = 0; float sel_s = 0.f, ssum = 0.f;
#pragma unroll
            for (int k = 0; k < TOPK; ++k) {
                const float lm = fmaxf(fmaxf(cd[0], cd[1]), fmaxf(cd[2], cd[3]));
                float v = fmaxf(lm, dppf<0xB1>(lm)); v = fmaxf(v, dppf<0x4E>(v)); v = fmaxf(v, dppf<0x141>(v)); v = fmaxf(v, dppf<0x140>(v));
                const float r0 = __builtin_bit_cast(float, __builtin_amdgcn_readlane(__builtin_bit_cast(int, v), 0)), r1 = __builtin_bit_cast(float, __builtin_amdgcn_readlane(__builtin_bit_cast(int, v), 16));
                const float r2 = __builtin_bit_cast(float, __builtin_amdgcn_readlane(__builtin_bit_cast(int, v), 32)), r3 = __builtin_bit_cast(float, __builtin_amdgcn_readlane(__builtin_bit_cast(int, v), 48));
                const float mx = fmaxf(fmaxf(r0, r1), fmaxf(r2, r3));
                const unsigned long long msk = __ballot(lm == mx);
                const int own = __builtin_ffsll((long long)msk) - 1;
                const int bi = cd[0] == mx ? 0 : (cd[1] == mx ? 1 : (cd[2] == mx ? 2 : 3));
                float myv = sc[0]; myv = bi == 1 ? sc[1] : myv; myv = bi == 2 ? sc[2] : myv; myv = bi == 3 ? sc[3] : myv;
                const int wi = __builtin_amdgcn_readlane(bi, own);
                const float sv = __builtin_bit_cast(float, __builtin_amdgcn_readlane(__builtin_bit_cast(int, myv), own));
                if (lane == own) {
#pragma unroll
                    for (int i = 0; i < 4; ++i) if (wi == i) cd[i] = -1e30f; }
                ssum += sv;
                if (lane == k) { sel_e = 4 * own + wi; sel_s = sv; }
            }
            if (lane < TOPK) {
                const unsigned rk = __hip_atomic_fetch_add(hist + sel_e, 1u, __ATOMIC_RELAXED, __HIP_MEMORY_SCOPE_WORKGROUP);
                asg[tloc * 8 + lane] = (unsigned)sel_e | (rk << 16);
                gatew[t * 8 + lane] = sel_s / ssum * 2.5f;
            }
        }
        __syncthreads();
        if (F.tid < 256) { const unsigned c = hist[F.tid]; basel[F.tid] = c ? atomicAdd(&gcnt[F.tid * 16], c) : 0u; }
        __syncthreads();
        for (int a = F.tid; a < 1024; a += NTHREADS) { const unsigned v = asg[a], e = v & 0xffffu, rk = v >> 16;
            bucket[(size_t)e * CAP + basel[e] + rk] = (unsigned)(blk * 1024 + a); }
    }
}

__device__ __forceinline__ void build_tables(Frame& F, int& nblk_total) {
    const unsigned* gcnt = (const unsigned*)(F.ws + WS_CTL) + CW_GCNT;
    LAS int* prefix = (LAS int*)(F.lds + TAB_OFF); LAS int* cnt = prefix + 260;
    __syncthreads();
    if (F.tid < 256) cnt[F.tid] = (int)__hip_atomic_load(&gcnt[F.tid * 16], __ATOMIC_RELAXED, __HIP_MEMORY_SCOPE_AGENT);
    __syncthreads();
    if (F.tid < 64) {
        int nb[4], sm = 0;
#pragma unroll
        for (int i = 0; i < 4; ++i) { nb[i] = (cnt[4 * F.tid + i] + 255) >> 8; sm += nb[i]; }
        int inc = sm;
#pragma unroll
        for (int o = 1; o < 64; o <<= 1) { const int t = __shfl_up(inc, o); if (F.tid >= o) inc += t; }
        int ex = inc - sm;
#pragma unroll
        for (int i = 0; i < 4; ++i) { prefix[4 * F.tid + i] = ex; ex += nb[i]; }
        if (F.tid == 63) prefix[NE] = inc;
    }
    __syncthreads();
    if (F.tid < 256) { LAS unsigned char* b2e = (LAS unsigned char*)(cnt + 256); for (int b = prefix[F.tid]; b < prefix[F.tid + 1]; ++b) b2e[b] = (unsigned char)F.tid; }
    __syncthreads();
    nblk_total = prefix[NE];
}

__device__ __forceinline__ void final_phase(Frame& F, const float* g_final) {
    const float* mod = (const float*)(F.ws + WS_MOD); const unsigned char* Y = (const unsigned char*)(F.ws + WS_Y);
    const unsigned* pos = (const unsigned*)(F.ws + WS_POS); const float* gatew = (const float*)(F.ws + WS_GATEW);
    const int c0 = 16 * F.lane;
    for (int blk = F.bid; blk < NT / 128; blk += F.G) {
        const int b = (blk * 128) >> 12; const float* g2 = mod + (size_t)b * 6144 + 5 * D + c0;
        f32x4 gb[4];
#pragma unroll
        for (int j = 0; j < 4; ++j) gb[j] = *(const f32x4*)(g2 + 4 * j);
        const size_t rowbase = (size_t)blk * 128 + F.wave * 16;
        const unsigned p0 = pos[rowbase * 8 + F.lane], p1 = pos[rowbase * 8 + 64 + F.lane];
        const float w0 = gatew[rowbase * 8 + F.lane] * Y_INV_SCALE, w1 = gatew[rowbase * 8 + 64 + F.lane] * Y_INV_SCALE;
#pragma nounroll
        for (int rr = 0; rr < 16; ++rr) {
            const size_t row = rowbase + rr;
            const v4u* dr = (const v4u*)((const bf16*)F.out + row * (2 * D) + c0);
            v4u xv[2], sv[2], yv[TOPK]; float wk[TOPK];
            xv[0] = dr[0]; xv[1] = dr[1]; sv[0] = dr[128]; sv[1] = dr[129];
#pragma unroll
            for (int k = 0; k < TOPK; ++k) { const int idx = rr * 8 + k;
                const unsigned pk = (unsigned)__builtin_amdgcn_readlane((int)(idx < 64 ? p0 : p1), idx & 63);
                wk[k] = __builtin_bit_cast(float, __builtin_amdgcn_readlane(__builtin_bit_cast(int, idx < 64 ? w0 : w1), idx & 63));
                yv[k] = *(const v4u*)(Y + (size_t)pk * D + c0); }
            f32x4 v[4]; float s = 0.f;
#pragma unroll
            for (int j = 0; j < 4; ++j) {
                const unsigned sw0 = sv[j >> 1][(j & 1) * 2], sw1 = sv[j >> 1][(j & 1) * 2 + 1];
                f32x4 r = (f32x4){bflo(sw0), bfhi(sw0), bflo(sw1), bfhi(sw1)};
#pragma unroll
                for (int k = 0; k < TOPK; ++k) { const int wd = (int)yv[k][j];
                    const auto lo = __builtin_amdgcn_cvt_pk_f32_fp8(wd, false), hi = __builtin_amdgcn_cvt_pk_f32_fp8(wd, true);
                    r += wk[k] * (f32x4){lo[0], lo[1], hi[0], hi[1]}; }
                const unsigned xw0 = xv[j >> 1][(j & 1) * 2], xw1 = xv[j >> 1][(j & 1) * 2 + 1];
                v[j] = (f32x4){bflo(xw0), bfhi(xw0), bflo(xw1), bfhi(xw1)} + gb[j] * r;
                s += (v[j].x * v[j].x + v[j].y * v[j].y) + (v[j].z * v[j].z + v[j].w * v[j].w); }
            const float rstd = 1.f / sqrtf(wave_sum(s) * (1.f / D) + NORM_EPS);
            f32x4* orow = (f32x4*)(F.out + row * D + c0);
#pragma unroll
            for (int j = 0; j < 4; ++j) orow[j] = v[j] * rstd * *(const f32x4*)(g_final + c0 + 4 * j);
        }
    }
}

constexpr int N_PHASES = 12;
__global__ void __launch_bounds__(NTHREADS, 2) fwd(Args args) {
    extern __shared__ __attribute__((aligned(16))) unsigned char lds_raw[];
    Frame F;
    F.lds = (LAS unsigned char*)lds_raw;
    F.tid = threadIdx.x; F.lane = F.tid & 63; F.wave = __builtin_amdgcn_readfirstlane(F.tid >> 6); F.G = gridDim.x; F.bid = blockIdx.x;
#define INP(i) ld_ptr(F.lds, (i))
    F.out = args.out; F.ws = args.ws;
    unsigned char* ws = args.ws;
    volatile LAS unsigned* MISC = (volatile LAS unsigned*)(F.lds + MISC_OFF);
    if (F.tid < 16) MISC[F.tid] = 0u;
    if (F.tid == 0) { LAS unsigned long long* pt = (LAS unsigned long long*)(F.lds + PT_OFF);
#pragma unroll
        for (int i = 0; i < 19; ++i) pt[i] = (unsigned long long)args.in[i]; }
    __syncthreads();
    const int lo = args.ph_lo, hi = args.ph_hi;
    XcdBarrier bar; bar.bar = (unsigned*)(ws + WS_CTL) + CW_BAR; bar.x = 0; bar.st = nullptr;
    if (hi - lo > 1) bar = xcd_barrier_post((unsigned*)(ws + WS_CTL) + CW_BAR, MISC + 8);
#ifndef PH_MASK
#define PH_MASK 0xfff
#endif
#define IN(k) (((PH_MASK >> (k)) & 1) && lo <= (k) && (k) < hi)
#if MK_PROBE >= 1000
#define PH_T0(k) unsigned long long _pt##k = 0; if (MK_PROBE == 1000 + (k)) _pt##k = __builtin_amdgcn_s_memrealtime();
#define PH_T1(k) if (MK_PROBE == 1000 + (k) && blockIdx.x == MK_PROBE_BLK && F.tid == 0) MISC[12] += (unsigned)(__builtin_amdgcn_s_memrealtime() - _pt##k);
#else
#define PH_T0(k)
#define PH_T1(k)
#endif
#if MK_PROBE >= 2000
#define SEAM_T0() const unsigned long long _st0 = __builtin_amdgcn_s_memrealtime();
#define SEAM_T1(k) if ((MK_PROBE == 2000 || MK_PROBE == 2001 + (k)) && blockIdx.x == MK_PROBE_BLK && F.tid == 0) MISC[12] += (unsigned)(__builtin_amdgcn_s_memrealtime() - _st0);
#else
#define SEAM_T0()
#define SEAM_T1(k)
#endif
#define SEAM(k) do { SEAM_T0() if (IN(k) && IN((k) + 1)) { if ((k) <= 8) xcd_barrier_work(bar, F, QD_CHUNKS); else xcd_barrier(bar); } SEAM_T1(k) { int _t = threadIdx.x; asm volatile("" : "+v"(_t)); F.tid = _t; F.lane = _t & 63; } } while (0)

    const int vcu = (F.G % 8 == 0) ? (F.bid % 8) * (F.G / 8) + F.bid / 8 : F.bid;
    unsigned char* h8 = ws + WS_H;
    bf16* h2b = (bf16*)(ws + WS_H2B); bf16* proj = (bf16*)(ws + WS_PROJ); bf16* mixin = (bf16*)(ws + WS_MIXIN);

    PH_T0(0) if (IN(0)) { p0_prologue(F); } PH_T1(0) SEAM(0);
    PH_T0(1) if (IN(1)) { modnorm_phase<false, false, true>(F, INP(0), INP(4), 0, nullptr, (bf16*)h8); } PH_T1(1) SEAM(1);
    PH_T0(2) if (IN(2)) {
        typedef DenseSchedT<NT / 256, NPROJ / 256, 1> SchedP2; SchedP2 S; S.init(h8, ws + WS_WIN_T, D, D, 0, F.G, F.bid);
        EpiProj E{proj};
        gemm_phase<EpiProj, SchedP2>(F.lds, D, D, S, E);
    } PH_T1(2) SEAM(2);
    PH_T0(3) if (IN(3)) {
#if MK_PROBE == 1103
        const unsigned long long _pp0 = __builtin_amdgcn_s_memrealtime();
#endif
        pool_phase(F, INP(7));
#if MK_PROBE == 1103
        if (blockIdx.x == MK_PROBE_BLK && F.tid == 0) MISC[12] += (unsigned)(__builtin_amdgcn_s_memrealtime() - _pp0);
#endif
#if MK_NAIVE_ATTN
        naive_attn_phase(F);
#else
        attn_phase(F);
#endif
    } PH_T1(3) SEAM(3);
    PH_T0(4) if (IN(4)) {
#if !MK_NAIVE_ATTN
        combine_phase(F);
#endif
    } PH_T1(4) SEAM(4);
    PH_T0(5) if (IN(5)) {
        typedef DenseSchedT<NT / 256, D / 256, 1> SchedP5; SchedP5 S; S.init(mixin, ws + WS_WOUT_T, NMIX, NMIX, 0, F.G, F.bid);
        EpiOut E{(bf16*)F.out};
        gemm_phase<EpiOut, SchedP5>(F.lds, NMIX, NMIX, S, E);
    } PH_T1(5) SEAM(5);
    PH_T0(6) if (IN(6)) { modnorm_phase<true, true, true>(F, INP(0), INP(9), 3, h8, h2b); } PH_T1(6) SEAM(6);
    PH_T0(7) if (IN(7)) {
        typedef DenseSchedT<NT / 256, NE / 256, 2> SchedP7; SchedP7 S; S.init(h2b, ws + WS_WR_T, D, D, 512, F.G, F.bid);
        EpiRouter E{(float*)(ws + WS_LOGIT)};
        gemm_phase<EpiRouter, SchedP7>(F.lds, 512, D, S, E);
    } PH_T1(7) SEAM(7);
    PH_T0(8) if (IN(8)) { routing_phase(F, INP(11)); drain_queue(F, QG_CHUNKS); } PH_T1(8) SEAM(8);
    PH_T0(9) if (IN(9)) {
        int nblk; build_tables(F, nblk);
        MoeSched<2, false> S; S.prefix = (const LAS int*)(F.lds + TAB_OFF); S.cnt = S.prefix + 260; S.bucket = (const unsigned*)(ws + WS_BUCKET);
        S.Ar = (const char*)h8; S.As = (const char*)h8; S.Br = (const char*)(ws + WS_WGU_T); S.Bs = (const char*)(ws + WS_WSGU_T);
        S.nRouted = nblk * 2; S.total = S.nRouted + (NT / 256) * 2; S.G = F.G; S.c = vcu;
        EpiGU E{ws + WS_ACT, ws + WS_ACTS, (const unsigned*)(ws + WS_BUCKET), (unsigned*)(ws + WS_POS)};
        S.i0 = 0; S.i1 = 0x3fffffff;
        gemm_phase<EpiGU, MoeSched<2, false>>(F.lds, D / 2, D / 2, S, E);
        drain_queue(F, QD_CHUNKS);
    } PH_T1(9) SEAM(9);
    PH_T0(10) if (IN(10)) {
        int nblk; build_tables(F, nblk);
        MoeSched<4, true> S; S.prefix = (const LAS int*)(F.lds + TAB_OFF); S.cnt = S.prefix + 260; S.bucket = (const unsigned*)(ws + WS_BUCKET);
        S.Ar = (const char*)(ws + WS_ACT); S.As = (const char*)(ws + WS_ACTS); S.Br = (const char*)(ws + WS_WD_T); S.Bs = (const char*)(ws + WS_WSD_T);
        S.nRouted = nblk * 4; S.total = S.nRouted + (NT / 256) * 4; S.G = F.G; S.c = vcu; S.i0 = 0; S.i1 = 0x3fffffff;
        EpiDown E{(unsigned char*)(ws + WS_Y), (bf16*)F.out};
        gemm_phase<EpiDown, MoeSched<4, true>>(F.lds, FF / 2, FF / 2, S, E);
    } PH_T1(10) SEAM(10);
    PH_T0(11) if (IN(11)) { final_phase(F, INP(18)); } PH_T1(11)
#if MK_PROBE
    if (blockIdx.x == MK_PROBE_BLK) { __syncthreads();
        if (F.tid == 0) { const unsigned long long span = (unsigned long long)MISC[12] * MK_PROBE_MULT, t0 = __builtin_amdgcn_s_memrealtime();
            while (__builtin_amdgcn_s_memrealtime() - t0 < span) __builtin_amdgcn_s_sleep(16); } }
#endif
#undef IN
#undef SEAM
#undef INP
}

extern "C" void kernel_launch(void* const* d_in, const int* in_sizes, int n_in, void* d_out, int out_size, void* d_ws, size_t ws_size, hipStream_t stream) {
    static int grid = 0;
    if (grid == 0) {
        if (n_in != 19 || out_size != NT * D || ws_size < WS_END) { fprintf(stderr, "kernel_launch: unexpected shapes (n_in %d out %d ws %zu)\n", n_in, out_size, ws_size); grid = -1; return; }
        int dev = 0, cus = 0;
        if (hipGetDevice(&dev) != hipSuccess || hipDeviceGetAttribute(&cus, hipDeviceAttributeMultiprocessorCount, dev) != hipSuccess) { grid = -1; return; }
        if (hipFuncSetAttribute((const void*)fwd, hipFuncAttributeMaxDynamicSharedMemorySize, LDS_BYTES) != hipSuccess) { fprintf(stderr, "kernel_launch: hipFuncSetAttribute failed\n"); grid = -1; return; }
        int per_cu = 0;
        if (hipOccupancyMaxActiveBlocksPerMultiprocessor(&per_cu, (const void*)fwd, NTHREADS, LDS_BYTES) != hipSuccess || per_cu < 1) { fprintf(stderr, "kernel_launch: occupancy query says %d\n", per_cu); }
        (void)hipGetLastError();
        grid = cus;
    }
    if (grid < 0) return;
    (void)hipMemsetAsync((char*)d_ws + WS_CTL, 0, CTL_ZERO_BYTES, stream);
    Args a{};
    for (int i = 0; i < 19; ++i) a.in[i] = (const float*)d_in[i];
    a.out = (float*)d_out; a.ws = (unsigned char*)d_ws;
#if MK_ONE_LAUNCH
    a.ph_lo = 0; a.ph_hi = N_PHASES;
    hipLaunchKernelGGL(fwd, dim3(grid), dim3(NTHREADS), LDS_BYTES, stream, a);
#else
    for (int p = 0; p < N_PHASES; ++p) { a.ph_lo = p; a.ph_hi = p + 1; const int reps = ((MK_REP_MASK >> p) & 1) ? 2 : 1;
        for (int r = 0; r < reps; ++r) hipLaunchKernelGGL(fwd, dim3(grid), dim3(NTHREADS), LDS_BYTES, stream, a); }
#endif
}
```

```cpp
#include <hip/hip_runtime.h>
#include <cstdio>
#include <cstdint>

#ifndef MK_ONE_LAUNCH
#define MK_ONE_LAUNCH 1
#endif
#ifndef MK_FAST_GEMM
#define MK_FAST_GEMM 1
#endif
#ifndef MK_REP_MASK
#define MK_REP_MASK 0x000
#endif
#ifndef MK_MX
#define MK_MX 1
#endif
#ifndef MK_PROBE
#define MK_PROBE 0
#endif
#ifndef MK_PROBE_BLK
#define MK_PROBE_BLK 0
#endif
#ifndef MK_PROBE_WAVE
#define MK_PROBE_WAVE 0
#endif
#ifndef MK_PROBE_MULT
#define MK_PROBE_MULT 4
#endif
#ifndef MK_NAIVE_ATTN
#define MK_NAIVE_ATTN 0
#endif

#define LAS __attribute__((address_space(3)))
#define GAS __attribute__((address_space(1)))
typedef unsigned short bf16;
typedef short bf16x8 __attribute__((ext_vector_type(8)));
typedef short s16x4 __attribute__((ext_vector_type(4)));
typedef float f32x4 __attribute__((ext_vector_type(4)));
typedef float f32x2 __attribute__((ext_vector_type(2)));
typedef long l64x2 __attribute__((ext_vector_type(2)));
typedef int i32x8 __attribute__((ext_vector_type(8)));
typedef int i32x4 __attribute__((ext_vector_type(4)));
typedef unsigned v4u __attribute__((ext_vector_type(4)));
typedef unsigned v2u __attribute__((ext_vector_type(2)));

constexpr int D = 1024, NB = 8, SEQ = 4096, NT = NB * SEQ;
constexpr int NPROJ = 2560, NE = 256, TOPK = 8, FF = 256, NMIX = 512;
constexpr int CAP = NT;
constexpr int MAXBLK = NT * TOPK / 256 + NE;
constexpr float NORM_EPS = 1e-6f;
constexpr int NWAVES = 8, NTHREADS = 512;

constexpr size_t MiB = 1u << 20;
constexpr size_t WS_CTL = 0, CTL_ZERO_BYTES = 1 * MiB;
constexpr size_t WS_MOD = 1 * MiB;
constexpr size_t WS_GATEW = 2 * MiB;
constexpr size_t WS_WIN_T = 4 * MiB;
constexpr size_t WS_WOUT_T = 9 * MiB;
constexpr size_t WS_WR_T = 10 * MiB;
constexpr size_t WS_WSGU_T = 11 * MiB;
constexpr size_t WS_WSD_T = 12 * MiB;
constexpr size_t WS_LSE = 13 * MiB;
constexpr size_t WS_WD_T = 16 * MiB;
constexpr size_t WS_ACT = 144 * MiB;
constexpr size_t WS_ACTS = 304 * MiB;
constexpr size_t WS_BUCKET = 320 * MiB;
constexpr size_t WS_WGU_T = 352 * MiB;
constexpr size_t WS_PROJ = 608 * MiB;
constexpr size_t WS_H = 768 * MiB;
constexpr size_t WS_ATTO = 832 * MiB;
constexpr size_t WS_MIXIN = 880 * MiB;
constexpr size_t WS_LOGIT = 912 * MiB;
constexpr size_t WS_Y = 352 * MiB;
constexpr size_t WS_H2B = 832 * MiB;
constexpr size_t WS_PWT = 15 * MiB;
constexpr size_t WS_POS = 3 * MiB;
constexpr size_t WS_END = 992 * MiB;
constexpr int CW_BAR = 4096;
constexpr int CW_GCNT = 16384;
constexpr int CW_QD = 24576;
constexpr unsigned QG_CHUNKS = NE * 16, QD_CHUNKS = QG_CHUNKS + NE * 16;

constexpr int RING_BYTES = 131072;
constexpr int TAB_OFF = RING_BYTES;
constexpr int MISC_OFF = TAB_OFF + 4096;
constexpr int PT_OFF = MISC_OFF + 256;
constexpr int LDS_BYTES = 147456;

__device__ __forceinline__ unsigned f2bf(float f) { unsigned u = __builtin_bit_cast(unsigned, f); return (u + 0x7fffu + ((u >> 16) & 1u)) >> 16; }
__device__ __forceinline__ unsigned pk2(float lo, float hi) { unsigned r; asm("v_cvt_pk_bf16_f32 %0, %1, %2" : "=v"(r) : "v"(lo), "v"(hi)); return r; }
constexpr float W_SCALE = 64.f, W_INV_SCALE = 1.f / 64.f;
constexpr float WD_SCALE = 4.f;
constexpr float ACT_SCALE = 4.f;
__device__ __forceinline__ unsigned pk4_fp8(float a, float b, float c, float d) {
    int w = __builtin_amdgcn_cvt_pk_fp8_f32(a, b, 0, false); w = __builtin_amdgcn_cvt_pk_fp8_f32(c, d, w, true); return (unsigned)w; }
__device__ __forceinline__ float bf2f(unsigned short b) { return __builtin_bit_cast(float, ((unsigned)b) << 16); }
__device__ __forceinline__ float bflo(unsigned u) { return __builtin_bit_cast(float, u << 16); }
__device__ __forceinline__ float bfhi(unsigned u) { return __builtin_bit_cast(float, u & 0xffff0000u); }
template <int CTRL> __device__ __forceinline__ float dppf(float v) {
    return __builtin_bit_cast(float, __builtin_amdgcn_update_dpp(0, __builtin_bit_cast(int, v), CTRL, 0xF, 0xF, true)); }
__device__ __forceinline__ float wave_sum(float v) {
    v += dppf<0xB1>(v); v += dppf<0x4E>(v); v += dppf<0x141>(v); v += dppf<0x140>(v);
    const float r0 = __builtin_bit_cast(float, __builtin_amdgcn_readlane(__builtin_bit_cast(int, v), 0)), r1 = __builtin_bit_cast(float, __builtin_amdgcn_readlane(__builtin_bit_cast(int, v), 16));
    const float r2 = __builtin_bit_cast(float, __builtin_amdgcn_readlane(__builtin_bit_cast(int, v), 32)), r3 = __builtin_bit_cast(float, __builtin_amdgcn_readlane(__builtin_bit_cast(int, v), 48));
    return (r0 + r1) + (r2 + r3);
}
__device__ __forceinline__ float silu_f(float g) { return g * __builtin_amdgcn_rcpf(1.f + __builtin_amdgcn_exp2f(-1.44269504f * g)); }

__device__ __forceinline__ const float* ld_ptr(LAS unsigned char* lds, int i) {
    const unsigned long long v = ((const LAS unsigned long long*)(lds + PT_OFF))[i];
    const unsigned lo = __builtin_amdgcn_readfirstlane((unsigned)v), hi = __builtin_amdgcn_readfirstlane((unsigned)(v >> 32));
    return (const float*)(((unsigned long long)hi << 32) | lo);
}
#define XB_TMO      128
#define XB_XCNT(j)  (256  + 64 * (j))
#define XB_XSUB(j)  (1280 + 64 * (j))
#define XB_XGEN(j)  (2304 + 64 * (j))
#define XB_TOP      3328
#define XB_TOPGEN   3392
#define XCD_BAR_WORDS 3456
#define XB_SPIN_CAP (1u << 18)
__device__ __forceinline__ unsigned xb_ld(unsigned* p)              { return __hip_atomic_load(p, __ATOMIC_RELAXED, __HIP_MEMORY_SCOPE_AGENT); }
__device__ __forceinline__ unsigned xb_add(unsigned* p, unsigned v) { return __hip_atomic_fetch_add(p, v, __ATOMIC_RELAXED, __HIP_MEMORY_SCOPE_AGENT); }
__device__ __forceinline__ unsigned xb_xcc_id() { return (unsigned)__builtin_amdgcn_s_getreg((3 << 11) | 20) & 0xFu; }
#define XB_SPIN(cond, bar) do { unsigned _sp = 0; while (cond) { __builtin_amdgcn_s_sleep(1); \
    if ((++_sp & 255u) == 0u) { if (xb_ld(&(bar)[XB_TMO])) break; if (_sp > XB_SPIN_CAP) { atomicAdd(&(bar)[XB_TMO], 1u); break; } } } } while (0)
struct XcdBarrier { unsigned* bar; unsigned x; volatile LAS unsigned* st; };
__device__ __forceinline__ XcdBarrier xcd_barrier_post(unsigned* bar, volatile LAS unsigned* st) {
    XcdBarrier b; b.bar = bar; b.x = xb_xcc_id(); b.st = st;
    if (threadIdx.x == 0) (void)xb_add(&bar[XB_XCNT(b.x)], 1u);
    return b;
}
__device__ __forceinline__ void xcd_barrier_complete(unsigned* bar, unsigned x, unsigned& nloc, unsigned& nx) {
    const unsigned G = gridDim.x * gridDim.y * gridDim.z;
    unsigned sum, cnt, mine, sp = 0u;
    for (;;) {
        sum = 0u; cnt = 0u; mine = 0u;
#pragma unroll
        for (unsigned j = 0; j < 16; ++j) { const unsigned c = xb_ld(&bar[XB_XCNT(j)]); sum += c; cnt += (c > 0u) ? 1u : 0u; mine = (j == x) ? c : mine; }
        if (sum == G) break;
        __builtin_amdgcn_s_sleep(1);
        if ((++sp & 255u) == 0u) { if (xb_ld(&bar[XB_TMO])) break; if (sp > XB_SPIN_CAP) { atomicAdd(&bar[XB_TMO], 1u); break; } }
    }
    nloc = mine > 0u ? mine : 1u; nx = cnt > 0u ? cnt : 1u;
}
__device__ __forceinline__ void xcd_barrier(const XcdBarrier& b) {
    asm volatile("s_waitcnt vmcnt(0)" ::: "memory");
    __syncthreads();
    if (threadIdx.x == 0) {
        unsigned* bar = b.bar;
        __builtin_amdgcn_s_waitcnt(0);
        unsigned nloc = b.st[0], nx = b.st[1];
        if (nloc == 0u) { xcd_barrier_complete(bar, b.x, nloc, nx); b.st[0] = nloc; b.st[1] = nx; }
        const unsigned old = xb_add(&bar[XB_XSUB(b.x)], 1u);
        const unsigned gen = old / nloc;
        if (old + 1u == (gen + 1u) * nloc) {
            __builtin_amdgcn_fence(__ATOMIC_RELEASE, "agent");
            asm volatile("s_waitcnt vmcnt(0)" ::: "memory");
            const unsigned og = xb_add(&bar[XB_TOP], 1u);
            const unsigned tg = og / nx;
            if (og + 1u == (tg + 1u) * nx) xb_add(&bar[XB_TOPGEN], 1u);
            else XB_SPIN(xb_ld(&bar[XB_TOPGEN]) == tg, bar);
            __builtin_amdgcn_fence(__ATOMIC_ACQUIRE, "agent");
            xb_add(&bar[XB_XGEN(b.x)], 1u);
            asm volatile("s_waitcnt vmcnt(0)" ::: "memory");
        } else {
            XB_SPIN(xb_ld(&bar[XB_XGEN(b.x)]) == gen, bar);
            __builtin_amdgcn_fence(__ATOMIC_ACQUIRE, "agent");
            asm volatile("s_waitcnt vmcnt(0)" ::: "memory");
        }
    }
    __syncthreads();
}

constexpr int BK = 64, HALF = 128, HTB = HALF * BK * 2;
__device__ __forceinline__ int lds_byte(int r, int c) { const int st = (r >> 4) * 2 + (c >> 5), rr = r & 15, cc = c & 31, ob = rr * 64 + cc * 2; return st * 1024 + (ob ^ (((ob >> 9) & 1) << 5)); }
__device__ __forceinline__ void stage_rc(int b, int& R, int& C) { const int st = b / 1024, sb = b % 1024, swz = sb ^ (((sb >> 9) & 1) << 5); R = (st >> 1) * 16 + swz / 64; C = (st & 1) * 32 + (swz % 64) / 2; }
__device__ __forceinline__ int perm32(int rho) { const int n = rho >> 4, i = rho & 15; return 8 * (i >> 2) + 4 * n + (i & 3); }

template <class Epi, class Sched>
__device__ __forceinline__ void gemm_simple(const int K, const int ldb, const Sched& S, const Epi& E) {
    const int tid = threadIdx.x, wid = __builtin_amdgcn_readfirstlane(tid >> 6), lane = tid & 63, wr = wid >> 2, wc = wid & 3, fr = lane & 15, fq = lane >> 4;
    typename Sched::Unit u;
    for (int ui = 0; S.next(ui, u); ++ui) {
        f32x4 acc[2][2][4][2];
#pragma unroll
        for (int a = 0; a < 2; ++a)
#pragma unroll
            for (int b = 0; b < 2; ++b)
#pragma unroll
                for (int m = 0; m < 4; ++m)
#pragma unroll
                    for (int n = 0; n < 2; ++n) acc[a][b][m][n] = (f32x4){0.f, 0.f, 0.f, 0.f};
        const char* A = S.a_base(u); const char* B = S.b_base(u);
        unsigned aoff[2][4], boff[2][2];
#pragma unroll
        for (int ai = 0; ai < 2; ++ai)
#pragma unroll
            for (int m = 0; m < 4; ++m) aoff[ai][m] = S.a_off(u, 128 * ai + 64 * wr + 16 * m + fr) + fq * 16;
#pragma unroll
        for (int bj = 0; bj < 2; ++bj)
#pragma unroll
            for (int n = 0; n < 2; ++n) { const int row = Epi::PERM == 2 ? 64 * wc + 16 * (fr >> 2) + 8 * bj + 4 * n + (fr & 3) : 128 * bj + 32 * wc + (Epi::PERM == 1 ? perm32(16 * n + fr) : 16 * n + fr); boff[bj][n] = (unsigned)(row * ldb) * 2u + fq * 16; }
        for (int k = 0; k < K; k += 32) {
            bf16x8 a[2][4], b[2][2];
#pragma unroll
            for (int ai = 0; ai < 2; ++ai)
#pragma unroll
                for (int m = 0; m < 4; ++m) a[ai][m] = *(const bf16x8*)(A + aoff[ai][m] + k * 2);
#pragma unroll
            for (int bj = 0; bj < 2; ++bj)
#pragma unroll
                for (int n = 0; n < 2; ++n) b[bj][n] = *(const bf16x8*)(B + boff[bj][n] + k * 2);
#pragma unroll
            for (int ai = 0; ai < 2; ++ai)
#pragma unroll
                for (int bj = 0; bj < 2; ++bj)
#pragma unroll
                    for (int m = 0; m < 4; ++m)
#pragma unroll
                        for (int n = 0; n < 2; ++n) acc[ai][bj][m][n] = __builtin_amdgcn_mfma_f32_16x16x32_bf16(b[bj][n], a[ai][m], acc[ai][bj][m][n], 0, 0, 0);
        }
        E(acc, u, wr, wc, fr, fq);
    }
}

template <class Epi, class Sched>
__device__ __forceinline__ void gemm_fast(LAS unsigned char* lds, const int K, const int ldb, const Sched& S, const Epi& E) {
    int tid0 = threadIdx.x; asm volatile("" : "+v"(tid0));
    const int tid = tid0, wid = __builtin_amdgcn_readfirstlane(tid >> 6), lane = tid & 63, wr = wid >> 2, wc = wid & 3, fr = lane & 15, fq = lane >> 4;
    int nt = K / BK; asm volatile("" : "+s"(nt));
    unsigned voffB0[2], voffB1[2];
#pragma unroll
    for (int i = 0; i < 2; ++i) { int R, C; stage_rc(tid * 16 + i * 8192, R, C);
        if (Epi::PERM == 2) { const int cb = 64 * (R >> 5) + 16 * ((R & 15) >> 2) + 4 * ((R >> 4) & 1) + (R & 3);
            voffB0[i] = (unsigned)(cb * ldb + C) * 2u; voffB1[i] = (unsigned)((cb + 8) * ldb + C) * 2u; }
        else { const int Rb = Epi::PERM == 1 ? ((R & ~31) + perm32(R & 31)) : R;
            voffB0[i] = (unsigned)(Rb * ldb + C) * 2u; voffB1[i] = (unsigned)((Rb + HALF) * ldb + C) * 2u; } }
#define PG8_AOFF(u) do { int _tz = threadIdx.x; asm volatile("" : "+v"(_tz)); _Pragma("unroll") for (int _i = 0; _i < 2; ++_i) { int _R, _C; stage_rc(_tz * 16 + _i * 8192, _R, _C); \
        vA0[_i] = S.a_off(u, _R) + (unsigned)_C * 2u; vA1[_i] = S.a_off(u, HALF + _R) + (unsigned)_C * 2u; } } while (0)
    const size_t kstep = (size_t)(BK * 2);
    const unsigned ldsw = (unsigned)wid * 1024u;
    const int aoff = lds_byte(wr * 64 + fr, fq * 8), boff = lds_byte(wc * 32 + fr, fq * 8);
#if MK_PROBE
#define PRB_NOW() __builtin_amdgcn_s_memrealtime()
#define PRB_ADD(IV, t0, t1) do { if (MK_PROBE == Epi::PID * 10 + (IV) && blockIdx.x == MK_PROBE_BLK && wid == MK_PROBE_WAVE && lane == 0) \
        __hip_atomic_fetch_add((LAS unsigned*)(lds + MISC_OFF + 48), (unsigned)((t1) - (t0)), __ATOMIC_RELAXED, __HIP_MEMORY_SCOPE_WORKGROUP); } while (0)
#else
#define PRB_NOW() 0ull
#define PRB_ADD(IV, t0, t1) do { } while (0)
#endif
#define PG8_SA(b, h) (((b) * 2 + (h)) * HTB)
#define PG8_SB(b, h) ((4 + (b) * 2 + (h)) * HTB)
#define PG8_STAGE(bufoff, gbase, voff) do { _Pragma("unroll") for (int _i = 0; _i < 2; ++_i) \
        __builtin_amdgcn_global_load_lds((const unsigned*)((const char*)(gbase) + (voff)[_i]), (LAS unsigned*)(lds + (bufoff) + ldsw + _i * 8192), 16, 0, 0); } while (0)
#define PG8_LDA(dst, b, h) do { _Pragma("unroll") for (int m = 0; m < 4; ++m) _Pragma("unroll") for (int k = 0; k < 2; ++k) dst[m][k] = *(const LAS bf16x8*)(lds + PG8_SA(b, h) + aoff + m * 2048 + k * 1024); } while (0)
#define PG8_LDB(dst, b, h) do { _Pragma("unroll") for (int n = 0; n < 2; ++n) _Pragma("unroll") for (int k = 0; k < 2; ++k) dst[n][k] = *(const LAS bf16x8*)(lds + PG8_SB(b, h) + boff + n * 2048 + k * 1024); } while (0)
#define PG8_MMA(ai, bj, At, Bt) do { __builtin_amdgcn_s_setprio(1); _Pragma("unroll") for (int m = 0; m < 4; ++m) _Pragma("unroll") for (int n = 0; n < 2; ++n) _Pragma("unroll") for (int k = 0; k < 2; ++k) { \
        if constexpr (Epi::FP8 && MK_MX) { if (k == 0) { \
            const i32x8 _a = __builtin_shufflevector(__builtin_bit_cast(i32x4, At[m][0]), __builtin_bit_cast(i32x4, At[m][1]), 0, 1, 2, 3, 4, 5, 6, 7); \
            const i32x8 _b = __builtin_shufflevector(__builtin_bit_cast(i32x4, Bt[n][0]), __builtin_bit_cast(i32x4, Bt[n][1]), 0, 1, 2, 3, 4, 5, 6, 7); \
            acc[ai][bj][m][n] = __builtin_amdgcn_mfma_scale_f32_16x16x128_f8f6f4(_b, _a, acc[ai][bj][m][n], 0, 0, 0, 0x7F7F7F7F, 0, 0x7F7F7F7F); } } \
        else if constexpr (Epi::FP8) { const l64x2 _a = __builtin_bit_cast(l64x2, At[m][k]), _b = __builtin_bit_cast(l64x2, Bt[n][k]); \
            acc[ai][bj][m][n] = __builtin_amdgcn_mfma_f32_16x16x32_fp8_fp8(_b[0], _a[0], acc[ai][bj][m][n], 0, 0, 0); \
            acc[ai][bj][m][n] = __builtin_amdgcn_mfma_f32_16x16x32_fp8_fp8(_b[1], _a[1], acc[ai][bj][m][n], 0, 0, 0); } \
        else acc[ai][bj][m][n] = __builtin_amdgcn_mfma_f32_16x16x32_bf16(Bt[n][k], At[m][k], acc[ai][bj][m][n], 0, 0, 0); } __builtin_amdgcn_s_setprio(0); } while (0)
#define PG8_WAIT_V(n) asm volatile("s_waitcnt vmcnt(" #n ")" ::: "memory")
#define PG8_WAIT_L(n) asm volatile("s_waitcnt lgkmcnt(" #n ")" ::: "memory")
#define PG8_BAR __builtin_amdgcn_s_barrier()
#define PG8_SCHED __builtin_amdgcn_sched_barrier(0)
    typename Sched::Unit cur, nxt; int ui = 0;
    if (!S.next(0, cur)) return;
    f32x4 acc[2][2][4][2];
#pragma unroll
    for (int a = 0; a < 2; ++a)
#pragma unroll
        for (int b = 0; b < 2; ++b)
#pragma unroll
            for (int m = 0; m < 4; ++m)
#pragma unroll
                for (int n = 0; n < 2; ++n) acc[a][b][m][n] = (f32x4){0.f, 0.f, 0.f, 0.f};
    bf16x8 At[4][2], B0[2][2], B1[2][2];
    const char* cA = S.a_base(cur); const char* cB = S.b_base(cur);
    unsigned vA0[2], vA1[2];
    PG8_AOFF(cur);
    PG8_STAGE(PG8_SB(0, 0), cB, voffB0); PG8_STAGE(PG8_SA(0, 0), cA, vA0); PG8_STAGE(PG8_SB(0, 1), cB, voffB1); PG8_STAGE(PG8_SA(0, 1), cA, vA1);
    if (wr == 1) PG8_BAR;
    PG8_WAIT_V(4); PG8_BAR;
    PG8_STAGE(PG8_SB(1, 0), cB + kstep, voffB0); PG8_STAGE(PG8_SA(1, 0), cA + kstep, vA0); PG8_STAGE(PG8_SB(1, 1), cB + kstep, voffB1);
    PG8_WAIT_V(6); PG8_BAR;
    for (;;) {
        const unsigned long long prb_a = PRB_NOW();
        const bool has_next = S.next(ui + 1, nxt);
        const char* nA = has_next ? S.a_base(nxt) : cA; const char* nB = has_next ? S.b_base(nxt) : cB;
        const unsigned long long prb_b = PRB_NOW(); PRB_ADD(1, prb_a, prb_b);
        for (int t = 0; t < nt; t += 2) {
            const unsigned long long prb_i0 = PRB_NOW();
            const bool last = (t == nt - 2);
            const char* a1 = cA + (size_t)(t + 1) * kstep;
            const char* a2 = last ? nA : cA + (size_t)(t + 2) * kstep; const char* b2 = last ? nB : cB + (size_t)(t + 2) * kstep;
            const char* a3 = a2 + kstep; const char* b3 = b2 + kstep;
            PG8_LDB(B0, 0, 0); PG8_SCHED; PG8_LDA(At, 0, 0); PG8_STAGE(PG8_SA(1, 1), a1, vA1);
            if (last && has_next) PG8_AOFF(nxt);
            PG8_WAIT_L(8); PG8_BAR; PG8_WAIT_L(0); PG8_MMA(0, 0, At, B0); PG8_BAR; PG8_SCHED;
            PG8_LDB(B1, 0, 1); PG8_STAGE(PG8_SB(0, 0), b2, voffB0);
            PG8_BAR; PG8_WAIT_L(0); PG8_MMA(0, 1, At, B1); PG8_BAR;
            PG8_LDA(At, 0, 1); PG8_STAGE(PG8_SA(0, 0), a2, vA0);
            PG8_BAR; PG8_WAIT_L(0); PG8_MMA(1, 0, At, B0); PG8_BAR; PG8_SCHED;
            PG8_STAGE(PG8_SB(0, 1), b2, voffB1);
            PG8_WAIT_V(6); PG8_BAR; PG8_MMA(1, 1, At, B1); PG8_BAR;
            PG8_LDB(B0, 1, 0); PG8_SCHED; PG8_LDA(At, 1, 0); PG8_STAGE(PG8_SA(0, 1), a2, vA1);
            PG8_WAIT_L(8); PG8_BAR; PG8_WAIT_L(0); PG8_MMA(0, 0, At, B0); PG8_BAR; PG8_SCHED;
            PG8_LDB(B1, 1, 1); PG8_STAGE(PG8_SB(1, 0), b3, voffB0);
            PG8_BAR; PG8_WAIT_L(0); PG8_MMA(0, 1, At, B1); PG8_BAR;
            PG8_LDA(At, 1, 1); PG8_STAGE(PG8_SA(1, 0), a3, vA0);
            PG8_BAR; PG8_WAIT_L(0); PG8_MMA(1, 0, At, B0); PG8_BAR; PG8_SCHED;
            PG8_STAGE(PG8_SB(1, 1), b3, voffB1);
            PG8_WAIT_V(6); PG8_BAR; PG8_MMA(1, 1, At, B1); PG8_BAR;
            { const unsigned long long prb_i1 = PRB_NOW(); if (t == 0) PRB_ADD(4, prb_i0, prb_i1); if (last) PRB_ADD(5, prb_i0, prb_i1); if (t != 0 && !last) PRB_ADD(6, prb_i0, prb_i1); }
        }
        const unsigned long long prb_c = PRB_NOW(); PRB_ADD(2, prb_b, prb_c);
        { int tz = threadIdx.x; asm volatile("" : "+v"(tz)); const int wz = tz >> 6, lz = tz & 63;
          E(acc, cur, wz >> 2, wz & 3, lz & 15, lz >> 4);
#if defined(MK_EPI_TWICE)
          if (Epi::TWICE) { asm volatile("" ::: "memory"); E(acc, cur, wz >> 2, wz & 3, lz & 15, lz >> 4); }
#endif
          }
        { const unsigned long long prb_d = PRB_NOW(); PRB_ADD(3, prb_c, prb_d); }
        if (!has_next) break;
#pragma unroll
        for (int a = 0; a < 2; ++a)
#pragma unroll
            for (int b = 0; b < 2; ++b)
#pragma unroll
                for (int m = 0; m < 4; ++m)
#pragma unroll
                    for (int n = 0; n < 2; ++n) acc[a][b][m][n] = (f32x4){0.f, 0.f, 0.f, 0.f};
        cur = nxt; cA = nA; cB = nB; ++ui;
    }
    PG8_WAIT_V(0);
    if (wr == 0) PG8_BAR;
    PG8_BAR;
#undef PG8_AOFF
#undef PRB_NOW
#undef PRB_ADD
#undef PG8_SA
#undef PG8_SB
#undef PG8_STAGE
#undef PG8_LDA
#undef PG8_LDB
#undef PG8_MMA
#undef PG8_WAIT_V
#undef PG8_WAIT_L
#undef PG8_BAR
#undef PG8_SCHED
}

template <class Epi, class Sched>
__device__ __forceinline__ void gemm_phase(LAS unsigned char* lds, const int K, const int ldb, const Sched& S, const Epi& E) {
#if MK_FAST_GEMM
    gemm_fast<Epi, Sched>(lds, K, ldb, S, E);
#else
    gemm_simple<Epi, Sched>(K, ldb, S, E);
#endif
}

struct DenseUnit { int pm, pn, ks; };
template <int NM, int NN, int KSPLIT>
struct DenseSchedT {
    typedef DenseUnit Unit;
    const char* A; const char* B; int lda2, ldb2, ksub2, G, c, i0, i1;
    __device__ __forceinline__ void init(const void* A_, const void* B_, int lda, int ldb, int Ksub, int G_, int c_) {
        A = (const char*)A_; B = (const char*)B_; lda2 = lda * 2; ldb2 = ldb * 2; ksub2 = Ksub * 2; G = G_; c = c_; i0 = 0; i1 = 0x3fffffff; }
    __device__ __forceinline__ bool next(int i, Unit& u) const {
        constexpr int nwg = NM * NN, total = nwg * KSPLIT;
        if (i + i0 >= i1) return false;
        const int L = (i + i0) * G + c; if (L >= total) return false;
        int id = L / KSPLIT; u.ks = L - id * KSPLIT;
        { constexpr int q = nwg / 8, r = nwg % 8; const int xcd = id % 8, off = id / 8; id = (xcd < r ? xcd * (q + 1) : r * (q + 1) + (xcd - r) * q) + off; }
        constexpr int nig = 8 * NN; const int gid = id / nig, fm = gid * 8, gsz = (NM - fm) < 8 ? (NM - fm) : 8;
        u.pm = fm + ((id % nig) % gsz); u.pn = (id % nig) / gsz; return true;
    }
    __device__ __forceinline__ const char* a_base(const Unit& u) const { return A + (size_t)u.pm * 256 * lda2 + (size_t)u.ks * ksub2; }
    __device__ __forceinline__ const char* b_base(const Unit& u) const { return B + (size_t)u.pn * 256 * ldb2 + (size_t)u.ks * ksub2; }
    __device__ __forceinline__ unsigned a_off(const Unit&, int r) const { return (unsigned)(r * lda2); }
};

template <int PN, bool DOWN>
struct MoeSched {
    struct Unit { int kind, e, rb, blk, valid, pm, pn; };
    const LAS int* prefix; const LAS int* cnt; const unsigned* bucket;
    const char* Ar; const char* As; const char* Br; const char* Bs;
    int nRouted, total, G, c, i0, i1;
    __device__ __forceinline__ bool next(int i, Unit& u) const {
        if (i + i0 >= i1) return false;
        const int id = (i + i0) * G + c; if (id >= total) return false;
        u.e = 0; u.rb = 0; u.blk = 0; u.pm = 0;
        if (id < nRouted) {
            const int blk = id / PN; u.pn = id % PN;
            const int lo = ((const LAS unsigned char*)(cnt + 256))[blk];
            u.kind = 0; u.e = lo; u.rb = blk - prefix[lo]; u.blk = blk; const int rem = cnt[lo] - u.rb * 256; u.valid = rem < 256 ? rem : 256;
        } else { const int s = id - nRouted; u.kind = 1; u.pm = s / PN; u.pn = s % PN; u.valid = 256; }
        return true;
    }
    __device__ __forceinline__ const char* a_base(const Unit& u) const { return u.kind == 0 ? Ar : As; }
    __device__ __forceinline__ const char* b_base(const Unit& u) const {
        if (!DOWN) return u.kind == 0 ? Br + ((size_t)u.e * 512 + (size_t)u.pn * 256) * D : Bs + (size_t)u.pn * 256 * D;
        else       return u.kind == 0 ? Br + ((size_t)u.e * 1024 + (size_t)u.pn * 256) * FF : Bs + (size_t)u.pn * 256 * FF;
    }
    __device__ __forceinline__ unsigned a_off(const Unit& u, int r) const {
        if (!DOWN) {
            if (u.kind == 0) { const int rr = r < u.valid ? r : u.valid - 1; const unsigned slot = bucket[(size_t)u.e * CAP + u.rb * 256 + rr]; return (slot >> 3) * (unsigned)D; }
            return (unsigned)(u.pm * 256 + r) * (unsigned)D;
        } else {
            return (unsigned)((u.kind == 0 ? u.blk : u.pm) * 256 + r) * (unsigned)FF;
        }
    }
};

struct EpiProj {
    static constexpr int PID = 2, PERM = 2;
    static constexpr bool TWICE = false, FP8 = false;
    bf16* O;
    __device__ __forceinline__ void operator()(const f32x4 (&acc)[2][2][4][2], const DenseUnit& u, int wr, int wc, int fr, int fq) const {
        const int row0 = u.pm * 256 + wr * 64 + fr, col0 = u.pn * 256 + wc * 64 + 16 * fq;
#pragma unroll
        for (int ai = 0; ai < 2; ++ai)
#pragma unroll
            for (int m = 0; m < 4; ++m) { bf16* rowp = O + (size_t)(row0 + ai * 128 + m * 16) * NPROJ + col0;
#pragma unroll
                for (int bj = 0; bj < 2; ++bj) { const f32x4 v0 = acc[ai][bj][m][0], v1 = acc[ai][bj][m][1];
                    *(v4u*)(rowp + bj * 8) = (v4u){pk2(v0[0], v0[1]), pk2(v0[2], v0[3]), pk2(v1[0], v1[1]), pk2(v1[2], v1[3])}; } }
    }
};
struct EpiOut {
    static constexpr int PID = 5, PERM = 2;
    static constexpr bool TWICE = false, FP8 = false;
    bf16* O;
    __device__ __forceinline__ void operator()(const f32x4 (&acc)[2][2][4][2], const DenseUnit& u, int wr, int wc, int fr, int fq) const {
        const int row0 = u.pm * 256 + wr * 64 + fr, col0 = u.pn * 256 + wc * 64 + 16 * fq;
#pragma unroll
        for (int ai = 0; ai < 2; ++ai)
#pragma unroll
            for (int m = 0; m < 4; ++m) { bf16* rowp = O + (size_t)(row0 + ai * 128 + m * 16) * (2 * D) + col0;
#pragma unroll
                for (int bj = 0; bj < 2; ++bj) { const f32x4 v0 = acc[ai][bj][m][0], v1 = acc[ai][bj][m][1];
                    *(v4u*)(rowp + bj * 8) = (v4u){pk2(v0[0], v0[1]), pk2(v0[2], v0[3]), pk2(v1[0], v1[1]), pk2(v1[2], v1[3])}; } }
    }
};
struct EpiRouter {
    static constexpr int PID = 7, PERM = 0;
    static constexpr bool TWICE = false, FP8 = false;
    float* L;
    __device__ __forceinline__ void operator()(const f32x4 (&acc)[2][2][4][2], const DenseUnit& u, int wr, int wc, int fr, int fq) const {
        const int row0 = u.pm * 256 + wr * 64 + fr, col0 = wc * 32 + 4 * fq;
        float* Lp = L + (size_t)u.ks * NT * NE;
#pragma unroll
        for (int ai = 0; ai < 2; ++ai)
#pragma unroll
            for (int m = 0; m < 4; ++m) { const size_t ro = (size_t)(row0 + ai * 128 + m * 16) * NE + col0;
#pragma unroll
                for (int bj = 0; bj < 2; ++bj)
#pragma unroll
                    for (int n = 0; n < 2; ++n) *(f32x4*)(Lp + ro + bj * 128 + n * 16) = acc[ai][bj][m][n]; }
    }
};
struct EpiGU {
    static constexpr int PID = 9, PERM = 1;
    static constexpr bool TWICE = false, FP8 = true;
    unsigned char* act; unsigned char* acts; const unsigned* bucket; unsigned* pos;
    __device__ __forceinline__ void operator()(const f32x4 (&acc)[2][2][4][2], const MoeSched<2, false>::Unit& u, int wr, int wc, int fr, int fq) const {
        unsigned char* O = u.kind == 0 ? act : acts;
        const int row0 = (u.kind == 0 ? u.blk : u.pm) * 256 + wr * 64 + fr, col0 = u.pn * 128 + wc * 32 + 8 * fq;
        if (u.kind == 0 && u.pn == 0 && wc == 0 && fq == 0) {
#pragma unroll
            for (int ai = 0; ai < 2; ++ai)
#pragma unroll
                for (int m = 0; m < 4; ++m) { const int r = ai * 128 + wr * 64 + m * 16 + fr;
                    if (r < u.valid) pos[bucket[(size_t)u.e * CAP + u.rb * 256 + r]] = (unsigned)(u.blk * 256 + r); } }
#pragma unroll
        for (int ai = 0; ai < 2; ++ai)
#pragma unroll
            for (int m = 0; m < 4; ++m) {
                const f32x4 g0 = acc[ai][0][m][0], g1 = acc[ai][0][m][1], u0 = acc[ai][1][m][0], u1 = acc[ai][1][m][1];
                float a[8];
#pragma unroll
                for (int j = 0; j < 4; j += 2) {
                    const f32x2 ga = (f32x2){g0[j], g0[j + 1]} * W_INV_SCALE, gb = (f32x2){g1[j], g1[j + 1]} * W_INV_SCALE;
                    const f32x2 ua = (f32x2){u0[j], u0[j + 1]} * (W_INV_SCALE * ACT_SCALE), ub = (f32x2){u1[j], u1[j + 1]} * (W_INV_SCALE * ACT_SCALE);
                    const f32x2 ea = ga * (-1.44269504f), eb = gb * (-1.44269504f);
                    f32x2 da, db; da.x = __builtin_amdgcn_exp2f(ea.x); da.y = __builtin_amdgcn_exp2f(ea.y); db.x = __builtin_amdgcn_exp2f(eb.x); db.y = __builtin_amdgcn_exp2f(eb.y);
                    da = da + 1.0f; db = db + 1.0f;
                    f32x2 ra, rb; ra.x = __builtin_amdgcn_rcpf(da.x); ra.y = __builtin_amdgcn_rcpf(da.y); rb.x = __builtin_amdgcn_rcpf(db.x); rb.y = __builtin_amdgcn_rcpf(db.y);
                    const f32x2 oa = (ga * ua) * ra, ob = (gb * ub) * rb;
                    a[j] = oa.x; a[j + 1] = oa.y; a[4 + j] = ob.x; a[4 + j + 1] = ob.y; }
                *(v2u*)(O + (size_t)(row0 + ai * 128 + m * 16) * FF + col0) = (v2u){pk4_fp8(a[0], a[1], a[2], a[3]), pk4_fp8(a[4], a[5], a[6], a[7])};
                __builtin_amdgcn_sched_barrier(0);
            }
    }
};
constexpr float Y_SCALE = ACT_SCALE * WD_SCALE, Y_INV_SCALE = 1.f / Y_SCALE;
struct EpiDown {
    static constexpr int PID = 10, PERM = 2;
    static constexpr bool TWICE = false, FP8 = true;
    unsigned char* Y; bf16* O;
    __device__ __forceinline__ void operator()(const f32x4 (&acc)[2][2][4][2], const MoeSched<4, true>::Unit& u, int wr, int wc, int fr, int fq) const {
        const int col0 = u.pn * 256 + wc * 64 + 16 * fq;
        if (u.kind == 0) {
            const int row0 = u.blk * 256 + wr * 64 + fr;
#pragma unroll
            for (int ai = 0; ai < 2; ++ai)
#pragma unroll
                for (int m = 0; m < 4; ++m) { unsigned char* rowp = Y + (size_t)(row0 + ai * 128 + m * 16) * D + col0;
                    unsigned w[4];
#pragma unroll
                    for (int bj = 0; bj < 2; ++bj)
#pragma unroll
                        for (int n = 0; n < 2; ++n) { f32x4 v = acc[ai][bj][m][n];
#pragma unroll
                            for (int j = 0; j < 4; ++j) v[j] = __builtin_amdgcn_fmed3f(v[j], -448.f, 448.f);
                            w[bj * 2 + n] = pk4_fp8(v[0], v[1], v[2], v[3]); }
                    *(v4u*)rowp = (v4u){w[0], w[1], w[2], w[3]}; }
        } else {
            const int row0 = u.pm * 256 + wr * 64 + fr;
#pragma unroll
            for (int ai = 0; ai < 2; ++ai)
#pragma unroll
                for (int m = 0; m < 4; ++m) { bf16* rowp = O + (size_t)(row0 + ai * 128 + m * 16) * (2 * D) + D + col0;
#pragma unroll
                    for (int bj = 0; bj < 2; ++bj) { const f32x4 v0 = acc[ai][bj][m][0] * Y_INV_SCALE, v1 = acc[ai][bj][m][1] * Y_INV_SCALE;
                        *(v4u*)(rowp + bj * 8) = (v4u){pk2(v0[0], v0[1]), pk2(v0[2], v0[3]), pk2(v1[0], v1[1]), pk2(v1[2], v1[3])}; } }
        }
    }
};

struct Args { const float* in[19]; float* out; unsigned char* ws; int ph_lo, ph_hi; };

struct Frame {
    LAS unsigned char* lds; int tid, lane, wave, G, bid;
    float* out; unsigned char* ws;
};

__device__ __forceinline__ void titem_load(const float* W, int N, int kb, int nb, int lane, float (&v)[32]) {
    const float* Wu = W + (size_t)(64 * kb) * N + 32 * nb;
    const unsigned loff = (unsigned)((lane >> 5) * N + (lane & 31)) * 4u;
#pragma unroll
    for (int i = 0; i < 32; ++i) v[i] = *(const float*)((const char*)(Wu + (size_t)(2 * i) * N) + loff);
}
template <bool FP8>
__device__ __forceinline__ void titem_store(const float (&v)[32], int K, void* WTv, int kb, int dst_row0, LAS float* scr, int lane, float wsc = W_SCALE) {
    const int k0 = 64 * kb;
#pragma unroll
    for (int i = 0; i < 32; ++i) { const int kk = 2 * i + (lane >> 5); scr[kk * 33 + (lane & 31)] = v[i]; }
    asm volatile("s_waitcnt lgkmcnt(0)" ::: "memory");
    const int c = lane & 7;
#pragma unroll
    for (int j = 0; j < 4; ++j) { const int n = (lane >> 3) + 8 * j; const LAS float* s = scr + (8 * c) * 33 + n;
        if (FP8) { v2u o; o.x = pk4_fp8(s[0 * 33] * wsc, s[1 * 33] * wsc, s[2 * 33] * wsc, s[3 * 33] * wsc);
            o.y = pk4_fp8(s[4 * 33] * wsc, s[5 * 33] * wsc, s[6 * 33] * wsc, s[7 * 33] * wsc);
            *(v2u*)((unsigned char*)WTv + (size_t)(dst_row0 + n) * K + k0 + 8 * c) = o; }
        else { v4u o; o.x = pk2(s[0 * 33], s[1 * 33]); o.y = pk2(s[2 * 33], s[3 * 33]); o.z = pk2(s[4 * 33], s[5 * 33]); o.w = pk2(s[6 * 33], s[7 * 33]);
            *(v4u*)((bf16*)WTv + (size_t)(dst_row0 + n) * K + k0 + 8 * c) = o; } }
    asm volatile("s_waitcnt lgkmcnt(0)" ::: "memory");
}
template <bool FP8>
__device__ __forceinline__ void transpose_item(const float* W, int K, int N, void* WT, int kb, int nb, int dst_row0, LAS float* scr, int lane, float wsc = W_SCALE) {
    float v[32]; titem_load(W, N, kb, nb, lane, v); titem_store<FP8>(v, K, WT, kb, dst_row0, scr, lane, wsc);
}
template <bool DOWN>
__device__ __forceinline__ void convert_expert(Frame& F, const float* Wa, const float* Wb, unsigned char* dst, int base = 0, int PER_WAVE = (DOWN ? 16 : 32)) {
    LAS float* scr = (LAS float*)(F.lds + F.wave * 16384);
    const int wv = F.wave;
    auto ld = [&](int i, float (&v)[32]) {
        if (!DOWN) titem_load((i >> 4) ? Wb : Wa, FF, i & 15, wv, F.lane, v);
        else titem_load(Wa, D, i >> 2, wv + 8 * (i & 3), F.lane, v); };
    auto st = [&](int i, const float (&v)[32]) {
        if (!DOWN) { const int n0 = wv * 32; titem_store<true>(v, D, dst, i & 15, (n0 >> 7) * 256 + ((i >> 4) ? 128 : 0) + (n0 & 127), scr, F.lane); }
        else titem_store<true>(v, FF, dst, i >> 2, (wv + 8 * (i & 3)) * 32, scr, F.lane, WD_SCALE); };
    float v0[32], v1[32], v2[32], v3[32];
    ld(base, v0); ld(base + 1, v1); ld(base + 2, v2);
    for (int i = 0; i < PER_WAVE; i += 4) {
        ld(base + i + 3, v3); st(base + i, v0);
        if (i + 4 < PER_WAVE) ld(base + i + 4, v0);
        st(base + i + 1, v1);
        if (i + 5 < PER_WAVE) ld(base + i + 5, v1);
        st(base + i + 2, v2);
        if (i + 6 < PER_WAVE) ld(base + i + 6, v2);
        st(base + i + 3, v3);
    }
}

__device__ __forceinline__ void chunk_load(Frame& F, unsigned ch, int wv, float (&v)[32]) {
    if (ch < QG_CHUNKS) { const int e = (int)(ch >> 4), i = (int)(ch & 15); titem_load(ld_ptr(F.lds, 12) + (size_t)e * D * FF, FF, i, wv, F.lane, v); }
    else { const unsigned c2 = ch - QG_CHUNKS; const int e = (int)(c2 >> 4), i = (int)(c2 & 15); titem_load(ld_ptr(F.lds, 14) + (size_t)e * FF * D, D, i >> 2, wv + 8 * (i & 3), F.lane, v); }
}
__device__ __forceinline__ void chunk_store(Frame& F, unsigned ch, int wv, const float (&v)[32], LAS float* scr) {
    if (ch < QG_CHUNKS) { const int e = (int)(ch >> 4), i = (int)(ch & 15), n0 = wv * 32;
        titem_store<true>(v, D, F.ws + WS_WGU_T + (size_t)e * 512 * D, i, (n0 >> 7) * 256 + (n0 & 127), scr, F.lane, W_SCALE); }
    else { const unsigned c2 = ch - QG_CHUNKS; const int e = (int)(c2 >> 4), i = (int)(c2 & 15);
        titem_store<true>(v, FF, F.ws + WS_WD_T + (size_t)e * D * FF, i >> 2, (wv + 8 * (i & 3)) * 32, scr, F.lane, WD_SCALE); }
}
__device__ __forceinline__ void convert_chunk(Frame& F, unsigned ch) {
    const int wv = __builtin_amdgcn_readfirstlane(F.wave);
    LAS float* scr = (LAS float*)(F.lds + wv * 16384);
    float va[32], vb[32];
    chunk_load(F, ch, wv, va); chunk_load(F, ch + 1, wv, vb);
    chunk_store(F, ch, wv, va, scr); chunk_store(F, ch + 1, wv, vb, scr);
}
__device__ __forceinline__ void xcd_barrier_work(const XcdBarrier& b, Frame& F, unsigned chunk_end) {
    asm volatile("s_waitcnt vmcnt(0)" ::: "memory");
    __syncthreads();
    volatile LAS unsigned* st = b.st;
    unsigned* bar = b.bar; unsigned* qd = (unsigned*)(F.ws + WS_CTL) + CW_QD;
    if (threadIdx.x == 0) {
        __builtin_amdgcn_s_waitcnt(0);
        unsigned nloc = st[0], nx = st[1];
        if (nloc == 0u) { xcd_barrier_complete(bar, b.x, nloc, nx); st[0] = nloc; st[1] = nx; }
        const unsigned old = xb_add(&bar[XB_XSUB(b.x)], 1u);
        const unsigned gen = old / nloc;
        if (old + 1u == (gen + 1u) * nloc) {
            __builtin_amdgcn_fence(__ATOMIC_RELEASE, "agent");
            asm volatile("s_waitcnt vmcnt(0)" ::: "memory");
            const unsigned og = xb_add(&bar[XB_TOP], 1u);
            const unsigned tg = og / nx;
            if (og + 1u == (tg + 1u) * nx) xb_add(&bar[XB_TOPGEN], 1u);
            else XB_SPIN(xb_ld(&bar[XB_TOPGEN]) == tg, bar);
            __builtin_amdgcn_fence(__ATOMIC_ACQUIRE, "agent");
            xb_add(&bar[XB_XGEN(b.x)], 1u);
            asm volatile("s_waitcnt vmcnt(0)" ::: "memory");
            st[3] = 1u; st[6] = 1u;
        } else { st[2] = gen; st[3] = 0u; st[6] = 0u; }
    }
    __syncthreads();
    unsigned spins = 0;
    while (st[3] == 0u) {
        if (threadIdx.x == 0) {
            if (xb_ld(&bar[XB_XGEN(b.x)]) != st[2]) st[3] = 1u;
            else { if (st[5] < chunk_end) st[5] = xb_add(qd, 2u);
                if ((++spins & 1023u) == 0u) { if (xb_ld(&bar[XB_TMO])) st[3] = 1u; else if (spins > XB_SPIN_CAP) { atomicAdd(&bar[XB_TMO], 1u); st[3] = 1u; } } }
        }
        __syncthreads();
        if (st[3] != 0u) break;
        const unsigned ch = st[5];
        if (ch < QD_CHUNKS) convert_chunk(F, ch); else __builtin_amdgcn_s_sleep(8);
        __syncthreads();
    }
    if (threadIdx.x == 0 && st[6] == 0u) { __builtin_amdgcn_fence(__ATOMIC_ACQUIRE, "agent"); asm volatile("s_waitcnt vmcnt(0)" ::: "memory"); }
    __syncthreads();
}
__device__ __forceinline__ void drain_queue(Frame& F, unsigned limit) {
    volatile LAS unsigned* MISC = (volatile LAS unsigned*)(F.lds + MISC_OFF); unsigned* qd = (unsigned*)(F.ws + WS_CTL) + CW_QD;
    for (;;) {
        __syncthreads();
        if (threadIdx.x == 0) { const bool more = MISC[13] < limit; MISC[15] = more ? 1u : 0u; if (more) MISC[13] = xb_add(qd, 2u); }
        __syncthreads();
        if (MISC[15] == 0u) break;
        const unsigned ch = MISC[13];
        if (ch < QD_CHUNKS) convert_chunk(F, ch);
        if (ch >= limit) break;
    }
    __syncthreads();
}

__device__ __forceinline__ void p0_prologue(Frame& F) {
#define INP(i) ld_ptr(F.lds, (i))
    if (F.bid < 192) {
        const float* cptr = INP(1); const float* w_ada = INP(2); const float* b_ada = INP(3);
        LAS float* cs = (LAS float*)F.lds;
        LAS float* red = (LAS float*)(F.lds + 32768);
        for (int i = F.tid; i < NB * D; i += NTHREADS) { const float v = cptr[i]; cs[i] = v / (1.f + __expf(-v)); }
        __syncthreads();
        const int col = F.tid & 31, kg = F.tid >> 5, j = F.bid * 32 + col;
        float a[NB];
#pragma unroll
        for (int b = 0; b < NB; ++b) a[b] = 0.f;
#pragma unroll 8
        for (int kk = 0; kk < 64; ++kk) { const int k = kg * 64 + kk; const float w = w_ada[(size_t)k * 6144 + j];
#pragma unroll
            for (int b = 0; b < NB; ++b) a[b] += cs[b * D + k] * w; }
#pragma unroll
        for (int b = 0; b < NB; ++b) red[(kg * NB + b) * 32 + col] = a[b];
        __syncthreads();
        if (F.tid < 256) { const int b = F.tid >> 5, cc = F.tid & 31; float s = 0.f;
#pragma unroll
            for (int g = 0; g < 16; ++g) s += red[(g * NB + b) * 32 + cc];
            ((float*)(F.ws + WS_MOD))[b * 6144 + F.bid * 32 + cc] = s + b_ada[F.bid * 32 + cc]; }
        __syncthreads();
    }
    if (F.bid == F.G - 1) { const float* pw = INP(6); bf16* pwt = (bf16*)(F.ws + WS_PWT);
        for (int i = F.tid; i < 4 * 64 * 64; i += NTHREADS) { const int g = i >> 12, d = (i >> 6) & 63, c = i & 63; pwt[i] = (bf16)f2bf(pw[(g * 64 + c) * 64 + d]); } }
    LAS float* scr = (LAS float*)(F.lds + F.wave * 16384);
    const int gw = F.bid * NWAVES + F.wave, NGW = F.G * NWAVES;
    constexpr int I_IN = 16 * 80, I_OUT = 8 * 32, I_R = 16 * 8, I_G = 16 * 8, I_D = 4 * 32;
    constexpr int I_SMALL = I_IN + I_OUT + I_R + 2 * I_G + I_D, I_EXP = 2 * I_G + I_D;
    constexpr int NITEMS = I_SMALL;
    unsigned char* win_t = F.ws + WS_WIN_T; bf16* wout_t = (bf16*)(F.ws + WS_WOUT_T); bf16* wr_t = (bf16*)(F.ws + WS_WR_T);
    unsigned char* wsgu_t = F.ws + WS_WSGU_T; unsigned char* wsd_t = F.ws + WS_WSD_T; unsigned char* wgu_t = F.ws + WS_WGU_T; unsigned char* wd_t = F.ws + WS_WD_T;
    for (int it = gw; it < NITEMS; it += NGW) {
        int r = it;
        if (r < I_IN) { transpose_item<false>(INP(5), D, NPROJ, win_t, r / 80, r % 80, (r % 80) * 32, scr, F.lane); continue; } r -= I_IN;
        if (r < I_OUT) { transpose_item<false>(INP(8), NMIX, D, wout_t, r / 32, r % 32, (r % 32) * 32, scr, F.lane); continue; } r -= I_OUT;
        if (r < I_R) { transpose_item<false>(INP(10), D, NE, wr_t, r / 8, r % 8, (r % 8) * 32, scr, F.lane); continue; } r -= I_R;
        const float *Wg, *Wu, *Wd; unsigned char *GU, *DN;
        if (r < 2 * I_G + I_D) { Wg = INP(15); Wu = INP(16); Wd = INP(17); GU = wsgu_t; DN = wsd_t; }
        else { r -= 2 * I_G + I_D; const int e = r / I_EXP; r -= e * I_EXP;
            Wg = INP(12) + (size_t)e * D * FF; Wu = INP(13) + (size_t)e * D * FF; Wd = INP(14) + (size_t)e * FF * D;
            GU = wgu_t + (size_t)e * 512 * D; DN = wd_t + (size_t)e * D * FF; }
        if (r < I_G) { const int nb = r % 8, n0 = nb * 32; transpose_item<true>(Wg, D, FF, GU, r / 8, nb, (n0 >> 7) * 256 + (n0 & 127), scr, F.lane); continue; } r -= I_G;
        if (r < I_G) { const int nb = r % 8, n0 = nb * 32; transpose_item<true>(Wu, D, FF, GU, r / 8, nb, (n0 >> 7) * 256 + 128 + (n0 & 127), scr, F.lane); continue; } r -= I_G;
        transpose_item<true>(Wd, FF, D, DN, r / 32, r % 32, (r % 32) * 32, scr, F.lane, WD_SCALE);
    }
#undef INP
}

template <bool HAS_DX, bool OUT8, bool OUTB>
__device__ __forceinline__ void modnorm_phase(Frame& F, const float* X, const float* g, int shift_chunk, unsigned char* O8, bf16* Ob) {
    const float* mod = (const float*)(F.ws + WS_MOD);
    constexpr int RW = 4;
    const unsigned l16 = (unsigned)F.lane * 16u, l8 = (unsigned)F.lane * 8u, l4 = (unsigned)F.lane * 4u;
    const int wv = __builtin_amdgcn_readfirstlane(F.wave);
    for (int blk = F.bid; blk < NT / 128; blk += F.G) {
        const int b = (blk * 128) >> 12;
        const float* sh = mod + (size_t)b * 6144 + shift_chunk * D; const float* sc = sh + D; const float* g1 = mod + (size_t)b * 6144 + 2 * D;
        f32x4 gg[4], ss[4], ga[4];
#pragma unroll
        for (int j = 0; j < 4; ++j) { const f32x4 gv = *(const f32x4*)((const char*)g + 1024 * j + l16), scv = *(const f32x4*)((const char*)sc + 1024 * j + l16);
            gg[j] = gv * (scv + 1.f); ss[j] = *(const f32x4*)((const char*)sh + 1024 * j + l16); ga[j] = HAS_DX ? *(const f32x4*)((const char*)g1 + 1024 * j + l16) : (f32x4){0.f, 0.f, 0.f, 0.f}; }
#pragma nounroll
        for (int rr = 0; rr < 16; rr += RW) {
            const int row = blk * 128 + wv * 16 + rr;
            f32x4 v[RW][4]; v2u dv[RW][4];
#pragma unroll
            for (int q = 0; q < RW; ++q) { const char* xr = (const char*)(X + (size_t)(row + q) * D);
#pragma unroll
                for (int j = 0; j < 4; ++j) v[q][j] = *(const f32x4*)(xr + 1024 * j + l16);
                if (HAS_DX) { const char* dr = (const char*)F.out + (size_t)(row + q) * (4 * D);
#pragma unroll
                    for (int j = 0; j < 4; ++j) dv[q][j] = *(const v2u*)(dr + 512 * j + l8); } }
#pragma unroll
            for (int q = 0; q < RW; ++q) { float s = 0.f;
#pragma unroll
                for (int j = 0; j < 4; ++j) {
                    if (HAS_DX) v[q][j] = v[q][j] + ga[j] * (f32x4){bflo(dv[q][j].x), bfhi(dv[q][j].x), bflo(dv[q][j].y), bfhi(dv[q][j].y)};
                    s += (v[q][j].x * v[q][j].x + v[q][j].y * v[q][j].y) + (v[q][j].z * v[q][j].z + v[q][j].w * v[q][j].w); }
                const float rstd = 1.f / sqrtf(wave_sum(s) * (1.f / D) + NORM_EPS);
                if (HAS_DX) { char* xo = (char*)F.out + (size_t)(row + q) * (4 * D);
#pragma unroll
                    for (int j = 0; j < 4; ++j) *(v2u*)(xo + 512 * j + l8) = (v2u){pk2(v[q][j].x, v[q][j].y), pk2(v[q][j].z, v[q][j].w)}; }
                char* o8 = (char*)O8 + (size_t)(row + q) * D; char* ob = (char*)Ob + (size_t)(row + q) * (2 * D);
#pragma unroll
                for (int j = 0; j < 4; ++j) { const f32x4 y = v[q][j] * rstd * gg[j] + ss[j]; if (OUT8) *(unsigned*)(o8 + 256 * j + l4) = pk4_fp8(y.x, y.y, y.z, y.w);
                    if (OUTB) *(v2u*)(ob + 512 * j + l8) = (v2u){pk2(y.x, y.y), pk2(y.z, y.w)}; }
                __builtin_amdgcn_sched_barrier(0); }
        }
    }
}

constexpr int POOL_T = 64, POOL_PITCH = 528;
__device__ __forceinline__ void pool_phase(Frame& F, const float* pool_scale) {
    const bf16* proj = (const bf16*)(F.ws + WS_PROJ); bf16* mixin = (bf16*)(F.ws + WS_MIXIN); const bf16* pwt = (const bf16*)(F.ws + WS_PWT);
    LAS unsigned char* us = F.lds;
    LAS unsigned char* pl = F.lds + 80 * POOL_PITCH;
    const int lane = F.lane, fr = lane & 15, fq = lane >> 4;
    for (int tile = F.bid; tile < NT / POOL_T; tile += F.G) {
        const int row0 = tile * POOL_T, tl0 = row0 & (SEQ - 1);
        __syncthreads();
        for (int p = F.tid; p < (POOL_T + 15) * 32; p += NTHREADS) { const int rr = p >> 5, pc = p & 31; const int tl = tl0 - 15 + rr;
            v4u raw = (v4u){0u, 0u, 0u, 0u};
            if (tl >= 0) raw = *(const v4u*)(proj + (size_t)(row0 - 15 + rr) * NPROJ + pc * 8);
            *(LAS v4u*)(us + rr * POOL_PITCH + pc * 16) = raw; }
        __syncthreads();
        {
            const int c8 = F.tid & 31, q = F.tid >> 5, w = 2 << (c8 >> 3);
            float sm[8];
#pragma unroll
            for (int e = 0; e < 8; ++e) sm[e] = 0.f;
            const int i0 = 15 + q * 4;
            for (int k = 0; k < w; ++k) { const v4u r = *(const LAS v4u*)(us + (i0 - k) * POOL_PITCH + c8 * 16);
                sm[0] += bflo(r.x); sm[1] += bfhi(r.x); sm[2] += bflo(r.y); sm[3] += bfhi(r.y); sm[4] += bflo(r.z); sm[5] += bfhi(r.z); sm[6] += bflo(r.w); sm[7] += bfhi(r.w); }
#pragma unroll
            for (int i = 0; i < 4; ++i) { const int tt = q * 4 + i, tl = tl0 + tt;
                const v4u cur = *(const LAS v4u*)(us + (15 + tt) * POOL_PITCH + c8 * 16);
                if (i > 0) { const v4u old = *(const LAS v4u*)(us + (15 + tt - w) * POOL_PITCH + c8 * 16);
                    sm[0] += bflo(cur.x) - bflo(old.x); sm[1] += bfhi(cur.x) - bfhi(old.x); sm[2] += bflo(cur.y) - bflo(old.y); sm[3] += bfhi(cur.y) - bfhi(old.y);
                    sm[4] += bflo(cur.z) - bflo(old.z); sm[5] += bfhi(cur.z) - bfhi(old.z); sm[6] += bflo(cur.w) - bflo(old.w); sm[7] += bfhi(cur.w) - bfhi(old.w); }
                const float ic = 1.f / (float)((tl + 1) < w ? (tl + 1) : w);
                v4u o; o.x = pk2(sm[0] * ic - bflo(cur.x), sm[1] * ic - bfhi(cur.x)); o.y = pk2(sm[2] * ic - bflo(cur.y), sm[3] * ic - bfhi(cur.y));
                o.z = pk2(sm[4] * ic - bflo(cur.z), sm[5] * ic - bfhi(cur.z)); o.w = pk2(sm[6] * ic - bflo(cur.w), sm[7] * ic - bfhi(cur.w));
                *(LAS v4u*)(pl + tt * POOL_PITCH + c8 * 16) = o; }
        }
        __syncthreads();
        {
            const int g = F.wave >> 1, mh = F.wave & 1;
            bf16x8 af[2][2], bfr[4][2];
#pragma unroll
            for (int mt = 0; mt < 2; ++mt)
#pragma unroll
                for (int k = 0; k < 2; ++k) af[mt][k] = *(const LAS bf16x8*)(pl + (32 * mh + 16 * mt + fr) * POOL_PITCH + (g * 64 + k * 32 + fq * 8) * 2);
#pragma unroll
            for (int nt = 0; nt < 4; ++nt)
#pragma unroll
                for (int k = 0; k < 2; ++k) bfr[nt][k] = *(const bf16x8*)(pwt + ((size_t)(g * 64 + nt * 16 + fr) * 64 + k * 32 + fq * 8));
#pragma unroll
            for (int mt = 0; mt < 2; ++mt)
#pragma unroll
                for (int nt = 0; nt < 4; ++nt) { f32x4 acc = (f32x4){0.f, 0.f, 0.f, 0.f};
                    acc = __builtin_amdgcn_mfma_f32_16x16x32_bf16(bfr[nt][0], af[mt][0], acc, 0, 0, 0);
                    acc = __builtin_amdgcn_mfma_f32_16x16x32_bf16(bfr[nt][1], af[mt][1], acc, 0, 0, 0);
                    const int col = g * 64 + nt * 16 + 4 * fq; const f32x4 sc = *(const f32x4*)(pool_scale + col);
                    const f32x4 o = acc * sc;
                    *(v2u*)(mixin + (size_t)(row0 + 32 * mh + 16 * mt + fr) * NMIX + col) = (v2u){pk2(o.x, o.y), pk2(o.z, o.w)}; }
        }
    }
}

constexpr int KV_PITCH = 144;
__device__ __forceinline__ void attn_phase(Frame& F) {
    const bf16* proj = (const bf16*)(F.ws + WS_PROJ);
    bf16* atto = (bf16*)(F.ws + WS_ATTO); float* lse = (float*)(F.ws + WS_LSE);
    LAS unsigned char* Ks = F.lds; LAS unsigned char* Vs = F.lds + 256 * KV_PITCH;
    const int lane = F.lane, fr = lane & 15, fq = lane >> 4, w = F.wave;
    const int w_i0 = 16 * w, c0 = w >> 1, qi = w_i0 + fr;
#define ATT_DECODE(unit_, rowb_, d_, r_, n_, g_, h_, colQ_) \
        const int rn_##unit_ = (unit_) & 31; const int h_ = ((unit_) >> 5) & 3, g_ = ((unit_) >> 7) % 3; const size_t rowb_ = (size_t)((unit_) / 384) * SEQ; \
        const int d_ = 1 << (2 * g_), nbk_##unit_ = 32 >> (2 * g_), r_ = rn_##unit_ / nbk_##unit_, n_ = rn_##unit_ % nbk_##unit_; const int colQ_ = 256 + g_ * 256 + h_ * 64;
    v4u kreg[4], vreg[4]; bf16x8 qn[2];
    {   const int unit0 = F.bid;
        if (unit0 < NB * 3 * 4 * 32) { ATT_DECODE(unit0, rowb, d, r, n, g, h, colQ)
            const size_t qrow = rowb + (size_t)(n * 128 + qi) * d + r;
#pragma unroll
            for (int ks = 0; ks < 2; ++ks) qn[ks] = *(const bf16x8*)(proj + qrow * NPROJ + colQ + ks * 32 + fq * 8);
#pragma unroll
            for (int cidx = 0; cidx < 4; ++cidx) { const int ch = F.tid + 512 * cidx, j = ch >> 3, pc = ch & 7;
                int p = (n - 1) * 128 + j; p = p < 0 ? 0 : p; const size_t row = rowb + (size_t)p * d + r;
                kreg[cidx] = *(const v4u*)(proj + row * NPROJ + colQ + 768 + pc * 8); vreg[cidx] = *(const v4u*)(proj + row * NPROJ + colQ + 1536 + pc * 8); } } }
    for (int unit = F.bid; unit < NB * 3 * 4 * 32; unit += F.G) {
        ATT_DECODE(unit, rowb, d, r, n, g, h, colQ)
        __syncthreads();
#pragma unroll
        for (int cidx = 0; cidx < 4; ++cidx) { const int ch = F.tid + 512 * cidx, j = ch >> 3, pc = ch & 7;
            *(LAS v4u*)(Ks + j * KV_PITCH + pc * 16) = kreg[cidx]; *(LAS v4u*)(Vs + j * KV_PITCH + pc * 16) = vreg[cidx]; }
        const size_t qrow = rowb + (size_t)(n * 128 + qi) * d + r;
        bf16x8 qf[2]; qf[0] = qn[0]; qf[1] = qn[1];
        __syncthreads();
        {   const int unit2 = unit + F.G;
            if (unit2 < NB * 3 * 4 * 32) { ATT_DECODE(unit2, rowb2, d2, r2, n2, g2, h2, colQ2)
                const size_t qrow2 = rowb2 + (size_t)(n2 * 128 + qi) * d2 + r2;
#pragma unroll
                for (int ks = 0; ks < 2; ++ks) qn[ks] = *(const bf16x8*)(proj + qrow2 * NPROJ + colQ2 + ks * 32 + fq * 8);
#pragma unroll
                for (int cidx = 0; cidx < 4; ++cidx) { const int ch = F.tid + 512 * cidx, j = ch >> 3, pc = ch & 7;
                    int p = (n2 - 1) * 128 + j; p = p < 0 ? 0 : p; const size_t row = rowb2 + (size_t)p * d2 + r2;
                    kreg[cidx] = *(const v4u*)(proj + row * NPROJ + colQ2 + 768 + pc * 8); vreg[cidx] = *(const v4u*)(proj + row * NPROJ + colQ2 + 1536 + pc * 8); } } }
        f32x4 s[5][2];
#pragma unroll
        for (int cc = 0; cc < 5; ++cc)
#pragma unroll
            for (int hh = 0; hh < 2; ++hh) {
                const int j = 32 * (c0 + cc) + 8 * (fr >> 2) + 4 * hh + (fr & 3);
                const bf16x8 k0 = *(const LAS bf16x8*)(Ks + j * KV_PITCH + fq * 16), k1 = *(const LAS bf16x8*)(Ks + j * KV_PITCH + 64 + fq * 16);
                f32x4 a = (f32x4){0.f, 0.f, 0.f, 0.f};
                a = __builtin_amdgcn_mfma_f32_16x16x32_bf16(k0, qf[0], a, 0, 0, 0);
                a = __builtin_amdgcn_mfma_f32_16x16x32_bf16(k1, qf[1], a, 0, 0, 0);
                s[cc][hh] = a;
            }
        float mx = -1e30f;
        int qil = qi; asm volatile("" : "+v"(qil));
#pragma unroll
        for (int cc = 0; cc < 5; ++cc)
#pragma unroll
            for (int hh = 0; hh < 2; ++hh)
#pragma unroll
                for (int rr = 0; rr < 4; ++rr) { const int j = 32 * (c0 + cc) + 8 * fq + 4 * hh + rr; const int dist = 128 + qil - j;
                    const bool valid = (dist >= 0) && (dist <= 128) && (n > 0 || j >= 128);
                    const float v = valid ? s[cc][hh][rr] * 0.18033688f : -1e30f; s[cc][hh][rr] = v; mx = fmaxf(mx, v); }
        mx = fmaxf(mx, __shfl_xor(mx, 16)); mx = fmaxf(mx, __shfl_xor(mx, 32));
        float l = 0.f;
#pragma unroll
        for (int cc = 0; cc < 5; ++cc)
#pragma unroll
            for (int hh = 0; hh < 2; ++hh)
#pragma unroll
                for (int rr = 0; rr < 4; ++rr) { const float p = __builtin_amdgcn_exp2f(s[cc][hh][rr] - mx); s[cc][hh][rr] = p; l += p; }
        l += __shfl_xor(l, 16); l += __shfl_xor(l, 32);
        f32x4 o[4];
#pragma unroll
        for (int eb = 0; eb < 4; ++eb) o[eb] = (f32x4){0.f, 0.f, 0.f, 0.f};
#pragma unroll
        for (int cc = 0; cc < 5; ++cc) {
            const v4u pu = (v4u){pk2(s[cc][0][0], s[cc][0][1]), pk2(s[cc][0][2], s[cc][0][3]), pk2(s[cc][1][0], s[cc][1][1]), pk2(s[cc][1][2], s[cc][1][3])};
            const bf16x8 pf = __builtin_bit_cast(bf16x8, pu);
            const int key0 = 32 * (c0 + cc) + 8 * fq + (fr >> 2);
#pragma unroll
            for (int eb = 0; eb < 4; ++eb) {
                const LAS unsigned char* vp = Vs + key0 * KV_PITCH + (16 * eb + 4 * (fr & 3)) * 2;
                const s16x4 lo = __builtin_bit_cast(s16x4, __builtin_amdgcn_ds_read_tr16_b64_v4i16((LAS s16x4*)vp));
                const s16x4 hi = __builtin_bit_cast(s16x4, __builtin_amdgcn_ds_read_tr16_b64_v4i16((LAS s16x4*)(vp + 4 * KV_PITCH)));
                const bf16x8 vf = (bf16x8){lo[0], lo[1], lo[2], lo[3], hi[0], hi[1], hi[2], hi[3]};
                o[eb] = __builtin_amdgcn_mfma_f32_16x16x32_bf16(vf, pf, o[eb], 0, 0, 0);
            }
        }
        const float il = 1.f / l;
        bf16* op = atto + ((size_t)g * NT + qrow) * 256 + h * 64 + 4 * fq;
#pragma unroll
        for (int eb = 0; eb < 4; ++eb) { const f32x4 v = o[eb] * il; *(v2u*)(op + 16 * eb) = (v2u){pk2(v.x, v.y), pk2(v.z, v.w)}; }
        if (fq == 0) lse[((size_t)g * NT + qrow) * 4 + h] = mx + __builtin_amdgcn_logf(l);
    }
#undef ATT_DECODE
}

__device__ __forceinline__ void combine_phase(Frame& F) {
    const bf16* atto = (const bf16*)(F.ws + WS_ATTO); const float* lse = (const float*)(F.ws + WS_LSE); bf16* mixin = (bf16*)(F.ws + WS_MIXIN);
    for (size_t idx = (size_t)F.bid * NTHREADS + F.tid; idx < (size_t)NT * 32; idx += (size_t)F.G * NTHREADS) {
        const size_t t = idx >> 5; const int pc = (int)(idx & 31), h = pc >> 3;
        const float l0 = lse[(0 * (size_t)NT + t) * 4 + h], l1 = lse[(1 * (size_t)NT + t) * 4 + h], l2 = lse[(2 * (size_t)NT + t) * 4 + h];
        const float m = fmaxf(l0, fmaxf(l1, l2));
        float a0 = __builtin_amdgcn_exp2f(l0 - m), a1 = __builtin_amdgcn_exp2f(l1 - m), a2 = __builtin_amdgcn_exp2f(l2 - m);
        const float inv = 1.f / (a0 + a1 + a2); a0 *= inv; a1 *= inv; a2 *= inv;
        const v4u v0 = *(const v4u*)(atto + (0 * (size_t)NT + t) * 256 + pc * 8), v1 = *(const v4u*)(atto + (1 * (size_t)NT + t) * 256 + pc * 8), v2 = *(const v4u*)(atto + (2 * (size_t)NT + t) * 256 + pc * 8);
        v4u o;
        o.x = pk2(a0 * bflo(v0.x) + a1 * bflo(v1.x) + a2 * bflo(v2.x), a0 * bfhi(v0.x) + a1 * bfhi(v1.x) + a2 * bfhi(v2.x));
        o.y = pk2(a0 * bflo(v0.y) + a1 * bflo(v1.y) + a2 * bflo(v2.y), a0 * bfhi(v0.y) + a1 * bfhi(v1.y) + a2 * bfhi(v2.y));
        o.z = pk2(a0 * bflo(v0.z) + a1 * bflo(v1.z) + a2 * bflo(v2.z), a0 * bfhi(v0.z) + a1 * bfhi(v1.z) + a2 * bfhi(v2.z));
        o.w = pk2(a0 * bflo(v0.w) + a1 * bflo(v1.w) + a2 * bflo(v2.w), a0 * bfhi(v0.w) + a1 * bfhi(v1.w) + a2 * bfhi(v2.w));
        *(v4u*)(mixin + t * NMIX + 256 + pc * 8) = o;
    }
}

#if MK_NAIVE_ATTN
__device__ __forceinline__ void naive_attn_phase(Frame& F) {
    const bf16* proj = (const bf16*)(F.ws + WS_PROJ); bf16* mixin = (bf16*)(F.ws + WS_MIXIN);
    for (size_t idx = (size_t)F.bid * NTHREADS + F.tid; idx < (size_t)NT * 4; idx += (size_t)F.G * NTHREADS) {
        const size_t tg = idx >> 2; const int h = (int)(idx & 3), t = (int)(tg & (SEQ - 1)); const size_t rowb = tg - t;
        float m = -1e30f, l = 0.f, o[64];
        for (int e = 0; e < 64; ++e) o[e] = 0.f;
        for (int g = 0; g < 3; ++g) { const int d = 1 << (2 * g); const int colQ = 256 + g * 256 + h * 64;
            const bf16* q = proj + tg * NPROJ + colQ;
            for (int j = 0; j <= 128; ++j) { const int tk = t - j * d; if (tk < 0) break;
                const bf16* k = proj + (rowb + tk) * NPROJ + colQ + 768; const bf16* v = k + 768;
                float sdot = 0.f; for (int e = 0; e < 64; ++e) sdot += bf2f(q[e]) * bf2f(k[e]);
                sdot *= 0.125f;
                const float mn = fmaxf(m, sdot), corr = __expf(m - mn), p = __expf(sdot - mn);
                l = l * corr + p; for (int e = 0; e < 64; ++e) o[e] = o[e] * corr + p * bf2f(v[e]); m = mn; } }
        const float il = 1.f / l;
        for (int e = 0; e < 64; ++e) mixin[tg * NMIX + 256 + h * 64 + e] = (bf16)f2bf(o[e] * il);
    }
}
#endif

__device__ __forceinline__ void routing_phase(Frame& F, const float* router_bias) {
    const float* L0 = (const float*)(F.ws + WS_LOGIT); const float* L1 = L0 + (size_t)NT * NE;
    float* gatew = (float*)(F.ws + WS_GATEW); unsigned* bucket = (unsigned*)(F.ws + WS_BUCKET); unsigned* gcnt = (unsigned*)(F.ws + WS_CTL) + CW_GCNT;
    LAS unsigned* hist = (LAS unsigned*)F.lds; LAS unsigned* basel = hist + 256; LAS unsigned* asg = hist + 512;
    const int lane = F.lane;
    for (int blk = F.bid; blk < NT / 128; blk += F.G) {
        __syncthreads();
        if (F.tid < 256) hist[F.tid] = 0u;
        __syncthreads();
        const f32x4 bias = *(const f32x4*)(router_bias + 4 * lane);
        f32x4 lgn; { const size_t t0 = (size_t)blk * 128 + F.wave * 16; lgn = *(const f32x4*)(L0 + t0 * NE + 4 * lane) + *(const f32x4*)(L1 + t0 * NE + 4 * lane); }
#pragma nounroll
        for (int tl = 0; tl < 16; ++tl) {
            const int tloc = F.wave * 16 + tl; const size_t t = (size_t)blk * 128 + tloc;
            const f32x4 lg = lgn;
            if (tl + 1 < 16) lgn = *(const f32x4*)(L0 + (t + 1) * NE + 4 * lane) + *(const f32x4*)(L1 + (t + 1) * NE + 4 * lane);
            float sc[4], cd[4];
#pragma unroll
            for (int i = 0; i < 4; ++i) { sc[i] = 1.f / (1.f + __expf(-lg[i])); cd[i] = sc[i] + bias[i]; }
            float a1 = fmaxf(cd[0], cd[1]), a2 = fminf(cd[0], cd[1]);
#pragma unroll
            for (int i = 2; i < 4; ++i) { const float v = cd[i]; a2 = fmaxf(a2, fminf(a1, v)); a1 = fmaxf(a1, v); }
            { float b1 = dppf<0xB1>(a1), b2 = dppf<0xB1>(a2); float n1 = fmaxf(a1, b1), n2 = fmaxf(fminf(a1, b1), fmaxf(a2, b2)); a1 = n1; a2 = n2;
              b1 = dppf<0x4E>(a1); b2 = dppf<0x4E>(a2); n1 = fmaxf(a1, b1); n2 = fmaxf(fminf(a1, b1), fmaxf(a2, b2)); a1 = n1; a2 = n2;
              b1 = dppf<0x141>(a1); b2 = dppf<0x141>(a2); n1 = fmaxf(a1, b1); n2 = fmaxf(fminf(a1, b1), fmaxf(a2, b2)); a1 = n1; a2 = n2; }
            const float gs = a1 + a2; const int myg = lane >> 3; int rank = 0;
#pragma unroll
            for (int gg = 0; gg < 8; ++gg) { const float o = __builtin_bit_cast(float, __builtin_amdgcn_readlane(__builtin_bit_cast(int, gs), gg * 8)); rank += (o > gs || (o == gs && gg < myg)) ? 1 : 0; }
            if (rank >= 4) {
#pragma unroll
                for (int i = 0; i < 4; ++i) cd[i] = -1e30f; }
            int sel_e = 0; float sel_s = 0.f, ssum = 0.f;
#pragma unroll
            for (int k = 0; k < TOPK; ++k) {
                const float lm = fmaxf(fmaxf(cd[0], cd[1]), fmaxf(cd[2], cd[3]));
                float v = fmaxf(lm, dppf<0xB1>(lm)); v = fmaxf(v, dppf<0x4E>(v)); v = fmaxf(v, dppf<0x141>(v)); v = fmaxf(v, dppf<0x140>(v));
                const float r0 = __builtin_bit_cast(float, __builtin_amdgcn_readlane(__builtin_bit_cast(int, v), 0)), r1 = __builtin_bit_cast(float, __builtin_amdgcn_readlane(__builtin_bit_cast(int, v), 16));
                const float r2 = __builtin_bit_cast(float, __builtin_amdgcn_readlane(__builtin_bit_cast(int, v), 32)), r3 = __builtin_bit_cast(float, __builtin_amdgcn_readlane(__builtin_bit_cast(int, v), 48));
                const float mx = fmaxf(fmaxf(r0, r1), fmaxf(r2, r3));
                const unsigned long long msk = __ballot(lm == mx);
                const int own = __builtin_ffsll((long long)msk) - 1;
                const int bi = cd[0] == mx ? 0 : (cd[1] == mx ? 1 : (cd[2] == mx ? 2 : 3));
                float myv = sc[0]; myv = bi == 1 ? sc[1] : myv; myv = bi == 2 ? sc[2] : myv; myv = bi == 3 ? sc[3] : myv;
                const int wi = __builtin_amdgcn_readlane(bi, own);
                const float sv = __builtin_bit_cast(float, __builtin_amdgcn_readlane(__builtin_bit_cast(int, myv), own));
                if (lane == own) {
#pragma unroll
                    for (int i = 0; i < 4; ++i) if (wi == i) cd[i] = -1e30f; }
                ssum += sv;
                if (lane == k) { sel_e = 4 * own + wi; sel_s = sv; }
            }
            if (lane < TOPK) {
                const unsigned rk = __hip_atomic_fetch_add(hist + sel_e, 1u, __ATOMIC_RELAXED, __HIP_MEMORY_SCOPE_WORKGROUP);
                asg[tloc * 8 + lane] = (unsigned)sel_e | (rk << 16);
                gatew[t * 8 + lane] = sel_s / ssum * 2.5f;
            }
        }
        __syncthreads();
        if (F.tid < 256) { const unsigned c = hist[F.tid]; basel[F.tid] = c ? atomicAdd(&gcnt[F.tid * 16], c) : 0u; }
        __syncthreads();
        for (int a = F.tid; a < 1024; a += NTHREADS) { const unsigned v = asg[a], e = v & 0xffffu, rk = v >> 16;
            bucket[(size_t)e * CAP + basel[e] + rk] = (unsigned)(blk * 1024 + a); }
    }
}

__device__ __forceinline__ void build_tables(Frame& F, int& nblk_total) {
    const unsigned* gcnt = (const unsigned*)(F.ws + WS_CTL) + CW_GCNT;
    LAS int* prefix = (LAS int*)(F.lds + TAB_OFF); LAS int* cnt = prefix + 260;
    __syncthreads();
    if (F.tid < 256) cnt[F.tid] = (int)__hip_atomic_load(&gcnt[F.tid * 16], __ATOMIC_RELAXED, __HIP_MEMORY_SCOPE_AGENT);
    __syncthreads();
    if (F.tid < 64) {
        int nb[4], sm = 0;
#pragma unroll
        for (int i = 0; i < 4; ++i) { nb[i] = (cnt[4 * F.tid + i] + 255) >> 8; sm += nb[i]; }
        int inc = sm;
#pragma unroll
        for (int o = 1; o < 64; o <<= 1) { const int t = __shfl_up(inc, o); if (F.tid >= o) inc += t; }
        int ex = inc - sm;
#pragma unroll
        for (int i = 0; i < 4; ++i) { prefix[4 * F.tid + i] = ex; ex += nb[i]; }
        if (F.tid == 63) prefix[NE] = inc;
    }
    __syncthreads();
    if (F.tid < 256) { LAS unsigned char* b2e = (LAS unsigned char*)(cnt + 256); for (int b = prefix[F.tid]; b < prefix[F.tid + 1]; ++b) b2e[b] = (unsigned char)F.tid; }
    __syncthreads();
    nblk_total = prefix[NE];
}

__device__ __forceinline__ void final_phase(Frame& F, const float* g_final) {
    const float* mod = (const float*)(F.ws + WS_MOD); const unsigned char* Y = (const unsigned char*)(F.ws + WS_Y);
    const unsigned* pos = (const unsigned*)(F.ws + WS_POS); const float* gatew = (const float*)(F.ws + WS_GATEW);
    const int c0 = 16 * F.lane;
    for (int blk = F.bid; blk < NT / 128; blk += F.G) {
        const int b = (blk * 128) >> 12; const float* g2 = mod + (size_t)b * 6144 + 5 * D + c0;
        f32x4 gb[4];
#pragma unroll
        for (int j = 0; j < 4; ++j) gb[j] = *(const f32x4*)(g2 + 4 * j);
        const size_t rowbase = (size_t)blk * 128 + F.wave * 16;
        const unsigned p0 = pos[rowbase * 8 + F.lane], p1 = pos[rowbase * 8 + 64 + F.lane];
        const float w0 = gatew[rowbase * 8 + F.lane] * Y_INV_SCALE, w1 = gatew[rowbase * 8 + 64 + F.lane] * Y_INV_SCALE;
#pragma nounroll
        for (int rr = 0; rr < 16; ++rr) {
            const size_t row = rowbase + rr;
            const v4u* dr = (const v4u*)((const bf16*)F.out + row * (2 * D) + c0);
            v4u xv[2], sv[2], yv[TOPK]; float wk[TOPK];
            xv[0] = dr[0]; xv[1] = dr[1]; sv[0] = dr[128]; sv[1] = dr[129];
#pragma unroll
            for (int k = 0; k < TOPK; ++k) { const int idx = rr * 8 + k;
                const unsigned pk = (unsigned)__builtin_amdgcn_readlane((int)(idx < 64 ? p0 : p1), idx & 63);
                wk[k] = __builtin_bit_cast(float, __builtin_amdgcn_readlane(__builtin_bit_cast(int, idx < 64 ? w0 : w1), idx & 63));
                yv[k] = *(const v4u*)(Y + (size_t)pk * D + c0); }
            f32x4 v[4]; float s = 0.f;
#pragma unroll
            for (int j = 0; j < 4; ++j) {
                const unsigned sw0 = sv[j >> 1][(j & 1) * 2], sw1 = sv[j >> 1][(j & 1) * 2 + 1];
                f32x4 r = (f32x4){bflo(sw0), bfhi(sw0), bflo(sw1), bfhi(sw1)};
#pragma unroll
                for (int k = 0; k < TOPK; ++k) { const int wd = (int)yv[k][j];
                    const auto lo = __builtin_amdgcn_cvt_pk_f32_fp8(wd, false), hi = __builtin_amdgcn_cvt_pk_f32_fp8(wd, true);
                    r += wk[k] * (f32x4){lo[0], lo[1], hi[0], hi[1]}; }
                const unsigned xw0 = xv[j >> 1][(j & 1) * 2], xw1 = xv[j >> 1][(j & 1) * 2 + 1];
                v[j] = (f32x4){bflo(xw0), bfhi(xw0), bflo(xw1), bfhi(xw1)} + gb[j] * r;
                s += (v[j].x * v[j].x + v[j].y * v[j].y) + (v[j].z * v[j].z + v[j].w * v[j].w); }
            const float rstd = 1.f / sqrtf(wave_sum(s) * (1.f / D) + NORM_EPS);
            f32x4* orow = (f32x4*)(F.out + row * D + c0);
#pragma unroll
            for (int j = 0; j < 4; ++j) orow[j] = v[j] * rstd * *(const f32x4*)(g_final + c0 + 4 * j);
        }
    }
}

constexpr int N_PHASES = 12;
__global__ void __launch_bounds__(NTHREADS, 2) fwd(Args args) {
    extern __shared__ __attribute__((aligned(16))) unsigned char lds_raw[];
    Frame F;
    F.lds = (LAS unsigned char*)lds_raw;
    F.tid = threadIdx.x; F.lane = F.tid & 63; F.wave = __builtin_amdgcn_readfirstlane(F.tid >> 6); F.G = gridDim.x; F.bid = blockIdx.x;
#define INP(i) ld_ptr(F.lds, (i))
    F.out = args.out; F.ws = args.ws;
    unsigned char* ws = args.ws;
    volatile LAS unsigned* MISC = (volatile LAS unsigned*)(F.lds + MISC_OFF);
    if (F.tid < 16) MISC[F.tid] = 0u;
    if (F.tid == 0) { LAS unsigned long long* pt = (LAS unsigned long long*)(F.lds + PT_OFF);
#pragma unroll
        for (int i = 0; i < 19; ++i) pt[i] = (unsigned long long)args.in[i]; }
    __syncthreads();
    const int lo = args.ph_lo, hi = args.ph_hi;
    XcdBarrier bar; bar.bar = (unsigned*)(ws + WS_CTL) + CW_BAR; bar.x = 0; bar.st = nullptr;
    if (hi - lo > 1) bar = xcd_barrier_post((unsigned*)(ws + WS_CTL) + CW_BAR, MISC + 8);
#ifndef PH_MASK
#define PH_MASK 0xfff
#endif
#define IN(k) (((PH_MASK >> (k)) & 1) && lo <= (k) && (k) < hi)
#if MK_PROBE >= 1000
#define PH_T0(k) unsigned long long _pt##k = 0; if (MK_PROBE == 1000 + (k)) _pt##k = __builtin_amdgcn_s_memrealtime();
#define PH_T1(k) if (MK_PROBE == 1000 + (k) && blockIdx.x == MK_PROBE_BLK && F.tid == 0) MISC[12] += (unsigned)(__builtin_amdgcn_s_memrealtime() - _pt##k);
#else
#define PH_T0(k)
#define PH_T1(k)
#endif
#if MK_PROBE >= 2000
#define SEAM_T0() const unsigned long long _st0 = __builtin_amdgcn_s_memrealtime();
#define SEAM_T1(k) if ((MK_PROBE == 2000 || MK_PROBE == 2001 + (k)) && blockIdx.x == MK_PROBE_BLK && F.tid == 0) MISC[12] += (unsigned)(__builtin_amdgcn_s_memrealtime() - _st0);
#else
#define SEAM_T0()
#define SEAM_T1(k)
#endif
#define SEAM(k) do { SEAM_T0() if (IN(k) && IN((k) + 1)) { if ((k) <= 8) xcd_barrier_work(bar, F, QD_CHUNKS); else xcd_barrier(bar); } SEAM_T1(k) { int _t = threadIdx.x; asm volatile("" : "+v"(_t)); F.tid = _t; F.lane = _t & 63; } } while (0)

    const int vcu = (F.G % 8 == 0) ? (F.bid % 8) * (F.G / 8) + F.bid / 8 : F.bid;
    unsigned char* h8 = ws + WS_H;
    bf16* h2b = (bf16*)(ws + WS_H2B); bf16* proj = (bf16*)(ws + WS_PROJ); bf16* mixin = (bf16*)(ws + WS_MIXIN);

    PH_T0(0) if (IN(0)) { p0_prologue(F); } PH_T1(0) SEAM(0);
    PH_T0(1) if (IN(1)) { modnorm_phase<false, false, true>(F, INP(0), INP(4), 0, nullptr, (bf16*)h8); } PH_T1(1) SEAM(1);
    PH_T0(2) if (IN(2)) {
        typedef DenseSchedT<NT / 256, NPROJ / 256, 1> SchedP2; SchedP2 S; S.init(h8, ws + WS_WIN_T, D, D, 0, F.G, F.bid);
        EpiProj E{proj};
        const int ksplit = vcu % 6;
        S.i0 = 0; S.i1 = ksplit;
        gemm_phase<EpiProj, SchedP2>(F.lds, D, D, S, E);
        __syncthreads();
        for (int e = F.bid; e < NE; e += F.G)
            convert_expert<false>(F, INP(12) + (size_t)e * D * FF, INP(13) + (size_t)e * D * FF, ws + WS_WGU_T + (size_t)e * 512 * D, 16, 16);
        __syncthreads();
        S.i0 = ksplit; S.i1 = 0x3fffffff;
        gemm_phase<EpiProj, SchedP2>(F.lds, D, D, S, E);
    } PH_T1(2) SEAM(2);
    PH_T0(3) if (IN(3)) {
#if MK_PROBE == 1103
        const unsigned long long _pp0 = __builtin_amdgcn_s_memrealtime();
#endif
        pool_phase(F, INP(7));
#if MK_PROBE == 1103
        if (blockIdx.x == MK_PROBE_BLK && F.tid == 0) MISC[12] += (unsigned)(__builtin_amdgcn_s_memrealtime() - _pp0);
#endif
#if MK_NAIVE_ATTN
        naive_attn_phase(F);
#else
        attn_phase(F);
#endif
    } PH_T1(3) SEAM(3);
    PH_T0(4) if (IN(4)) {
#if !MK_NAIVE_ATTN
        combine_phase(F);
#endif
    } PH_T1(4) SEAM(4);
    PH_T0(5) if (IN(5)) {
        typedef DenseSchedT<NT / 256, D / 256, 1> SchedP5; SchedP5 S; S.init(mixin, ws + WS_WOUT_T, NMIX, NMIX, 0, F.G, F.bid);
        EpiOut E{(bf16*)F.out};
        gemm_phase<EpiOut, SchedP5>(F.lds, NMIX, NMIX, S, E);
    } PH_T1(5) SEAM(5);
    PH_T0(6) if (IN(6)) { modnorm_phase<true, true, true>(F, INP(0), INP(9), 3, h8, h2b); } PH_T1(6) SEAM(6);
    PH_T0(7) if (IN(7)) {
        typedef DenseSchedT<NT / 256, NE / 256, 2> SchedP7; SchedP7 S; S.init(h2b, ws + WS_WR_T, D, D, 512, F.G, F.bid);
        EpiRouter E{(float*)(ws + WS_LOGIT)};
        gemm_phase<EpiRouter, SchedP7>(F.lds, 512, D, S, E);
    } PH_T1(7) SEAM(7);
    PH_T0(8) if (IN(8)) { routing_phase(F, INP(11)); drain_queue(F, QG_CHUNKS); } PH_T1(8) SEAM(8);
    PH_T0(9) if (IN(9)) {
        int nblk; build_tables(F, nblk);
        MoeSched<2, false> S; S.prefix = (const LAS int*)(F.lds + TAB_OFF); S.cnt = S.prefix + 260; S.bucket = (const unsigned*)(ws + WS_BUCKET);
        S.Ar = (const char*)h8; S.As = (const char*)h8; S.Br = (const char*)(ws + WS_WGU_T); S.Bs = (const char*)(ws + WS_WSGU_T);
        S.nRouted = nblk * 2; S.total = S.nRouted + (NT / 256) * 2; S.G = F.G; S.c = vcu;
        EpiGU E{ws + WS_ACT, ws + WS_ACTS, (const unsigned*)(ws + WS_BUCKET), (unsigned*)(ws + WS_POS)};
        S.i0 = 0; S.i1 = 0x3fffffff;
        gemm_phase<EpiGU, MoeSched<2, false>>(F.lds, D / 2, D / 2, S, E);
        drain_queue(F, QD_CHUNKS);
    } PH_T1(9) SEAM(9);
    PH_T0(10) if (IN(10)) {
        int nblk; build_tables(F, nblk);
        MoeSched<4, true> S; S.prefix = (const LAS int*)(F.lds + TAB_OFF); S.cnt = S.prefix + 260; S.bucket = (const unsigned*)(ws + WS_BUCKET);
        S.Ar = (const char*)(ws + WS_ACT); S.As = (const char*)(ws + WS_ACTS); S.Br = (const char*)(ws + WS_WD_T); S.Bs = (const char*)(ws + WS_WSD_T);
        S.nRouted = nblk * 4; S.total = S.nRouted + (NT / 256) * 4; S.G = F.G; S.c = vcu; S.i0 = 0; S.i1 = 0x3fffffff;
        EpiDown E{(unsigned char*)(ws + WS_Y), (bf16*)F.out};
        gemm_phase<EpiDown, MoeSched<4, true>>(F.lds, FF / 2, FF / 2, S, E);
    } PH_T1(10) SEAM(10);
    PH_T0(11) if (IN(11)) { final_phase(F, INP(18)); } PH_T1(11)
#if MK_PROBE
    if (blockIdx.x == MK_PROBE_BLK) { __syncthreads();
        if (F.tid == 0) { const unsigned long long span = (unsigned long long)MISC[12] * MK_PROBE_MULT, t0 = __builtin_amdgcn_s_memrealtime();
            while (__builtin_amdgcn_s_memrealtime() - t0 < span) __builtin_amdgcn_s_sleep(16); } }
#endif
#undef IN
#undef SEAM
#undef INP
}

extern "C" void kernel_launch(void* const* d_in, const int* in_sizes, int n_in, void* d_out, int out_size, void* d_ws, size_t ws_size, hipStream_t stream) {
    static int grid = 0;
    if (grid == 0) {
        if (n_in != 19 || out_size != NT * D || ws_size < WS_END) { fprintf(stderr, "kernel_launch: unexpected shapes (n_in %d out %d ws %zu)\n", n_in, out_size, ws_size); grid = -1; return; }
        int dev = 0, cus = 0;
        if (hipGetDevice(&dev) != hipSuccess || hipDeviceGetAttribute(&cus, hipDeviceAttributeMultiprocessorCount, dev) != hipSuccess) { grid = -1; return; }
        if (hipFuncSetAttribute((const void*)fwd, hipFuncAttributeMaxDynamicSharedMemorySize, LDS_BYTES) != hipSuccess) { fprintf(stderr, "kernel_launch: hipFuncSetAttribute failed\n"); grid = -1; return; }
        int per_cu = 0;
        if (hipOccupancyMaxActiveBlocksPerMultiprocessor(&per_cu, (const void*)fwd, NTHREADS, LDS_BYTES) != hipSuccess || per_cu < 1) { fprintf(stderr, "kernel_launch: occupancy query says %d\n", per_cu); }
        (void)hipGetLastError();
        grid = cus;
    }
    if (grid < 0) return;
    (void)hipMemsetAsync((char*)d_ws + WS_CTL, 0, CTL_ZERO_BYTES, stream);
    Args a{};
    for (int i = 0; i < 19; ++i) a.in[i] = (const float*)d_in[i];
    a.out = (float*)d_out; a.ws = (unsigned char*)d_ws;
#if MK_ONE_LAUNCH
    a.ph_lo = 0; a.ph_hi = N_PHASES;
    hipLaunchKernelGGL(fwd, dim3(grid), dim3(NTHREADS), LDS_BYTES, stream, a);
#else
    for (int p = 0; p < N_PHASES; ++p) { a.ph_lo = p; a.ph_hi = p + 1; const int reps = ((MK_REP_MASK >> p) & 1) ? 2 : 1;
        for (int r = 0; r < reps; ++r) hipLaunchKernelGGL(fwd, dim3(grid), dim3(NTHREADS), LDS_BYTES, stream, a); }
#endif
}
```

```cpp
#include <hip/hip_runtime.h>
#include <cstdio>
#include <cstdint>

#ifndef MK_ONE_LAUNCH
#define MK_ONE_LAUNCH 1
#endif
#ifndef MK_FAST_GEMM
#define MK_FAST_GEMM 1
#endif
#ifndef MK_REP_MASK
#define MK_REP_MASK 0x000
#endif
#ifndef MK_MX
#define MK_MX 1
#endif
#ifndef MK_PROBE
#define MK_PROBE 0
#endif
#ifndef MK_PROBE_BLK
#define MK_PROBE_BLK 0
#endif
#ifndef MK_PROBE_WAVE
#define MK_PROBE_WAVE 0
#endif
#ifndef MK_PROBE_MULT
#define MK_PROBE_MULT 4
#endif
#ifndef MK_NAIVE_ATTN
#define MK_NAIVE_ATTN 0
#endif

#define LAS __attribute__((address_space(3)))
#define GAS __attribute__((address_space(1)))
typedef unsigned short bf16;
typedef short bf16x8 __attribute__((ext_vector_type(8)));
typedef short s16x4 __attribute__((ext_vector_type(4)));
typedef float f32x4 __attribute__((ext_vector_type(4)));
typedef float f32x2 __attribute__((ext_vector_type(2)));
typedef long l64x2 __attribute__((ext_vector_type(2)));
typedef int i32x8 __attribute__((ext_vector_type(8)));
typedef int i32x4 __attribute__((ext_vector_type(4)));
typedef unsigned v4u __attribute__((ext_vector_type(4)));
typedef unsigned v2u __attribute__((ext_vector_type(2)));

constexpr int D = 1024, NB = 8, SEQ = 4096, NT = NB * SEQ;
constexpr int NPROJ = 2560, NE = 256, TOPK = 8, FF = 256, NMIX = 512;
constexpr int CAP = NT;
constexpr int MAXBLK = NT * TOPK / 256 + NE;
constexpr float NORM_EPS = 1e-6f;
constexpr int NWAVES = 8, NTHREADS = 512;

constexpr size_t MiB = 1u << 20;
constexpr size_t WS_CTL = 0, CTL_ZERO_BYTES = 1 * MiB;
constexpr size_t WS_MOD = 1 * MiB;
constexpr size_t WS_GATEW = 2 * MiB;
constexpr size_t WS_WIN_T = 4 * MiB;
constexpr size_t WS_WOUT_T = 9 * MiB;
constexpr size_t WS_WR_T = 10 * MiB;
constexpr size_t WS_WSGU_T = 11 * MiB;
constexpr size_t WS_WSD_T = 12 * MiB;
constexpr size_t WS_LSE = 13 * MiB;
constexpr size_t WS_WD_T = 16 * MiB;
constexpr size_t WS_ACT = 144 * MiB;
constexpr size_t WS_ACTS = 304 * MiB;
constexpr size_t WS_BUCKET = 320 * MiB;
constexpr size_t WS_WGU_T = 352 * MiB;
constexpr size_t WS_PROJ = 608 * MiB;
constexpr size_t WS_H = 768 * MiB;
constexpr size_t WS_ATTO = 832 * MiB;
constexpr size_t WS_MIXIN = 880 * MiB;
constexpr size_t WS_LOGIT = 912 * MiB;
constexpr size_t WS_Y = 352 * MiB;
constexpr size_t WS_H2B = 832 * MiB;
constexpr size_t WS_ROWSC = 14 * MiB + 512 * 1024;
constexpr size_t WS_COLSC = 14 * MiB + 768 * 1024;
constexpr size_t WS_PWT = 15 * MiB;
constexpr size_t WS_POS = 3 * MiB;
constexpr size_t WS_END = 992 * MiB;
constexpr int CW_BAR = 4096;
constexpr int CW_GCNT = 16384;
constexpr int CW_QD = 24576;
constexpr unsigned QG_CHUNKS = NE * 16, QD_CHUNKS = QG_CHUNKS + NE * 16;

constexpr int RING_BYTES = 131072;
constexpr int TAB_OFF = RING_BYTES;
constexpr int MISC_OFF = TAB_OFF + 4096;
constexpr int PT_OFF = MISC_OFF + 256;
constexpr int LDS_BYTES = 147456;

__device__ __forceinline__ unsigned f2bf(float f) { unsigned u = __builtin_bit_cast(unsigned, f); return (u + 0x7fffu + ((u >> 16) & 1u)) >> 16; }
__device__ __forceinline__ unsigned pk2(float lo, float hi) { unsigned r; asm("v_cvt_pk_bf16_f32 %0, %1, %2" : "=v"(r) : "v"(lo), "v"(hi)); return r; }
constexpr float W_SCALE = 64.f, W_INV_SCALE = 1.f / 64.f;
constexpr float WD_SCALE = 4.f;
constexpr float ACT_SCALE = 4.f;
__device__ __forceinline__ unsigned pk4_fp8(float a, float b, float c, float d) {
    int w = __builtin_amdgcn_cvt_pk_fp8_f32(a, b, 0, false); w = __builtin_amdgcn_cvt_pk_fp8_f32(c, d, w, true); return (unsigned)w; }
__device__ __forceinline__ unsigned pk4_i8(float a, float b, float c, float d) {
    const int ia = (int)__builtin_rintf(a), ib = (int)__builtin_rintf(b), ic = (int)__builtin_rintf(c), id = (int)__builtin_rintf(d);
    return (unsigned)(ia & 255) | ((unsigned)(ib & 255) << 8) | ((unsigned)(ic & 255) << 16) | ((unsigned)id << 24); }
__device__ __forceinline__ float bf2f(unsigned short b) { return __builtin_bit_cast(float, ((unsigned)b) << 16); }
__device__ __forceinline__ float bflo(unsigned u) { return __builtin_bit_cast(float, u << 16); }
__device__ __forceinline__ float bfhi(unsigned u) { return __builtin_bit_cast(float, u & 0xffff0000u); }
template <int CTRL> __device__ __forceinline__ float dppf(float v) {
    return __builtin_bit_cast(float, __builtin_amdgcn_update_dpp(0, __builtin_bit_cast(int, v), CTRL, 0xF, 0xF, true)); }
__device__ __forceinline__ float wave_sum(float v) {
    v += dppf<0xB1>(v); v += dppf<0x4E>(v); v += dppf<0x141>(v); v += dppf<0x140>(v);
    const float r0 = __builtin_bit_cast(float, __builtin_amdgcn_readlane(__builtin_bit_cast(int, v), 0)), r1 = __builtin_bit_cast(float, __builtin_amdgcn_readlane(__builtin_bit_cast(int, v), 16));
    const float r2 = __builtin_bit_cast(float, __builtin_amdgcn_readlane(__builtin_bit_cast(int, v), 32)), r3 = __builtin_bit_cast(float, __builtin_amdgcn_readlane(__builtin_bit_cast(int, v), 48));
    return (r0 + r1) + (r2 + r3);
}
__device__ __forceinline__ float wave_max(float v) {
    v = fmaxf(v, dppf<0xB1>(v)); v = fmaxf(v, dppf<0x4E>(v)); v = fmaxf(v, dppf<0x141>(v)); v = fmaxf(v, dppf<0x140>(v));
    const float r0 = __builtin_bit_cast(float, __builtin_amdgcn_readlane(__builtin_bit_cast(int, v), 0)), r1 = __builtin_bit_cast(float, __builtin_amdgcn_readlane(__builtin_bit_cast(int, v), 16));
    const float r2 = __builtin_bit_cast(float, __builtin_amdgcn_readlane(__builtin_bit_cast(int, v), 32)), r3 = __builtin_bit_cast(float, __builtin_amdgcn_readlane(__builtin_bit_cast(int, v), 48));
    return fmaxf(fmaxf(r0, r1), fmaxf(r2, r3));
}
__device__ __forceinline__ float silu_f(float g) { return g * __builtin_amdgcn_rcpf(1.f + __builtin_amdgcn_exp2f(-1.44269504f * g)); }

__device__ __forceinline__ const float* ld_ptr(LAS unsigned char* lds, int i) {
    const unsigned long long v = ((const LAS unsigned long long*)(lds + PT_OFF))[i];
    const unsigned lo = __builtin_amdgcn_readfirstlane((unsigned)v), hi = __builtin_amdgcn_readfirstlane((unsigned)(v >> 32));
    return (const float*)(((unsigned long long)hi << 32) | lo);
}
#define XB_TMO      128
#define XB_XCNT(j)  (256  + 64 * (j))
#define XB_XSUB(j)  (1280 + 64 * (j))
#define XB_XGEN(j)  (2304 + 64 * (j))
#define XB_TOP      3328
#define XB_TOPGEN   3392
#define XCD_BAR_WORDS 3456
#define XB_SPIN_CAP (1u << 18)
__device__ __forceinline__ unsigned xb_ld(unsigned* p)              { return __hip_atomic_load(p, __ATOMIC_RELAXED, __HIP_MEMORY_SCOPE_AGENT); }
__device__ __forceinline__ unsigned xb_add(unsigned* p, unsigned v) { return __hip_atomic_fetch_add(p, v, __ATOMIC_RELAXED, __HIP_MEMORY_SCOPE_AGENT); }
__device__ __forceinline__ unsigned xb_xcc_id() { return (unsigned)__builtin_amdgcn_s_getreg((3 << 11) | 20) & 0xFu; }
#define XB_SPIN(cond, bar) do { unsigned _sp = 0; while (cond) { __builtin_amdgcn_s_sleep(1); \
    if ((++_sp & 255u) == 0u) { if (xb_ld(&(bar)[XB_TMO])) break; if (_sp > XB_SPIN_CAP) { atomicAdd(&(bar)[XB_TMO], 1u); break; } } } } while (0)
struct XcdBarrier { unsigned* bar; unsigned x; volatile LAS unsigned* st; };
__device__ __forceinline__ XcdBarrier xcd_barrier_post(unsigned* bar, volatile LAS unsigned* st) {
    XcdBarrier b; b.bar = bar; b.x = xb_xcc_id(); b.st = st;
    if (threadIdx.x == 0) (void)xb_add(&bar[XB_XCNT(b.x)], 1u);
    return b;
}
__device__ __forceinline__ void xcd_barrier_complete(unsigned* bar, unsigned x, unsigned& nloc, unsigned& nx) {
    const unsigned G = gridDim.x * gridDim.y * gridDim.z;
    unsigned sum, cnt, mine, sp = 0u;
    for (;;) {
        sum = 0u; cnt = 0u; mine = 0u;
#pragma unroll
        for (unsigned j = 0; j < 16; ++j) { const unsigned c = xb_ld(&bar[XB_XCNT(j)]); sum += c; cnt += (c > 0u) ? 1u : 0u; mine = (j == x) ? c : mine; }
        if (sum == G) break;
        __builtin_amdgcn_s_sleep(1);
        if ((++sp & 255u) == 0u) { if (xb_ld(&bar[XB_TMO])) break; if (sp > XB_SPIN_CAP) { atomicAdd(&bar[XB_TMO], 1u); break; } }
    }
    nloc = mine > 0u ? mine : 1u; nx = cnt > 0u ? cnt : 1u;
}
__device__ __forceinline__ void xcd_barrier(const XcdBarrier& b) {
    asm volatile("s_waitcnt vmcnt(0)" ::: "memory");
    __syncthreads();
    if (threadIdx.x == 0) {
        unsigned* bar = b.bar;
        __builtin_amdgcn_s_waitcnt(0);
        unsigned nloc = b.st[0], nx = b.st[1];
        if (nloc == 0u) { xcd_barrier_complete(bar, b.x, nloc, nx); b.st[0] = nloc; b.st[1] = nx; }
        const unsigned old = xb_add(&bar[XB_XSUB(b.x)], 1u);
        const unsigned gen = old / nloc;
        if (old + 1u == (gen + 1u) * nloc) {
            __builtin_amdgcn_fence(__ATOMIC_RELEASE, "agent");
            asm volatile("s_waitcnt vmcnt(0)" ::: "memory");
            const unsigned og = xb_add(&bar[XB_TOP], 1u);
            const unsigned tg = og / nx;
            if (og + 1u == (tg + 1u) * nx) xb_add(&bar[XB_TOPGEN], 1u);
            else XB_SPIN(xb_ld(&bar[XB_TOPGEN]) == tg, bar);
            __builtin_amdgcn_fence(__ATOMIC_ACQUIRE, "agent");
            xb_add(&bar[XB_XGEN(b.x)], 1u);
            asm volatile("s_waitcnt vmcnt(0)" ::: "memory");
        } else {
            XB_SPIN(xb_ld(&bar[XB_XGEN(b.x)]) == gen, bar);
            __builtin_amdgcn_fence(__ATOMIC_ACQUIRE, "agent");
            asm volatile("s_waitcnt vmcnt(0)" ::: "memory");
        }
    }
    __syncthreads();
}

constexpr int BK = 64, HALF = 128, HTB = HALF * BK * 2;
__device__ __forceinline__ int lds_byte(int r, int c) { const int st = (r >> 4) * 2 + (c >> 5), rr = r & 15, cc = c & 31, ob = rr * 64 + cc * 2; return st * 1024 + (ob ^ (((ob >> 9) & 1) << 5)); }
__device__ __forceinline__ void stage_rc(int b, int& R, int& C) { const int st = b / 1024, sb = b % 1024, swz = sb ^ (((sb >> 9) & 1) << 5); R = (st >> 1) * 16 + swz / 64; C = (st & 1) * 32 + (swz % 64) / 2; }
__device__ __forceinline__ int perm32(int rho) { const int n = rho >> 4, i = rho & 15; return 8 * (i >> 2) + 4 * n + (i & 3); }

template <class Epi, class Sched>
__device__ __forceinline__ void gemm_simple(const int K, const int ldb, const Sched& S, const Epi& E) {
    const int tid = threadIdx.x, wid = __builtin_amdgcn_readfirstlane(tid >> 6), lane = tid & 63, wr = wid >> 2, wc = wid & 3, fr = lane & 15, fq = lane >> 4;
    typename Sched::Unit u;
    for (int ui = 0; S.next(ui, u); ++ui) {
        f32x4 acc[2][2][4][2];
#pragma unroll
        for (int a = 0; a < 2; ++a)
#pragma unroll
            for (int b = 0; b < 2; ++b)
#pragma unroll
                for (int m = 0; m < 4; ++m)
#pragma unroll
                    for (int n = 0; n < 2; ++n) acc[a][b][m][n] = (f32x4){0.f, 0.f, 0.f, 0.f};
        const char* A = S.a_base(u); const char* B = S.b_base(u);
        unsigned aoff[2][4], boff[2][2];
#pragma unroll
        for (int ai = 0; ai < 2; ++ai)
#pragma unroll
            for (int m = 0; m < 4; ++m) aoff[ai][m] = S.a_off(u, 128 * ai + 64 * wr + 16 * m + fr) + fq * 16;
#pragma unroll
        for (int bj = 0; bj < 2; ++bj)
#pragma unroll
            for (int n = 0; n < 2; ++n) { const int row = Epi::PERM == 2 ? 64 * wc + 16 * (fr >> 2) + 8 * bj + 4 * n + (fr & 3) : 128 * bj + 32 * wc + (Epi::PERM == 1 ? perm32(16 * n + fr) : 16 * n + fr); boff[bj][n] = (unsigned)(row * ldb) * 2u + fq * 16; }
        for (int k = 0; k < K; k += 32) {
            bf16x8 a[2][4], b[2][2];
#pragma unroll
            for (int ai = 0; ai < 2; ++ai)
#pragma unroll
                for (int m = 0; m < 4; ++m) a[ai][m] = *(const bf16x8*)(A + aoff[ai][m] + k * 2);
#pragma unroll
            for (int bj = 0; bj < 2; ++bj)
#pragma unroll
                for (int n = 0; n < 2; ++n) b[bj][n] = *(const bf16x8*)(B + boff[bj][n] + k * 2);
#pragma unroll
            for (int ai = 0; ai < 2; ++ai)
#pragma unroll
                for (int bj = 0; bj < 2; ++bj)
#pragma unroll
                    for (int m = 0; m < 4; ++m)
#pragma unroll
                        for (int n = 0; n < 2; ++n) acc[ai][bj][m][n] = __builtin_amdgcn_mfma_f32_16x16x32_bf16(b[bj][n], a[ai][m], acc[ai][bj][m][n], 0, 0, 0);
        }
        E(acc, u, wr, wc, fr, fq);
    }
}

template <class Epi, class Sched>
__device__ __forceinline__ void gemm_fast(LAS unsigned char* lds, const int K, const int ldb, const Sched& S, const Epi& E) {
    int tid0 = threadIdx.x; asm volatile("" : "+v"(tid0));
    const int tid = tid0, wid = __builtin_amdgcn_readfirstlane(tid >> 6), lane = tid & 63, wr = wid >> 2, wc = wid & 3, fr = lane & 15, fq = lane >> 4;
    int nt = K / BK; asm volatile("" : "+s"(nt));
    unsigned voffB0[2], voffB1[2];
#pragma unroll
    for (int i = 0; i < 2; ++i) { int R, C; stage_rc(tid * 16 + i * 8192, R, C);
        if (Epi::PERM == 2) { const int cb = 64 * (R >> 5) + 16 * ((R & 15) >> 2) + 4 * ((R >> 4) & 1) + (R & 3);
            voffB0[i] = (unsigned)(cb * ldb + C) * 2u; voffB1[i] = (unsigned)((cb + 8) * ldb + C) * 2u; }
        else { const int Rb = Epi::PERM == 1 ? ((R & ~31) + perm32(R & 31)) : R;
            voffB0[i] = (unsigned)(Rb * ldb + C) * 2u; voffB1[i] = (unsigned)((Rb + HALF) * ldb + C) * 2u; } }
#define PG8_AOFF(u) do { int _tz = threadIdx.x; asm volatile("" : "+v"(_tz)); _Pragma("unroll") for (int _i = 0; _i < 2; ++_i) { int _R, _C; stage_rc(_tz * 16 + _i * 8192, _R, _C); \
        vA0[_i] = S.a_off(u, _R) + (unsigned)_C * 2u; vA1[_i] = S.a_off(u, HALF + _R) + (unsigned)_C * 2u; } } while (0)
    const size_t kstep = (size_t)(BK * 2);
    const unsigned ldsw = (unsigned)wid * 1024u;
    const int aoff = lds_byte(wr * 64 + fr, fq * 8), boff = lds_byte(wc * 32 + fr, fq * 8);
#if MK_PROBE
#define PRB_NOW() __builtin_amdgcn_s_memrealtime()
#define PRB_ADD(IV, t0, t1) do { if (MK_PROBE == Epi::PID * 10 + (IV) && blockIdx.x == MK_PROBE_BLK && wid == MK_PROBE_WAVE && lane == 0) \
        __hip_atomic_fetch_add((LAS unsigned*)(lds + MISC_OFF + 48), (unsigned)((t1) - (t0)), __ATOMIC_RELAXED, __HIP_MEMORY_SCOPE_WORKGROUP); } while (0)
#else
#define PRB_NOW() 0ull
#define PRB_ADD(IV, t0, t1) do { } while (0)
#endif
#define PG8_SA(b, h) (((b) * 2 + (h)) * HTB)
#define PG8_SB(b, h) ((4 + (b) * 2 + (h)) * HTB)
#define PG8_STAGE(bufoff, gbase, voff) do { _Pragma("unroll") for (int _i = 0; _i < 2; ++_i) \
        __builtin_amdgcn_global_load_lds((const unsigned*)((const char*)(gbase) + (voff)[_i]), (LAS unsigned*)(lds + (bufoff) + ldsw + _i * 8192), 16, 0, 0); } while (0)
#define PG8_LDA(dst, b, h) do { _Pragma("unroll") for (int m = 0; m < 4; ++m) _Pragma("unroll") for (int k = 0; k < 2; ++k) dst[m][k] = *(const LAS bf16x8*)(lds + PG8_SA(b, h) + aoff + m * 2048 + k * 1024); } while (0)
#define PG8_LDB(dst, b, h) do { _Pragma("unroll") for (int n = 0; n < 2; ++n) _Pragma("unroll") for (int k = 0; k < 2; ++k) dst[n][k] = *(const LAS bf16x8*)(lds + PG8_SB(b, h) + boff + n * 2048 + k * 1024); } while (0)
#define PG8_MMA(ai, bj, At, Bt) do { __builtin_amdgcn_s_setprio(1); _Pragma("unroll") for (int m = 0; m < 4; ++m) _Pragma("unroll") for (int n = 0; n < 2; ++n) _Pragma("unroll") for (int k = 0; k < 2; ++k) { \
        if constexpr (Epi::FP8 && MK_MX) { if (k == 0) { \
            const i32x8 _a = __builtin_shufflevector(__builtin_bit_cast(i32x4, At[m][0]), __builtin_bit_cast(i32x4, At[m][1]), 0, 1, 2, 3, 4, 5, 6, 7); \
            const i32x8 _b = __builtin_shufflevector(__builtin_bit_cast(i32x4, Bt[n][0]), __builtin_bit_cast(i32x4, Bt[n][1]), 0, 1, 2, 3, 4, 5, 6, 7); \
            acc[ai][bj][m][n] = __builtin_amdgcn_mfma_scale_f32_16x16x128_f8f6f4(_b, _a, acc[ai][bj][m][n], 0, 0, 0, 0x7F7F7F7F, 0, 0x7F7F7F7F); } } \
        else if constexpr (Epi::I8) acc[ai][bj][m][n] = __builtin_bit_cast(f32x4, __builtin_amdgcn_mfma_i32_16x16x64_i8(__builtin_bit_cast(i32x4, Bt[n][k]), __builtin_bit_cast(i32x4, At[m][k]), __builtin_bit_cast(i32x4, acc[ai][bj][m][n]), 0, 0, 0)); \
        else if constexpr (Epi::FP8) { const l64x2 _a = __builtin_bit_cast(l64x2, At[m][k]), _b = __builtin_bit_cast(l64x2, Bt[n][k]); \
            acc[ai][bj][m][n] = __builtin_amdgcn_mfma_f32_16x16x32_fp8_fp8(_b[0], _a[0], acc[ai][bj][m][n], 0, 0, 0); \
            acc[ai][bj][m][n] = __builtin_amdgcn_mfma_f32_16x16x32_fp8_fp8(_b[1], _a[1], acc[ai][bj][m][n], 0, 0, 0); } \
        else acc[ai][bj][m][n] = __builtin_amdgcn_mfma_f32_16x16x32_bf16(Bt[n][k], At[m][k], acc[ai][bj][m][n], 0, 0, 0); } __builtin_amdgcn_s_setprio(0); } while (0)
#define PG8_WAIT_V(n) asm volatile("s_waitcnt vmcnt(" #n ")" ::: "memory")
#define PG8_WAIT_L(n) asm volatile("s_waitcnt lgkmcnt(" #n ")" ::: "memory")
#define PG8_BAR __builtin_amdgcn_s_barrier()
#define PG8_SCHED __builtin_amdgcn_sched_barrier(0)
    typename Sched::Unit cur, nxt; int ui = 0;
    if (!S.next(0, cur)) return;
    f32x4 acc[2][2][4][2];
#pragma unroll
    for (int a = 0; a < 2; ++a)
#pragma unroll
        for (int b = 0; b < 2; ++b)
#pragma unroll
            for (int m = 0; m < 4; ++m)
#pragma unroll
                for (int n = 0; n < 2; ++n) acc[a][b][m][n] = (f32x4){0.f, 0.f, 0.f, 0.f};
    bf16x8 At[4][2], B0[2][2], B1[2][2];
    const char* cA = S.a_base(cur); const char* cB = S.b_base(cur);
    unsigned vA0[2], vA1[2];
    PG8_AOFF(cur);
    PG8_STAGE(PG8_SB(0, 0), cB, voffB0); PG8_STAGE(PG8_SA(0, 0), cA, vA0); PG8_STAGE(PG8_SB(0, 1), cB, voffB1); PG8_STAGE(PG8_SA(0, 1), cA, vA1);
    if (wr == 1) PG8_BAR;
    PG8_WAIT_V(4); PG8_BAR;
    PG8_STAGE(PG8_SB(1, 0), cB + kstep, voffB0); PG8_STAGE(PG8_SA(1, 0), cA + kstep, vA0); PG8_STAGE(PG8_SB(1, 1), cB + kstep, voffB1);
    PG8_WAIT_V(6); PG8_BAR;
    for (;;) {
        const unsigned long long prb_a = PRB_NOW();
        const bool has_next = S.next(ui + 1, nxt);
        const char* nA = has_next ? S.a_base(nxt) : cA; const char* nB = has_next ? S.b_base(nxt) : cB;
        const unsigned long long prb_b = PRB_NOW(); PRB_ADD(1, prb_a, prb_b);
        for (int t = 0; t < nt; t += 2) {
            const unsigned long long prb_i0 = PRB_NOW();
            const bool last = (t == nt - 2);
            const char* a1 = cA + (size_t)(t + 1) * kstep;
            const char* a2 = last ? nA : cA + (size_t)(t + 2) * kstep; const char* b2 = last ? nB : cB + (size_t)(t + 2) * kstep;
            const char* a3 = a2 + kstep; const char* b3 = b2 + kstep;
            PG8_LDB(B0, 0, 0); PG8_SCHED; PG8_LDA(At, 0, 0); PG8_STAGE(PG8_SA(1, 1), a1, vA1);
            if (last && has_next) PG8_AOFF(nxt);
            PG8_WAIT_L(8); PG8_BAR; PG8_WAIT_L(0); PG8_MMA(0, 0, At, B0); PG8_BAR; PG8_SCHED;
            PG8_LDB(B1, 0, 1); PG8_STAGE(PG8_SB(0, 0), b2, voffB0);
            PG8_BAR; PG8_WAIT_L(0); PG8_MMA(0, 1, At, B1); PG8_BAR;
            PG8_LDA(At, 0, 1); PG8_STAGE(PG8_SA(0, 0), a2, vA0);
            PG8_BAR; PG8_WAIT_L(0); PG8_MMA(1, 0, At, B0); PG8_BAR; PG8_SCHED;
            PG8_STAGE(PG8_SB(0, 1), b2, voffB1);
            PG8_WAIT_V(6); PG8_BAR; PG8_MMA(1, 1, At, B1); PG8_BAR;
            PG8_LDB(B0, 1, 0); PG8_SCHED; PG8_LDA(At, 1, 0); PG8_STAGE(PG8_SA(0, 1), a2, vA1);
            PG8_WAIT_L(8); PG8_BAR; PG8_WAIT_L(0); PG8_MMA(0, 0, At, B0); PG8_BAR; PG8_SCHED;
            PG8_LDB(B1, 1, 1); PG8_STAGE(PG8_SB(1, 0), b3, voffB0);
            PG8_BAR; PG8_WAIT_L(0); PG8_MMA(0, 1, At, B1); PG8_BAR;
            PG8_LDA(At, 1, 1); PG8_STAGE(PG8_SA(1, 0), a3, vA0);
            PG8_BAR; PG8_WAIT_L(0); PG8_MMA(1, 0, At, B0); PG8_BAR; PG8_SCHED;
            PG8_STAGE(PG8_SB(1, 1), b3, voffB1);
            PG8_WAIT_V(6); PG8_BAR; PG8_MMA(1, 1, At, B1); PG8_BAR;
            { const unsigned long long prb_i1 = PRB_NOW(); if (t == 0) PRB_ADD(4, prb_i0, prb_i1); if (last) PRB_ADD(5, prb_i0, prb_i1); if (t != 0 && !last) PRB_ADD(6, prb_i0, prb_i1); }
        }
        const unsigned long long prb_c = PRB_NOW(); PRB_ADD(2, prb_b, prb_c);
        { int tz = threadIdx.x; asm volatile("" : "+v"(tz)); const int wz = tz >> 6, lz = tz & 63;
          E(acc, cur, wz >> 2, wz & 3, lz & 15, lz >> 4);
#if defined(MK_EPI_TWICE)
          if (Epi::TWICE) { asm volatile("" ::: "memory"); E(acc, cur, wz >> 2, wz & 3, lz & 15, lz >> 4); }
#endif
          }
        { const unsigned long long prb_d = PRB_NOW(); PRB_ADD(3, prb_c, prb_d); }
        if (!has_next) break;
#pragma unroll
        for (int a = 0; a < 2; ++a)
#pragma unroll
            for (int b = 0; b < 2; ++b)
#pragma unroll
                for (int m = 0; m < 4; ++m)
#pragma unroll
                    for (int n = 0; n < 2; ++n) acc[a][b][m][n] = (f32x4){0.f, 0.f, 0.f, 0.f};
        cur = nxt; cA = nA; cB = nB; ++ui;
    }
    PG8_WAIT_V(0);
    if (wr == 0) PG8_BAR;
    PG8_BAR;
#undef PG8_AOFF
#undef PRB_NOW
#undef PRB_ADD
#undef PG8_SA
#undef PG8_SB
#undef PG8_STAGE
#undef PG8_LDA
#undef PG8_LDB
#undef PG8_MMA
#undef PG8_WAIT_V
#undef PG8_WAIT_L
#undef PG8_BAR
#undef PG8_SCHED
}

template <class Epi, class Sched>
__device__ __forceinline__ void gemm_phase(LAS unsigned char* lds, const int K, const int ldb, const Sched& S, const Epi& E) {
#if MK_FAST_GEMM
    gemm_fast<Epi, Sched>(lds, K, ldb, S, E);
#else
    gemm_simple<Epi, Sched>(K, ldb, S, E);
#endif
}

struct DenseUnit { int pm, pn, ks; };
template <int NM, int NN, int KSPLIT>
struct DenseSchedT {
    typedef DenseUnit Unit;
    const char* A; const char* B; int lda2, ldb2, ksub2, G, c, i0, i1;
    __device__ __forceinline__ void init(const void* A_, const void* B_, int lda, int ldb, int Ksub, int G_, int c_) {
        A = (const char*)A_; B = (const char*)B_; lda2 = lda * 2; ldb2 = ldb * 2; ksub2 = Ksub * 2; G = G_; c = c_; i0 = 0; i1 = 0x3fffffff; }
    __device__ __forceinline__ bool next(int i, Unit& u) const {
        constexpr int nwg = NM * NN, total = nwg * KSPLIT;
        if (i + i0 >= i1) return false;
        const int L = (i + i0) * G + c; if (L >= total) return false;
        int id = L / KSPLIT; u.ks = L - id * KSPLIT;
        { constexpr int q = nwg / 8, r = nwg % 8; const int xcd = id % 8, off = id / 8; id = (xcd < r ? xcd * (q + 1) : r * (q + 1) + (xcd - r) * q) + off; }
        constexpr int nig = 8 * NN; const int gid = id / nig, fm = gid * 8, gsz = (NM - fm) < 8 ? (NM - fm) : 8;
        u.pm = fm + ((id % nig) % gsz); u.pn = (id % nig) / gsz; return true;
    }
    __device__ __forceinline__ const char* a_base(const Unit& u) const { return A + (size_t)u.pm * 256 * lda2 + (size_t)u.ks * ksub2; }
    __device__ __forceinline__ const char* b_base(const Unit& u) const { return B + (size_t)u.pn * 256 * ldb2 + (size_t)u.ks * ksub2; }
    __device__ __forceinline__ unsigned a_off(const Unit&, int r) const { return (unsigned)(r * lda2); }
};

template <int PN, bool DOWN>
struct MoeSched {
    struct Unit { int kind, e, rb, blk, valid, pm, pn; };
    const LAS int* prefix; const LAS int* cnt; const unsigned* bucket;
    const char* Ar; const char* As; const char* Br; const char* Bs;
    int nRouted, total, G, c, i0, i1;
    __device__ __forceinline__ bool next(int i, Unit& u) const {
        if (i + i0 >= i1) return false;
        const int id = (i + i0) * G + c; if (id >= total) return false;
        u.e = 0; u.rb = 0; u.blk = 0; u.pm = 0;
        if (id < nRouted) {
            const int blk = id / PN; u.pn = id % PN;
            const int lo = ((const LAS unsigned char*)(cnt + 256))[blk];
            u.kind = 0; u.e = lo; u.rb = blk - prefix[lo]; u.blk = blk; const int rem = cnt[lo] - u.rb * 256; u.valid = rem < 256 ? rem : 256;
        } else { const int s = id - nRouted; u.kind = 1; u.pm = s / PN; u.pn = s % PN; u.valid = 256; }
        return true;
    }
    __device__ __forceinline__ const char* a_base(const Unit& u) const { return u.kind == 0 ? Ar : As; }
    __device__ __forceinline__ const char* b_base(const Unit& u) const {
        if (!DOWN) return u.kind == 0 ? Br + ((size_t)u.e * 512 + (size_t)u.pn * 256) * D : Bs + (size_t)u.pn * 256 * D;
        else       return u.kind == 0 ? Br + ((size_t)u.e * 1024 + (size_t)u.pn * 256) * FF : Bs + (size_t)u.pn * 256 * FF;
    }
    __device__ __forceinline__ unsigned a_off(const Unit& u, int r) const {
        if (!DOWN) {
            if (u.kind == 0) { const int rr = r < u.valid ? r : u.valid - 1; const unsigned slot = bucket[(size_t)u.e * CAP + u.rb * 256 + rr]; return (slot >> 3) * (unsigned)D; }
            return (unsigned)(u.pm * 256 + r) * (unsigned)D;
        } else {
            return (unsigned)((u.kind == 0 ? u.blk : u.pm) * 256 + r) * (unsigned)FF;
        }
    }
};

struct EpiProj {
    static constexpr int PID = 2, PERM = 2;
    static constexpr bool TWICE = false, FP8 = false, I8 = true;
    bf16* O; const float* rowsc; const float* colq;
    __device__ __forceinline__ void operator()(const f32x4 (&acc)[2][2][4][2], const DenseUnit& u, int wr, int wc, int fr, int fq) const {
        const int row0 = u.pm * 256 + wr * 64 + fr, col0 = u.pn * 256 + wc * 64 + 16 * fq;
        f32x4 cs[2][2];
#pragma unroll
        for (int bj = 0; bj < 2; ++bj)
#pragma unroll
            for (int n = 0; n < 2; ++n) { const f32x4 q = *(const f32x4*)(colq + col0 + 8 * bj + 4 * n);
                cs[bj][n] = (f32x4){__builtin_amdgcn_rcpf(q.x), __builtin_amdgcn_rcpf(q.y), __builtin_amdgcn_rcpf(q.z), __builtin_amdgcn_rcpf(q.w)}; }
#pragma unroll
        for (int ai = 0; ai < 2; ++ai)
#pragma unroll
            for (int m = 0; m < 4; ++m) { const int row = row0 + ai * 128 + m * 16; bf16* rowp = O + (size_t)row * NPROJ + col0; const float rs = rowsc[row];
#pragma unroll
                for (int bj = 0; bj < 2; ++bj) { const i32x4 a0 = __builtin_bit_cast(i32x4, acc[ai][bj][m][0]), a1 = __builtin_bit_cast(i32x4, acc[ai][bj][m][1]);
                    const f32x4 v0 = (f32x4){(float)a0[0], (float)a0[1], (float)a0[2], (float)a0[3]} * cs[bj][0] * rs, v1 = (f32x4){(float)a1[0], (float)a1[1], (float)a1[2], (float)a1[3]} * cs[bj][1] * rs;
                    *(v4u*)(rowp + bj * 8) = (v4u){pk2(v0[0], v0[1]), pk2(v0[2], v0[3]), pk2(v1[0], v1[1]), pk2(v1[2], v1[3])}; } }
    }
};
struct EpiOut {
    static constexpr int PID = 5, PERM = 2;
    static constexpr bool TWICE = false, FP8 = false, I8 = false;
    bf16* O;
    __device__ __forceinline__ void operator()(const f32x4 (&acc)[2][2][4][2], const DenseUnit& u, int wr, int wc, int fr, int fq) const {
        const int row0 = u.pm * 256 + wr * 64 + fr, col0 = u.pn * 256 + wc * 64 + 16 * fq;
#pragma unroll
        for (int ai = 0; ai < 2; ++ai)
#pragma unroll
            for (int m = 0; m < 4; ++m) { bf16* rowp = O + (size_t)(row0 + ai * 128 + m * 16) * (2 * D) + col0;
#pragma unroll
                for (int bj = 0; bj < 2; ++bj) { const f32x4 v0 = acc[ai][bj][m][0], v1 = acc[ai][bj][m][1];
                    *(v4u*)(rowp + bj * 8) = (v4u){pk2(v0[0], v0[1]), pk2(v0[2], v0[3]), pk2(v1[0], v1[1]), pk2(v1[2], v1[3])}; } }
    }
};
struct EpiRouter {
    static constexpr int PID = 7, PERM = 0;
    static constexpr bool TWICE = false, FP8 = false, I8 = false;
    float* L;
    __device__ __forceinline__ void operator()(const f32x4 (&acc)[2][2][4][2], const DenseUnit& u, int wr, int wc, int fr, int fq) const {
        const int row0 = u.pm * 256 + wr * 64 + fr, col0 = wc * 32 + 4 * fq;
        float* Lp = L + (size_t)u.ks * NT * NE;
#pragma unroll
        for (int ai = 0; ai < 2; ++ai)
#pragma unroll
            for (int m = 0; m < 4; ++m) { const size_t ro = (size_t)(row0 + ai * 128 + m * 16) * NE + col0;
#pragma unroll
                for (int bj = 0; bj < 2; ++bj)
#pragma unroll
                    for (int n = 0; n < 2; ++n) *(f32x4*)(Lp + ro + bj * 128 + n * 16) = acc[ai][bj][m][n]; }
    }
};
struct EpiGU {
    static constexpr int PID = 9, PERM = 1;
    static constexpr bool TWICE = false, FP8 = true, I8 = false;
    unsigned char* act; unsigned char* acts; const unsigned* bucket; unsigned* pos;
    __device__ __forceinline__ void operator()(const f32x4 (&acc)[2][2][4][2], const MoeSched<2, false>::Unit& u, int wr, int wc, int fr, int fq) const {
        unsigned char* O = u.kind == 0 ? act : acts;
        const int row0 = (u.kind == 0 ? u.blk : u.pm) * 256 + wr * 64 + fr, col0 = u.pn * 128 + wc * 32 + 8 * fq;
        if (u.kind == 0 && u.pn == 0 && wc == 0 && fq == 0) {
#pragma unroll
            for (int ai = 0; ai < 2; ++ai)
#pragma unroll
                for (int m = 0; m < 4; ++m) { const int r = ai * 128 + wr * 64 + m * 16 + fr;
                    if (r < u.valid) pos[bucket[(size_t)u.e * CAP + u.rb * 256 + r]] = (unsigned)(u.blk * 256 + r); } }
#pragma unroll
        for (int ai = 0; ai < 2; ++ai)
#pragma unroll
            for (int m = 0; m < 4; ++m) {
                const f32x4 g0 = acc[ai][0][m][0], g1 = acc[ai][0][m][1], u0 = acc[ai][1][m][0], u1 = acc[ai][1][m][1];
                float a[8];
#pragma unroll
                for (int j = 0; j < 4; j += 2) {
                    const f32x2 ga = (f32x2){g0[j], g0[j + 1]} * W_INV_SCALE, gb = (f32x2){g1[j], g1[j + 1]} * W_INV_SCALE;
                    const f32x2 ua = (f32x2){u0[j], u0[j + 1]} * (W_INV_SCALE * ACT_SCALE), ub = (f32x2){u1[j], u1[j + 1]} * (W_INV_SCALE * ACT_SCALE);
                    const f32x2 ea = ga * (-1.44269504f), eb = gb * (-1.44269504f);
                    f32x2 da, db; da.x = __builtin_amdgcn_exp2f(ea.x); da.y = __builtin_amdgcn_exp2f(ea.y); db.x = __builtin_amdgcn_exp2f(eb.x); db.y = __builtin_amdgcn_exp2f(eb.y);
                    da = da + 1.0f; db = db + 1.0f;
                    f32x2 ra, rb; ra.x = __builtin_amdgcn_rcpf(da.x); ra.y = __builtin_amdgcn_rcpf(da.y); rb.x = __builtin_amdgcn_rcpf(db.x); rb.y = __builtin_amdgcn_rcpf(db.y);
                    const f32x2 oa = (ga * ua) * ra, ob = (gb * ub) * rb;
                    a[j] = oa.x; a[j + 1] = oa.y; a[4 + j] = ob.x; a[4 + j + 1] = ob.y; }
                *(v2u*)(O + (size_t)(row0 + ai * 128 + m * 16) * FF + col0) = (v2u){pk4_fp8(a[0], a[1], a[2], a[3]), pk4_fp8(a[4], a[5], a[6], a[7])};
                __builtin_amdgcn_sched_barrier(0);
            }
    }
};
constexpr float Y_SCALE = ACT_SCALE * WD_SCALE, Y_INV_SCALE = 1.f / Y_SCALE;
struct EpiDown {
    static constexpr int PID = 10, PERM = 2;
    static constexpr bool TWICE = false, FP8 = true, I8 = false;
    unsigned char* Y; bf16* O;
    __device__ __forceinline__ void operator()(const f32x4 (&acc)[2][2][4][2], const MoeSched<4, true>::Unit& u, int wr, int wc, int fr, int fq) const {
        const int col0 = u.pn * 256 + wc * 64 + 16 * fq;
        if (u.kind == 0) {
            const int row0 = u.blk * 256 + wr * 64 + fr;
#pragma unroll
            for (int ai = 0; ai < 2; ++ai)
#pragma unroll
                for (int m = 0; m < 4; ++m) { unsigned char* rowp = Y + (size_t)(row0 + ai * 128 + m * 16) * D + col0;
                    unsigned w[4];
#pragma unroll
                    for (int bj = 0; bj < 2; ++bj)
#pragma unroll
                        for (int n = 0; n < 2; ++n) { f32x4 v = acc[ai][bj][m][n];
#pragma unroll
                            for (int j = 0; j < 4; ++j) v[j] = __builtin_amdgcn_fmed3f(v[j], -448.f, 448.f);
                            w[bj * 2 + n] = pk4_fp8(v[0], v[1], v[2], v[3]); }
                    *(v4u*)rowp = (v4u){w[0], w[1], w[2], w[3]}; }
        } else {
            const int row0 = u.pm * 256 + wr * 64 + fr;
#pragma unroll
            for (int ai = 0; ai < 2; ++ai)
#pragma unroll
                for (int m = 0; m < 4; ++m) { bf16* rowp = O + (size_t)(row0 + ai * 128 + m * 16) * (2 * D) + D + col0;
#pragma unroll
                    for (int bj = 0; bj < 2; ++bj) { const f32x4 v0 = acc[ai][bj][m][0] * Y_INV_SCALE, v1 = acc[ai][bj][m][1] * Y_INV_SCALE;
                        *(v4u*)(rowp + bj * 8) = (v4u){pk2(v0[0], v0[1]), pk2(v0[2], v0[3]), pk2(v1[0], v1[1]), pk2(v1[2], v1[3])}; } }
        }
    }
};

struct Args { const float* in[19]; float* out; unsigned char* ws; int ph_lo, ph_hi; };

struct Frame {
    LAS unsigned char* lds; int tid, lane, wave, G, bid;
    float* out; unsigned char* ws;
};

__device__ __forceinline__ void titem_load(const float* W, int N, int kb, int nb, int lane, float (&v)[32]) {
    const float* Wu = W + (size_t)(64 * kb) * N + 32 * nb;
    const unsigned loff = (unsigned)((lane >> 5) * N + (lane & 31)) * 4u;
#pragma unroll
    for (int i = 0; i < 32; ++i) v[i] = *(const float*)((const char*)(Wu + (size_t)(2 * i) * N) + loff);
}
template <int FP8>
__device__ __forceinline__ void titem_store(const float (&v)[32], int K, void* WTv, int kb, int dst_row0, LAS float* scr, int lane, float wsc = W_SCALE, const float* colq = nullptr) {
    const int k0 = 64 * kb;
#pragma unroll
    for (int i = 0; i < 32; ++i) { const int kk = 2 * i + (lane >> 5); scr[kk * 33 + (lane & 31)] = v[i]; }
    asm volatile("s_waitcnt lgkmcnt(0)" ::: "memory");
    const int c = lane & 7;
#pragma unroll
    for (int j = 0; j < 4; ++j) { const int n = (lane >> 3) + 8 * j; const LAS float* s = scr + (8 * c) * 33 + n;
        if (FP8 == 2) { const float qs = colq[dst_row0 + n]; v2u o; o.x = pk4_i8(s[0 * 33] * qs, s[1 * 33] * qs, s[2 * 33] * qs, s[3 * 33] * qs);
            o.y = pk4_i8(s[4 * 33] * qs, s[5 * 33] * qs, s[6 * 33] * qs, s[7 * 33] * qs);
            *(v2u*)((unsigned char*)WTv + (size_t)(dst_row0 + n) * K + k0 + 8 * c) = o; }
        else if (FP8 == 1) { v2u o; o.x = pk4_fp8(s[0 * 33] * wsc, s[1 * 33] * wsc, s[2 * 33] * wsc, s[3 * 33] * wsc);
            o.y = pk4_fp8(s[4 * 33] * wsc, s[5 * 33] * wsc, s[6 * 33] * wsc, s[7 * 33] * wsc);
            *(v2u*)((unsigned char*)WTv + (size_t)(dst_row0 + n) * K + k0 + 8 * c) = o; }
        else { v4u o; o.x = pk2(s[0 * 33], s[1 * 33]); o.y = pk2(s[2 * 33], s[3 * 33]); o.z = pk2(s[4 * 33], s[5 * 33]); o.w = pk2(s[6 * 33], s[7 * 33]);
            *(v4u*)((bf16*)WTv + (size_t)(dst_row0 + n) * K + k0 + 8 * c) = o; } }
    asm volatile("s_waitcnt lgkmcnt(0)" ::: "memory");
}
template <int FP8>
__device__ __forceinline__ void transpose_item(const float* W, int K, int N, void* WT, int kb, int nb, int dst_row0, LAS float* scr, int lane, float wsc = W_SCALE, const float* colq = nullptr) {
    float v[32]; titem_load(W, N, kb, nb, lane, v); titem_store<FP8>(v, K, WT, kb, dst_row0, scr, lane, wsc, colq);
}
template <bool DOWN>
__device__ __forceinline__ void convert_expert(Frame& F, const float* Wa, const float* Wb, unsigned char* dst, int base = 0, int PER_WAVE = (DOWN ? 16 : 32)) {
    LAS float* scr = (LAS float*)(F.lds + F.wave * 16384);
    const int wv = F.wave;
    auto ld = [&](int i, float (&v)[32]) {
        if (!DOWN) titem_load((i >> 4) ? Wb : Wa, FF, i & 15, wv, F.lane, v);
        else titem_load(Wa, D, i >> 2, wv + 8 * (i & 3), F.lane, v); };
    auto st = [&](int i, const float (&v)[32]) {
        if (!DOWN) { const int n0 = wv * 32; titem_store<true>(v, D, dst, i & 15, (n0 >> 7) * 256 + ((i >> 4) ? 128 : 0) + (n0 & 127), scr, F.lane); }
        else titem_store<true>(v, FF, dst, i >> 2, (wv + 8 * (i & 3)) * 32, scr, F.lane, WD_SCALE); };
    float v0[32], v1[32], v2[32], v3[32];
    ld(base, v0); ld(base + 1, v1); ld(base + 2, v2);
    for (int i = 0; i < PER_WAVE; i += 4) {
        ld(base + i + 3, v3); st(base + i, v0);
        if (i + 4 < PER_WAVE) ld(base + i + 4, v0);
        st(base + i + 1, v1);
        if (i + 5 < PER_WAVE) ld(base + i + 5, v1);
        st(base + i + 2, v2);
        if (i + 6 < PER_WAVE) ld(base + i + 6, v2);
        st(base + i + 3, v3);
    }
}

__device__ __forceinline__ void chunk_load(Frame& F, unsigned ch, int wv, float (&v)[32]) {
    if (ch < QG_CHUNKS) { const int e = (int)(ch >> 4), i = (int)(ch & 15); titem_load(ld_ptr(F.lds, 12) + (size_t)e * D * FF, FF, i, wv, F.lane, v); }
    else { const unsigned c2 = ch - QG_CHUNKS; const int e = (int)(c2 >> 4), i = (int)(c2 & 15); titem_load(ld_ptr(F.lds, 14) + (size_t)e * FF * D, D, i >> 2, wv + 8 * (i & 3), F.lane, v); }
}
__device__ __forceinline__ void chunk_store(Frame& F, unsigned ch, int wv, const float (&v)[32], LAS float* scr) {
    if (ch < QG_CHUNKS) { const int e = (int)(ch >> 4), i = (int)(ch & 15), n0 = wv * 32;
        titem_store<true>(v, D, F.ws + WS_WGU_T + (size_t)e * 512 * D, i, (n0 >> 7) * 256 + (n0 & 127), scr, F.lane, W_SCALE); }
    else { const unsigned c2 = ch - QG_CHUNKS; const int e = (int)(c2 >> 4), i = (int)(c2 & 15);
        titem_store<true>(v, FF, F.ws + WS_WD_T + (size_t)e * D * FF, i >> 2, (wv + 8 * (i & 3)) * 32, scr, F.lane, WD_SCALE); }
}
__device__ __forceinline__ void convert_chunk(Frame& F, unsigned ch) {
    const int wv = __builtin_amdgcn_readfirstlane(F.wave);
    LAS float* scr = (LAS float*)(F.lds + wv * 16384);
    float va[32], vb[32];
    chunk_load(F, ch, wv, va); chunk_load(F, ch + 1, wv, vb);
    chunk_store(F, ch, wv, va, scr); chunk_store(F, ch + 1, wv, vb, scr);
}
__device__ __forceinline__ void xcd_barrier_work(const XcdBarrier& b, Frame& F, unsigned chunk_end) {
    asm volatile("s_waitcnt vmcnt(0)" ::: "memory");
    __syncthreads();
    volatile LAS unsigned* st = b.st;
    unsigned* bar = b.bar; unsigned* qd = (unsigned*)(F.ws + WS_CTL) + CW_QD;
    if (threadIdx.x == 0) {
        __builtin_amdgcn_s_waitcnt(0);
        unsigned nloc = st[0], nx = st[1];
        if (nloc == 0u) { xcd_barrier_complete(bar, b.x, nloc, nx); st[0] = nloc; st[1] = nx; }
        const unsigned old = xb_add(&bar[XB_XSUB(b.x)], 1u);
        const unsigned gen = old / nloc;
        if (old + 1u == (gen + 1u) * nloc) {
            __builtin_amdgcn_fence(__ATOMIC_RELEASE, "agent");
            asm volatile("s_waitcnt vmcnt(0)" ::: "memory");
            const unsigned og = xb_add(&bar[XB_TOP], 1u);
            const unsigned tg = og / nx;
            if (og + 1u == (tg + 1u) * nx) xb_add(&bar[XB_TOPGEN], 1u);
            else XB_SPIN(xb_ld(&bar[XB_TOPGEN]) == tg, bar);
            __builtin_amdgcn_fence(__ATOMIC_ACQUIRE, "agent");
            xb_add(&bar[XB_XGEN(b.x)], 1u);
            asm volatile("s_waitcnt vmcnt(0)" ::: "memory");
            st[3] = 1u; st[6] = 1u;
        } else { st[2] = gen; st[3] = 0u; st[6] = 0u; }
    }
    __syncthreads();
    unsigned spins = 0;
    while (st[3] == 0u) {
        if (threadIdx.x == 0) {
            if (xb_ld(&bar[XB_XGEN(b.x)]) != st[2]) st[3] = 1u;
            else { if (st[5] < chunk_end) st[5] = xb_add(qd, 2u);
                if ((++spins & 1023u) == 0u) { if (xb_ld(&bar[XB_TMO])) st[3] = 1u; else if (spins > XB_SPIN_CAP) { atomicAdd(&bar[XB_TMO], 1u); st[3] = 1u; } } }
        }
        __syncthreads();
        if (st[3] != 0u) break;
        const unsigned ch = st[5];
        if (ch < QD_CHUNKS) convert_chunk(F, ch); else __builtin_amdgcn_s_sleep(8);
        __syncthreads();
    }
    if (threadIdx.x == 0 && st[6] == 0u) { __builtin_amdgcn_fence(__ATOMIC_ACQUIRE, "agent"); asm volatile("s_waitcnt vmcnt(0)" ::: "memory"); }
    __syncthreads();
}
__device__ __forceinline__ void drain_queue(Frame& F, unsigned limit) {
    volatile LAS unsigned* MISC = (volatile LAS unsigned*)(F.lds + MISC_OFF); unsigned* qd = (unsigned*)(F.ws + WS_CTL) + CW_QD;
    for (;;) {
        __syncthreads();
        if (threadIdx.x == 0) { const bool more = MISC[13] < limit; MISC[15] = more ? 1u : 0u; if (more) MISC[13] = xb_add(qd, 2u); }
        __syncthreads();
        if (MISC[15] == 0u) break;
        const unsigned ch = MISC[13];
        if (ch < QD_CHUNKS) convert_chunk(F, ch);
        if (ch >= limit) break;
    }
    __syncthreads();
}

__device__ __forceinline__ void p0_prologue(Frame& F) {
#define INP(i) ld_ptr(F.lds, (i))
    if (F.bid < 192) {
        const float* cptr = INP(1); const float* w_ada = INP(2); const float* b_ada = INP(3);
        LAS float* cs = (LAS float*)F.lds;
        LAS float* red = (LAS float*)(F.lds + 32768);
        for (int i = F.tid; i < NB * D; i += NTHREADS) { const float v = cptr[i]; cs[i] = v / (1.f + __expf(-v)); }
        __syncthreads();
        const int col = F.tid & 31, kg = F.tid >> 5, j = F.bid * 32 + col;
        float a[NB];
#pragma unroll
        for (int b = 0; b < NB; ++b) a[b] = 0.f;
#pragma unroll 8
        for (int kk = 0; kk < 64; ++kk) { const int k = kg * 64 + kk; const float w = w_ada[(size_t)k * 6144 + j];
#pragma unroll
            for (int b = 0; b < NB; ++b) a[b] += cs[b * D + k] * w; }
#pragma unroll
        for (int b = 0; b < NB; ++b) red[(kg * NB + b) * 32 + col] = a[b];
        __syncthreads();
        if (F.tid < 256) { const int b = F.tid >> 5, cc = F.tid & 31; float s = 0.f;
#pragma unroll
            for (int g = 0; g < 16; ++g) s += red[(g * NB + b) * 32 + cc];
            ((float*)(F.ws + WS_MOD))[b * 6144 + F.bid * 32 + cc] = s + b_ada[F.bid * 32 + cc]; }
        __syncthreads();
    }
    if (F.bid >= 192) {
        const float* wi = INP(5); float* colq = (float*)(F.ws + WS_COLSC); LAS float* red = (LAS float*)F.lds;
        const int cb = (F.bid - 192) * 40, col = F.tid % 40, part = F.tid / 40;
        float am = 0.f;
        if (part < 12) for (int k = part; k < D; k += 12) am = fmaxf(am, fabsf(wi[(size_t)k * NPROJ + cb + col]));
        if (part < 12) red[part * 40 + col] = am;
        __syncthreads();
        if (F.tid < 40) { float m = 0.f; for (int q = 0; q < 12; ++q) m = fmaxf(m, red[q * 40 + F.tid]); colq[cb + F.tid] = 127.f / fmaxf(m, 1e-20f); }
        __syncthreads();
    }
    if (F.bid == F.G - 1) { const float* pw = INP(6); bf16* pwt = (bf16*)(F.ws + WS_PWT);
        for (int i = F.tid; i < 4 * 64 * 64; i += NTHREADS) { const int g = i >> 12, d = (i >> 6) & 63, c = i & 63; pwt[i] = (bf16)f2bf(pw[(g * 64 + c) * 64 + d]); } }
    LAS float* scr = (LAS float*)(F.lds + F.wave * 16384);
    const int gw = F.bid * NWAVES + F.wave, NGW = F.G * NWAVES;
    constexpr int I_IN = 16 * 80, I_OUT = 8 * 32, I_R = 16 * 8, I_G = 16 * 8, I_D = 4 * 32;
    constexpr int I_SMALL = I_IN + I_OUT + I_R + 2 * I_G + I_D, I_EXP = 2 * I_G + I_D;
    constexpr int NITEMS = I_SMALL;
    unsigned char* win_t = F.ws + WS_WIN_T; bf16* wout_t = (bf16*)(F.ws + WS_WOUT_T); bf16* wr_t = (bf16*)(F.ws + WS_WR_T);
    unsigned char* wsgu_t = F.ws + WS_WSGU_T; unsigned char* wsd_t = F.ws + WS_WSD_T; unsigned char* wgu_t = F.ws + WS_WGU_T; unsigned char* wd_t = F.ws + WS_WD_T;
    for (int it = gw; it < NITEMS; it += NGW) {
        int r = it;
        if (r < I_IN) continue; r -= I_IN;
        if (r < I_OUT) { transpose_item<false>(INP(8), NMIX, D, wout_t, r / 32, r % 32, (r % 32) * 32, scr, F.lane); continue; } r -= I_OUT;
        if (r < I_R) { transpose_item<false>(INP(10), D, NE, wr_t, r / 8, r % 8, (r % 8) * 32, scr, F.lane); continue; } r -= I_R;
        const float *Wg, *Wu, *Wd; unsigned char *GU, *DN;
        if (r < 2 * I_G + I_D) { Wg = INP(15); Wu = INP(16); Wd = INP(17); GU = wsgu_t; DN = wsd_t; }
        else { r -= 2 * I_G + I_D; const int e = r / I_EXP; r -= e * I_EXP;
            Wg = INP(12) + (size_t)e * D * FF; Wu = INP(13) + (size_t)e * D * FF; Wd = INP(14) + (size_t)e * FF * D;
            GU = wgu_t + (size_t)e * 512 * D; DN = wd_t + (size_t)e * D * FF; }
        if (r < I_G) { const int nb = r % 8, n0 = nb * 32; transpose_item<true>(Wg, D, FF, GU, r / 8, nb, (n0 >> 7) * 256 + (n0 & 127), scr, F.lane); continue; } r -= I_G;
        if (r < I_G) { const int nb = r % 8, n0 = nb * 32; transpose_item<true>(Wu, D, FF, GU, r / 8, nb, (n0 >> 7) * 256 + 128 + (n0 & 127), scr, F.lane); continue; } r -= I_G;
        transpose_item<true>(Wd, FF, D, DN, r / 32, r % 32, (r % 32) * 32, scr, F.lane, WD_SCALE);
    }
#undef INP
}

__device__ __forceinline__ void win_int8_phase(Frame& F, const float* w_in) {
    __syncthreads();
    LAS float* scr = (LAS float*)(F.lds + F.wave * 16384);
    const float* colq = (const float*)(F.ws + WS_COLSC);
    for (int r = F.bid * NWAVES + F.wave; r < 16 * 80; r += F.G * NWAVES)
        transpose_item<2>(w_in, D, NPROJ, F.ws + WS_WIN_T, r / 80, r % 80, (r % 80) * 32, scr, F.lane, 1.f, colq);
}
template <bool HAS_DX, int OUT8, bool OUTB>
__device__ __forceinline__ void modnorm_phase(Frame& F, const float* X, const float* g, int shift_chunk, unsigned char* O8, bf16* Ob) {
    const float* mod = (const float*)(F.ws + WS_MOD);
    constexpr int RW = 4;
    const unsigned l16 = (unsigned)F.lane * 16u, l8 = (unsigned)F.lane * 8u, l4 = (unsigned)F.lane * 4u;
    const int wv = __builtin_amdgcn_readfirstlane(F.wave);
    for (int blk = F.bid; blk < NT / 128; blk += F.G) {
        const int b = (blk * 128) >> 12;
        const float* sh = mod + (size_t)b * 6144 + shift_chunk * D; const float* sc = sh + D; const float* g1 = mod + (size_t)b * 6144 + 2 * D;
        f32x4 gg[4], ss[4], ga[4];
#pragma unroll
        for (int j = 0; j < 4; ++j) { const f32x4 gv = *(const f32x4*)((const char*)g + 1024 * j + l16), scv = *(const f32x4*)((const char*)sc + 1024 * j + l16);
            gg[j] = gv * (scv + 1.f); ss[j] = *(const f32x4*)((const char*)sh + 1024 * j + l16); ga[j] = HAS_DX ? *(const f32x4*)((const char*)g1 + 1024 * j + l16) : (f32x4){0.f, 0.f, 0.f, 0.f}; }
#pragma nounroll
        for (int rr = 0; rr < 16; rr += RW) {
            const int row = blk * 128 + wv * 16 + rr;
            f32x4 v[RW][4]; v2u dv[RW][4];
#pragma unroll
            for (int q = 0; q < RW; ++q) { const char* xr = (const char*)(X + (size_t)(row + q) * D);
#pragma unroll
                for (int j = 0; j < 4; ++j) v[q][j] = *(const f32x4*)(xr + 1024 * j + l16);
                if (HAS_DX) { const char* dr = (const char*)F.out + (size_t)(row + q) * (4 * D);
#pragma unroll
                    for (int j = 0; j < 4; ++j) dv[q][j] = *(const v2u*)(dr + 512 * j + l8); } }
#pragma unroll
            for (int q = 0; q < RW; ++q) { float s = 0.f;
#pragma unroll
                for (int j = 0; j < 4; ++j) {
                    if (HAS_DX) v[q][j] = v[q][j] + ga[j] * (f32x4){bflo(dv[q][j].x), bfhi(dv[q][j].x), bflo(dv[q][j].y), bfhi(dv[q][j].y)};
                    s += (v[q][j].x * v[q][j].x + v[q][j].y * v[q][j].y) + (v[q][j].z * v[q][j].z + v[q][j].w * v[q][j].w); }
                const float rstd = 1.f / sqrtf(wave_sum(s) * (1.f / D) + NORM_EPS);
                if (HAS_DX) { char* xo = (char*)F.out + (size_t)(row + q) * (4 * D);
#pragma unroll
                    for (int j = 0; j < 4; ++j) *(v2u*)(xo + 512 * j + l8) = (v2u){pk2(v[q][j].x, v[q][j].y), pk2(v[q][j].z, v[q][j].w)}; }
                char* o8 = (char*)O8 + (size_t)(row + q) * D; char* ob = (char*)Ob + (size_t)(row + q) * (2 * D);
                if (OUT8 == 2) {
                    f32x4 y[4]; float am = 0.f;
#pragma unroll
                    for (int j = 0; j < 4; ++j) { y[j] = v[q][j] * rstd * gg[j] + ss[j]; am = fmaxf(am, fmaxf(fmaxf(fabsf(y[j].x), fabsf(y[j].y)), fmaxf(fabsf(y[j].z), fabsf(y[j].w)))); }
                    am = fmaxf(wave_max(am), 1e-20f); const float qs = 127.f / am;
#pragma unroll
                    for (int j = 0; j < 4; ++j) *(unsigned*)(o8 + 256 * j + l4) = pk4_i8(y[j].x * qs, y[j].y * qs, y[j].z * qs, y[j].w * qs);
                    if (F.lane == 0) ((float*)(F.ws + WS_ROWSC))[row + q] = am * (1.f / 127.f);
                } else {
#pragma unroll
                for (int j = 0; j < 4; ++j) { const f32x4 y = v[q][j] * rstd * gg[j] + ss[j]; if (OUT8 == 1) *(unsigned*)(o8 + 256 * j + l4) = pk4_fp8(y.x, y.y, y.z, y.w);
                    if (OUTB) *(v2u*)(ob + 512 * j + l8) = (v2u){pk2(y.x, y.y), pk2(y.z, y.w)}; } }
                __builtin_amdgcn_sched_barrier(0); }
        }
    }
}

constexpr int POOL_T = 64, POOL_PITCH = 528;
__device__ __forceinline__ void pool_phase(Frame& F, const float* pool_scale) {
    const bf16* proj = (const bf16*)(F.ws + WS_PROJ); bf16* mixin = (bf16*)(F.ws + WS_MIXIN); const bf16* pwt = (const bf16*)(F.ws + WS_PWT);
    LAS unsigned char* us = F.lds;
    LAS unsigned char* pl = F.lds + 80 * POOL_PITCH;
    const int lane = F.lane, fr = lane & 15, fq = lane >> 4;
    for (int tile = F.bid; tile < NT / POOL_T; tile += F.G) {
        const int row0 = tile * POOL_T, tl0 = row0 & (SEQ - 1);
        __syncthreads();
        for (int p = F.tid; p < (POOL_T + 15) * 32; p += NTHREADS) { const int rr = p >> 5, pc = p & 31; const int tl = tl0 - 15 + rr;
            v4u raw = (v4u){0u, 0u, 0u, 0u};
            if (tl >= 0) raw = *(const v4u*)(proj + (size_t)(row0 - 15 + rr) * NPROJ + pc * 8);
            *(LAS v4u*)(us + rr * POOL_PITCH + pc * 16) = raw; }
        __syncthreads();
        {
            const int c8 = F.tid & 31, q = F.tid >> 5, w = 2 << (c8 >> 3);
            float sm[8];
#pragma unroll
            for (int e = 0; e < 8; ++e) sm[e] = 0.f;
            const int i0 = 15 + q * 4;
            for (int k = 0; k < w; ++k) { const v4u r = *(const LAS v4u*)(us + (i0 - k) * POOL_PITCH + c8 * 16);
                sm[0] += bflo(r.x); sm[1] += bfhi(r.x); sm[2] += bflo(r.y); sm[3] += bfhi(r.y); sm[4] += bflo(r.z); sm[5] += bfhi(r.z); sm[6] += bflo(r.w); sm[7] += bfhi(r.w); }
#pragma unroll
            for (int i = 0; i < 4; ++i) { const int tt = q * 4 + i, tl = tl0 + tt;
                const v4u cur = *(const LAS v4u*)(us + (15 + tt) * POOL_PITCH + c8 * 16);
                if (i > 0) { const v4u old = *(const LAS v4u*)(us + (15 + tt - w) * POOL_PITCH + c8 * 16);
                    sm[0] += bflo(cur.x) - bflo(old.x); sm[1] += bfhi(cur.x) - bfhi(old.x); sm[2] += bflo(cur.y) - bflo(old.y); sm[3] += bfhi(cur.y) - bfhi(old.y);
                    sm[4] += bflo(cur.z) - bflo(old.z); sm[5] += bfhi(cur.z) - bfhi(old.z); sm[6] += bflo(cur.w) - bflo(old.w); sm[7] += bfhi(cur.w) - bfhi(old.w); }
                const float ic = 1.f / (float)((tl + 1) < w ? (tl + 1) : w);
                v4u o; o.x = pk2(sm[0] * ic - bflo(cur.x), sm[1] * ic - bfhi(cur.x)); o.y = pk2(sm[2] * ic - bflo(cur.y), sm[3] * ic - bfhi(cur.y));
                o.z = pk2(sm[4] * ic - bflo(cur.z), sm[5] * ic - bfhi(cur.z)); o.w = pk2(sm[6] * ic - bflo(cur.w), sm[7] * ic - bfhi(cur.w));
                *(LAS v4u*)(pl + tt * POOL_PITCH + c8 * 16) = o; }
        }
        __syncthreads();
        {
            const int g = F.wave >> 1, mh = F.wave & 1;
            bf16x8 af[2][2], bfr[4][2];
#pragma unroll
            for (int mt = 0; mt < 2; ++mt)
#pragma unroll
                for (int k = 0; k < 2; ++k) af[mt][k] = *(const LAS bf16x8*)(pl + (32 * mh + 16 * mt + fr) * POOL_PITCH + (g * 64 + k * 32 + fq * 8) * 2);
#pragma unroll
            for (int nt = 0; nt < 4; ++nt)
#pragma unroll
                for (int k = 0; k < 2; ++k) bfr[nt][k] = *(const bf16x8*)(pwt + ((size_t)(g * 64 + nt * 16 + fr) * 64 + k * 32 + fq * 8));
#pragma unroll
            for (int mt = 0; mt < 2; ++mt)
#pragma unroll
                for (int nt = 0; nt < 4; ++nt) { f32x4 acc = (f32x4){0.f, 0.f, 0.f, 0.f};
                    acc = __builtin_amdgcn_mfma_f32_16x16x32_bf16(bfr[nt][0], af[mt][0], acc, 0, 0, 0);
                    acc = __builtin_amdgcn_mfma_f32_16x16x32_bf16(bfr[nt][1], af[mt][1], acc, 0, 0, 0);
                    const int col = g * 64 + nt * 16 + 4 * fq; const f32x4 sc = *(const f32x4*)(pool_scale + col);
                    const f32x4 o = acc * sc;
                    *(v2u*)(mixin + (size_t)(row0 + 32 * mh + 16 * mt + fr) * NMIX + col) = (v2u){pk2(o.x, o.y), pk2(o.z, o.w)}; }
        }
    }
}

constexpr int KV_PITCH = 144;
__device__ __forceinline__ void attn_phase(Frame& F) {
    const bf16* proj = (const bf16*)(F.ws + WS_PROJ);
    bf16* atto = (bf16*)(F.ws + WS_ATTO); float* lse = (float*)(F.ws + WS_LSE);
    LAS unsigned char* Ks = F.lds; LAS unsigned char* Vs = F.lds + 256 * KV_PITCH;
    const int lane = F.lane, fr = lane & 15, fq = lane >> 4, w = F.wave;
    const int w_i0 = 16 * w, c0 = w >> 1, qi = w_i0 + fr;
#define ATT_DECODE(unit_, rowb_, d_, r_, n_, g_, h_, colQ_) \
        const int rn_##unit_ = (unit_) & 31; const int h_ = ((unit_) >> 5) & 3, g_ = ((unit_) >> 7) % 3; const size_t rowb_ = (size_t)((unit_) / 384) * SEQ; \
        const int d_ = 1 << (2 * g_), nbk_##unit_ = 32 >> (2 * g_), r_ = rn_##unit_ / nbk_##unit_, n_ = rn_##unit_ % nbk_##unit_; const int colQ_ = 256 + g_ * 256 + h_ * 64;
    v4u kreg[4], vreg[4]; bf16x8 qn[2];
    {   const int unit0 = F.bid;
        if (unit0 < NB * 3 * 4 * 32) { ATT_DECODE(unit0, rowb, d, r, n, g, h, colQ)
            const size_t qrow = rowb + (size_t)(n * 128 + qi) * d + r;
#pragma unroll
            for (int ks = 0; ks < 2; ++ks) qn[ks] = *(const bf16x8*)(proj + qrow * NPROJ + colQ + ks * 32 + fq * 8);
#pragma unroll
            for (int cidx = 0; cidx < 4; ++cidx) { const int ch = F.tid + 512 * cidx, j = ch >> 3, pc = ch & 7;
                int p = (n - 1) * 128 + j; p = p < 0 ? 0 : p; const size_t row = rowb + (size_t)p * d + r;
                kreg[cidx] = *(const v4u*)(proj + row * NPROJ + colQ + 768 + pc * 8); vreg[cidx] = *(const v4u*)(proj + row * NPROJ + colQ + 1536 + pc * 8); } } }
    for (int unit = F.bid; unit < NB * 3 * 4 * 32; unit += F.G) {
        ATT_DECODE(unit, rowb, d, r, n, g, h, colQ)
        __syncthreads();
#pragma unroll
        for (int cidx = 0; cidx < 4; ++cidx) { const int ch = F.tid + 512 * cidx, j = ch >> 3, pc = ch & 7;
            *(LAS v4u*)(Ks + j * KV_PITCH + pc * 16) = kreg[cidx]; *(LAS v4u*)(Vs + j * KV_PITCH + pc * 16) = vreg[cidx]; }
        const size_t qrow = rowb + (size_t)(n * 128 + qi) * d + r;
        bf16x8 qf[2]; qf[0] = qn[0]; qf[1] = qn[1];
        __syncthreads();
        {   const int unit2 = unit + F.G;
            if (unit2 < NB * 3 * 4 * 32) { ATT_DECODE(unit2, rowb2, d2, r2, n2, g2, h2, colQ2)
                const size_t qrow2 = rowb2 + (size_t)(n2 * 128 + qi) * d2 + r2;
#pragma unroll
                for (int ks = 0; ks < 2; ++ks) qn[ks] = *(const bf16x8*)(proj + qrow2 * NPROJ + colQ2 + ks * 32 + fq * 8);
#pragma unroll
                for (int cidx = 0; cidx < 4; ++cidx) { const int ch = F.tid + 512 * cidx, j = ch >> 3, pc = ch & 7;
                    int p = (n2 - 1) * 128 + j; p = p < 0 ? 0 : p; const size_t row = rowb2 + (size_t)p * d2 + r2;
                    kreg[cidx] = *(const v4u*)(proj + row * NPROJ + colQ2 + 768 + pc * 8); vreg[cidx] = *(const v4u*)(proj + row * NPROJ + colQ2 + 1536 + pc * 8); } } }
        f32x4 s[5][2];
#pragma unroll
        for (int cc = 0; cc < 5; ++cc)
#pragma unroll
            for (int hh = 0; hh < 2; ++hh) {
                const int j = 32 * (c0 + cc) + 8 * (fr >> 2) + 4 * hh + (fr & 3);
                const bf16x8 k0 = *(const LAS bf16x8*)(Ks + j * KV_PITCH + fq * 16), k1 = *(const LAS bf16x8*)(Ks + j * KV_PITCH + 64 + fq * 16);
                f32x4 a = (f32x4){0.f, 0.f, 0.f, 0.f};
                a = __builtin_amdgcn_mfma_f32_16x16x32_bf16(k0, qf[0], a, 0, 0, 0);
                a = __builtin_amdgcn_mfma_f32_16x16x32_bf16(k1, qf[1], a, 0, 0, 0);
                s[cc][hh] = a;
            }
        float mx = -1e30f;
        int qil = qi; asm volatile("" : "+v"(qil));
#pragma unroll
        for (int cc = 0; cc < 5; ++cc)
#pragma unroll
            for (int hh = 0; hh < 2; ++hh)
#pragma unroll
                for (int rr = 0; rr < 4; ++rr) { const int j = 32 * (c0 + cc) + 8 * fq + 4 * hh + rr; const int dist = 128 + qil - j;
                    const bool valid = (dist >= 0) && (dist <= 128) && (n > 0 || j >= 128);
                    const float v = valid ? s[cc][hh][rr] * 0.18033688f : -1e30f; s[cc][hh][rr] = v; mx = fmaxf(mx, v); }
        mx = fmaxf(mx, __shfl_xor(mx, 16)); mx = fmaxf(mx, __shfl_xor(mx, 32));
        float l = 0.f;
#pragma unroll
        for (int cc = 0; cc < 5; ++cc)
#pragma unroll
            for (int hh = 0; hh < 2; ++hh)
#pragma unroll
                for (int rr = 0; rr < 4; ++rr) { const float p = __builtin_amdgcn_exp2f(s[cc][hh][rr] - mx); s[cc][hh][rr] = p; l += p; }
        l += __shfl_xor(l, 16); l += __shfl_xor(l, 32);
        f32x4 o[4];
#pragma unroll
        for (int eb = 0; eb < 4; ++eb) o[eb] = (f32x4){0.f, 0.f, 0.f, 0.f};
#pragma unroll
        for (int cc = 0; cc < 5; ++cc) {
            const v4u pu = (v4u){pk2(s[cc][0][0], s[cc][0][1]), pk2(s[cc][0][2], s[cc][0][3]), pk2(s[cc][1][0], s[cc][1][1]), pk2(s[cc][1][2], s[cc][1][3])};
            const bf16x8 pf = __builtin_bit_cast(bf16x8, pu);
            const int key0 = 32 * (c0 + cc) + 8 * fq + (fr >> 2);
#pragma unroll
            for (int eb = 0; eb < 4; ++eb) {
                const LAS unsigned char* vp = Vs + key0 * KV_PITCH + (16 * eb + 4 * (fr & 3)) * 2;
                const s16x4 lo = __builtin_bit_cast(s16x4, __builtin_amdgcn_ds_read_tr16_b64_v4i16((LAS s16x4*)vp));
                const s16x4 hi = __builtin_bit_cast(s16x4, __builtin_amdgcn_ds_read_tr16_b64_v4i16((LAS s16x4*)(vp + 4 * KV_PITCH)));
                const bf16x8 vf = (bf16x8){lo[0], lo[1], lo[2], lo[3], hi[0], hi[1], hi[2], hi[3]};
                o[eb] = __builtin_amdgcn_mfma_f32_16x16x32_bf16(vf, pf, o[eb], 0, 0, 0);
            }
        }
        const float il = 1.f / l;
        bf16* op = atto + ((size_t)g * NT + qrow) * 256 + h * 64 + 4 * fq;
#pragma unroll
        for (int eb = 0; eb < 4; ++eb) { const f32x4 v = o[eb] * il; *(v2u*)(op + 16 * eb) = (v2u){pk2(v.x, v.y), pk2(v.z, v.w)}; }
        if (fq == 0) lse[((size_t)g * NT + qrow) * 4 + h] = mx + __builtin_amdgcn_logf(l);
    }
#undef ATT_DECODE
}

__device__ __forceinline__ void combine_phase(Frame& F) {
    const bf16* atto = (const bf16*)(F.ws + WS_ATTO); const float* lse = (const float*)(F.ws + WS_LSE); bf16* mixin = (bf16*)(F.ws + WS_MIXIN);
    for (size_t idx = (size_t)F.bid * NTHREADS + F.tid; idx < (size_t)NT * 32; idx += (size_t)F.G * NTHREADS) {
        const size_t t = idx >> 5; const int pc = (int)(idx & 31), h = pc >> 3;
        const float l0 = lse[(0 * (size_t)NT + t) * 4 + h], l1 = lse[(1 * (size_t)NT + t) * 4 + h], l2 = lse[(2 * (size_t)NT + t) * 4 + h];
        const float m = fmaxf(l0, fmaxf(l1, l2));
        float a0 = __builtin_amdgcn_exp2f(l0 - m), a1 = __builtin_amdgcn_exp2f(l1 - m), a2 = __builtin_amdgcn_exp2f(l2 - m);
        const float inv = 1.f / (a0 + a1 + a2); a0 *= inv; a1 *= inv; a2 *= inv;
        const v4u v0 = *(const v4u*)(atto + (0 * (size_t)NT + t) * 256 + pc * 8), v1 = *(const v4u*)(atto + (1 * (size_t)NT + t) * 256 + pc * 8), v2 = *(const v4u*)(atto + (2 * (size_t)NT + t) * 256 + pc * 8);
        v4u o;
        o.x = pk2(a0 * bflo(v0.x) + a1 * bflo(v1.x) + a2 * bflo(v2.x), a0 * bfhi(v0.x) + a1 * bfhi(v1.x) + a2 * bfhi(v2.x));
        o.y = pk2(a0 * bflo(v0.y) + a1 * bflo(v1.y) + a2 * bflo(v2.y), a0 * bfhi(v0.y) + a1 * bfhi(v1.y) + a2 * bfhi(v2.y));
        o.z = pk2(a0 * bflo(v0.z) + a1 * bflo(v1.z) + a2 * bflo(v2.z), a0 * bfhi(v0.z) + a1 * bfhi(v1.z) + a2 * bfhi(v2.z));
        o.w = pk2(a0 * bflo(v0.w) + a1 * bflo(v1.w) + a2 * bflo(v2.w), a0 * bfhi(v0.w) + a1 * bfhi(v1.w) + a2 * bfhi(v2.w));
        *(v4u*)(mixin + t * NMIX + 256 + pc * 8) = o;
    }
}

#if MK_NAIVE_ATTN
__device__ __forceinline__ void naive_attn_phase(Frame& F) {
    const bf16* proj = (const bf16*)(F.ws + WS_PROJ); bf16* mixin = (bf16*)(F.ws + WS_MIXIN);
    for (size_t idx = (size_t)F.bid * NTHREADS + F.tid; idx < (size_t)NT * 4; idx += (size_t)F.G * NTHREADS) {
        const size_t tg = idx >> 2; const int h = (int)(idx & 3), t = (int)(tg & (SEQ - 1)); const size_t rowb = tg - t;
        float m = -1e30f, l = 0.f, o[64];
        for (int e = 0; e < 64; ++e) o[e] = 0.f;
        for (int g = 0; g < 3; ++g) { const int d = 1 << (2 * g); const int colQ = 256 + g * 256 + h * 64;
            const bf16* q = proj + tg * NPROJ + colQ;
            for (int j = 0; j <= 128; ++j) { const int tk = t - j * d; if (tk < 0) break;
                const bf16* k = proj + (rowb + tk) * NPROJ + colQ + 768; const bf16* v = k + 768;
                float sdot = 0.f; for (int e = 0; e < 64; ++e) sdot += bf2f(q[e]) * bf2f(k[e]);
                sdot *= 0.125f;
                const float mn = fmaxf(m, sdot), corr = __expf(m - mn), p = __expf(sdot - mn);
                l = l * corr + p; for (int e = 0; e < 64; ++e) o[e] = o[e] * corr + p * bf2f(v[e]); m = mn; } }
        const float il = 1.f / l;
        for (int e = 0; e < 64; ++e) mixin[tg * NMIX + 256 + h * 64 + e] = (bf16)f2bf(o[e] * il);
    }
}
#endif

__device__ __forceinline__ void routing_phase(Frame& F, const float* router_bias) {
    const float* L0 = (const float*)(F.ws + WS_LOGIT); const float* L1 = L0 + (size_t)NT * NE;
    float* gatew = (float*)(F.ws + WS_GATEW); unsigned* bucket = (unsigned*)(F.ws + WS_BUCKET); unsigned* gcnt = (unsigned*)(F.ws + WS_CTL) + CW_GCNT;
    LAS unsigned* hist = (LAS unsigned*)F.lds; LAS unsigned* basel = hist + 256; LAS unsigned* asg = hist + 512;
    const int lane = F.lane;
    for (int blk = F.bid; blk < NT / 128; blk += F.G) {
        __syncthreads();
        if (F.tid < 256) hist[F.tid] = 0u;
        __syncthreads();
        const f32x4 bias = *(const f32x4*)(router_bias + 4 * lane);
        f32x4 lgn; { const size_t t0 = (size_t)blk * 128 + F.wave * 16; lgn = *(const f32x4*)(L0 + t0 * NE + 4 * lane) + *(const f32x4*)(L1 + t0 * NE + 4 * lane); }
#pragma nounroll
        for (int tl = 0; tl < 16; ++tl) {
            const int tloc = F.wave * 16 + tl; const size_t t = (size_t)blk * 128 + tloc;
            const f32x4 lg = lgn;
            if (tl + 1 < 16) lgn = *(const f32x4*)(L0 + (t + 1) * NE + 4 * lane) + *(const f32x4*)(L1 + (t + 1) * NE + 4 * lane);
            float sc[4], cd[4];
#pragma unroll
            for (int i = 0; i < 4; ++i) { sc[i] = 1.f / (1.f + __expf(-lg[i])); cd[i] = sc[i] + bias[i]; }
            float a1 = fmaxf(cd[0], cd[1]), a2 = fminf(cd[0], cd[1]);
#pragma unroll
            for (int i = 2; i < 4; ++i) { const float v = cd[i]; a2 = fmaxf(a2, fminf(a1, v)); a1 = fmaxf(a1, v); }
            { float b1 = dppf<0xB1>(a1), b2 = dppf<0xB1>(a2); float n1 = fmaxf(a1, b1), n2 = fmaxf(fminf(a1, b1), fmaxf(a2, b2)); a1 = n1; a2 = n2;
              b1 = dppf<0x4E>(a1); b2 = dppf<0x4E>(a2); n1 = fmaxf(a1, b1); n2 = fmaxf(fminf(a1, b1), fmaxf(a2, b2)); a1 = n1; a2 = n2;
              b1 = dppf<0x141>(a1); b2 = dppf<0x141>(a2); n1 = fmaxf(a1, b1); n2 = fmaxf(fminf(a1, b1), fmaxf(a2, b2)); a1 = n1; a2 = n2; }
            const float gs = a1 + a2; const int myg = lane >> 3; int rank = 0;
#pragma unroll
            for (int gg = 0; gg < 8; ++gg) { const float o = __builtin_bit_cast(float, __builtin_amdgcn_readlane(__builtin_bit_cast(int, gs), gg * 8)); rank += (o > gs || (o == gs && gg < myg)) ? 1 : 0; }
            if (rank >= 4) {
#pragma unroll
                for (int i = 0; i < 4; ++i) cd[i] = -1e30f; }
            int sel_e = 0; float sel_s = 0.f, ssum = 0.f;
#pragma unroll
            for (int k = 0; k < TOPK; ++k) {
                const float lm = fmaxf(fmaxf(cd[0], cd[1]), fmaxf(cd[2], cd[3]));
                float v = fmaxf(lm, dppf<0xB1>(lm)); v = fmaxf(v, dppf<0x4E>(v)); v = fmaxf(v, dppf<0x141>(v)); v = fmaxf(v, dppf<0x140>(v));
                const float r0 = __builtin_bit_cast(float, __builtin_amdgcn_readlane(__builtin_bit_cast(int, v), 0)), r1 = __builtin_bit_cast(float, __builtin_amdgcn_readlane(__builtin_bit_cast(int, v), 16));
                const float r2 = __builtin_bit_cast(float, __builtin_amdgcn_readlane(__builtin_bit_cast(int, v), 32)), r3 = __builtin_bit_cast(float, __builtin_amdgcn_readlane(__builtin_bit_cast(int, v), 48));
                const float mx = fmaxf(fmaxf(r0, r1), fmaxf(r2, r3));
                const unsigned long long msk = __ballot(lm == mx);
                const int own = __builtin_ffsll((long long)msk) - 1;
                const int bi = cd[0] == mx ? 0 : (cd[1] == mx ? 1 : (cd[2] == mx ? 2 : 3));
                float myv = sc[0]; myv = bi == 1 ? sc[1] : myv; myv = bi == 2 ? sc[2] : myv; myv = bi == 3 ? sc[3] : myv;
                const int wi = __builtin_amdgcn_readlane(bi, own);
                const float sv = __builtin_bit_cast(float, __builtin_amdgcn_readlane(__builtin_bit_cast(int, myv), own));
                if (lane == own) {
#pragma unroll
                    for (int i = 0; i < 4; ++i) if (wi == i) cd[i] = -1e30f; }
                ssum += sv;
                if (lane == k) { sel_e = 4 * own + wi; sel_s = sv; }
            }
            if (lane < TOPK) {
                const unsigned rk = __hip_atomic_fetch_add(hist + sel_e, 1u, __ATOMIC_RELAXED, __HIP_MEMORY_SCOPE_WORKGROUP);
                asg[tloc * 8 + lane] = (unsigned)sel_e | (rk << 16);
                gatew[t * 8 + lane] = sel_s / ssum * 2.5f;
            }
        }
        __syncthreads();
        if (F.tid < 256) { const unsigned c = hist[F.tid]; basel[F.tid] = c ? atomicAdd(&gcnt[F.tid * 16], c) : 0u; }
        __syncthreads();
        for (int a = F.tid; a < 1024; a += NTHREADS) { const unsigned v = asg[a], e = v & 0xffffu, rk = v >> 16;
            bucket[(size_t)e * CAP + basel[e] + rk] = (unsigned)(blk * 1024 + a); }
    }
}

__device__ __forceinline__ void build_tables(Frame& F, int& nblk_total) {
    const unsigned* gcnt = (const unsigned*)(F.ws + WS_CTL) + CW_GCNT;
    LAS int* prefix = (LAS int*)(F.lds + TAB_OFF); LAS int* cnt = prefix + 260;
    __syncthreads();
    if (F.tid < 256) cnt[F.tid] = (int)__hip_atomic_load(&gcnt[F.tid * 16], __ATOMIC_RELAXED, __HIP_MEMORY_SCOPE_AGENT);
    __syncthreads();
    if (F.tid < 64) {
        int nb[4], sm = 0;
#pragma unroll
        for (int i = 0; i < 4; ++i) { nb[i] = (cnt[4 * F.tid + i] + 255) >> 8; sm += nb[i]; }
        int inc = sm;
#pragma unroll
        for (int o = 1; o < 64; o <<= 1) { const int t = __shfl_up(inc, o); if (F.tid >= o) inc += t; }
        int ex = inc - sm;
#pragma unroll
        for (int i = 0; i < 4; ++i) { prefix[4 * F.tid + i] = ex; ex += nb[i]; }
        if (F.tid == 63) prefix[NE] = inc;
    }
    __syncthreads();
    if (F.tid < 256) { LAS unsigned char* b2e = (LAS unsigned char*)(cnt + 256); for (int b = prefix[F.tid]; b < prefix[F.tid + 1]; ++b) b2e[b] = (unsigned char)F.tid; }
    __syncthreads();
    nblk_total = prefix[NE];
}

__device__ __forceinline__ void final_phase(Frame& F, const float* g_final) {
    const float* mod = (const float*)(F.ws + WS_MOD); const unsigned char* Y = (const unsigned char*)(F.ws + WS_Y);
    const unsigned* pos = (const unsigned*)(F.ws + WS_POS); const float* gatew = (const float*)(F.ws + WS_GATEW);
    const int c0 = 16 * F.lane;
    for (int blk = F.bid; blk < NT / 128; blk += F.G) {
        const int b = (blk * 128) >> 12; const float* g2 = mod + (size_t)b * 6144 + 5 * D + c0;
        f32x4 gb[4];
#pragma unroll
        for (int j = 0; j < 4; ++j) gb[j] = *(const f32x4*)(g2 + 4 * j);
        const size_t rowbase = (size_t)blk * 128 + F.wave * 16;
        const unsigned p0 = pos[rowbase * 8 + F.lane], p1 = pos[rowbase * 8 + 64 + F.lane];
        const float w0 = gatew[rowbase * 8 + F.lane] * Y_INV_SCALE, w1 = gatew[rowbase * 8 + 64 + F.lane] * Y_INV_SCALE;
#pragma nounroll
        for (int rr = 0; rr < 16; ++rr) {
            const size_t row = rowbase + rr;
            const v4u* dr = (const v4u*)((const bf16*)F.out + row * (2 * D) + c0);
            v4u xv[2], sv[2], yv[TOPK]; float wk[TOPK];
            xv[0] = dr[0]; xv[1] = dr[1]; sv[0] = dr[128]; sv[1] = dr[129];
#pragma unroll
            for (int k = 0; k < TOPK; ++k) { const int idx = rr * 8 + k;
                const unsigned pk = (unsigned)__builtin_amdgcn_readlane((int)(idx < 64 ? p0 : p1), idx & 63);
                wk[k] = __builtin_bit_cast(float, __builtin_amdgcn_readlane(__builtin_bit_cast(int, idx < 64 ? w0 : w1), idx & 63));
                yv[k] = *(const v4u*)(Y + (size_t)pk * D + c0); }
            f32x4 v[4]; float s = 0.f;
#pragma unroll
            for (int j = 0; j < 4; ++j) {
                const unsigned sw0 = sv[j >> 1][(j & 1) * 2], sw1 = sv[j >> 1][(j & 1) * 2 + 1];
                f32x4 r = (f32x4){bflo(sw0), bfhi(sw0), bflo(sw1), bfhi(sw1)};
#pragma unroll
                for (int k = 0; k < TOPK; ++k) { const int wd = (int)yv[k][j];
                    const auto lo = __builtin_amdgcn_cvt_pk_f32_fp8(wd, false), hi = __builtin_amdgcn_cvt_pk_f32_fp8(wd, true);
                    r += wk[k] * (f32x4){lo[0], lo[1], hi[0], hi[1]}; }
                const unsigned xw0 = xv[j >> 1][(j & 1) * 2], xw1 = xv[j >> 1][(j & 1) * 2 + 1];
                v[j] = (f32x4){bflo(xw0), bfhi(xw0), bflo(xw1), bfhi(xw1)} + gb[j] * r;
                s += (v[j].x * v[j].x + v[j].y * v[j].y) + (v[j].z * v[j].z + v[j].w * v[j].w); }
            const float rstd = 1.f / sqrtf(wave_sum(s) * (1.f / D) + NORM_EPS);
            f32x4* orow = (f32x4*)(F.out + row * D + c0);
#pragma unroll
            for (int j = 0; j < 4; ++j) orow[j] = v[j] * rstd * *(const f32x4*)(g_final + c0 + 4 * j);
        }
    }
}

constexpr int N_PHASES = 12;
__global__ void __launch_bounds__(NTHREADS, 2) fwd(Args args) {
    extern __shared__ __attribute__((aligned(16))) unsigned char lds_raw[];
    Frame F;
    F.lds = (LAS unsigned char*)lds_raw;
    F.tid = threadIdx.x; F.lane = F.tid & 63; F.wave = __builtin_amdgcn_readfirstlane(F.tid >> 6); F.G = gridDim.x; F.bid = blockIdx.x;
#define INP(i) ld_ptr(F.lds, (i))
    F.out = args.out; F.ws = args.ws;
    unsigned char* ws = args.ws;
    volatile LAS unsigned* MISC = (volatile LAS unsigned*)(F.lds + MISC_OFF);
    if (F.tid < 16) MISC[F.tid] = 0u;
    if (F.tid == 0) { LAS unsigned long long* pt = (LAS unsigned long long*)(F.lds + PT_OFF);
#pragma unroll
        for (int i = 0; i < 19; ++i) pt[i] = (unsigned long long)args.in[i]; }
    __syncthreads();
    const int lo = args.ph_lo, hi = args.ph_hi;
    XcdBarrier bar; bar.bar = (unsigned*)(ws + WS_CTL) + CW_BAR; bar.x = 0; bar.st = nullptr;
    if (hi - lo > 1) bar = xcd_barrier_post((unsigned*)(ws + WS_CTL) + CW_BAR, MISC + 8);
#ifndef PH_MASK
#define PH_MASK 0xfff
#endif
#define IN(k) (((PH_MASK >> (k)) & 1) && lo <= (k) && (k) < hi)
#if MK_PROBE >= 1000
#define PH_T0(k) unsigned long long _pt##k = 0; if (MK_PROBE == 1000 + (k)) _pt##k = __builtin_amdgcn_s_memrealtime();
#define PH_T1(k) if (MK_PROBE == 1000 + (k) && blockIdx.x == MK_PROBE_BLK && F.tid == 0) MISC[12] += (unsigned)(__builtin_amdgcn_s_memrealtime() - _pt##k);
#else
#define PH_T0(k)
#define PH_T1(k)
#endif
#if MK_PROBE >= 2000
#define SEAM_T0() const unsigned long long _st0 = __builtin_amdgcn_s_memrealtime();
#define SEAM_T1(k) if ((MK_PROBE == 2000 || MK_PROBE == 2001 + (k)) && blockIdx.x == MK_PROBE_BLK && F.tid == 0) MISC[12] += (unsigned)(__builtin_amdgcn_s_memrealtime() - _st0);
#else
#define SEAM_T0()
#define SEAM_T1(k)
#endif
#define SEAM(k) do { SEAM_T0() if (IN(k) && IN((k) + 1)) { if ((k) <= 8) xcd_barrier_work(bar, F, QD_CHUNKS); else xcd_barrier(bar); } SEAM_T1(k) { int _t = threadIdx.x; asm volatile("" : "+v"(_t)); F.tid = _t; F.lane = _t & 63; } } while (0)

    const int vcu = (F.G % 8 == 0) ? (F.bid % 8) * (F.G / 8) + F.bid / 8 : F.bid;
    unsigned char* h8 = ws + WS_H;
    bf16* h2b = (bf16*)(ws + WS_H2B); bf16* proj = (bf16*)(ws + WS_PROJ); bf16* mixin = (bf16*)(ws + WS_MIXIN);

    PH_T0(0) if (IN(0)) { p0_prologue(F); } PH_T1(0) SEAM(0);
    PH_T0(1) if (IN(1)) { modnorm_phase<false, 2, false>(F, INP(0), INP(4), 0, h8, nullptr); win_int8_phase(F, INP(5)); } PH_T1(1) SEAM(1);
    PH_T0(2) if (IN(2)) {
        typedef DenseSchedT<NT / 256, NPROJ / 256, 1> SchedP2; SchedP2 S; S.init(h8, ws + WS_WIN_T, D / 2, D / 2, 0, F.G, F.bid);
        EpiProj E{proj, (const float*)(ws + WS_ROWSC), (const float*)(ws + WS_COLSC)};
        const int ksplit = vcu % 6;
        S.i0 = 0; S.i1 = ksplit;
        gemm_phase<EpiProj, SchedP2>(F.lds, D / 2, D / 2, S, E);
        __syncthreads();
        for (int e = F.bid; e < NE; e += F.G)
            convert_expert<false>(F, INP(12) + (size_t)e * D * FF, INP(13) + (size_t)e * D * FF, ws + WS_WGU_T + (size_t)e * 512 * D, 16, 16);
        __syncthreads();
        S.i0 = ksplit; S.i1 = 0x3fffffff;
        gemm_phase<EpiProj, SchedP2>(F.lds, D / 2, D / 2, S, E);
    } PH_T1(2) SEAM(2);
    PH_T0(3) if (IN(3)) {
#if MK_PROBE == 1103
        const unsigned long long _pp0 = __builtin_amdgcn_s_memrealtime();
#endif
        pool_phase(F, INP(7));
#if MK_PROBE == 1103
        if (blockIdx.x == MK_PROBE_BLK && F.tid == 0) MISC[12] += (unsigned)(__builtin_amdgcn_s_memrealtime() - _pp0);
#endif
#if MK_NAIVE_ATTN
        naive_attn_phase(F);
#else
        attn_phase(F);
#endif
    } PH_T1(3) SEAM(3);
    PH_T0(4) if (IN(4)) {
#if !MK_NAIVE_ATTN
        combine_phase(F);
#endif
    } PH_T1(4) SEAM(4);
    PH_T0(5) if (IN(5)) {
        typedef DenseSchedT<NT / 256, D / 256, 1> SchedP5; SchedP5 S; S.init(mixin, ws + WS_WOUT_T, NMIX, NMIX, 0, F.G, F.bid);
        EpiOut E{(bf16*)F.out};
        gemm_phase<EpiOut, SchedP5>(F.lds, NMIX, NMIX, S, E);
    } PH_T1(5) SEAM(5);
    PH_T0(6) if (IN(6)) { modnorm_phase<true, 1, true>(F, INP(0), INP(9), 3, h8, h2b); } PH_T1(6) SEAM(6);
    PH_T0(7) if (IN(7)) {
        typedef DenseSchedT<NT / 256, NE / 256, 2> SchedP7; SchedP7 S; S.init(h2b, ws + WS_WR_T, D, D, 512, F.G, F.bid);
        EpiRouter E{(float*)(ws + WS_LOGIT)};
        gemm_phase<EpiRouter, SchedP7>(F.lds, 512, D, S, E);
    } PH_T1(7) SEAM(7);
    PH_T0(8) if (IN(8)) { routing_phase(F, INP(11)); drain_queue(F, QG_CHUNKS); } PH_T1(8) SEAM(8);
    PH_T0(9) if (IN(9)) {
        int nblk; build_tables(F, nblk);
        MoeSched<2, false> S; S.prefix = (const LAS int*)(F.lds + TAB_OFF); S.cnt = S.prefix + 260; S.bucket = (const unsigned*)(ws + WS_BUCKET);
        S.Ar = (const char*)h8; S.As = (const char*)h8; S.Br = (const char*)(ws + WS_WGU_T); S.Bs = (const char*)(ws + WS_WSGU_T);
        S.nRouted = nblk * 2; S.total = S.nRouted + (NT / 256) * 2; S.G = F.G; S.c = vcu;
        EpiGU E{ws + WS_ACT, ws + WS_ACTS, (const unsigned*)(ws + WS_BUCKET), (unsigned*)(ws + WS_POS)};
        S.i0 = 0; S.i1 = 0x3fffffff;
        gemm_phase<EpiGU, MoeSched<2, false>>(F.lds, D / 2, D / 2, S, E);
        drain_queue(F, QD_CHUNKS);
    } PH_T1(9) SEAM(9);
    PH_T0(10) if (IN(10)) {
        int nblk; build_tables(F, nblk);
        MoeSched<4, true> S; S.prefix = (const LAS int*)(F.lds + TAB_OFF); S.cnt = S.prefix + 260; S.bucket = (const unsigned*)(ws + WS_BUCKET);
        S.Ar = (const char*)(ws + WS_ACT); S.As = (const char*)(ws + WS_ACTS); S.Br = (const char*)(ws + WS_WD_T); S.Bs = (const char*)(ws + WS_WSD_T);
        S.nRouted = nblk * 4; S.total = S.nRouted + (NT / 256) * 4; S.G = F.G; S.c = vcu; S.i0 = 0; S.i1 = 0x3fffffff;
        EpiDown E{(unsigned char*)(ws + WS_Y), (bf16*)F.out};
        gemm_phase<EpiDown, MoeSched<4, true>>(F.lds, FF / 2, FF / 2, S, E);
    } PH_T1(10) SEAM(10);
    PH_T0(11) if (IN(11)) { final_phase(F, INP(18)); } PH_T1(11)
#if MK_PROBE
    if (blockIdx.x == MK_PROBE_BLK) { __syncthreads();
        if (F.tid == 0) { const unsigned long long span = (unsigned long long)MISC[12] * MK_PROBE_MULT, t0 = __builtin_amdgcn_s_memrealtime();
            while (__builtin_amdgcn_s_memrealtime() - t0 < span) __builtin_amdgcn_s_sleep(16); } }
#endif
#undef IN
#undef SEAM
#undef INP
}

extern "C" void kernel_launch(void* const* d_in, const int* in_sizes, int n_in, void* d_out, int out_size, void* d_ws, size_t ws_size, hipStream_t stream) {
    static int grid = 0;
    if (grid == 0) {
        if (n_in != 19 || out_size != NT * D || ws_size < WS_END) { fprintf(stderr, "kernel_launch: unexpected shapes (n_in %d out %d ws %zu)\n", n_in, out_size, ws_size); grid = -1; return; }
        int dev = 0, cus = 0;
        if (hipGetDevice(&dev) != hipSuccess || hipDeviceGetAttribute(&cus, hipDeviceAttributeMultiprocessorCount, dev) != hipSuccess) { grid = -1; return; }
        if (hipFuncSetAttribute((const void*)fwd, hipFuncAttributeMaxDynamicSharedMemorySize, LDS_BYTES) != hipSuccess) { fprintf(stderr, "kernel_launch: hipFuncSetAttribute failed\n"); grid = -1; return; }
        int per_cu = 0;
        if (hipOccupancyMaxActiveBlocksPerMultiprocessor(&per_cu, (const void*)fwd, NTHREADS, LDS_BYTES) != hipSuccess || per_cu < 1) { fprintf(stderr, "kernel_launch: occupancy query says %d\n", per_cu); }
        (void)hipGetLastError();
        grid = cus;
    }
    if (grid < 0) return;
    (void)hipMemsetAsync((char*)d_ws + WS_CTL, 0, CTL_ZERO_BYTES, stream);
    Args a{};
    for (int i = 0; i < 19; ++i) a.in[i] = (const float*)d_in[i];
    a.out = (float*)d_out; a.ws = (unsigned char*)d_ws;
#if MK_ONE_LAUNCH
    a.ph_lo = 0; a.ph_hi = N_PHASES;
    hipLaunchKernelGGL(fwd, dim3(grid), dim3(NTHREADS), LDS_BYTES, stream, a);
#else
    for (int p = 0; p < N_PHASES; ++p) { a.ph_lo = p; a.ph_hi = p + 1; const int reps = ((MK_REP_MASK >> p) & 1) ? 2 : 1;
        for (int r = 0; r < reps; ++r) hipLaunchKernelGGL(fwd, dim3(grid), dim3(NTHREADS), LDS_BYTES, stream, a); }
#endif
}
```

```cpp
#include <hip/hip_runtime.h>
#include <cstdio>
#include <cstdint>

#ifndef MK_ONE_LAUNCH
#define MK_ONE_LAUNCH 1
#endif
#ifndef MK_FAST_GEMM
#define MK_FAST_GEMM 1
#endif
#ifndef MK_REP_MASK
#define MK_REP_MASK 0x000
#endif
#ifndef MK_MX
#define MK_MX 1
#endif
#ifndef MK_PROBE
#define MK_PROBE 0
#endif
#ifndef MK_PROBE_BLK
#define MK_PROBE_BLK 0
#endif
#ifndef MK_PROBE_WAVE
#define MK_PROBE_WAVE 0
#endif
#ifndef MK_PROBE_MULT
#define MK_PROBE_MULT 4
#endif
#ifndef MK_NAIVE_ATTN
#define MK_NAIVE_ATTN 0
#endif

#define LAS __attribute__((address_space(3)))
#define GAS __attribute__((address_space(1)))
typedef unsigned short bf16;
typedef short bf16x8 __attribute__((ext_vector_type(8)));
typedef short s16x4 __attribute__((ext_vector_type(4)));
typedef float f32x4 __attribute__((ext_vector_type(4)));
typedef float f32x2 __attribute__((ext_vector_type(2)));
typedef long l64x2 __attribute__((ext_vector_type(2)));
typedef int i32x8 __attribute__((ext_vector_type(8)));
typedef int i32x4 __attribute__((ext_vector_type(4)));
typedef unsigned v4u __attribute__((ext_vector_type(4)));
typedef unsigned v2u __attribute__((ext_vector_type(2)));

constexpr int D = 1024, NB = 8, SEQ = 4096, NT = NB * SEQ;
constexpr int NPROJ = 2560, NE = 256, TOPK = 8, FF = 256, NMIX = 512;
constexpr int CAP = NT;
constexpr int MAXBLK = NT * TOPK / 256 + NE;
constexpr float NORM_EPS = 1e-6f;
constexpr int NWAVES = 8, NTHREADS = 512;

constexpr size_t MiB = 1u << 20;
constexpr size_t WS_CTL = 0, CTL_ZERO_BYTES = 1 * MiB;
constexpr size_t WS_MOD = 1 * MiB;
constexpr size_t WS_GATEW = 2 * MiB;
constexpr size_t WS_WIN_T = 4 * MiB;
constexpr size_t WS_WOUT_T = 9 * MiB;
constexpr size_t WS_WR_T = 10 * MiB;
constexpr size_t WS_WSGU_T = 11 * MiB;
constexpr size_t WS_WSD_T = 12 * MiB;
constexpr size_t WS_LSE = 13 * MiB;
constexpr size_t WS_WD_T = 16 * MiB;
constexpr size_t WS_ACT = 144 * MiB;
constexpr size_t WS_ACTS = 304 * MiB;
constexpr size_t WS_BUCKET = 320 * MiB;
constexpr size_t WS_WGU_T = 352 * MiB;
constexpr size_t WS_PROJ = 608 * MiB;
constexpr size_t WS_H = 768 * MiB;
constexpr size_t WS_ATTO = 832 * MiB;
constexpr size_t WS_MIXIN = 880 * MiB;
constexpr size_t WS_LOGIT = 912 * MiB;
constexpr size_t WS_Y = 352 * MiB;
constexpr size_t WS_H2B = 832 * MiB;
constexpr size_t WS_ROWSC = 14 * MiB + 512 * 1024;
constexpr size_t WS_COLSC = 14 * MiB + 768 * 1024;
constexpr size_t WS_PWT = 15 * MiB;
constexpr size_t WS_POS = 3 * MiB;
constexpr size_t WS_END = 992 * MiB;
constexpr int CW_BAR = 4096;
constexpr int CW_GCNT = 16384;
constexpr int CW_QD = 24576;
constexpr unsigned QG_CHUNKS = NE * 16, QD_CHUNKS = QG_CHUNKS + NE * 16;

constexpr int RING_BYTES = 131072;
constexpr int TAB_OFF = RING_BYTES;
constexpr int MISC_OFF = TAB_OFF + 4096;
constexpr int PT_OFF = MISC_OFF + 256;
constexpr int LDS_BYTES = 147456;

__device__ __forceinline__ unsigned f2bf(float f) { unsigned u = __builtin_bit_cast(unsigned, f); return (u + 0x7fffu + ((u >> 16) & 1u)) >> 16; }
__device__ __forceinline__ unsigned pk2(float lo, float hi) { unsigned r; asm("v_cvt_pk_bf16_f32 %0, %1, %2" : "=v"(r) : "v"(lo), "v"(hi)); return r; }
constexpr float W_SCALE = 64.f, W_INV_SCALE = 1.f / 64.f;
constexpr float WD_SCALE = 4.f;
constexpr float ACT_SCALE = 4.f;
__device__ __forceinline__ unsigned pk4_fp8(float a, float b, float c, float d) {
    int w = __builtin_amdgcn_cvt_pk_fp8_f32(a, b, 0, false); w = __builtin_amdgcn_cvt_pk_fp8_f32(c, d, w, true); return (unsigned)w; }
__device__ __forceinline__ unsigned pk4_i8(float a, float b, float c, float d) {
    const int ia = (int)__builtin_rintf(a), ib = (int)__builtin_rintf(b), ic = (int)__builtin_rintf(c), id = (int)__builtin_rintf(d);
    return (unsigned)(ia & 255) | ((unsigned)(ib & 255) << 8) | ((unsigned)(ic & 255) << 16) | ((unsigned)id << 24); }
__device__ __forceinline__ float bf2f(unsigned short b) { return __builtin_bit_cast(float, ((unsigned)b) << 16); }
__device__ __forceinline__ float bflo(unsigned u) { return __builtin_bit_cast(float, u << 16); }
__device__ __forceinline__ float bfhi(unsigned u) { return __builtin_bit_cast(float, u & 0xffff0000u); }
template <int CTRL> __device__ __forceinline__ float dppf(float v) {
    return __builtin_bit_cast(float, __builtin_amdgcn_update_dpp(0, __builtin_bit_cast(int, v), CTRL, 0xF, 0xF, true)); }
__device__ __forceinline__ float wave_sum(float v) {
    v += dppf<0xB1>(v); v += dppf<0x4E>(v); v += dppf<0x141>(v); v += dppf<0x140>(v);
    const float r0 = __builtin_bit_cast(float, __builtin_amdgcn_readlane(__builtin_bit_cast(int, v), 0)), r1 = __builtin_bit_cast(float, __builtin_amdgcn_readlane(__builtin_bit_cast(int, v), 16));
    const float r2 = __builtin_bit_cast(float, __builtin_amdgcn_readlane(__builtin_bit_cast(int, v), 32)), r3 = __builtin_bit_cast(float, __builtin_amdgcn_readlane(__builtin_bit_cast(int, v), 48));
    return (r0 + r1) + (r2 + r3);
}
__device__ __forceinline__ float wave_max(float v) {
    v = fmaxf(v, dppf<0xB1>(v)); v = fmaxf(v, dppf<0x4E>(v)); v = fmaxf(v, dppf<0x141>(v)); v = fmaxf(v, dppf<0x140>(v));
    const float r0 = __builtin_bit_cast(float, __builtin_amdgcn_readlane(__builtin_bit_cast(int, v), 0)), r1 = __builtin_bit_cast(float, __builtin_amdgcn_readlane(__builtin_bit_cast(int, v), 16));
    const float r2 = __builtin_bit_cast(float, __builtin_amdgcn_readlane(__builtin_bit_cast(int, v), 32)), r3 = __builtin_bit_cast(float, __builtin_amdgcn_readlane(__builtin_bit_cast(int, v), 48));
    return fmaxf(fmaxf(r0, r1), fmaxf(r2, r3));
}
__device__ __forceinline__ float silu_f(float g) { return g * __builtin_amdgcn_rcpf(1.f + __builtin_amdgcn_exp2f(-1.44269504f * g)); }

__device__ __forceinline__ const float* ld_ptr(LAS unsigned char* lds, int i) {
    const unsigned long long v = ((const LAS unsigned long long*)(lds + PT_OFF))[i];
    const unsigned lo = __builtin_amdgcn_readfirstlane((unsigned)v), hi = __builtin_amdgcn_readfirstlane((unsigned)(v >> 32));
    return (const float*)(((unsigned long long)hi << 32) | lo);
}
#define XB_TMO      128
#define XB_XCNT(j)  (256  + 64 * (j))
#define XB_XSUB(j)  (1280 + 64 * (j))
#define XB_XGEN(j)  (2304 + 64 * (j))
#define XB_TOP      3328
#define XB_TOPGEN   3392
#define XCD_BAR_WORDS 3456
#define XB_SPIN_CAP (1u << 18)
__device__ __forceinline__ unsigned xb_ld(unsigned* p)              { return __hip_atomic_load(p, __ATOMIC_RELAXED, __HIP_MEMORY_SCOPE_AGENT); }
__device__ __forceinline__ unsigned xb_add(unsigned* p, unsigned v) { return __hip_atomic_fetch_add(p, v, __ATOMIC_RELAXED, __HIP_MEMORY_SCOPE_AGENT); }
__device__ __forceinline__ unsigned xb_xcc_id() { return (unsigned)__builtin_amdgcn_s_getreg((3 << 11) | 20) & 0xFu; }
#define XB_SPIN(cond, bar) do { unsigned _sp = 0; while (cond) { __builtin_amdgcn_s_sleep(1); \
    if ((++_sp & 255u) == 0u) { if (xb_ld(&(bar)[XB_TMO])) break; if (_sp > XB_SPIN_CAP) { atomicAdd(&(bar)[XB_TMO], 1u); break; } } } } while (0)
struct XcdBarrier { unsigned* bar; unsigned x; volatile LAS unsigned* st; };
__device__ __forceinline__ XcdBarrier xcd_barrier_post(unsigned* bar, volatile LAS unsigned* st) {
    XcdBarrier b; b.bar = bar; b.x = xb_xcc_id(); b.st = st;
    if (threadIdx.x == 0) (void)xb_add(&bar[XB_XCNT(b.x)], 1u);
    return b;
}
__device__ __forceinline__ void xcd_barrier_complete(unsigned* bar, unsigned x, unsigned& nloc, unsigned& nx) {
    const unsigned G = gridDim.x * gridDim.y * gridDim.z;
    unsigned sum, cnt, mine, sp = 0u;
    for (;;) {
        sum = 0u; cnt = 0u; mine = 0u;
#pragma unroll
        for (unsigned j = 0; j < 16; ++j) { const unsigned c = xb_ld(&bar[XB_XCNT(j)]); sum += c; cnt += (c > 0u) ? 1u : 0u; mine = (j == x) ? c : mine; }
        if (sum == G) break;
        __builtin_amdgcn_s_sleep(1);
        if ((++sp & 255u) == 0u) { if (xb_ld(&bar[XB_TMO])) break; if (sp > XB_SPIN_CAP) { atomicAdd(&bar[XB_TMO], 1u); break; } }
    }
    nloc = mine > 0u ? mine : 1u; nx = cnt > 0u ? cnt : 1u;
}
__device__ __forceinline__ void xcd_barrier(const XcdBarrier& b) {
    asm volatile("s_waitcnt vmcnt(0)" ::: "memory");
    __syncthreads();
    if (threadIdx.x == 0) {
        unsigned* bar = b.bar;
        __builtin_amdgcn_s_waitcnt(0);
        unsigned nloc = b.st[0], nx = b.st[1];
        if (nloc == 0u) { xcd_barrier_complete(bar, b.x, nloc, nx); b.st[0] = nloc; b.st[1] = nx; }
        const unsigned old = xb_add(&bar[XB_XSUB(b.x)], 1u);
        const unsigned gen = old / nloc;
        if (old + 1u == (gen + 1u) * nloc) {
            __builtin_amdgcn_fence(__ATOMIC_RELEASE, "agent");
            asm volatile("s_waitcnt vmcnt(0)" ::: "memory");
            const unsigned og = xb_add(&bar[XB_TOP], 1u);
            const unsigned tg = og / nx;
            if (og + 1u == (tg + 1u) * nx) xb_add(&bar[XB_TOPGEN], 1u);
            else XB_SPIN(xb_ld(&bar[XB_TOPGEN]) == tg, bar);
            __builtin_amdgcn_fence(__ATOMIC_ACQUIRE, "agent");
            xb_add(&bar[XB_XGEN(b.x)], 1u);
            asm volatile("s_waitcnt vmcnt(0)" ::: "memory");
        } else {
            XB_SPIN(xb_ld(&bar[XB_XGEN(b.x)]) == gen, bar);
            __builtin_amdgcn_fence(__ATOMIC_ACQUIRE, "agent");
            asm volatile("s_waitcnt vmcnt(0)" ::: "memory");
        }
    }
    __syncthreads();
}

constexpr int BK = 64, HALF = 128, HTB = HALF * BK * 2;
__device__ __forceinline__ int lds_byte(int r, int c) { const int st = (r >> 4) * 2 + (c >> 5), rr = r & 15, cc = c & 31, ob = rr * 64 + cc * 2; return st * 1024 + (ob ^ (((ob >> 9) & 1) << 5)); }
__device__ __forceinline__ void stage_rc(int b, int& R, int& C) { const int st = b / 1024, sb = b % 1024, swz = sb ^ (((sb >> 9) & 1) << 5); R = (st >> 1) * 16 + swz / 64; C = (st & 1) * 32 + (swz % 64) / 2; }
__device__ __forceinline__ int perm32(int rho) { const int n = rho >> 4, i = rho & 15; return 8 * (i >> 2) + 4 * n + (i & 3); }

template <class Epi, class Sched>
__device__ __forceinline__ void gemm_simple(const int K, const int ldb, const Sched& S, const Epi& E) {
    const int tid = threadIdx.x, wid = __builtin_amdgcn_readfirstlane(tid >> 6), lane = tid & 63, wr = wid >> 2, wc = wid & 3, fr = lane & 15, fq = lane >> 4;
    typename Sched::Unit u;
    for (int ui = 0; S.next(ui, u); ++ui) {
        f32x4 acc[2][2][4][2];
#pragma unroll
        for (int a = 0; a < 2; ++a)
#pragma unroll
            for (int b = 0; b < 2; ++b)
#pragma unroll
                for (int m = 0; m < 4; ++m)
#pragma unroll
                    for (int n = 0; n < 2; ++n) acc[a][b][m][n] = (f32x4){0.f, 0.f, 0.f, 0.f};
        const char* A = S.a_base(u); const char* B = S.b_base(u);
        unsigned aoff[2][4], boff[2][2];
#pragma unroll
        for (int ai = 0; ai < 2; ++ai)
#pragma unroll
            for (int m = 0; m < 4; ++m) aoff[ai][m] = S.a_off(u, 128 * ai + 64 * wr + 16 * m + fr) + fq * 16;
#pragma unroll
        for (int bj = 0; bj < 2; ++bj)
#pragma unroll
            for (int n = 0; n < 2; ++n) { const int row = Epi::PERM == 2 ? 64 * wc + 16 * (fr >> 2) + 8 * bj + 4 * n + (fr & 3) : 128 * bj + 32 * wc + (Epi::PERM == 1 ? perm32(16 * n + fr) : 16 * n + fr); boff[bj][n] = (unsigned)(row * ldb) * 2u + fq * 16; }
        for (int k = 0; k < K; k += 32) {
            bf16x8 a[2][4], b[2][2];
#pragma unroll
            for (int ai = 0; ai < 2; ++ai)
#pragma unroll
                for (int m = 0; m < 4; ++m) a[ai][m] = *(const bf16x8*)(A + aoff[ai][m] + k * 2);
#pragma unroll
            for (int bj = 0; bj < 2; ++bj)
#pragma unroll
                for (int n = 0; n < 2; ++n) b[bj][n] = *(const bf16x8*)(B + boff[bj][n] + k * 2);
#pragma unroll
            for (int ai = 0; ai < 2; ++ai)
#pragma unroll
                for (int bj = 0; bj < 2; ++bj)
#pragma unroll
                    for (int m = 0; m < 4; ++m)
#pragma unroll
                        for (int n = 0; n < 2; ++n) acc[ai][bj][m][n] = __builtin_amdgcn_mfma_f32_16x16x32_bf16(b[bj][n], a[ai][m], acc[ai][bj][m][n], 0, 0, 0);
        }
        E(acc, u, wr, wc, fr, fq);
    }
}

template <class Epi, class Sched>
__device__ __forceinline__ void gemm_fast(LAS unsigned char* lds, const int K, const int ldb, const Sched& S, const Epi& E) {
    int tid0 = threadIdx.x; asm volatile("" : "+v"(tid0));
    const int tid = tid0, wid = __builtin_amdgcn_readfirstlane(tid >> 6), lane = tid & 63, wr = wid >> 2, wc = wid & 3, fr = lane & 15, fq = lane >> 4;
    int nt = K / BK; asm volatile("" : "+s"(nt));
    unsigned voffB0[2], voffB1[2];
#pragma unroll
    for (int i = 0; i < 2; ++i) { int R, C; stage_rc(tid * 16 + i * 8192, R, C);
        if (Epi::PERM == 2) { const int cb = 64 * (R >> 5) + 16 * ((R & 15) >> 2) + 4 * ((R >> 4) & 1) + (R & 3);
            voffB0[i] = (unsigned)(cb * ldb + C) * 2u; voffB1[i] = (unsigned)((cb + 8) * ldb + C) * 2u; }
        else { const int Rb = Epi::PERM == 1 ? ((R & ~31) + perm32(R & 31)) : R;
            voffB0[i] = (unsigned)(Rb * ldb + C) * 2u; voffB1[i] = (unsigned)((Rb + HALF) * ldb + C) * 2u; } }
#define PG8_AOFF(u) do { int _tz = threadIdx.x; asm volatile("" : "+v"(_tz)); _Pragma("unroll") for (int _i = 0; _i < 2; ++_i) { int _R, _C; stage_rc(_tz * 16 + _i * 8192, _R, _C); \
        vA0[_i] = S.a_off(u, _R) + (unsigned)_C * 2u; vA1[_i] = S.a_off(u, HALF + _R) + (unsigned)_C * 2u; } } while (0)
    const size_t kstep = (size_t)(BK * 2);
    const unsigned ldsw = (unsigned)wid * 1024u;
    const int aoff = lds_byte(wr * 64 + fr, fq * 8), boff = lds_byte(wc * 32 + fr, fq * 8);
#if MK_PROBE
#define PRB_NOW() __builtin_amdgcn_s_memrealtime()
#define PRB_ADD(IV, t0, t1) do { if (MK_PROBE == Epi::PID * 10 + (IV) && blockIdx.x == MK_PROBE_BLK && wid == MK_PROBE_WAVE && lane == 0) \
        __hip_atomic_fetch_add((LAS unsigned*)(lds + MISC_OFF + 48), (unsigned)((t1) - (t0)), __ATOMIC_RELAXED, __HIP_MEMORY_SCOPE_WORKGROUP); } while (0)
#else
#define PRB_NOW() 0ull
#define PRB_ADD(IV, t0, t1) do { } while (0)
#endif
#define PG8_SA(b, h) (((b) * 2 + (h)) * HTB)
#define PG8_SB(b, h) ((4 + (b) * 2 + (h)) * HTB)
#define PG8_STAGE(bufoff, gbase, voff) do { _Pragma("unroll") for (int _i = 0; _i < 2; ++_i) \
        __builtin_amdgcn_global_load_lds((const unsigned*)((const char*)(gbase) + (voff)[_i]), (LAS unsigned*)(lds + (bufoff) + ldsw + _i * 8192), 16, 0, 0); } while (0)
#define PG8_LDA(dst, b, h) do { _Pragma("unroll") for (int m = 0; m < 4; ++m) _Pragma("unroll") for (int k = 0; k < 2; ++k) dst[m][k] = *(const LAS bf16x8*)(lds + PG8_SA(b, h) + aoff + m * 2048 + k * 1024); } while (0)
#define PG8_LDB(dst, b, h) do { _Pragma("unroll") for (int n = 0; n < 2; ++n) _Pragma("unroll") for (int k = 0; k < 2; ++k) dst[n][k] = *(const LAS bf16x8*)(lds + PG8_SB(b, h) + boff + n * 2048 + k * 1024); } while (0)
#define PG8_MMA(ai, bj, At, Bt) do { __builtin_amdgcn_s_setprio(1); _Pragma("unroll") for (int m = 0; m < 4; ++m) _Pragma("unroll") for (int n = 0; n < 2; ++n) _Pragma("unroll") for (int k = 0; k < 2; ++k) { \
        if constexpr (Epi::FP8 && MK_MX) { if (k == 0) { \
            const i32x8 _a = __builtin_shufflevector(__builtin_bit_cast(i32x4, At[m][0]), __builtin_bit_cast(i32x4, At[m][1]), 0, 1, 2, 3, 4, 5, 6, 7); \
            const i32x8 _b = __builtin_shufflevector(__builtin_bit_cast(i32x4, Bt[n][0]), __builtin_bit_cast(i32x4, Bt[n][1]), 0, 1, 2, 3, 4, 5, 6, 7); \
            acc[ai][bj][m][n] = __builtin_amdgcn_mfma_scale_f32_16x16x128_f8f6f4(_b, _a, acc[ai][bj][m][n], 0, 0, 0, 0x7F7F7F7F, 0, 0x7F7F7F7F); } } \
        else if constexpr (Epi::I8) acc[ai][bj][m][n] = __builtin_bit_cast(f32x4, __builtin_amdgcn_mfma_i32_16x16x64_i8(__builtin_bit_cast(i32x4, Bt[n][k]), __builtin_bit_cast(i32x4, At[m][k]), __builtin_bit_cast(i32x4, acc[ai][bj][m][n]), 0, 0, 0)); \
        else if constexpr (Epi::FP8) { const l64x2 _a = __builtin_bit_cast(l64x2, At[m][k]), _b = __builtin_bit_cast(l64x2, Bt[n][k]); \
            acc[ai][bj][m][n] = __builtin_amdgcn_mfma_f32_16x16x32_fp8_fp8(_b[0], _a[0], acc[ai][bj][m][n], 0, 0, 0); \
            acc[ai][bj][m][n] = __builtin_amdgcn_mfma_f32_16x16x32_fp8_fp8(_b[1], _a[1], acc[ai][bj][m][n], 0, 0, 0); } \
        else acc[ai][bj][m][n] = __builtin_amdgcn_mfma_f32_16x16x32_bf16(Bt[n][k], At[m][k], acc[ai][bj][m][n], 0, 0, 0); } __builtin_amdgcn_s_setprio(0); } while (0)
#define PG8_WAIT_V(n) asm volatile("s_waitcnt vmcnt(" #n ")" ::: "memory")
#define PG8_WAIT_L(n) asm volatile("s_waitcnt lgkmcnt(" #n ")" ::: "memory")
#define PG8_BAR __builtin_amdgcn_s_barrier()
#define PG8_SCHED __builtin_amdgcn_sched_barrier(0)
    typename Sched::Unit cur, nxt; int ui = 0;
    if (!S.next(0, cur)) return;
    f32x4 acc[2][2][4][2];
#pragma unroll
    for (int a = 0; a < 2; ++a)
#pragma unroll
        for (int b = 0; b < 2; ++b)
#pragma unroll
            for (int m = 0; m < 4; ++m)
#pragma unroll
                for (int n = 0; n < 2; ++n) acc[a][b][m][n] = (f32x4){0.f, 0.f, 0.f, 0.f};
    bf16x8 At[4][2], B0[2][2], B1[2][2];
    const char* cA = S.a_base(cur); const char* cB = S.b_base(cur);
    unsigned vA0[2], vA1[2];
    PG8_AOFF(cur);
    PG8_STAGE(PG8_SB(0, 0), cB, voffB0); PG8_STAGE(PG8_SA(0, 0), cA, vA0); PG8_STAGE(PG8_SB(0, 1), cB, voffB1); PG8_STAGE(PG8_SA(0, 1), cA, vA1);
    if (wr == 1) PG8_BAR;
    PG8_WAIT_V(4); PG8_BAR;
    PG8_STAGE(PG8_SB(1, 0), cB + kstep, voffB0); PG8_STAGE(PG8_SA(1, 0), cA + kstep, vA0); PG8_STAGE(PG8_SB(1, 1), cB + kstep, voffB1);
    PG8_WAIT_V(6); PG8_BAR;
    for (;;) {
        const unsigned long long prb_a = PRB_NOW();
        const bool has_next = S.next(ui + 1, nxt);
        const char* nA = has_next ? S.a_base(nxt) : cA; const char* nB = has_next ? S.b_base(nxt) : cB;
        const unsigned long long prb_b = PRB_NOW(); PRB_ADD(1, prb_a, prb_b);
        for (int t = 0; t < nt; t += 2) {
            const unsigned long long prb_i0 = PRB_NOW();
            const bool last = (t == nt - 2);
            const char* a1 = cA + (size_t)(t + 1) * kstep;
            const char* a2 = last ? nA : cA + (size_t)(t + 2) * kstep; const char* b2 = last ? nB : cB + (size_t)(t + 2) * kstep;
            const char* a3 = a2 + kstep; const char* b3 = b2 + kstep;
            PG8_LDB(B0, 0, 0); PG8_SCHED; PG8_LDA(At, 0, 0); PG8_STAGE(PG8_SA(1, 1), a1, vA1);
            if (last && has_next) PG8_AOFF(nxt);
            PG8_WAIT_L(8); PG8_BAR; PG8_WAIT_L(0); PG8_MMA(0, 0, At, B0); PG8_BAR; PG8_SCHED;
            PG8_LDB(B1, 0, 1); PG8_STAGE(PG8_SB(0, 0), b2, voffB0);
            PG8_BAR; PG8_WAIT_L(0); PG8_MMA(0, 1, At, B1); PG8_BAR;
            PG8_LDA(At, 0, 1); PG8_STAGE(PG8_SA(0, 0), a2, vA0);
            PG8_BAR; PG8_WAIT_L(0); PG8_MMA(1, 0, At, B0); PG8_BAR; PG8_SCHED;
            PG8_STAGE(PG8_SB(0, 1), b2, voffB1);
            PG8_WAIT_V(6); PG8_BAR; PG8_MMA(1, 1, At, B1); PG8_BAR;
            PG8_LDB(B0, 1, 0); PG8_SCHED; PG8_LDA(At, 1, 0); PG8_STAGE(PG8_SA(0, 1), a2, vA1);
            PG8_WAIT_L(8); PG8_BAR; PG8_WAIT_L(0); PG8_MMA(0, 0, At, B0); PG8_BAR; PG8_SCHED;
            PG8_LDB(B1, 1, 1); PG8_STAGE(PG8_SB(1, 0), b3, voffB0);
            PG8_BAR; PG8_WAIT_L(0); PG8_MMA(0, 1, At, B1); PG8_BAR;
            PG8_LDA(At, 1, 1); PG8_STAGE(PG8_SA(1, 0), a3, vA0);
            PG8_BAR; PG8_WAIT_L(0); PG8_MMA(1, 0, At, B0); PG8_BAR; PG8_SCHED;
            PG8_STAGE(PG8_SB(1, 1), b3, voffB1);
            PG8_WAIT_V(6); PG8_BAR; PG8_MMA(1, 1, At, B1); PG8_BAR;
            { const unsigned long long prb_i1 = PRB_NOW(); if (t == 0) PRB_ADD(4, prb_i0, prb_i1); if (last) PRB_ADD(5, prb_i0, prb_i1); if (t != 0 && !last) PRB_ADD(6, prb_i0, prb_i1); }
        }
        const unsigned long long prb_c = PRB_NOW(); PRB_ADD(2, prb_b, prb_c);
        { int tz = threadIdx.x; asm volatile("" : "+v"(tz)); const int wz = tz >> 6, lz = tz & 63;
          E(acc, cur, wz >> 2, wz & 3, lz & 15, lz >> 4);
#if defined(MK_EPI_TWICE)
          if (Epi::TWICE) { asm volatile("" ::: "memory"); E(acc, cur, wz >> 2, wz & 3, lz & 15, lz >> 4); }
#endif
          }
        { const unsigned long long prb_d = PRB_NOW(); PRB_ADD(3, prb_c, prb_d); }
        if (!has_next) break;
#pragma unroll
        for (int a = 0; a < 2; ++a)
#pragma unroll
            for (int b = 0; b < 2; ++b)
#pragma unroll
                for (int m = 0; m < 4; ++m)
#pragma unroll
                    for (int n = 0; n < 2; ++n) acc[a][b][m][n] = (f32x4){0.f, 0.f, 0.f, 0.f};
        cur = nxt; cA = nA; cB = nB; ++ui;
    }
    PG8_WAIT_V(0);
    if (wr == 0) PG8_BAR;
    PG8_BAR;
#undef PG8_AOFF
#undef PRB_NOW
#undef PRB_ADD
#undef PG8_SA
#undef PG8_SB
#undef PG8_STAGE
#undef PG8_LDA
#undef PG8_LDB
#undef PG8_MMA
#undef PG8_WAIT_V
#undef PG8_WAIT_L
#undef PG8_BAR
#undef PG8_SCHED
}

template <class Epi, class Sched>
__device__ __forceinline__ void gemm_phase(LAS unsigned char* lds, const int K, const int ldb, const Sched& S, const Epi& E) {
#if MK_FAST_GEMM
    gemm_fast<Epi, Sched>(lds, K, ldb, S, E);
#else
    gemm_simple<Epi, Sched>(K, ldb, S, E);
#endif
}

struct DenseUnit { int pm, pn, ks; };
template <int NM, int NN, int KSPLIT>
struct DenseSchedT {
    typedef DenseUnit Unit;
    const char* A; const char* B; int lda2, ldb2, ksub2, G, c, i0, i1;
    __device__ __forceinline__ void init(const void* A_, const void* B_, int lda, int ldb, int Ksub, int G_, int c_) {
        A = (const char*)A_; B = (const char*)B_; lda2 = lda * 2; ldb2 = ldb * 2; ksub2 = Ksub * 2; G = G_; c = c_; i0 = 0; i1 = 0x3fffffff; }
    __device__ __forceinline__ bool next(int i, Unit& u) const {
        constexpr int nwg = NM * NN, total = nwg * KSPLIT;
        if (i + i0 >= i1) return false;
        const int L = (i + i0) * G + c; if (L >= total) return false;
        int id = L / KSPLIT; u.ks = L - id * KSPLIT;
        { constexpr int q = nwg / 8, r = nwg % 8; const int xcd = id % 8, off = id / 8; id = (xcd < r ? xcd * (q + 1) : r * (q + 1) + (xcd - r) * q) + off; }
        constexpr int nig = 8 * NN; const int gid = id / nig, fm = gid * 8, gsz = (NM - fm) < 8 ? (NM - fm) : 8;
        u.pm = fm + ((id % nig) % gsz); u.pn = (id % nig) / gsz; return true;
    }
    __device__ __forceinline__ const char* a_base(const Unit& u) const { return A + (size_t)u.pm * 256 * lda2 + (size_t)u.ks * ksub2; }
    __device__ __forceinline__ const char* b_base(const Unit& u) const { return B + (size_t)u.pn * 256 * ldb2 + (size_t)u.ks * ksub2; }
    __device__ __forceinline__ unsigned a_off(const Unit&, int r) const { return (unsigned)(r * lda2); }
};

template <int PN, bool DOWN>
struct MoeSched {
    struct Unit { int kind, e, rb, blk, valid, pm, pn; };
    const LAS int* prefix; const LAS int* cnt; const unsigned* bucket;
    const char* Ar; const char* As; const char* Br; const char* Bs;
    int nRouted, total, G, c, i0, i1;
    __device__ __forceinline__ bool next(int i, Unit& u) const {
        if (i + i0 >= i1) return false;
        const int id = (i + i0) * G + c; if (id >= total) return false;
        u.e = 0; u.rb = 0; u.blk = 0; u.pm = 0;
        if (id < nRouted) {
            const int blk = id / PN; u.pn = id % PN;
            const int lo = ((const LAS unsigned char*)(cnt + 256))[blk];
            u.kind = 0; u.e = lo; u.rb = blk - prefix[lo]; u.blk = blk; const int rem = cnt[lo] - u.rb * 256; u.valid = rem < 256 ? rem : 256;
        } else { const int s = id - nRouted; u.kind = 1; u.pm = s / PN; u.pn = s % PN; u.valid = 256; }
        return true;
    }
    __device__ __forceinline__ const char* a_base(const Unit& u) const { return u.kind == 0 ? Ar : As; }
    __device__ __forceinline__ const char* b_base(const Unit& u) const {
        if (!DOWN) return u.kind == 0 ? Br + ((size_t)u.e * 512 + (size_t)u.pn * 256) * D : Bs + (size_t)u.pn * 256 * D;
        else       return u.kind == 0 ? Br + ((size_t)u.e * 1024 + (size_t)u.pn * 256) * FF : Bs + (size_t)u.pn * 256 * FF;
    }
    __device__ __forceinline__ unsigned a_off(const Unit& u, int r) const {
        if (!DOWN) {
            if (u.kind == 0) { const int rr = r < u.valid ? r : u.valid - 1; const unsigned slot = bucket[(size_t)u.e * CAP + u.rb * 256 + rr]; return (slot >> 3) * (unsigned)D; }
            return (unsigned)(u.pm * 256 + r) * (unsigned)D;
        } else {
            return (unsigned)((u.kind == 0 ? u.blk : u.pm) * 256 + r) * (unsigned)FF;
        }
    }
};

struct EpiProj {
    static constexpr int PID = 2, PERM = 2;
    static constexpr bool TWICE = false, FP8 = false, I8 = true;
    bf16* O; const float* rowsc; const float* colq;
    __device__ __forceinline__ void operator()(const f32x4 (&acc)[2][2][4][2], const DenseUnit& u, int wr, int wc, int fr, int fq) const {
        const int row0 = u.pm * 256 + wr * 64 + fr, col0 = u.pn * 256 + wc * 64 + 16 * fq;
        f32x4 cs[2][2];
#pragma unroll
        for (int bj = 0; bj < 2; ++bj)
#pragma unroll
            for (int n = 0; n < 2; ++n) { const f32x4 q = *(const f32x4*)(colq + col0 + 8 * bj + 4 * n);
                cs[bj][n] = (f32x4){__builtin_amdgcn_rcpf(q.x), __builtin_amdgcn_rcpf(q.y), __builtin_amdgcn_rcpf(q.z), __builtin_amdgcn_rcpf(q.w)}; }
#pragma unroll
        for (int ai = 0; ai < 2; ++ai)
#pragma unroll
            for (int m = 0; m < 4; ++m) { const int row = row0 + ai * 128 + m * 16; bf16* rowp = O + (size_t)row * NPROJ + col0; const float rs = rowsc[row];
#pragma unroll
                for (int bj = 0; bj < 2; ++bj) { const i32x4 a0 = __builtin_bit_cast(i32x4, acc[ai][bj][m][0]), a1 = __builtin_bit_cast(i32x4, acc[ai][bj][m][1]);
                    const f32x4 v0 = (f32x4){(float)a0[0], (float)a0[1], (float)a0[2], (float)a0[3]} * cs[bj][0] * rs, v1 = (f32x4){(float)a1[0], (float)a1[1], (float)a1[2], (float)a1[3]} * cs[bj][1] * rs;
                    *(v4u*)(rowp + bj * 8) = (v4u){pk2(v0[0], v0[1]), pk2(v0[2], v0[3]), pk2(v1[0], v1[1]), pk2(v1[2], v1[3])}; } }
    }
};
struct EpiOut {
    static constexpr int PID = 5, PERM = 2;
    static constexpr bool TWICE = false, FP8 = false, I8 = false;
    bf16* O;
    __device__ __forceinline__ void operator()(const f32x4 (&acc)[2][2][4][2], const DenseUnit& u, int wr, int wc, int fr, int fq) const {
        const int row0 = u.pm * 256 + wr * 64 + fr, col0 = u.pn * 256 + wc * 64 + 16 * fq;
#pragma unroll
        for (int ai = 0; ai < 2; ++ai)
#pragma unroll
            for (int m = 0; m < 4; ++m) { bf16* rowp = O + (size_t)(row0 + ai * 128 + m * 16) * (2 * D) + col0;
#pragma unroll
                for (int bj = 0; bj < 2; ++bj) { const f32x4 v0 = acc[ai][bj][m][0], v1 = acc[ai][bj][m][1];
                    *(v4u*)(rowp + bj * 8) = (v4u){pk2(v0[0], v0[1]), pk2(v0[2], v0[3]), pk2(v1[0], v1[1]), pk2(v1[2], v1[3])}; } }
    }
};
struct EpiRouter {
    static constexpr int PID = 7, PERM = 0;
    static constexpr bool TWICE = false, FP8 = false, I8 = false;
    float* L;
    __device__ __forceinline__ void operator()(const f32x4 (&acc)[2][2][4][2], const DenseUnit& u, int wr, int wc, int fr, int fq) const {
        const int row0 = u.pm * 256 + wr * 64 + fr, col0 = wc * 32 + 4 * fq;
        float* Lp = L + (size_t)u.ks * NT * NE;
#pragma unroll
        for (int ai = 0; ai < 2; ++ai)
#pragma unroll
            for (int m = 0; m < 4; ++m) { const size_t ro = (size_t)(row0 + ai * 128 + m * 16) * NE + col0;
#pragma unroll
                for (int bj = 0; bj < 2; ++bj)
#pragma unroll
                    for (int n = 0; n < 2; ++n) *(f32x4*)(Lp + ro + bj * 128 + n * 16) = acc[ai][bj][m][n]; }
    }
};
struct EpiGU {
    static constexpr int PID = 9, PERM = 1;
    static constexpr bool TWICE = false, FP8 = true, I8 = false;
    unsigned char* act; unsigned char* acts; const unsigned* bucket; unsigned* pos;
    __device__ __forceinline__ void operator()(const f32x4 (&acc)[2][2][4][2], const MoeSched<2, false>::Unit& u, int wr, int wc, int fr, int fq) const {
        unsigned char* O = u.kind == 0 ? act : acts;
        const int row0 = (u.kind == 0 ? u.blk : u.pm) * 256 + wr * 64 + fr, col0 = u.pn * 128 + wc * 32 + 8 * fq;
        if (u.kind == 0 && u.pn == 0 && wc == 0 && fq == 0) {
#pragma unroll
            for (int ai = 0; ai < 2; ++ai)
#pragma unroll
                for (int m = 0; m < 4; ++m) { const int r = ai * 128 + wr * 64 + m * 16 + fr;
                    if (r < u.valid) pos[bucket[(size_t)u.e * CAP + u.rb * 256 + r]] = (unsigned)(u.blk * 256 + r); } }
#pragma unroll
        for (int ai = 0; ai < 2; ++ai)
#pragma unroll
            for (int m = 0; m < 4; ++m) {
                const f32x4 g0 = acc[ai][0][m][0], g1 = acc[ai][0][m][1], u0 = acc[ai][1][m][0], u1 = acc[ai][1][m][1];
                float a[8];
#pragma unroll
                for (int j = 0; j < 4; j += 2) {
                    const f32x2 ga = (f32x2){g0[j], g0[j + 1]} * W_INV_SCALE, gb = (f32x2){g1[j], g1[j + 1]} * W_INV_SCALE;
                    const f32x2 ua = (f32x2){u0[j], u0[j + 1]} * (W_INV_SCALE * ACT_SCALE), ub = (f32x2){u1[j], u1[j + 1]} * (W_INV_SCALE * ACT_SCALE);
                    const f32x2 ea = ga * (-1.44269504f), eb = gb * (-1.44269504f);
                    f32x2 da, db; da.x = __builtin_amdgcn_exp2f(ea.x); da.y = __builtin_amdgcn_exp2f(ea.y); db.x = __builtin_amdgcn_exp2f(eb.x); db.y = __builtin_amdgcn_exp2f(eb.y);
                    da = da + 1.0f; db = db + 1.0f;
                    f32x2 ra, rb; ra.x = __builtin_amdgcn_rcpf(da.x); ra.y = __builtin_amdgcn_rcpf(da.y); rb.x = __builtin_amdgcn_rcpf(db.x); rb.y = __builtin_amdgcn_rcpf(db.y);
                    const f32x2 oa = (ga * ua) * ra, ob = (gb * ub) * rb;
                    a[j] = oa.x; a[j + 1] = oa.y; a[4 + j] = ob.x; a[4 + j + 1] = ob.y; }
                *(v2u*)(O + (size_t)(row0 + ai * 128 + m * 16) * FF + col0) = (v2u){pk4_fp8(a[0], a[1], a[2], a[3]), pk4_fp8(a[4], a[5], a[6], a[7])};
                __builtin_amdgcn_sched_barrier(0);
            }
    }
};
constexpr float Y_SCALE = ACT_SCALE * WD_SCALE, Y_INV_SCALE = 1.f / Y_SCALE;
struct EpiDown {
    static constexpr int PID = 10, PERM = 2;
    static constexpr bool TWICE = false, FP8 = true, I8 = false;
    unsigned char* Y; bf16* O;
    __device__ __forceinline__ void operator()(const f32x4 (&acc)[2][2][4][2], const MoeSched<4, true>::Unit& u, int wr, int wc, int fr, int fq) const {
        const int col0 = u.pn * 256 + wc * 64 + 16 * fq;
        if (u.kind == 0) {
            const int row0 = u.blk * 256 + wr * 64 + fr;
#pragma unroll
            for (int ai = 0; ai < 2; ++ai)
#pragma unroll
                for (int m = 0; m < 4; ++m) { unsigned char* rowp = Y + (size_t)(row0 + ai * 128 + m * 16) * D + col0;
                    unsigned w[4];
#pragma unroll
                    for (int bj = 0; bj < 2; ++bj)
#pragma unroll
                        for (int n = 0; n < 2; ++n) { f32x4 v = acc[ai][bj][m][n];
#pragma unroll
                            for (int j = 0; j < 4; ++j) v[j] = __builtin_amdgcn_fmed3f(v[j], -448.f, 448.f);
                            w[bj * 2 + n] = pk4_fp8(v[0], v[1], v[2], v[3]); }
                    *(v4u*)rowp = (v4u){w[0], w[1], w[2], w[3]}; }
        } else {
            const int row0 = u.pm * 256 + wr * 64 + fr;
#pragma unroll
            for (int ai = 0; ai < 2; ++ai)
#pragma unroll
                for (int m = 0; m < 4; ++m) { unsigned char* rowp = (unsigned char*)O + (size_t)(row0 + ai * 128 + m * 16) * (4 * D) + 2 * D + col0;
                    unsigned w[4];
#pragma unroll
                    for (int bj = 0; bj < 2; ++bj)
#pragma unroll
                        for (int n = 0; n < 2; ++n) { f32x4 v = acc[ai][bj][m][n];
#pragma unroll
                            for (int j = 0; j < 4; ++j) v[j] = __builtin_amdgcn_fmed3f(v[j], -448.f, 448.f);
                            w[bj * 2 + n] = pk4_fp8(v[0], v[1], v[2], v[3]); }
                    *(v4u*)rowp = (v4u){w[0], w[1], w[2], w[3]}; }
        }
    }
};

struct Args { const float* in[19]; float* out; unsigned char* ws; int ph_lo, ph_hi; };

struct Frame {
    LAS unsigned char* lds; int tid, lane, wave, G, bid;
    float* out; unsigned char* ws;
};

__device__ __forceinline__ void titem_load(const float* W, int N, int kb, int nb, int lane, float (&v)[32]) {
    const float* Wu = W + (size_t)(64 * kb) * N + 32 * nb;
    const unsigned loff = (unsigned)((lane >> 5) * N + (lane & 31)) * 4u;
#pragma unroll
    for (int i = 0; i < 32; ++i) v[i] = *(const float*)((const char*)(Wu + (size_t)(2 * i) * N) + loff);
}
template <int FP8>
__device__ __forceinline__ void titem_store(const float (&v)[32], int K, void* WTv, int kb, int dst_row0, LAS float* scr, int lane, float wsc = W_SCALE, const float* colq = nullptr) {
    const int k0 = 64 * kb;
#pragma unroll
    for (int i = 0; i < 32; ++i) { const int kk = 2 * i + (lane >> 5); scr[kk * 33 + (lane & 31)] = v[i]; }
    asm volatile("s_waitcnt lgkmcnt(0)" ::: "memory");
    const int c = lane & 7;
#pragma unroll
    for (int j = 0; j < 4; ++j) { const int n = (lane >> 3) + 8 * j; const LAS float* s = scr + (8 * c) * 33 + n;
        if (FP8 == 2) { const float qs = colq[dst_row0 + n]; v2u o; o.x = pk4_i8(s[0 * 33] * qs, s[1 * 33] * qs, s[2 * 33] * qs, s[3 * 33] * qs);
            o.y = pk4_i8(s[4 * 33] * qs, s[5 * 33] * qs, s[6 * 33] * qs, s[7 * 33] * qs);
            *(v2u*)((unsigned char*)WTv + (size_t)(dst_row0 + n) * K + k0 + 8 * c) = o; }
        else if (FP8 == 1) { v2u o; o.x = pk4_fp8(s[0 * 33] * wsc, s[1 * 33] * wsc, s[2 * 33] * wsc, s[3 * 33] * wsc);
            o.y = pk4_fp8(s[4 * 33] * wsc, s[5 * 33] * wsc, s[6 * 33] * wsc, s[7 * 33] * wsc);
            *(v2u*)((unsigned char*)WTv + (size_t)(dst_row0 + n) * K + k0 + 8 * c) = o; }
        else { v4u o; o.x = pk2(s[0 * 33], s[1 * 33]); o.y = pk2(s[2 * 33], s[3 * 33]); o.z = pk2(s[4 * 33], s[5 * 33]); o.w = pk2(s[6 * 33], s[7 * 33]);
            *(v4u*)((bf16*)WTv + (size_t)(dst_row0 + n) * K + k0 + 8 * c) = o; } }
    asm volatile("s_waitcnt lgkmcnt(0)" ::: "memory");
}
template <int FP8>
__device__ __forceinline__ void transpose_item(const float* W, int K, int N, void* WT, int kb, int nb, int dst_row0, LAS float* scr, int lane, float wsc = W_SCALE, const float* colq = nullptr) {
    float v[32]; titem_load(W, N, kb, nb, lane, v); titem_store<FP8>(v, K, WT, kb, dst_row0, scr, lane, wsc, colq);
}
template <bool DOWN>
__device__ __forceinline__ void convert_expert(Frame& F, const float* Wa, const float* Wb, unsigned char* dst, int base = 0, int PER_WAVE = (DOWN ? 16 : 32)) {
    LAS float* scr = (LAS float*)(F.lds + F.wave * 16384);
    const int wv = F.wave;
    auto ld = [&](int i, float (&v)[32]) {
        if (!DOWN) titem_load((i >> 4) ? Wb : Wa, FF, i & 15, wv, F.lane, v);
        else titem_load(Wa, D, i >> 2, wv + 8 * (i & 3), F.lane, v); };
    auto st = [&](int i, const float (&v)[32]) {
        if (!DOWN) { const int n0 = wv * 32; titem_store<true>(v, D, dst, i & 15, (n0 >> 7) * 256 + ((i >> 4) ? 128 : 0) + (n0 & 127), scr, F.lane); }
        else titem_store<true>(v, FF, dst, i >> 2, (wv + 8 * (i & 3)) * 32, scr, F.lane, WD_SCALE); };
    float v0[32], v1[32], v2[32], v3[32];
    ld(base, v0); ld(base + 1, v1); ld(base + 2, v2);
    for (int i = 0; i < PER_WAVE; i += 4) {
        ld(base + i + 3, v3); st(base + i, v0);
        if (i + 4 < PER_WAVE) ld(base + i + 4, v0);
        st(base + i + 1, v1);
        if (i + 5 < PER_WAVE) ld(base + i + 5, v1);
        st(base + i + 2, v2);
        if (i + 6 < PER_WAVE) ld(base + i + 6, v2);
        st(base + i + 3, v3);
    }
}

__device__ __forceinline__ void chunk_load(Frame& F, unsigned ch, int wv, float (&v)[32]) {
    if (ch < QG_CHUNKS) { const int e = (int)(ch >> 4), i = (int)(ch & 15); titem_load(ld_ptr(F.lds, 12) + (size_t)e * D * FF, FF, i, wv, F.lane, v); }
    else { const unsigned c2 = ch - QG_CHUNKS; const int e = (int)(c2 >> 4), i = (int)(c2 & 15); titem_load(ld_ptr(F.lds, 14) + (size_t)e * FF * D, D, i >> 2, wv + 8 * (i & 3), F.lane, v); }
}
__device__ __forceinline__ void chunk_store(Frame& F, unsigned ch, int wv, const float (&v)[32], LAS float* scr) {
    if (ch < QG_CHUNKS) { const int e = (int)(ch >> 4), i = (int)(ch & 15), n0 = wv * 32;
        titem_store<true>(v, D, F.ws + WS_WGU_T + (size_t)e * 512 * D, i, (n0 >> 7) * 256 + (n0 & 127), scr, F.lane, W_SCALE); }
    else { const unsigned c2 = ch - QG_CHUNKS; const int e = (int)(c2 >> 4), i = (int)(c2 & 15);
        titem_store<true>(v, FF, F.ws + WS_WD_T + (size_t)e * D * FF, i >> 2, (wv + 8 * (i & 3)) * 32, scr, F.lane, WD_SCALE); }
}
__device__ __forceinline__ void convert_chunk(Frame& F, unsigned ch) {
    const int wv = __builtin_amdgcn_readfirstlane(F.wave);
    LAS float* scr = (LAS float*)(F.lds + wv * 16384);
    float va[32], vb[32];
    chunk_load(F, ch, wv, va); chunk_load(F, ch + 1, wv, vb);
    chunk_store(F, ch, wv, va, scr); chunk_store(F, ch + 1, wv, vb, scr);
}
__device__ __forceinline__ void xcd_barrier_work(const XcdBarrier& b, Frame& F, unsigned chunk_end) {
    asm volatile("s_waitcnt vmcnt(0)" ::: "memory");
    __syncthreads();
    volatile LAS unsigned* st = b.st;
    unsigned* bar = b.bar; unsigned* qd = (unsigned*)(F.ws + WS_CTL) + CW_QD;
    if (threadIdx.x == 0) {
        __builtin_amdgcn_s_waitcnt(0);
        unsigned nloc = st[0], nx = st[1];
        if (nloc == 0u) { xcd_barrier_complete(bar, b.x, nloc, nx); st[0] = nloc; st[1] = nx; }
        const unsigned old = xb_add(&bar[XB_XSUB(b.x)], 1u);
        const unsigned gen = old / nloc;
        if (old + 1u == (gen + 1u) * nloc) {
            __builtin_amdgcn_fence(__ATOMIC_RELEASE, "agent");
            asm volatile("s_waitcnt vmcnt(0)" ::: "memory");
            const unsigned og = xb_add(&bar[XB_TOP], 1u);
            const unsigned tg = og / nx;
            if (og + 1u == (tg + 1u) * nx) xb_add(&bar[XB_TOPGEN], 1u);
            else XB_SPIN(xb_ld(&bar[XB_TOPGEN]) == tg, bar);
            __builtin_amdgcn_fence(__ATOMIC_ACQUIRE, "agent");
            xb_add(&bar[XB_XGEN(b.x)], 1u);
            asm volatile("s_waitcnt vmcnt(0)" ::: "memory");
            st[3] = 1u; st[6] = 1u;
        } else { st[2] = gen; st[3] = 0u; st[6] = 0u; }
    }
    __syncthreads();
    unsigned spins = 0;
    while (st[3] == 0u) {
        if (threadIdx.x == 0) {
            if (xb_ld(&bar[XB_XGEN(b.x)]) != st[2]) st[3] = 1u;
            else { if (st[5] < chunk_end) st[5] = xb_add(qd, 2u);
                if ((++spins & 1023u) == 0u) { if (xb_ld(&bar[XB_TMO])) st[3] = 1u; else if (spins > XB_SPIN_CAP) { atomicAdd(&bar[XB_TMO], 1u); st[3] = 1u; } } }
        }
        __syncthreads();
        if (st[3] != 0u) break;
        const unsigned ch = st[5];
        if (ch < QD_CHUNKS) convert_chunk(F, ch); else __builtin_amdgcn_s_sleep(8);
        __syncthreads();
    }
    if (threadIdx.x == 0 && st[6] == 0u) { __builtin_amdgcn_fence(__ATOMIC_ACQUIRE, "agent"); asm volatile("s_waitcnt vmcnt(0)" ::: "memory"); }
    __syncthreads();
}
__device__ __forceinline__ void drain_queue(Frame& F, unsigned limit) {
    volatile LAS unsigned* MISC = (volatile LAS unsigned*)(F.lds + MISC_OFF); unsigned* qd = (unsigned*)(F.ws + WS_CTL) + CW_QD;
    for (;;) {
        __syncthreads();
        if (threadIdx.x == 0) { const bool more = MISC[13] < limit; MISC[15] = more ? 1u : 0u; if (more) MISC[13] = xb_add(qd, 2u); }
        __syncthreads();
        if (MISC[15] == 0u) break;
        const unsigned ch = MISC[13];
        if (ch < QD_CHUNKS) convert_chunk(F, ch);
        if (ch >= limit) break;
    }
    __syncthreads();
}

__device__ __forceinline__ void p0_prologue(Frame& F) {
#define INP(i) ld_ptr(F.lds, (i))
    for (int job = F.bid; job < 256; job += F.G) {
      __syncthreads();
      if (job < 192) {
        const float* cptr = INP(1); const float* w_ada = INP(2); const float* b_ada = INP(3);
        LAS float* cs = (LAS float*)F.lds;
        LAS float* red = (LAS float*)(F.lds + 32768);
        for (int i = F.tid; i < NB * D; i += NTHREADS) { const float v = cptr[i]; cs[i] = v / (1.f + __expf(-v)); }
        __syncthreads();
        const int col = F.tid & 31, kg = F.tid >> 5, j = job * 32 + col;
        float a[NB], w[64];
#pragma unroll
        for (int b = 0; b < NB; ++b) a[b] = 0.f;
#pragma unroll
        for (int kk = 0; kk < 64; ++kk) w[kk] = w_ada[(size_t)(kg * 64 + kk) * 6144 + j];
#pragma unroll
        for (int kk = 0; kk < 64; ++kk) {
#pragma unroll
            for (int b = 0; b < NB; ++b) a[b] += cs[b * D + kg * 64 + kk] * w[kk]; }
#pragma unroll
        for (int b = 0; b < NB; ++b) red[(kg * NB + b) * 32 + col] = a[b];
        __syncthreads();
        if (F.tid < 256) { const int b = F.tid >> 5, cc = F.tid & 31; float s = 0.f;
#pragma unroll
            for (int g = 0; g < 16; ++g) s += red[(g * NB + b) * 32 + cc];
            ((float*)(F.ws + WS_MOD))[b * 6144 + job * 32 + cc] = s + b_ada[job * 32 + cc]; }
      } else {
        const float* wi = INP(5); float* colq = (float*)(F.ws + WS_COLSC); LAS float* red = (LAS float*)F.lds;
        const int cb = (job - 192) * 40, col = F.tid % 40, part = F.tid / 40;
        float am = 0.f;
        if (part < 12) for (int k = part; k < D; k += 12) am = fmaxf(am, fabsf(wi[(size_t)k * NPROJ + cb + col]));
        if (part < 12) red[part * 40 + col] = am;
        __syncthreads();
        if (F.tid < 40) { float m = 0.f; for (int q = 0; q < 12; ++q) m = fmaxf(m, red[q * 40 + F.tid]); colq[cb + F.tid] = 127.f / fmaxf(m, 1e-20f); }
      }
    }
    __syncthreads();
    if (F.bid == F.G - 1) { const float* pw = INP(6); bf16* pwt = (bf16*)(F.ws + WS_PWT);
        for (int i = F.tid; i < 4 * 64 * 64; i += NTHREADS) { const int g = i >> 12, d = (i >> 6) & 63, c = i & 63; pwt[i] = (bf16)f2bf(pw[(g * 64 + c) * 64 + d]); } }
    LAS float* scr = (LAS float*)(F.lds + F.wave * 16384);
    const int gw = F.bid * NWAVES + F.wave, NGW = F.G * NWAVES;
    constexpr int I_IN = 16 * 80, I_OUT = 8 * 32, I_R = 16 * 8, I_G = 16 * 8, I_D = 4 * 32;
    constexpr int I_SMALL = I_IN + I_OUT + I_R + 2 * I_G + I_D, I_EXP = 2 * I_G + I_D;
    constexpr int NITEMS = I_SMALL;
    unsigned char* win_t = F.ws + WS_WIN_T; bf16* wout_t = (bf16*)(F.ws + WS_WOUT_T); bf16* wr_t = (bf16*)(F.ws + WS_WR_T);
    unsigned char* wsgu_t = F.ws + WS_WSGU_T; unsigned char* wsd_t = F.ws + WS_WSD_T; unsigned char* wgu_t = F.ws + WS_WGU_T; unsigned char* wd_t = F.ws + WS_WD_T;
    for (int it = gw; it < NITEMS; it += NGW) {
        int r = it;
        if (r < I_IN) continue; r -= I_IN;
        if (r < I_OUT) { transpose_item<false>(INP(8), NMIX, D, wout_t, r / 32, r % 32, (r % 32) * 32, scr, F.lane); continue; } r -= I_OUT;
        if (r < I_R) { transpose_item<false>(INP(10), D, NE, wr_t, r / 8, r % 8, (r % 8) * 32, scr, F.lane); continue; } r -= I_R;
        const float *Wg, *Wu, *Wd; unsigned char *GU, *DN;
        if (r < 2 * I_G + I_D) { Wg = INP(15); Wu = INP(16); Wd = INP(17); GU = wsgu_t; DN = wsd_t; }
        else { r -= 2 * I_G + I_D; const int e = r / I_EXP; r -= e * I_EXP;
            Wg = INP(12) + (size_t)e * D * FF; Wu = INP(13) + (size_t)e * D * FF; Wd = INP(14) + (size_t)e * FF * D;
            GU = wgu_t + (size_t)e * 512 * D; DN = wd_t + (size_t)e * D * FF; }
        if (r < I_G) { const int nb = r % 8, n0 = nb * 32; transpose_item<true>(Wg, D, FF, GU, r / 8, nb, (n0 >> 7) * 256 + (n0 & 127), scr, F.lane); continue; } r -= I_G;
        if (r < I_G) { const int nb = r % 8, n0 = nb * 32; transpose_item<true>(Wu, D, FF, GU, r / 8, nb, (n0 >> 7) * 256 + 128 + (n0 & 127), scr, F.lane); continue; } r -= I_G;
        transpose_item<true>(Wd, FF, D, DN, r / 32, r % 32, (r % 32) * 32, scr, F.lane, WD_SCALE);
    }
#undef INP
}

__device__ __forceinline__ void win_int8_phase(Frame& F, const float* w_in) {
    __syncthreads();
    LAS float* scr = (LAS float*)(F.lds + F.wave * 16384);
    const float* colq = (const float*)(F.ws + WS_COLSC);
    for (int r = F.bid * NWAVES + F.wave; r < 16 * 80; r += F.G * NWAVES)
        transpose_item<2>(w_in, D, NPROJ, F.ws + WS_WIN_T, r / 80, r % 80, (r % 80) * 32, scr, F.lane, 1.f, colq);
}
template <bool HAS_DX, int OUT8, bool OUTB>
__device__ __forceinline__ void modnorm_phase(Frame& F, const float* X, const float* g, int shift_chunk, unsigned char* O8, bf16* Ob) {
    const float* mod = (const float*)(F.ws + WS_MOD);
    constexpr int RW = 4;
    const unsigned l16 = (unsigned)F.lane * 16u, l8 = (unsigned)F.lane * 8u, l4 = (unsigned)F.lane * 4u;
    const int wv = __builtin_amdgcn_readfirstlane(F.wave);
    for (int blk = F.bid; blk < NT / 128; blk += F.G) {
        const int b = (blk * 128) >> 12;
        const float* sh = mod + (size_t)b * 6144 + shift_chunk * D; const float* sc = sh + D; const float* g1 = mod + (size_t)b * 6144 + 2 * D;
        f32x4 gg[4], ss[4], ga[4];
#pragma unroll
        for (int j = 0; j < 4; ++j) { const f32x4 gv = *(const f32x4*)((const char*)g + 1024 * j + l16), scv = *(const f32x4*)((const char*)sc + 1024 * j + l16);
            gg[j] = gv * (scv + 1.f); ss[j] = *(const f32x4*)((const char*)sh + 1024 * j + l16); ga[j] = HAS_DX ? *(const f32x4*)((const char*)g1 + 1024 * j + l16) : (f32x4){0.f, 0.f, 0.f, 0.f}; }
#pragma nounroll
        for (int rr = 0; rr < 16; rr += RW) {
            const int row = blk * 128 + wv * 16 + rr;
            f32x4 v[RW][4]; v2u dv[RW][4];
#pragma unroll
            for (int q = 0; q < RW; ++q) { const char* xr = (const char*)(X + (size_t)(row + q) * D);
#pragma unroll
                for (int j = 0; j < 4; ++j) v[q][j] = *(const f32x4*)(xr + 1024 * j + l16);
                if (HAS_DX) { const char* dr = (const char*)F.out + (size_t)(row + q) * (4 * D);
#pragma unroll
                    for (int j = 0; j < 4; ++j) dv[q][j] = *(const v2u*)(dr + 512 * j + l8); } }
#pragma unroll
            for (int q = 0; q < RW; ++q) { float s = 0.f;
#pragma unroll
                for (int j = 0; j < 4; ++j) {
                    if (HAS_DX) v[q][j] = v[q][j] + ga[j] * (f32x4){bflo(dv[q][j].x), bfhi(dv[q][j].x), bflo(dv[q][j].y), bfhi(dv[q][j].y)};
                    s += (v[q][j].x * v[q][j].x + v[q][j].y * v[q][j].y) + (v[q][j].z * v[q][j].z + v[q][j].w * v[q][j].w); }
                const float rstd = 1.f / sqrtf(wave_sum(s) * (1.f / D) + NORM_EPS);
                if (HAS_DX) { char* xo = (char*)F.out + (size_t)(row + q) * (4 * D);
#pragma unroll
                    for (int j = 0; j < 4; ++j) *(v2u*)(xo + 512 * j + l8) = (v2u){pk2(v[q][j].x, v[q][j].y), pk2(v[q][j].z, v[q][j].w)}; }
                char* o8 = (char*)O8 + (size_t)(row + q) * D; char* ob = (char*)Ob + (size_t)(row + q) * (2 * D);
                if (OUT8 == 2) {
                    f32x4 y[4]; float am = 0.f;
#pragma unroll
                    for (int j = 0; j < 4; ++j) { y[j] = v[q][j] * rstd * gg[j] + ss[j]; am = fmaxf(am, fmaxf(fmaxf(fabsf(y[j].x), fabsf(y[j].y)), fmaxf(fabsf(y[j].z), fabsf(y[j].w)))); }
                    am = fmaxf(wave_max(am), 1e-20f); const float qs = 127.f / am;
#pragma unroll
                    for (int j = 0; j < 4; ++j) *(unsigned*)(o8 + 256 * j + l4) = pk4_i8(y[j].x * qs, y[j].y * qs, y[j].z * qs, y[j].w * qs);
                    if (F.lane == 0) ((float*)(F.ws + WS_ROWSC))[row + q] = am * (1.f / 127.f);
                } else {
#pragma unroll
                for (int j = 0; j < 4; ++j) { const f32x4 y = v[q][j] * rstd * gg[j] + ss[j]; if (OUT8 == 1) *(unsigned*)(o8 + 256 * j + l4) = pk4_fp8(y.x, y.y, y.z, y.w);
                    if (OUTB) *(v2u*)(ob + 512 * j + l8) = (v2u){pk2(y.x, y.y), pk2(y.z, y.w)}; } }
                __builtin_amdgcn_sched_barrier(0); }
        }
    }
}

constexpr int POOL_T = 64, POOL_PITCH = 528;
__device__ __forceinline__ void pool_phase(Frame& F, const float* pool_scale) {
    const bf16* proj = (const bf16*)(F.ws + WS_PROJ); bf16* mixin = (bf16*)(F.ws + WS_MIXIN); const bf16* pwt = (const bf16*)(F.ws + WS_PWT);
    LAS unsigned char* us = F.lds;
    LAS unsigned char* pl = F.lds + 80 * POOL_PITCH;
    const int lane = F.lane, fr = lane & 15, fq = lane >> 4;
    for (int tile = F.bid; tile < NT / POOL_T; tile += F.G) {
        const int row0 = tile * POOL_T, tl0 = row0 & (SEQ - 1);
        __syncthreads();
        for (int p = F.tid; p < (POOL_T + 15) * 32; p += NTHREADS) { const int rr = p >> 5, pc = p & 31; const int tl = tl0 - 15 + rr;
            v4u raw = (v4u){0u, 0u, 0u, 0u};
            if (tl >= 0) raw = *(const v4u*)(proj + (size_t)(row0 - 15 + rr) * NPROJ + pc * 8);
            *(LAS v4u*)(us + rr * POOL_PITCH + pc * 16) = raw; }
        __syncthreads();
        {
            const int c8 = F.tid & 31, q = F.tid >> 5, w = 2 << (c8 >> 3);
            float sm[8];
#pragma unroll
            for (int e = 0; e < 8; ++e) sm[e] = 0.f;
            const int i0 = 15 + q * 4;
            for (int k = 0; k < w; ++k) { const v4u r = *(const LAS v4u*)(us + (i0 - k) * POOL_PITCH + c8 * 16);
                sm[0] += bflo(r.x); sm[1] += bfhi(r.x); sm[2] += bflo(r.y); sm[3] += bfhi(r.y); sm[4] += bflo(r.z); sm[5] += bfhi(r.z); sm[6] += bflo(r.w); sm[7] += bfhi(r.w); }
#pragma unroll
            for (int i = 0; i < 4; ++i) { const int tt = q * 4 + i, tl = tl0 + tt;
                const v4u cur = *(const LAS v4u*)(us + (15 + tt) * POOL_PITCH + c8 * 16);
                if (i > 0) { const v4u old = *(const LAS v4u*)(us + (15 + tt - w) * POOL_PITCH + c8 * 16);
                    sm[0] += bflo(cur.x) - bflo(old.x); sm[1] += bfhi(cur.x) - bfhi(old.x); sm[2] += bflo(cur.y) - bflo(old.y); sm[3] += bfhi(cur.y) - bfhi(old.y);
                    sm[4] += bflo(cur.z) - bflo(old.z); sm[5] += bfhi(cur.z) - bfhi(old.z); sm[6] += bflo(cur.w) - bflo(old.w); sm[7] += bfhi(cur.w) - bfhi(old.w); }
                const float ic = 1.f / (float)((tl + 1) < w ? (tl + 1) : w);
                v4u o; o.x = pk2(sm[0] * ic - bflo(cur.x), sm[1] * ic - bfhi(cur.x)); o.y = pk2(sm[2] * ic - bflo(cur.y), sm[3] * ic - bfhi(cur.y));
                o.z = pk2(sm[4] * ic - bflo(cur.z), sm[5] * ic - bfhi(cur.z)); o.w = pk2(sm[6] * ic - bflo(cur.w), sm[7] * ic - bfhi(cur.w));
                *(LAS v4u*)(pl + tt * POOL_PITCH + c8 * 16) = o; }
        }
        __syncthreads();
        {
            const int g = F.wave >> 1, mh = F.wave & 1;
            bf16x8 af[2][2], bfr[4][2];
#pragma unroll
            for (int mt = 0; mt < 2; ++mt)
#pragma unroll
                for (int k = 0; k < 2; ++k) af[mt][k] = *(const LAS bf16x8*)(pl + (32 * mh + 16 * mt + fr) * POOL_PITCH + (g * 64 + k * 32 + fq * 8) * 2);
#pragma unroll
            for (int nt = 0; nt < 4; ++nt)
#pragma unroll
                for (int k = 0; k < 2; ++k) bfr[nt][k] = *(const bf16x8*)(pwt + ((size_t)(g * 64 + nt * 16 + fr) * 64 + k * 32 + fq * 8));
#pragma unroll
            for (int mt = 0; mt < 2; ++mt)
#pragma unroll
                for (int nt = 0; nt < 4; ++nt) { f32x4 acc = (f32x4){0.f, 0.f, 0.f, 0.f};
                    acc = __builtin_amdgcn_mfma_f32_16x16x32_bf16(bfr[nt][0], af[mt][0], acc, 0, 0, 0);
                    acc = __builtin_amdgcn_mfma_f32_16x16x32_bf16(bfr[nt][1], af[mt][1], acc, 0, 0, 0);
                    const int col = g * 64 + nt * 16 + 4 * fq; const f32x4 sc = *(const f32x4*)(pool_scale + col);
                    const f32x4 o = acc * sc;
                    *(v2u*)(mixin + (size_t)(row0 + 32 * mh + 16 * mt + fr) * NMIX + col) = (v2u){pk2(o.x, o.y), pk2(o.z, o.w)}; }
        }
    }
}

constexpr int KV_PITCH = 144;
__device__ __forceinline__ void attn_phase(Frame& F) {
    const bf16* proj = (const bf16*)(F.ws + WS_PROJ);
    bf16* atto = (bf16*)(F.ws + WS_ATTO); float* lse = (float*)(F.ws + WS_LSE);
    LAS unsigned char* Ks = F.lds; LAS unsigned char* Vs = F.lds + 256 * KV_PITCH;
    const int lane = F.lane, fr = lane & 15, fq = lane >> 4, w = F.wave;
    const int w_i0 = 16 * w, c0 = w >> 1, qi = w_i0 + fr;
#define ATT_DECODE(unit_, rowb_, d_, r_, n_, g_, h_, colQ_) \
        const int rn_##unit_ = (unit_) & 31; const int h_ = ((unit_) >> 5) & 3, g_ = ((unit_) >> 7) % 3; const size_t rowb_ = (size_t)((unit_) / 384) * SEQ; \
        const int d_ = 1 << (2 * g_), nbk_##unit_ = 32 >> (2 * g_), r_ = rn_##unit_ / nbk_##unit_, n_ = rn_##unit_ % nbk_##unit_; const int colQ_ = 256 + g_ * 256 + h_ * 64;
    v4u kreg[4], vreg[4]; bf16x8 qn[2];
    {   const int unit0 = F.bid;
        if (unit0 < NB * 3 * 4 * 32) { ATT_DECODE(unit0, rowb, d, r, n, g, h, colQ)
            const size_t qrow = rowb + (size_t)(n * 128 + qi) * d + r;
#pragma unroll
            for (int ks = 0; ks < 2; ++ks) qn[ks] = *(const bf16x8*)(proj + qrow * NPROJ + colQ + ks * 32 + fq * 8);
#pragma unroll
            for (int cidx = 0; cidx < 4; ++cidx) { const int ch = F.tid + 512 * cidx, j = ch >> 3, pc = ch & 7;
                int p = (n - 1) * 128 + j; p = p < 0 ? 0 : p; const size_t row = rowb + (size_t)p * d + r;
                kreg[cidx] = *(const v4u*)(proj + row * NPROJ + colQ + 768 + pc * 8); vreg[cidx] = *(const v4u*)(proj + row * NPROJ + colQ + 1536 + pc * 8); } } }
    for (int unit = F.bid; unit < NB * 3 * 4 * 32; unit += F.G) {
        ATT_DECODE(unit, rowb, d, r, n, g, h, colQ)
        __syncthreads();
#pragma unroll
        for (int cidx = 0; cidx < 4; ++cidx) { const int ch = F.tid + 512 * cidx, j = ch >> 3, pc = ch & 7;
            *(LAS v4u*)(Ks + j * KV_PITCH + pc * 16) = kreg[cidx]; *(LAS v4u*)(Vs + j * KV_PITCH + pc * 16) = vreg[cidx]; }
        const size_t qrow = rowb + (size_t)(n * 128 + qi) * d + r;
        bf16x8 qf[2]; qf[0] = qn[0]; qf[1] = qn[1];
        __syncthreads();
        {   const int unit2 = unit + F.G;
            if (unit2 < NB * 3 * 4 * 32) { ATT_DECODE(unit2, rowb2, d2, r2, n2, g2, h2, colQ2)
                const size_t qrow2 = rowb2 + (size_t)(n2 * 128 + qi) * d2 + r2;
#pragma unroll
                for (int ks = 0; ks < 2; ++ks) qn[ks] = *(const bf16x8*)(proj + qrow2 * NPROJ + colQ2 + ks * 32 + fq * 8);
#pragma unroll
                for (int cidx = 0; cidx < 4; ++cidx) { const int ch = F.tid + 512 * cidx, j = ch >> 3, pc = ch & 7;
                    int p = (n2 - 1) * 128 + j; p = p < 0 ? 0 : p; const size_t row = rowb2 + (size_t)p * d2 + r2;
                    kreg[cidx] = *(const v4u*)(proj + row * NPROJ + colQ2 + 768 + pc * 8); vreg[cidx] = *(const v4u*)(proj + row * NPROJ + colQ2 + 1536 + pc * 8); } } }
        f32x4 s[5][2];
#pragma unroll
        for (int cc = 0; cc < 5; ++cc)
#pragma unroll
            for (int hh = 0; hh < 2; ++hh) {
                const int j = 32 * (c0 + cc) + 8 * (fr >> 2) + 4 * hh + (fr & 3);
                const bf16x8 k0 = *(const LAS bf16x8*)(Ks + j * KV_PITCH + fq * 16), k1 = *(const LAS bf16x8*)(Ks + j * KV_PITCH + 64 + fq * 16);
                f32x4 a = (f32x4){0.f, 0.f, 0.f, 0.f};
                a = __builtin_amdgcn_mfma_f32_16x16x32_bf16(k0, qf[0], a, 0, 0, 0);
                a = __builtin_amdgcn_mfma_f32_16x16x32_bf16(k1, qf[1], a, 0, 0, 0);
                s[cc][hh] = a;
            }
        float mx = -1e30f;
        int qil = qi; asm volatile("" : "+v"(qil));
#pragma unroll
        for (int cc = 0; cc < 5; ++cc)
#pragma unroll
            for (int hh = 0; hh < 2; ++hh)
#pragma unroll
                for (int rr = 0; rr < 4; ++rr) { const int j = 32 * (c0 + cc) + 8 * fq + 4 * hh + rr; const int dist = 128 + qil - j;
                    const bool valid = (dist >= 0) && (dist <= 128) && (n > 0 || j >= 128);
                    const float v = valid ? s[cc][hh][rr] * 0.18033688f : -1e30f; s[cc][hh][rr] = v; mx = fmaxf(mx, v); }
        mx = fmaxf(mx, __shfl_xor(mx, 16)); mx = fmaxf(mx, __shfl_xor(mx, 32));
        float l = 0.f;
#pragma unroll
        for (int cc = 0; cc < 5; ++cc)
#pragma unroll
            for (int hh = 0; hh < 2; ++hh)
#pragma unroll
                for (int rr = 0; rr < 4; ++rr) { const float p = __builtin_amdgcn_exp2f(s[cc][hh][rr] - mx); s[cc][hh][rr] = p; l += p; }
        l += __shfl_xor(l, 16); l += __shfl_xor(l, 32);
        f32x4 o[4];
#pragma unroll
        for (int eb = 0; eb < 4; ++eb) o[eb] = (f32x4){0.f, 0.f, 0.f, 0.f};
#pragma unroll
        for (int cc = 0; cc < 5; ++cc) {
            const v4u pu = (v4u){pk2(s[cc][0][0], s[cc][0][1]), pk2(s[cc][0][2], s[cc][0][3]), pk2(s[cc][1][0], s[cc][1][1]), pk2(s[cc][1][2], s[cc][1][3])};
            const bf16x8 pf = __builtin_bit_cast(bf16x8, pu);
            const int key0 = 32 * (c0 + cc) + 8 * fq + (fr >> 2);
#pragma unroll
            for (int eb = 0; eb < 4; ++eb) {
                const LAS unsigned char* vp = Vs + key0 * KV_PITCH + (16 * eb + 4 * (fr & 3)) * 2;
                const s16x4 lo = __builtin_bit_cast(s16x4, __builtin_amdgcn_ds_read_tr16_b64_v4i16((LAS s16x4*)vp));
                const s16x4 hi = __builtin_bit_cast(s16x4, __builtin_amdgcn_ds_read_tr16_b64_v4i16((LAS s16x4*)(vp + 4 * KV_PITCH)));
                const bf16x8 vf = (bf16x8){lo[0], lo[1], lo[2], lo[3], hi[0], hi[1], hi[2], hi[3]};
                o[eb] = __builtin_amdgcn_mfma_f32_16x16x32_bf16(vf, pf, o[eb], 0, 0, 0);
            }
        }
        const float il = 1.f / l;
        bf16* op = atto + ((size_t)g * NT + qrow) * 256 + h * 64 + 4 * fq;
#pragma unroll
        for (int eb = 0; eb < 4; ++eb) { const f32x4 v = o[eb] * il; *(v2u*)(op + 16 * eb) = (v2u){pk2(v.x, v.y), pk2(v.z, v.w)}; }
        if (fq == 0) lse[((size_t)g * NT + qrow) * 4 + h] = mx + __builtin_amdgcn_logf(l);
    }
#undef ATT_DECODE
}

__device__ __forceinline__ void combine_phase(Frame& F) {
    const bf16* atto = (const bf16*)(F.ws + WS_ATTO); const float* lse = (const float*)(F.ws + WS_LSE); bf16* mixin = (bf16*)(F.ws + WS_MIXIN);
    for (size_t idx = (size_t)F.bid * NTHREADS + F.tid; idx < (size_t)NT * 32; idx += (size_t)F.G * NTHREADS) {
        const size_t t = idx >> 5; const int pc = (int)(idx & 31), h = pc >> 3;
        const float l0 = lse[(0 * (size_t)NT + t) * 4 + h], l1 = lse[(1 * (size_t)NT + t) * 4 + h], l2 = lse[(2 * (size_t)NT + t) * 4 + h];
        const float m = fmaxf(l0, fmaxf(l1, l2));
        float a0 = __builtin_amdgcn_exp2f(l0 - m), a1 = __builtin_amdgcn_exp2f(l1 - m), a2 = __builtin_amdgcn_exp2f(l2 - m);
        const float inv = 1.f / (a0 + a1 + a2); a0 *= inv; a1 *= inv; a2 *= inv;
        const v4u v0 = *(const v4u*)(atto + (0 * (size_t)NT + t) * 256 + pc * 8), v1 = *(const v4u*)(atto + (1 * (size_t)NT + t) * 256 + pc * 8), v2 = *(const v4u*)(atto + (2 * (size_t)NT + t) * 256 + pc * 8);
        v4u o;
        o.x = pk2(a0 * bflo(v0.x) + a1 * bflo(v1.x) + a2 * bflo(v2.x), a0 * bfhi(v0.x) + a1 * bfhi(v1.x) + a2 * bfhi(v2.x));
        o.y = pk2(a0 * bflo(v0.y) + a1 * bflo(v1.y) + a2 * bflo(v2.y), a0 * bfhi(v0.y) + a1 * bfhi(v1.y) + a2 * bfhi(v2.y));
        o.z = pk2(a0 * bflo(v0.z) + a1 * bflo(v1.z) + a2 * bflo(v2.z), a0 * bfhi(v0.z) + a1 * bfhi(v1.z) + a2 * bfhi(v2.z));
        o.w = pk2(a0 * bflo(v0.w) + a1 * bflo(v1.w) + a2 * bflo(v2.w), a0 * bfhi(v0.w) + a1 * bfhi(v1.w) + a2 * bfhi(v2.w));
        *(v4u*)(mixin + t * NMIX + 256 + pc * 8) = o;
    }
}

#if MK_NAIVE_ATTN
__device__ __forceinline__ void naive_attn_phase(Frame& F) {
    const bf16* proj = (const bf16*)(F.ws + WS_PROJ); bf16* mixin = (bf16*)(F.ws + WS_MIXIN);
    for (size_t idx = (size_t)F.bid * NTHREADS + F.tid; idx < (size_t)NT * 4; idx += (size_t)F.G * NTHREADS) {
        const size_t tg = idx >> 2; const int h = (int)(idx & 3), t = (int)(tg & (SEQ - 1)); const size_t rowb = tg - t;
        float m = -1e30f, l = 0.f, o[64];
        for (int e = 0; e < 64; ++e) o[e] = 0.f;
        for (int g = 0; g < 3; ++g) { const int d = 1 << (2 * g); const int colQ = 256 + g * 256 + h * 64;
            const bf16* q = proj + tg * NPROJ + colQ;
            for (int j = 0; j <= 128; ++j) { const int tk = t - j * d; if (tk < 0) break;
                const bf16* k = proj + (rowb + tk) * NPROJ + colQ + 768; const bf16* v = k + 768;
                float sdot = 0.f; for (int e = 0; e < 64; ++e) sdot += bf2f(q[e]) * bf2f(k[e]);
                sdot *= 0.125f;
                const float mn = fmaxf(m, sdot), corr = __expf(m - mn), p = __expf(sdot - mn);
                l = l * corr + p; for (int e = 0; e < 64; ++e) o[e] = o[e] * corr + p * bf2f(v[e]); m = mn; } }
        const float il = 1.f / l;
        for (int e = 0; e < 64; ++e) mixin[tg * NMIX + 256 + h * 64 + e] = (bf16)f2bf(o[e] * il);
    }
}
#endif

__device__ __forceinline__ void routing_phase(Frame& F, const float* router_bias) {
    const float* L0 = (const float*)(F.ws + WS_LOGIT); const float* L1 = L0 + (size_t)NT * NE;
    float* gatew = (float*)(F.ws + WS_GATEW); unsigned* bucket = (unsigned*)(F.ws + WS_BUCKET); unsigned* gcnt = (unsigned*)(F.ws + WS_CTL) + CW_GCNT;
    LAS unsigned* hist = (LAS unsigned*)F.lds; LAS unsigned* basel = hist + 256; LAS unsigned* asg = hist + 512;
    const int lane = F.lane;
    for (int blk = F.bid; blk < NT / 128; blk += F.G) {
        __syncthreads();
        if (F.tid < 256) hist[F.tid] = 0u;
        __syncthreads();
        const f32x4 bias = *(const f32x4*)(router_bias + 4 * lane);
        f32x4 lgn; { const size_t t0 = (size_t)blk * 128 + F.wave * 16; lgn = *(const f32x4*)(L0 + t0 * NE + 4 * lane) + *(const f32x4*)(L1 + t0 * NE + 4 * lane); }
#pragma nounroll
        for (int tl = 0; tl < 16; ++tl) {
            const int tloc = F.wave * 16 + tl; const size_t t = (size_t)blk * 128 + tloc;
            const f32x4 lg = lgn;
            if (tl + 1 < 16) lgn = *(const f32x4*)(L0 + (t + 1) * NE + 4 * lane) + *(const f32x4*)(L1 + (t + 1) * NE + 4 * lane);
            float sc[4], cd[4];
#pragma unroll
            for (int i = 0; i < 4; ++i) { sc[i] = 1.f / (1.f + __expf(-lg[i])); cd[i] = sc[i] + bias[i]; }
            float a1 = fmaxf(cd[0], cd[1]), a2 = fminf(cd[0], cd[1]);
#pragma unroll
            for (int i = 2; i < 4; ++i) { const float v = cd[i]; a2 = fmaxf(a2, fminf(a1, v)); a1 = fmaxf(a1, v); }
            { float b1 = dppf<0xB1>(a1), b2 = dppf<0xB1>(a2); float n1 = fmaxf(a1, b1), n2 = fmaxf(fminf(a1, b1), fmaxf(a2, b2)); a1 = n1; a2 = n2;
              b1 = dppf<0x4E>(a1); b2 = dppf<0x4E>(a2); n1 = fmaxf(a1, b1); n2 = fmaxf(fminf(a1, b1), fmaxf(a2, b2)); a1 = n1; a2 = n2;
              b1 = dppf<0x141>(a1); b2 = dppf<0x141>(a2); n1 = fmaxf(a1, b1); n2 = fmaxf(fminf(a1, b1), fmaxf(a2, b2)); a1 = n1; a2 = n2; }
            const float gs = a1 + a2; const int myg = lane >> 3; int rank = 0;
#pragma unroll
            for (int gg = 0; gg < 8; ++gg) { const float o = __builtin_bit_cast(float, __builtin_amdgcn_readlane(__builtin_bit_cast(int, gs), gg * 8)); rank += (o > gs || (o == gs && gg < myg)) ? 1 : 0; }
            if (rank >= 4) {
#pragma unroll
                for (int i = 0; i < 4; ++i) cd[i] = -1e30f; }
            int sel_e = 0; float sel_s = 0.f, ssum = 0.f;
#pragma unroll
            for (int k = 0; k < TOPK; ++k) {
                const float lm = fmaxf(fmaxf(cd[0], cd[1]), fmaxf(cd[2], cd[3]));
                float v = fmaxf(lm, dppf<0xB1>(lm)); v = fmaxf(v, dppf<0x4E>(v)); v = fmaxf(v, dppf<0x141>(v)); v = fmaxf(v, dppf<0x140>(v));
                const float r0 = __builtin_bit_cast(float, __builtin_amdgcn_readlane(__builtin_bit_cast(int, v), 0)), r1 = __builtin_bit_cast(float, __builtin_amdgcn_readlane(__builtin_bit_cast(int, v), 16));
                const float r2 = __builtin_bit_cast(float, __builtin_amdgcn_readlane(__builtin_bit_cast(int, v), 32)), r3 = __builtin_bit_cast(float, __builtin_amdgcn_readlane(__builtin_bit_cast(int, v), 48));
                const float mx = fmaxf(fmaxf(r0, r1), fmaxf(r2, r3));
                const unsigned long long msk = __ballot(lm == mx);
                const int own = __builtin_ffsll((long long)msk) - 1;
                const int bi = cd[0] == mx ? 0 : (cd[1] == mx ? 1 : (cd[2] == mx ? 2 : 3));
                float myv = sc[0]; myv = bi == 1 ? sc[1] : myv; myv = bi == 2 ? sc[2] : myv; myv = bi == 3 ? sc[3] : myv;
                const int wi = __builtin_amdgcn_readlane(bi, own);
                const float sv = __builtin_bit_cast(float, __builtin_amdgcn_readlane(__builtin_bit_cast(int, myv), own));
                if (lane == own) {
#pragma unroll
                    for (int i = 0; i < 4; ++i) if (wi == i) cd[i] = -1e30f; }
                ssum += sv;
                if (lane == k) { sel_e = 4 * own + wi; sel_s = sv; }
            }
            if (lane < TOPK) {
                const unsigned rk = __hip_atomic_fetch_add(hist + sel_e, 1u, __ATOMIC_RELAXED, __HIP_MEMORY_SCOPE_WORKGROUP);
                asg[tloc * 8 + lane] = (unsigned)sel_e | (rk << 16);
                gatew[t * 8 + lane] = sel_s / ssum * 2.5f;
            }
        }
        __syncthreads();
        if (F.tid < 256) { const unsigned c = hist[F.tid]; basel[F.tid] = c ? atomicAdd(&gcnt[F.tid * 16], c) : 0u; }
        __syncthreads();
        for (int a = F.tid; a < 1024; a += NTHREADS) { const unsigned v = asg[a], e = v & 0xffffu, rk = v >> 16;
            bucket[(size_t)e * CAP + basel[e] + rk] = (unsigned)(blk * 1024 + a); }
    }
}

__device__ __forceinline__ void build_tables(Frame& F, int& nblk_total) {
    const unsigned* gcnt = (const unsigned*)(F.ws + WS_CTL) + CW_GCNT;
    LAS int* prefix = (LAS int*)(F.lds + TAB_OFF); LAS int* cnt = prefix + 260;
    __syncthreads();
    if (F.tid < 256) cnt[F.tid] = (int)__hip_atomic_load(&gcnt[F.tid * 16], __ATOMIC_RELAXED, __HIP_MEMORY_SCOPE_AGENT);
    __syncthreads();
    if (F.tid < 64) {
        int nb[4], sm = 0;
#pragma unroll
        for (int i = 0; i < 4; ++i) { nb[i] = (cnt[4 * F.tid + i] + 255) >> 8; sm += nb[i]; }
        int inc = sm;
#pragma unroll
        for (int o = 1; o < 64; o <<= 1) { const int t = __shfl_up(inc, o); if (F.tid >= o) inc += t; }
        int ex = inc - sm;
#pragma unroll
        for (int i = 0; i < 4; ++i) { prefix[4 * F.tid + i] = ex; ex += nb[i]; }
        if (F.tid == 63) prefix[NE] = inc;
    }
    __syncthreads();
    if (F.tid < 256) { LAS unsigned char* b2e = (LAS unsigned char*)(cnt + 256); for (int b = prefix[F.tid]; b < prefix[F.tid + 1]; ++b) b2e[b] = (unsigned char)F.tid; }
    __syncthreads();
    nblk_total = prefix[NE];
}

__device__ __forceinline__ void final_phase(Frame& F, const float* g_final) {
    const float* mod = (const float*)(F.ws + WS_MOD); const unsigned char* Y = (const unsigned char*)(F.ws + WS_Y);
    const unsigned* pos = (const unsigned*)(F.ws + WS_POS); const float* gatew = (const float*)(F.ws + WS_GATEW);
    const int c0 = 16 * F.lane;
    for (int blk = F.bid; blk < NT / 128; blk += F.G) {
        const int b = (blk * 128) >> 12; const float* g2 = mod + (size_t)b * 6144 + 5 * D + c0;
        f32x4 gb[4];
#pragma unroll
        for (int j = 0; j < 4; ++j) gb[j] = *(const f32x4*)(g2 + 4 * j);
        const size_t rowbase = (size_t)blk * 128 + F.wave * 16;
        const unsigned p0 = pos[rowbase * 8 + F.lane], p1 = pos[rowbase * 8 + 64 + F.lane];
        const float w0 = gatew[rowbase * 8 + F.lane] * Y_INV_SCALE, w1 = gatew[rowbase * 8 + 64 + F.lane] * Y_INV_SCALE;
#pragma nounroll
        for (int rr = 0; rr < 16; ++rr) {
            const size_t row = rowbase + rr;
            const v4u* dr = (const v4u*)((const bf16*)F.out + row * (2 * D) + c0);
            v4u xv[2], sv, yv[TOPK]; float wk[TOPK];
            xv[0] = dr[0]; xv[1] = dr[1]; sv = *(const v4u*)((const unsigned char*)F.out + row * (4 * D) + 2 * D + c0);
#pragma unroll
            for (int k = 0; k < TOPK; ++k) { const int idx = rr * 8 + k;
                const unsigned pk = (unsigned)__builtin_amdgcn_readlane((int)(idx < 64 ? p0 : p1), idx & 63);
                wk[k] = __builtin_bit_cast(float, __builtin_amdgcn_readlane(__builtin_bit_cast(int, idx < 64 ? w0 : w1), idx & 63));
                yv[k] = *(const v4u*)(Y + (size_t)pk * D + c0); }
            f32x4 v[4]; float s = 0.f;
#pragma unroll
            for (int j = 0; j < 4; ++j) {
                const auto slo = __builtin_amdgcn_cvt_pk_f32_fp8((int)sv[j], false), shi = __builtin_amdgcn_cvt_pk_f32_fp8((int)sv[j], true);
                f32x4 r = (f32x4){slo[0], slo[1], shi[0], shi[1]} * Y_INV_SCALE;
#pragma unroll
                for (int k = 0; k < TOPK; ++k) { const int wd = (int)yv[k][j];
                    const auto lo = __builtin_amdgcn_cvt_pk_f32_fp8(wd, false), hi = __builtin_amdgcn_cvt_pk_f32_fp8(wd, true);
                    r += wk[k] * (f32x4){lo[0], lo[1], hi[0], hi[1]}; }
                const unsigned xw0 = xv[j >> 1][(j & 1) * 2], xw1 = xv[j >> 1][(j & 1) * 2 + 1];
                v[j] = (f32x4){bflo(xw0), bfhi(xw0), bflo(xw1), bfhi(xw1)} + gb[j] * r;
                s += (v[j].x * v[j].x + v[j].y * v[j].y) + (v[j].z * v[j].z + v[j].w * v[j].w); }
            const float rstd = 1.f / sqrtf(wave_sum(s) * (1.f / D) + NORM_EPS);
            f32x4* orow = (f32x4*)(F.out + row * D + c0);
#pragma unroll
            for (int j = 0; j < 4; ++j) orow[j] = v[j] * rstd * *(const f32x4*)(g_final + c0 + 4 * j);
        }
    }
}

constexpr int N_PHASES = 12;
__global__ void __launch_bounds__(NTHREADS, 2) fwd(Args args) {
    extern __shared__ __attribute__((aligned(16))) unsigned char lds_raw[];
    Frame F;
    F.lds = (LAS unsigned char*)lds_raw;
    F.tid = threadIdx.x; F.lane = F.tid & 63; F.wave = __builtin_amdgcn_readfirstlane(F.tid >> 6); F.G = gridDim.x; F.bid = blockIdx.x;
#define INP(i) ld_ptr(F.lds, (i))
    F.out = args.out; F.ws = args.ws;
    unsigned char* ws = args.ws;
    volatile LAS unsigned* MISC = (volatile LAS unsigned*)(F.lds + MISC_OFF);
    if (F.tid < 16) MISC[F.tid] = 0u;
    if (F.tid == 0) { LAS unsigned long long* pt = (LAS unsigned long long*)(F.lds + PT_OFF);
#pragma unroll
        for (int i = 0; i < 19; ++i) pt[i] = (unsigned long long)args.in[i]; }
    __syncthreads();
    const int lo = args.ph_lo, hi = args.ph_hi;
    XcdBarrier bar; bar.bar = (unsigned*)(ws + WS_CTL) + CW_BAR; bar.x = 0; bar.st = nullptr;
    if (hi - lo > 1) bar = xcd_barrier_post((unsigned*)(ws + WS_CTL) + CW_BAR, MISC + 8);
#ifndef PH_MASK
#define PH_MASK 0xfff
#endif
#define IN(k) (((PH_MASK >> (k)) & 1) && lo <= (k) && (k) < hi)
#if MK_PROBE >= 1000
#define PH_T0(k) unsigned long long _pt##k = 0; if (MK_PROBE == 1000 + (k)) _pt##k = __builtin_amdgcn_s_memrealtime();
#define PH_T1(k) if (MK_PROBE == 1000 + (k) && blockIdx.x == MK_PROBE_BLK && F.tid == 0) MISC[12] += (unsigned)(__builtin_amdgcn_s_memrealtime() - _pt##k);
#else
#define PH_T0(k)
#define PH_T1(k)
#endif
#if MK_PROBE >= 2000
#define SEAM_T0() const unsigned long long _st0 = __builtin_amdgcn_s_memrealtime();
#ifndef MK_SEAM_MASK
#define MK_SEAM_MASK 0
#endif
#define SEAM_T1(k) if ((MK_PROBE == 2000 || MK_PROBE == 2001 + (k) || (MK_PROBE == 2100 && ((MK_SEAM_MASK >> (k)) & 1))) && blockIdx.x == MK_PROBE_BLK && F.tid == 0) MISC[12] += (unsigned)(__builtin_amdgcn_s_memrealtime() - _st0);
#else
#define SEAM_T0()
#define SEAM_T1(k)
#endif
#define SEAM(k) do { SEAM_T0() if (IN(k) && IN((k) + 1)) { if ((k) <= 8) xcd_barrier_work(bar, F, QD_CHUNKS); else xcd_barrier(bar); } SEAM_T1(k) { int _t = threadIdx.x; asm volatile("" : "+v"(_t)); F.tid = _t; F.lane = _t & 63; } } while (0)

    const int vcu = (F.G % 8 == 0) ? (F.bid % 8) * (F.G / 8) + F.bid / 8 : F.bid;
    unsigned char* h8 = ws + WS_H;
    bf16* h2b = (bf16*)(ws + WS_H2B); bf16* proj = (bf16*)(ws + WS_PROJ); bf16* mixin = (bf16*)(ws + WS_MIXIN);

    PH_T0(0) if (IN(0)) { p0_prologue(F); } PH_T1(0) SEAM(0);
    PH_T0(1) if (IN(1)) { modnorm_phase<false, 2, false>(F, INP(0), INP(4), 0, h8, nullptr); win_int8_phase(F, INP(5)); } PH_T1(1) SEAM(1);
    PH_T0(2) if (IN(2)) {
        typedef DenseSchedT<NT / 256, NPROJ / 256, 1> SchedP2; SchedP2 S; S.init(h8, ws + WS_WIN_T, D / 2, D / 2, 0, F.G, F.bid);
        EpiProj E{proj, (const float*)(ws + WS_ROWSC), (const float*)(ws + WS_COLSC)};
        const int ksplit = vcu % 6;
        S.i0 = 0; S.i1 = ksplit;
        gemm_phase<EpiProj, SchedP2>(F.lds, D / 2, D / 2, S, E);
        __syncthreads();
        for (int e = F.bid; e < NE; e += F.G)
            convert_expert<false>(F, INP(12) + (size_t)e * D * FF, INP(13) + (size_t)e * D * FF, ws + WS_WGU_T + (size_t)e * 512 * D, 16, 16);
        __syncthreads();
        S.i0 = ksplit; S.i1 = 0x3fffffff;
        gemm_phase<EpiProj, SchedP2>(F.lds, D / 2, D / 2, S, E);
    } PH_T1(2) SEAM(2);
    PH_T0(3) if (IN(3)) {
#if MK_PROBE == 1103
        const unsigned long long _pp0 = __builtin_amdgcn_s_memrealtime();
#endif
        pool_phase(F, INP(7));
#if MK_PROBE == 1103
        if (blockIdx.x == MK_PROBE_BLK && F.tid == 0) MISC[12] += (unsigned)(__builtin_amdgcn_s_memrealtime() - _pp0);
#endif
#if MK_NAIVE_ATTN
        naive_attn_phase(F);
#else
        attn_phase(F);
#endif
    } PH_T1(3) SEAM(3);
    PH_T0(4) if (IN(4)) {
#if !MK_NAIVE_ATTN
        combine_phase(F);
#endif
    } PH_T1(4) SEAM(4);
    PH_T0(5) if (IN(5)) {
        typedef DenseSchedT<NT / 256, D / 256, 1> SchedP5; SchedP5 S; S.init(mixin, ws + WS_WOUT_T, NMIX, NMIX, 0, F.G, F.bid);
        EpiOut E{(bf16*)F.out};
        gemm_phase<EpiOut, SchedP5>(F.lds, NMIX, NMIX, S, E);
    } PH_T1(5) SEAM(5);
    PH_T0(6) if (IN(6)) { modnorm_phase<true, 1, true>(F, INP(0), INP(9), 3, h8, h2b); } PH_T1(6) SEAM(6);
    PH_T0(7) if (IN(7)) {
        typedef DenseSchedT<NT / 256, NE / 256, 2> SchedP7; SchedP7 S; S.init(h2b, ws + WS_WR_T, D, D, 512, F.G, F.bid);
        EpiRouter E{(float*)(ws + WS_LOGIT)};
        gemm_phase<EpiRouter, SchedP7>(F.lds, 512, D, S, E);
    } PH_T1(7) SEAM(7);
    PH_T0(8) if (IN(8)) { routing_phase(F, INP(11)); drain_queue(F, QG_CHUNKS); } PH_T1(8) SEAM(8);
    PH_T0(9) if (IN(9)) {
        int nblk; build_tables(F, nblk);
        MoeSched<2, false> S; S.prefix = (const LAS int*)(F.lds + TAB_OFF); S.cnt = S.prefix + 260; S.bucket = (const unsigned*)(ws + WS_BUCKET);
        S.Ar = (const char*)h8; S.As = (const char*)h8; S.Br = (const char*)(ws + WS_WGU_T); S.Bs = (const char*)(ws + WS_WSGU_T);
        S.nRouted = nblk * 2; S.total = S.nRouted + (NT / 256) * 2; S.G = F.G; S.c = vcu;
        EpiGU E{ws + WS_ACT, ws + WS_ACTS, (const unsigned*)(ws + WS_BUCKET), (unsigned*)(ws + WS_POS)};
        S.i0 = 0; S.i1 = 0x3fffffff;
        gemm_phase<EpiGU, MoeSched<2, false>>(F.lds, D / 2, D / 2, S, E);
        drain_queue(F, QD_CHUNKS);
    } PH_T1(9) SEAM(9);
    PH_T0(10) if (IN(10)) {
        int nblk; build_tables(F, nblk);
        MoeSched<4, true> S; S.prefix = (const LAS int*)(F.lds + TAB_OFF); S.cnt = S.prefix + 260; S.bucket = (const unsigned*)(ws + WS_BUCKET);
        S.Ar = (const char*)(ws + WS_ACT); S.As = (const char*)(ws + WS_ACTS); S.Br = (const char*)(ws + WS_WD_T); S.Bs = (const char*)(ws + WS_WSD_T);
        S.nRouted = nblk * 4; S.total = S.nRouted + (NT / 256) * 4; S.G = F.G; S.c = vcu; S.i0 = 0; S.i1 = 0x3fffffff;
        EpiDown E{(unsigned char*)(ws + WS_Y), (bf16*)F.out};
        gemm_phase<EpiDown, MoeSched<4, true>>(F.lds, FF / 2, FF / 2, S, E);
    } PH_T1(10) SEAM(10);
    PH_T0(11) if (IN(11)) { final_phase(F, INP(18)); } PH_T1(11)
#if MK_PROBE
    if (blockIdx.x == MK_PROBE_BLK) { __syncthreads();
        if (F.tid == 0) { const unsigned long long span = (unsigned long long)MISC[12] * MK_PROBE_MULT, t0 = __builtin_amdgcn_s_memrealtime();
            while (__builtin_amdgcn_s_memrealtime() - t0 < span) __builtin_amdgcn_s_sleep(16); } }
#endif
#undef IN
#undef SEAM
#undef INP
}

extern "C" void kernel_launch(void* const* d_in, const int* in_sizes, int n_in, void* d_out, int out_size, void* d_ws, size_t ws_size, hipStream_t stream) {
    static int grid = 0;
    if (grid == 0) {
        if (n_in != 19 || out_size != NT * D || ws_size < WS_END) { fprintf(stderr, "kernel_launch: unexpected shapes (n_in %d out %d ws %zu)\n", n_in, out_size, ws_size); grid = -1; return; }
        int dev = 0, cus = 0;
        if (hipGetDevice(&dev) != hipSuccess || hipDeviceGetAttribute(&cus, hipDeviceAttributeMultiprocessorCount, dev) != hipSuccess) { grid = -1; return; }
        if (hipFuncSetAttribute((const void*)fwd, hipFuncAttributeMaxDynamicSharedMemorySize, LDS_BYTES) != hipSuccess) { fprintf(stderr, "kernel_launch: hipFuncSetAttribute failed\n"); grid = -1; return; }
        int per_cu = 0;
        if (hipOccupancyMaxActiveBlocksPerMultiprocessor(&per_cu, (const void*)fwd, NTHREADS, LDS_BYTES) != hipSuccess || per_cu < 1) { fprintf(stderr, "kernel_launch: occupancy query says %d\n", per_cu); }
        (void)hipGetLastError();
        grid = cus;
    }
    if (grid < 0) return;
    (void)hipMemsetAsync((char*)d_ws + WS_CTL, 0, CTL_ZERO_BYTES, stream);
    Args a{};
    for (int i = 0; i < 19; ++i) a.in[i] = (const float*)d_in[i];
    a.out = (float*)d_out; a.ws = (unsigned char*)d_ws;
#if MK_ONE_LAUNCH
    a.ph_lo = 0; a.ph_hi = N_PHASES;
    hipLaunchKernelGGL(fwd, dim3(grid), dim3(NTHREADS), LDS_BYTES, stream, a);
#else
    for (int p = 0; p < N_PHASES; ++p) { a.ph_lo = p; a.ph_hi = p + 1; const int reps = ((MK_REP_MASK >> p) & 1) ? 2 : 1;
        for (int r = 0; r < reps; ++r) hipLaunchKernelGGL(fwd, dim3(grid), dim3(NTHREADS), LDS_BYTES, stream, a); }
#endif
}
```

```cpp
#include <hip/hip_runtime.h>
#include <cstdio>
#include <cstdint>

#ifndef MK_ONE_LAUNCH
#define MK_ONE_LAUNCH 1
#endif
#ifndef MK_FAST_GEMM
#define MK_FAST_GEMM 1
#endif
#ifndef MK_REP_MASK
#define MK_REP_MASK 0x000
#endif
#ifndef MK_MX
#define MK_MX 1
#endif
#ifndef MK_PROBE
#define MK_PROBE 0
#endif
#ifndef MK_PROBE_BLK
#define MK_PROBE_BLK 0
#endif
#ifndef MK_PROBE_WAVE
#define MK_PROBE_WAVE 0
#endif
#ifndef MK_PROBE_MULT
#define MK_PROBE_MULT 4
#endif
#ifndef MK_NAIVE_ATTN
#define MK_NAIVE_ATTN 0
#endif

#define LAS __attribute__((address_space(3)))
#define GAS __attribute__((address_space(1)))
typedef unsigned short bf16;
typedef short bf16x8 __attribute__((ext_vector_type(8)));
typedef short s16x4 __attribute__((ext_vector_type(4)));
typedef float f32x4 __attribute__((ext_vector_type(4)));
typedef float f32x2 __attribute__((ext_vector_type(2)));
typedef long l64x2 __attribute__((ext_vector_type(2)));
typedef int i32x8 __attribute__((ext_vector_type(8)));
typedef int i32x4 __attribute__((ext_vector_type(4)));
typedef unsigned v4u __attribute__((ext_vector_type(4)));
typedef unsigned v2u __attribute__((ext_vector_type(2)));

constexpr int D = 1024, NB = 8, SEQ = 4096, NT = NB * SEQ;
constexpr int NPROJ = 2560, NE = 256, TOPK = 8, FF = 256, NMIX = 512;
constexpr int CAP = NT;
constexpr int MAXBLK = NT * TOPK / 256 + NE;
constexpr float NORM_EPS = 1e-6f;
constexpr int NWAVES = 8, NTHREADS = 512;

constexpr size_t MiB = 1u << 20;
constexpr size_t WS_CTL = 0, CTL_ZERO_BYTES = 1 * MiB;
constexpr size_t WS_MOD = 1 * MiB;
constexpr size_t WS_GATEW = 2 * MiB;
constexpr size_t WS_WIN_T = 4 * MiB;
constexpr size_t WS_WOUT_T = 9 * MiB;
constexpr size_t WS_WR_T = 10 * MiB;
constexpr size_t WS_WSGU_T = 11 * MiB;
constexpr size_t WS_WSD_T = 12 * MiB;
constexpr size_t WS_LSE = 13 * MiB;
constexpr size_t WS_WD_T = 16 * MiB;
constexpr size_t WS_ACT = 144 * MiB;
constexpr size_t WS_ACTS = 304 * MiB;
constexpr size_t WS_BUCKET = 320 * MiB;
constexpr size_t WS_WGU_T = 352 * MiB;
constexpr size_t WS_PROJ = 608 * MiB;
constexpr size_t WS_H = 768 * MiB;
constexpr size_t WS_ATTO = 832 * MiB;
constexpr size_t WS_MIXIN = 880 * MiB;
constexpr size_t WS_LOGIT = 912 * MiB;
constexpr size_t WS_Y = 352 * MiB;
constexpr size_t WS_H2B = 832 * MiB;
constexpr size_t WS_ROWSC = 14 * MiB + 512 * 1024;
constexpr size_t WS_COLSC = 14 * MiB + 768 * 1024;
constexpr size_t WS_PWT = 15 * MiB;
constexpr size_t WS_POS = 3 * MiB;
constexpr size_t WS_END = 992 * MiB;
constexpr int CW_BAR = 4096;
constexpr int CW_GCNT = 16384;
constexpr int CW_QD = 24576;
constexpr unsigned QG_CHUNKS = NE * 16, QD_CHUNKS = QG_CHUNKS + NE * 16;

constexpr int RING_BYTES = 131072;
constexpr int TAB_OFF = RING_BYTES;
constexpr int MISC_OFF = TAB_OFF + 4096;
constexpr int PT_OFF = MISC_OFF + 256;
constexpr int LDS_BYTES = 147456;

__device__ __forceinline__ unsigned f2bf(float f) { unsigned u = __builtin_bit_cast(unsigned, f); return (u + 0x7fffu + ((u >> 16) & 1u)) >> 16; }
__device__ __forceinline__ unsigned pk2(float lo, float hi) { unsigned r; asm("v_cvt_pk_bf16_f32 %0, %1, %2" : "=v"(r) : "v"(lo), "v"(hi)); return r; }
constexpr float W_SCALE = 64.f, W_INV_SCALE = 1.f / 64.f;
constexpr float WD_SCALE = 4.f;
constexpr float ACT_SCALE = 4.f;
__device__ __forceinline__ unsigned pk4_fp8(float a, float b, float c, float d) {
    int w = __builtin_amdgcn_cvt_pk_fp8_f32(a, b, 0, false); w = __builtin_amdgcn_cvt_pk_fp8_f32(c, d, w, true); return (unsigned)w; }
__device__ __forceinline__ unsigned pk4_i8(float a, float b, float c, float d) {
    const int ia = (int)__builtin_rintf(a), ib = (int)__builtin_rintf(b), ic = (int)__builtin_rintf(c), id = (int)__builtin_rintf(d);
    return (unsigned)(ia & 255) | ((unsigned)(ib & 255) << 8) | ((unsigned)(ic & 255) << 16) | ((unsigned)id << 24); }
__device__ __forceinline__ float bf2f(unsigned short b) { return __builtin_bit_cast(float, ((unsigned)b) << 16); }
__device__ __forceinline__ float bflo(unsigned u) { return __builtin_bit_cast(float, u << 16); }
__device__ __forceinline__ float bfhi(unsigned u) { return __builtin_bit_cast(float, u & 0xffff0000u); }
template <int CTRL> __device__ __forceinline__ float dppf(float v) {
    return __builtin_bit_cast(float, __builtin_amdgcn_update_dpp(0, __builtin_bit_cast(int, v), CTRL, 0xF, 0xF, true)); }
__device__ __forceinline__ float wave_sum(float v) {
    v += dppf<0xB1>(v); v += dppf<0x4E>(v); v += dppf<0x141>(v); v += dppf<0x140>(v);
    const float r0 = __builtin_bit_cast(float, __builtin_amdgcn_readlane(__builtin_bit_cast(int, v), 0)), r1 = __builtin_bit_cast(float, __builtin_amdgcn_readlane(__builtin_bit_cast(int, v), 16));
    const float r2 = __builtin_bit_cast(float, __builtin_amdgcn_readlane(__builtin_bit_cast(int, v), 32)), r3 = __builtin_bit_cast(float, __builtin_amdgcn_readlane(__builtin_bit_cast(int, v), 48));
    return (r0 + r1) + (r2 + r3);
}
__device__ __forceinline__ float wave_max(float v) {
    v = fmaxf(v, dppf<0xB1>(v)); v = fmaxf(v, dppf<0x4E>(v)); v = fmaxf(v, dppf<0x141>(v)); v = fmaxf(v, dppf<0x140>(v));
    const float r0 = __builtin_bit_cast(float, __builtin_amdgcn_readlane(__builtin_bit_cast(int, v), 0)), r1 = __builtin_bit_cast(float, __builtin_amdgcn_readlane(__builtin_bit_cast(int, v), 16));
    const float r2 = __builtin_bit_cast(float, __builtin_amdgcn_readlane(__builtin_bit_cast(int, v), 32)), r3 = __builtin_bit_cast(float, __builtin_amdgcn_readlane(__builtin_bit_cast(int, v), 48));
    return fmaxf(fmaxf(r0, r1), fmaxf(r2, r3));
}
__device__ __forceinline__ float silu_f(float g) { return g * __builtin_amdgcn_rcpf(1.f + __builtin_amdgcn_exp2f(-1.44269504f * g)); }

__device__ __forceinline__ const float* ld_ptr(LAS unsigned char* lds, int i) {
    const unsigned long long v = ((const LAS unsigned long long*)(lds + PT_OFF))[i];
    const unsigned lo = __builtin_amdgcn_readfirstlane((unsigned)v), hi = __builtin_amdgcn_readfirstlane((unsigned)(v >> 32));
    return (const float*)(((unsigned long long)hi << 32) | lo);
}
#define XB_TMO      128
#define XB_XCNT(j)  (256  + 64 * (j))
#define XB_XSUB(j)  (1280 + 64 * (j))
#define XB_XGEN(j)  (2304 + 64 * (j))
#define XB_TOP      3328
#define XB_TOPGEN   3392
#define XCD_BAR_WORDS 3456
#define XB_SPIN_CAP (1u << 18)
__device__ __forceinline__ unsigned xb_ld(unsigned* p)              { return __hip_atomic_load(p, __ATOMIC_RELAXED, __HIP_MEMORY_SCOPE_AGENT); }
__device__ __forceinline__ unsigned xb_add(unsigned* p, unsigned v) { return __hip_atomic_fetch_add(p, v, __ATOMIC_RELAXED, __HIP_MEMORY_SCOPE_AGENT); }
__device__ __forceinline__ unsigned xb_xcc_id() { return (unsigned)__builtin_amdgcn_s_getreg((3 << 11) | 20) & 0xFu; }
#define XB_SPIN(cond, bar) do { unsigned _sp = 0; while (cond) { __builtin_amdgcn_s_sleep(1); \
    if ((++_sp & 255u) == 0u) { if (xb_ld(&(bar)[XB_TMO])) break; if (_sp > XB_SPIN_CAP) { atomicAdd(&(bar)[XB_TMO], 1u); break; } } } } while (0)
struct XcdBarrier { unsigned* bar; unsigned x; volatile LAS unsigned* st; };
__device__ __forceinline__ XcdBarrier xcd_barrier_post(unsigned* bar, volatile LAS unsigned* st) {
    XcdBarrier b; b.bar = bar; b.x = xb_xcc_id(); b.st = st;
    if (threadIdx.x == 0) (void)xb_add(&bar[XB_XCNT(b.x)], 1u);
    return b;
}
__device__ __forceinline__ void xcd_barrier_complete(unsigned* bar, unsigned x, unsigned& nloc, unsigned& nx) {
    const unsigned G = gridDim.x * gridDim.y * gridDim.z;
    unsigned sum, cnt, mine, sp = 0u;
    for (;;) {
        sum = 0u; cnt = 0u; mine = 0u;
#pragma unroll
        for (unsigned j = 0; j < 16; ++j) { const unsigned c = xb_ld(&bar[XB_XCNT(j)]); sum += c; cnt += (c > 0u) ? 1u : 0u; mine = (j == x) ? c : mine; }
        if (sum == G) break;
        __builtin_amdgcn_s_sleep(1);
        if ((++sp & 255u) == 0u) { if (xb_ld(&bar[XB_TMO])) break; if (sp > XB_SPIN_CAP) { atomicAdd(&bar[XB_TMO], 1u); break; } }
    }
    nloc = mine > 0u ? mine : 1u; nx = cnt > 0u ? cnt : 1u;
}
__device__ __forceinline__ void xcd_barrier(const XcdBarrier& b) {
    asm volatile("s_waitcnt vmcnt(0)" ::: "memory");
    __syncthreads();
    if (threadIdx.x == 0) {
        unsigned* bar = b.bar;
        __builtin_amdgcn_s_waitcnt(0);
        unsigned nloc = b.st[0], nx = b.st[1];
        if (nloc == 0u) { xcd_barrier_complete(bar, b.x, nloc, nx); b.st[0] = nloc; b.st[1] = nx; }
        const unsigned old = xb_add(&bar[XB_XSUB(b.x)], 1u);
        const unsigned gen = old / nloc;
        if (old + 1u == (gen + 1u) * nloc) {
            __builtin_amdgcn_fence(__ATOMIC_RELEASE, "agent");
            asm volatile("s_waitcnt vmcnt(0)" ::: "memory");
            const unsigned og = xb_add(&bar[XB_TOP], 1u);
            const unsigned tg = og / nx;
            if (og + 1u == (tg + 1u) * nx) xb_add(&bar[XB_TOPGEN], 1u);
            else XB_SPIN(xb_ld(&bar[XB_TOPGEN]) == tg, bar);
            __builtin_amdgcn_fence(__ATOMIC_ACQUIRE, "agent");
            xb_add(&bar[XB_XGEN(b.x)], 1u);
            asm volatile("s_waitcnt vmcnt(0)" ::: "memory");
        } else {
            XB_SPIN(xb_ld(&bar[XB_XGEN(b.x)]) == gen, bar);
            __builtin_amdgcn_fence(__ATOMIC_ACQUIRE, "agent");
            asm volatile("s_waitcnt vmcnt(0)" ::: "memory");
        }
    }
    __syncthreads();
}

constexpr int BK = 64, HALF = 128, HTB = HALF * BK * 2;
__device__ __forceinline__ int lds_byte(int r, int c) { const int st = (r >> 4) * 2 + (c >> 5), rr = r & 15, cc = c & 31, ob = rr * 64 + cc * 2; return st * 1024 + (ob ^ (((ob >> 9) & 1) << 5)); }
__device__ __forceinline__ void stage_rc(int b, int& R, int& C) { const int st = b / 1024, sb = b % 1024, swz = sb ^ (((sb >> 9) & 1) << 5); R = (st >> 1) * 16 + swz / 64; C = (st & 1) * 32 + (swz % 64) / 2; }
__device__ __forceinline__ int perm32(int rho) { const int n = rho >> 4, i = rho & 15; return 8 * (i >> 2) + 4 * n + (i & 3); }

template <class Epi, class Sched>
__device__ __forceinline__ void gemm_simple(const int K, const int ldb, const Sched& S, const Epi& E) {
    const int tid = threadIdx.x, wid = __builtin_amdgcn_readfirstlane(tid >> 6), lane = tid & 63, wr = wid >> 2, wc = wid & 3, fr = lane & 15, fq = lane >> 4;
    typename Sched::Unit u;
    for (int ui = 0; S.next(ui, u); ++ui) {
        f32x4 acc[2][2][4][2];
#pragma unroll
        for (int a = 0; a < 2; ++a)
#pragma unroll
            for (int b = 0; b < 2; ++b)
#pragma unroll
                for (int m = 0; m < 4; ++m)
#pragma unroll
                    for (int n = 0; n < 2; ++n) acc[a][b][m][n] = (f32x4){0.f, 0.f, 0.f, 0.f};
        const char* A = S.a_base(u); const char* B = S.b_base(u);
        unsigned aoff[2][4], boff[2][2];
#pragma unroll
        for (int ai = 0; ai < 2; ++ai)
#pragma unroll
            for (int m = 0; m < 4; ++m) aoff[ai][m] = S.a_off(u, 128 * ai + 64 * wr + 16 * m + fr) + fq * 16;
#pragma unroll
        for (int bj = 0; bj < 2; ++bj)
#pragma unroll
            for (int n = 0; n < 2; ++n) { const int row = Epi::PERM == 2 ? 64 * wc + 16 * (fr >> 2) + 8 * bj + 4 * n + (fr & 3) : 128 * bj + 32 * wc + (Epi::PERM == 1 ? perm32(16 * n + fr) : 16 * n + fr); boff[bj][n] = (unsigned)(row * ldb) * 2u + fq * 16; }
        for (int k = 0; k < K; k += 32) {
            bf16x8 a[2][4], b[2][2];
#pragma unroll
            for (int ai = 0; ai < 2; ++ai)
#pragma unroll
                for (int m = 0; m < 4; ++m) a[ai][m] = *(const bf16x8*)(A + aoff[ai][m] + k * 2);
#pragma unroll
            for (int bj = 0; bj < 2; ++bj)
#pragma unroll
                for (int n = 0; n < 2; ++n) b[bj][n] = *(const bf16x8*)(B + boff[bj][n] + k * 2);
#pragma unroll
            for (int ai = 0; ai < 2; ++ai)
#pragma unroll
                for (int bj = 0; bj < 2; ++bj)
#pragma unroll
                    for (int m = 0; m < 4; ++m)
#pragma unroll
                        for (int n = 0; n < 2; ++n) acc[ai][bj][m][n] = __builtin_amdgcn_mfma_f32_16x16x32_bf16(b[bj][n], a[ai][m], acc[ai][bj][m][n], 0, 0, 0);
        }
        E(acc, u, wr, wc, fr, fq);
    }
}

template <class Epi, class Sched>
__device__ __forceinline__ void gemm_fast(LAS unsigned char* lds, const int K, const int ldb, const Sched& S, const Epi& E) {
    int tid0 = threadIdx.x; asm volatile("" : "+v"(tid0));
    const int tid = tid0, wid = __builtin_amdgcn_readfirstlane(tid >> 6), lane = tid & 63, wr = wid >> 2, wc = wid & 3, fr = lane & 15, fq = lane >> 4;
    int nt = K / BK; asm volatile("" : "+s"(nt));
    unsigned voffB0[2], voffB1[2];
#pragma unroll
    for (int i = 0; i < 2; ++i) { int R, C; stage_rc(tid * 16 + i * 8192, R, C);
        if (Epi::PERM == 2) { const int cb = 64 * (R >> 5) + 16 * ((R & 15) >> 2) + 4 * ((R >> 4) & 1) + (R & 3);
            voffB0[i] = (unsigned)(cb * ldb + C) * 2u; voffB1[i] = (unsigned)((cb + 8) * ldb + C) * 2u; }
        else { const int Rb = Epi::PERM == 1 ? ((R & ~31) + perm32(R & 31)) : R;
            voffB0[i] = (unsigned)(Rb * ldb + C) * 2u; voffB1[i] = (unsigned)((Rb + HALF) * ldb + C) * 2u; } }
#define PG8_AOFF(u) do { int _tz = threadIdx.x; asm volatile("" : "+v"(_tz)); _Pragma("unroll") for (int _i = 0; _i < 2; ++_i) { int _R, _C; stage_rc(_tz * 16 + _i * 8192, _R, _C); \
        vA0[_i] = S.a_off(u, _R) + (unsigned)_C * 2u; vA1[_i] = S.a_off(u, HALF + _R) + (unsigned)_C * 2u; } } while (0)
    const size_t kstep = (size_t)(BK * 2);
    const unsigned ldsw = (unsigned)wid * 1024u;
    const int aoff = lds_byte(wr * 64 + fr, fq * 8), boff = lds_byte(wc * 32 + fr, fq * 8);
#if MK_PROBE
#define PRB_NOW() __builtin_amdgcn_s_memrealtime()
#define PRB_ADD(IV, t0, t1) do { if (MK_PROBE == Epi::PID * 10 + (IV) && blockIdx.x == MK_PROBE_BLK && wid == MK_PROBE_WAVE && lane == 0) \
        __hip_atomic_fetch_add((LAS unsigned*)(lds + MISC_OFF + 48), (unsigned)((t1) - (t0)), __ATOMIC_RELAXED, __HIP_MEMORY_SCOPE_WORKGROUP); } while (0)
#else
#define PRB_NOW() 0ull
#define PRB_ADD(IV, t0, t1) do { } while (0)
#endif
#define PG8_SA(b, h) (((b) * 2 + (h)) * HTB)
#define PG8_SB(b, h) ((4 + (b) * 2 + (h)) * HTB)
#define PG8_STAGE(bufoff, gbase, voff) do { _Pragma("unroll") for (int _i = 0; _i < 2; ++_i) \
        __builtin_amdgcn_global_load_lds((const unsigned*)((const char*)(gbase) + (voff)[_i]), (LAS unsigned*)(lds + (bufoff) + ldsw + _i * 8192), 16, 0, 0); } while (0)
#define PG8_LDA(dst, b, h) do { _Pragma("unroll") for (int m = 0; m < 4; ++m) _Pragma("unroll") for (int k = 0; k < 2; ++k) dst[m][k] = *(const LAS bf16x8*)(lds + PG8_SA(b, h) + aoff + m * 2048 + k * 1024); } while (0)
#define PG8_LDB(dst, b, h) do { _Pragma("unroll") for (int n = 0; n < 2; ++n) _Pragma("unroll") for (int k = 0; k < 2; ++k) dst[n][k] = *(const LAS bf16x8*)(lds + PG8_SB(b, h) + boff + n * 2048 + k * 1024); } while (0)
#define PG8_MMA(ai, bj, At, Bt) do { __builtin_amdgcn_s_setprio(1); _Pragma("unroll") for (int m = 0; m < 4; ++m) _Pragma("unroll") for (int n = 0; n < 2; ++n) _Pragma("unroll") for (int k = 0; k < 2; ++k) { \
        if constexpr (Epi::FP8 && MK_MX) { if (k == 0) { \
            const i32x8 _a = __builtin_shufflevector(__builtin_bit_cast(i32x4, At[m][0]), __builtin_bit_cast(i32x4, At[m][1]), 0, 1, 2, 3, 4, 5, 6, 7); \
            const i32x8 _b = __builtin_shufflevector(__builtin_bit_cast(i32x4, Bt[n][0]), __builtin_bit_cast(i32x4, Bt[n][1]), 0, 1, 2, 3, 4, 5, 6, 7); \
            acc[ai][bj][m][n] = __builtin_amdgcn_mfma_scale_f32_16x16x128_f8f6f4(_b, _a, acc[ai][bj][m][n], 0, 0, 0, 0x7F7F7F7F, 0, 0x7F7F7F7F); } } \
        else if constexpr (Epi::I8) acc[ai][bj][m][n] = __builtin_bit_cast(f32x4, __builtin_amdgcn_mfma_i32_16x16x64_i8(__builtin_bit_cast(i32x4, Bt[n][k]), __builtin_bit_cast(i32x4, At[m][k]), __builtin_bit_cast(i32x4, acc[ai][bj][m][n]), 0, 0, 0)); \
        else if constexpr (Epi::FP8) { const l64x2 _a = __builtin_bit_cast(l64x2, At[m][k]), _b = __builtin_bit_cast(l64x2, Bt[n][k]); \
            acc[ai][bj][m][n] = __builtin_amdgcn_mfma_f32_16x16x32_fp8_fp8(_b[0], _a[0], acc[ai][bj][m][n], 0, 0, 0); \
            acc[ai][bj][m][n] = __builtin_amdgcn_mfma_f32_16x16x32_fp8_fp8(_b[1], _a[1], acc[ai][bj][m][n], 0, 0, 0); } \
        else acc[ai][bj][m][n] = __builtin_amdgcn_mfma_f32_16x16x32_bf16(Bt[n][k], At[m][k], acc[ai][bj][m][n], 0, 0, 0); } __builtin_amdgcn_s_setprio(0); } while (0)
#define PG8_WAIT_V(n) asm volatile("s_waitcnt vmcnt(" #n ")" ::: "memory")
#define PG8_WAIT_L(n) asm volatile("s_waitcnt lgkmcnt(" #n ")" ::: "memory")
#define PG8_BAR __builtin_amdgcn_s_barrier()
#define PG8_SCHED __builtin_amdgcn_sched_barrier(0)
    typename Sched::Unit cur, nxt; int ui = 0;
    if (!S.next(0, cur)) return;
    f32x4 acc[2][2][4][2];
#pragma unroll
    for (int a = 0; a < 2; ++a)
#pragma unroll
        for (int b = 0; b < 2; ++b)
#pragma unroll
            for (int m = 0; m < 4; ++m)
#pragma unroll
                for (int n = 0; n < 2; ++n) acc[a][b][m][n] = (f32x4){0.f, 0.f, 0.f, 0.f};
    bf16x8 At[4][2], B0[2][2], B1[2][2];
    const char* cA = S.a_base(cur); const char* cB = S.b_base(cur);
    unsigned vA0[2], vA1[2];
    PG8_AOFF(cur);
    PG8_STAGE(PG8_SB(0, 0), cB, voffB0); PG8_STAGE(PG8_SA(0, 0), cA, vA0); PG8_STAGE(PG8_SB(0, 1), cB, voffB1); PG8_STAGE(PG8_SA(0, 1), cA, vA1);
    if (wr == 1) PG8_BAR;
    PG8_WAIT_V(4); PG8_BAR;
    PG8_STAGE(PG8_SB(1, 0), cB + kstep, voffB0); PG8_STAGE(PG8_SA(1, 0), cA + kstep, vA0); PG8_STAGE(PG8_SB(1, 1), cB + kstep, voffB1);
    PG8_WAIT_V(6); PG8_BAR;
    for (;;) {
        const unsigned long long prb_a = PRB_NOW();
        const bool has_next = S.next(ui + 1, nxt);
        const char* nA = has_next ? S.a_base(nxt) : cA; const char* nB = has_next ? S.b_base(nxt) : cB;
        const unsigned long long prb_b = PRB_NOW(); PRB_ADD(1, prb_a, prb_b);
        for (int t = 0; t < nt; t += 2) {
            const unsigned long long prb_i0 = PRB_NOW();
            const bool last = (t == nt - 2);
            const char* a1 = cA + (size_t)(t + 1) * kstep;
            const char* a2 = last ? nA : cA + (size_t)(t + 2) * kstep; const char* b2 = last ? nB : cB + (size_t)(t + 2) * kstep;
            const char* a3 = a2 + kstep; const char* b3 = b2 + kstep;
            PG8_LDB(B0, 0, 0); PG8_SCHED; PG8_LDA(At, 0, 0); PG8_STAGE(PG8_SA(1, 1), a1, vA1);
            if (last && has_next) PG8_AOFF(nxt);
            PG8_WAIT_L(8); PG8_BAR; PG8_WAIT_L(0); PG8_MMA(0, 0, At, B0); PG8_BAR; PG8_SCHED;
            PG8_LDB(B1, 0, 1); PG8_STAGE(PG8_SB(0, 0), b2, voffB0);
            PG8_BAR; PG8_WAIT_L(0); PG8_MMA(0, 1, At, B1); PG8_BAR;
            PG8_LDA(At, 0, 1); PG8_STAGE(PG8_SA(0, 0), a2, vA0);
            PG8_BAR; PG8_WAIT_L(0); PG8_MMA(1, 0, At, B0); PG8_BAR; PG8_SCHED;
            PG8_STAGE(PG8_SB(0, 1), b2, voffB1);
            PG8_WAIT_V(6); PG8_BAR; PG8_MMA(1, 1, At, B1); PG8_BAR;
            PG8_LDB(B0, 1, 0); PG8_SCHED; PG8_LDA(At, 1, 0); PG8_STAGE(PG8_SA(0, 1), a2, vA1);
            PG8_WAIT_L(8); PG8_BAR; PG8_WAIT_L(0); PG8_MMA(0, 0, At, B0); PG8_BAR; PG8_SCHED;
            PG8_LDB(B1, 1, 1); PG8_STAGE(PG8_SB(1, 0), b3, voffB0);
            PG8_BAR; PG8_WAIT_L(0); PG8_MMA(0, 1, At, B1); PG8_BAR;
            PG8_LDA(At, 1, 1); PG8_STAGE(PG8_SA(1, 0), a3, vA0);
            PG8_BAR; PG8_WAIT_L(0); PG8_MMA(1, 0, At, B0);
            if constexpr (Epi::EARLY > 0) {
                int tz = threadIdx.x; asm volatile("" : "+v"(tz)); const int wz = tz >> 6, lz = tz & 63;
                E.template half<0>(acc, cur, wz >> 2, wz & 3, lz & 15, lz >> 4); }
            PG8_BAR; PG8_SCHED;
            PG8_STAGE(PG8_SB(1, 1), b3, voffB1);
            if constexpr (Epi::EARLY == 4) PG8_WAIT_V(10); else PG8_WAIT_V(6);
            PG8_BAR; PG8_MMA(1, 1, At, B1); PG8_BAR;
            { const unsigned long long prb_i1 = PRB_NOW(); if (t == 0) PRB_ADD(4, prb_i0, prb_i1); if (last) PRB_ADD(5, prb_i0, prb_i1); if (t != 0 && !last) PRB_ADD(6, prb_i0, prb_i1); }
        }
        const unsigned long long prb_c = PRB_NOW(); PRB_ADD(2, prb_b, prb_c);
        { int tz = threadIdx.x; asm volatile("" : "+v"(tz)); const int wz = tz >> 6, lz = tz & 63;
          E(acc, cur, wz >> 2, wz & 3, lz & 15, lz >> 4);
#if defined(MK_EPI_TWICE)
          if (Epi::TWICE) { asm volatile("" ::: "memory"); E(acc, cur, wz >> 2, wz & 3, lz & 15, lz >> 4); }
#endif
          }
        { const unsigned long long prb_d = PRB_NOW(); PRB_ADD(3, prb_c, prb_d); }
        if (!has_next) break;
#pragma unroll
        for (int a = 0; a < 2; ++a)
#pragma unroll
            for (int b = 0; b < 2; ++b)
#pragma unroll
                for (int m = 0; m < 4; ++m)
#pragma unroll
                    for (int n = 0; n < 2; ++n) acc[a][b][m][n] = (f32x4){0.f, 0.f, 0.f, 0.f};
        cur = nxt; cA = nA; cB = nB; ++ui;
    }
    PG8_WAIT_V(0);
    if (wr == 0) PG8_BAR;
    PG8_BAR;
#undef PG8_AOFF
#undef PRB_NOW
#undef PRB_ADD
#undef PG8_SA
#undef PG8_SB
#undef PG8_STAGE
#undef PG8_LDA
#undef PG8_LDB
#undef PG8_MMA
#undef PG8_WAIT_V
#undef PG8_WAIT_L
#undef PG8_BAR
#undef PG8_SCHED
}

template <class Epi, class Sched>
__device__ __forceinline__ void gemm_phase(LAS unsigned char* lds, const int K, const int ldb, const Sched& S, const Epi& E) {
#if MK_FAST_GEMM
    gemm_fast<Epi, Sched>(lds, K, ldb, S, E);
#else
    gemm_simple<Epi, Sched>(K, ldb, S, E);
#endif
}

struct DenseUnit { int pm, pn, ks; };
template <int NM, int NN, int KSPLIT>
struct DenseSchedT {
    typedef DenseUnit Unit;
    const char* A; const char* B; int lda2, ldb2, ksub2, G, c, i0, i1;
    __device__ __forceinline__ void init(const void* A_, const void* B_, int lda, int ldb, int Ksub, int G_, int c_) {
        A = (const char*)A_; B = (const char*)B_; lda2 = lda * 2; ldb2 = ldb * 2; ksub2 = Ksub * 2; G = G_; c = c_; i0 = 0; i1 = 0x3fffffff; }
    __device__ __forceinline__ bool next(int i, Unit& u) const {
        constexpr int nwg = NM * NN, total = nwg * KSPLIT;
        if (i + i0 >= i1) return false;
        const int L = (i + i0) * G + c; if (L >= total) return false;
        int id = L / KSPLIT; u.ks = L - id * KSPLIT;
        { constexpr int q = nwg / 8, r = nwg % 8; const int xcd = id % 8, off = id / 8; id = (xcd < r ? xcd * (q + 1) : r * (q + 1) + (xcd - r) * q) + off; }
        constexpr int nig = 8 * NN; const int gid = id / nig, fm = gid * 8, gsz = (NM - fm) < 8 ? (NM - fm) : 8;
        u.pm = fm + ((id % nig) % gsz); u.pn = (id % nig) / gsz; return true;
    }
    __device__ __forceinline__ const char* a_base(const Unit& u) const { return A + (size_t)u.pm * 256 * lda2 + (size_t)u.ks * ksub2; }
    __device__ __forceinline__ const char* b_base(const Unit& u) const { return B + (size_t)u.pn * 256 * ldb2 + (size_t)u.ks * ksub2; }
    __device__ __forceinline__ unsigned a_off(const Unit&, int r) const { return (unsigned)(r * lda2); }
};

template <int PN, bool DOWN>
struct MoeSched {
    struct Unit { int kind, e, rb, blk, valid, pm, pn; };
    const LAS int* prefix; const LAS int* cnt; const unsigned* bucket;
    const char* Ar; const char* As; const char* Br; const char* Bs;
    int nRouted, total, G, c, i0, i1;
    __device__ __forceinline__ bool next(int i, Unit& u) const {
        if (i + i0 >= i1) return false;
        const int id = (i + i0) * G + c; if (id >= total) return false;
        u.e = 0; u.rb = 0; u.blk = 0; u.pm = 0;
        if (id < nRouted) {
            const int blk = id / PN; u.pn = id % PN;
            const int lo = ((const LAS unsigned char*)(cnt + 256))[blk];
            u.kind = 0; u.e = lo; u.rb = blk - prefix[lo]; u.blk = blk; const int rem = cnt[lo] - u.rb * 256; u.valid = rem < 256 ? rem : 256;
        } else { const int s = id - nRouted; u.kind = 1; u.pm = s / PN; u.pn = s % PN; u.valid = 256; }
        return true;
    }
    __device__ __forceinline__ const char* a_base(const Unit& u) const { return u.kind == 0 ? Ar : As; }
    __device__ __forceinline__ const char* b_base(const Unit& u) const {
        if (!DOWN) return u.kind == 0 ? Br + ((size_t)u.e * 512 + (size_t)u.pn * 256) * D : Bs + (size_t)u.pn * 256 * D;
        else       return u.kind == 0 ? Br + ((size_t)u.e * 1024 + (size_t)u.pn * 256) * FF : Bs + (size_t)u.pn * 256 * FF;
    }
    __device__ __forceinline__ unsigned a_off(const Unit& u, int r) const {
        if (!DOWN) {
            if (u.kind == 0) { const int rr = r < u.valid ? r : u.valid - 1; const unsigned slot = bucket[(size_t)u.e * CAP + u.rb * 256 + rr]; return (slot >> 3) * (unsigned)D; }
            return (unsigned)(u.pm * 256 + r) * (unsigned)D;
        } else {
            return (unsigned)((u.kind == 0 ? u.blk : u.pm) * 256 + r) * (unsigned)FF;
        }
    }
};

struct EpiProj {
    static constexpr int PID = 2, PERM = 2, EARLY = 0;
    static constexpr bool TWICE = false, FP8 = false, I8 = true;
    bf16* O; const float* rowsc; const float* colq;
    __device__ __forceinline__ void operator()(const f32x4 (&acc)[2][2][4][2], const DenseUnit& u, int wr, int wc, int fr, int fq) const {
        const int row0 = u.pm * 256 + wr * 64 + fr, col0 = u.pn * 256 + wc * 64 + 16 * fq;
        f32x4 cs[2][2];
#pragma unroll
        for (int bj = 0; bj < 2; ++bj)
#pragma unroll
            for (int n = 0; n < 2; ++n) { const f32x4 q = *(const f32x4*)(colq + col0 + 8 * bj + 4 * n);
                cs[bj][n] = (f32x4){__builtin_amdgcn_rcpf(q.x), __builtin_amdgcn_rcpf(q.y), __builtin_amdgcn_rcpf(q.z), __builtin_amdgcn_rcpf(q.w)}; }
#pragma unroll
        for (int ai = 0; ai < 2; ++ai)
#pragma unroll
            for (int m = 0; m < 4; ++m) { const int row = row0 + ai * 128 + m * 16; bf16* rowp = O + (size_t)row * NPROJ + col0; const float rs = rowsc[row];
#pragma unroll
                for (int bj = 0; bj < 2; ++bj) { const i32x4 a0 = __builtin_bit_cast(i32x4, acc[ai][bj][m][0]), a1 = __builtin_bit_cast(i32x4, acc[ai][bj][m][1]);
                    const f32x4 v0 = (f32x4){(float)a0[0], (float)a0[1], (float)a0[2], (float)a0[3]} * cs[bj][0] * rs, v1 = (f32x4){(float)a1[0], (float)a1[1], (float)a1[2], (float)a1[3]} * cs[bj][1] * rs;
                    *(v4u*)(rowp + bj * 8) = (v4u){pk2(v0[0], v0[1]), pk2(v0[2], v0[3]), pk2(v1[0], v1[1]), pk2(v1[2], v1[3])}; } }
    }
};
struct EpiOut {
    static constexpr int PID = 5, PERM = 2, EARLY = 0;
    static constexpr bool TWICE = false, FP8 = false, I8 = false;
    bf16* O;
    __device__ __forceinline__ void operator()(const f32x4 (&acc)[2][2][4][2], const DenseUnit& u, int wr, int wc, int fr, int fq) const {
        const int row0 = u.pm * 256 + wr * 64 + fr, col0 = u.pn * 256 + wc * 64 + 16 * fq;
#pragma unroll
        for (int ai = 0; ai < 2; ++ai)
#pragma unroll
            for (int m = 0; m < 4; ++m) { bf16* rowp = O + (size_t)(row0 + ai * 128 + m * 16) * (2 * D) + col0;
#pragma unroll
                for (int bj = 0; bj < 2; ++bj) { const f32x4 v0 = acc[ai][bj][m][0], v1 = acc[ai][bj][m][1];
                    *(v4u*)(rowp + bj * 8) = (v4u){pk2(v0[0], v0[1]), pk2(v0[2], v0[3]), pk2(v1[0], v1[1]), pk2(v1[2], v1[3])}; } }
    }
};
struct EpiRouter {
    static constexpr int PID = 7, PERM = 0, EARLY = 0;
    static constexpr bool TWICE = false, FP8 = false, I8 = false;
    float* L;
    __device__ __forceinline__ void operator()(const f32x4 (&acc)[2][2][4][2], const DenseUnit& u, int wr, int wc, int fr, int fq) const {
        const int row0 = u.pm * 256 + wr * 64 + fr, col0 = wc * 32 + 4 * fq;
        float* Lp = L + (size_t)u.ks * NT * NE;
#pragma unroll
        for (int ai = 0; ai < 2; ++ai)
#pragma unroll
            for (int m = 0; m < 4; ++m) { const size_t ro = (size_t)(row0 + ai * 128 + m * 16) * NE + col0;
#pragma unroll
                for (int bj = 0; bj < 2; ++bj)
#pragma unroll
                    for (int n = 0; n < 2; ++n) *(f32x4*)(Lp + ro + bj * 128 + n * 16) = acc[ai][bj][m][n]; }
    }
};
struct EpiGU {
    static constexpr int PID = 9, PERM = 1, EARLY = 0;
    static constexpr bool TWICE = false, FP8 = true, I8 = false;
    unsigned char* act; unsigned char* acts; const unsigned* bucket; unsigned* pos;
    __device__ __forceinline__ void operator()(const f32x4 (&acc)[2][2][4][2], const MoeSched<2, false>::Unit& u, int wr, int wc, int fr, int fq) const {
        unsigned char* O = u.kind == 0 ? act : acts;
        const int row0 = (u.kind == 0 ? u.blk : u.pm) * 256 + wr * 64 + fr, col0 = u.pn * 128 + wc * 32 + 8 * fq;
        if (u.kind == 0 && u.pn == 0 && wc == 0 && fq == 0) {
#pragma unroll
            for (int ai = 0; ai < 2; ++ai)
#pragma unroll
                for (int m = 0; m < 4; ++m) { const int r = ai * 128 + wr * 64 + m * 16 + fr;
                    if (r < u.valid) pos[bucket[(size_t)u.e * CAP + u.rb * 256 + r]] = (unsigned)(u.blk * 256 + r); } }
#pragma unroll
        for (int ai = 0; ai < 2; ++ai)
#pragma unroll
            for (int m = 0; m < 4; ++m) {
                const f32x4 g0 = acc[ai][0][m][0], g1 = acc[ai][0][m][1], u0 = acc[ai][1][m][0], u1 = acc[ai][1][m][1];
                float a[8];
#pragma unroll
                for (int j = 0; j < 4; j += 2) {
                    const f32x2 ga = (f32x2){g0[j], g0[j + 1]} * W_INV_SCALE, gb = (f32x2){g1[j], g1[j + 1]} * W_INV_SCALE;
                    const f32x2 ua = (f32x2){u0[j], u0[j + 1]} * (W_INV_SCALE * ACT_SCALE), ub = (f32x2){u1[j], u1[j + 1]} * (W_INV_SCALE * ACT_SCALE);
                    const f32x2 ea = ga * (-1.44269504f), eb = gb * (-1.44269504f);
                    f32x2 da, db; da.x = __builtin_amdgcn_exp2f(ea.x); da.y = __builtin_amdgcn_exp2f(ea.y); db.x = __builtin_amdgcn_exp2f(eb.x); db.y = __builtin_amdgcn_exp2f(eb.y);
                    da = da + 1.0f; db = db + 1.0f;
                    f32x2 ra, rb; ra.x = __builtin_amdgcn_rcpf(da.x); ra.y = __builtin_amdgcn_rcpf(da.y); rb.x = __builtin_amdgcn_rcpf(db.x); rb.y = __builtin_amdgcn_rcpf(db.y);
                    const f32x2 oa = (ga * ua) * ra, ob = (gb * ub) * rb;
                    a[j] = oa.x; a[j + 1] = oa.y; a[4 + j] = ob.x; a[4 + j + 1] = ob.y; }
                *(v2u*)(O + (size_t)(row0 + ai * 128 + m * 16) * FF + col0) = (v2u){pk4_fp8(a[0], a[1], a[2], a[3]), pk4_fp8(a[4], a[5], a[6], a[7])};
                __builtin_amdgcn_sched_barrier(0);
            }
    }
};
constexpr float Y_SCALE = ACT_SCALE * WD_SCALE, Y_INV_SCALE = 1.f / Y_SCALE;
struct EpiDown {
    static constexpr int PID = 10, PERM = 2, EARLY = 4;
    static constexpr bool TWICE = false, FP8 = true, I8 = false;
    unsigned char* Y; bf16* O;
    template <int AI>
    __device__ __forceinline__ void half(const f32x4 (&acc)[2][2][4][2], const MoeSched<4, true>::Unit& u, int wr, int wc, int fr, int fq) const {
        const int col0 = u.pn * 256 + wc * 64 + 16 * fq;
        unsigned char* base = u.kind == 0 ? Y + (size_t)(u.blk * 256) * D : (unsigned char*)O + (size_t)(u.pm * 256) * (4 * D) + 2 * D;
        const size_t pitch = u.kind == 0 ? (size_t)D : (size_t)(4 * D);
#pragma unroll
        for (int m = 0; m < 4; ++m) { unsigned char* rowp = base + (size_t)(AI * 128 + wr * 64 + m * 16 + fr) * pitch + col0;
            unsigned w[4];
#pragma unroll
            for (int bj = 0; bj < 2; ++bj)
#pragma unroll
                for (int n = 0; n < 2; ++n) { f32x4 v = acc[AI][bj][m][n];
#pragma unroll
                    for (int j = 0; j < 4; ++j) v[j] = __builtin_amdgcn_fmed3f(v[j], -448.f, 448.f);
                    w[bj * 2 + n] = pk4_fp8(v[0], v[1], v[2], v[3]); }
            *(v4u*)rowp = (v4u){w[0], w[1], w[2], w[3]}; }
    }
    __device__ __forceinline__ void operator()(const f32x4 (&acc)[2][2][4][2], const MoeSched<4, true>::Unit& u, int wr, int wc, int fr, int fq) const { half<1>(acc, u, wr, wc, fr, fq); }
};

struct Args { const float* in[19]; float* out; unsigned char* ws; int ph_lo, ph_hi; };

struct Frame {
    LAS unsigned char* lds; int tid, lane, wave, G, bid;
    float* out; unsigned char* ws;
};

__device__ __forceinline__ void titem_load(const float* W, int N, int kb, int nb, int lane, float (&v)[32]) {
    const float* Wu = W + (size_t)(64 * kb) * N + 32 * nb;
    const unsigned loff = (unsigned)((lane >> 5) * N + (lane & 31)) * 4u;
#pragma unroll
    for (int i = 0; i < 32; ++i) v[i] = *(const float*)((const char*)(Wu + (size_t)(2 * i) * N) + loff);
}
template <int FP8>
__device__ __forceinline__ void titem_store(const float (&v)[32], int K, void* WTv, int kb, int dst_row0, LAS float* scr, int lane, float wsc = W_SCALE, const float* colq = nullptr) {
    const int k0 = 64 * kb;
#pragma unroll
    for (int i = 0; i < 32; ++i) { const int kk = 2 * i + (lane >> 5); scr[kk * 33 + (lane & 31)] = v[i]; }
    asm volatile("s_waitcnt lgkmcnt(0)" ::: "memory");
    const int c = lane & 7;
#pragma unroll
    for (int j = 0; j < 4; ++j) { const int n = (lane >> 3) + 8 * j; const LAS float* s = scr + (8 * c) * 33 + n;
        if (FP8 == 2) { const float qs = colq[dst_row0 + n]; v2u o; o.x = pk4_i8(s[0 * 33] * qs, s[1 * 33] * qs, s[2 * 33] * qs, s[3 * 33] * qs);
            o.y = pk4_i8(s[4 * 33] * qs, s[5 * 33] * qs, s[6 * 33] * qs, s[7 * 33] * qs);
            *(v2u*)((unsigned char*)WTv + (size_t)(dst_row0 + n) * K + k0 + 8 * c) = o; }
        else if (FP8 == 1) { v2u o; o.x = pk4_fp8(s[0 * 33] * wsc, s[1 * 33] * wsc, s[2 * 33] * wsc, s[3 * 33] * wsc);
            o.y = pk4_fp8(s[4 * 33] * wsc, s[5 * 33] * wsc, s[6 * 33] * wsc, s[7 * 33] * wsc);
            *(v2u*)((unsigned char*)WTv + (size_t)(dst_row0 + n) * K + k0 + 8 * c) = o; }
        else { v4u o; o.x = pk2(s[0 * 33], s[1 * 33]); o.y = pk2(s[2 * 33], s[3 * 33]); o.z = pk2(s[4 * 33], s[5 * 33]); o.w = pk2(s[6 * 33], s[7 * 33]);
            *(v4u*)((bf16*)WTv + (size_t)(dst_row0 + n) * K + k0 + 8 * c) = o; } }
    asm volatile("s_waitcnt lgkmcnt(0)" ::: "memory");
}
template <int FP8>
__device__ __forceinline__ void transpose_item(const float* W, int K, int N, void* WT, int kb, int nb, int dst_row0, LAS float* scr, int lane, float wsc = W_SCALE, const float* colq = nullptr) {
    float v[32]; titem_load(W, N, kb, nb, lane, v); titem_store<FP8>(v, K, WT, kb, dst_row0, scr, lane, wsc, colq);
}
template <bool DOWN>
__device__ __forceinline__ void convert_expert(Frame& F, const float* Wa, const float* Wb, unsigned char* dst, int base = 0, int PER_WAVE = (DOWN ? 16 : 32)) {
    LAS float* scr = (LAS float*)(F.lds + F.wave * 16384);
    const int wv = F.wave;
    auto ld = [&](int i, float (&v)[32]) {
        if (!DOWN) titem_load((i >> 4) ? Wb : Wa, FF, i & 15, wv, F.lane, v);
        else titem_load(Wa, D, i >> 2, wv + 8 * (i & 3), F.lane, v); };
    auto st = [&](int i, const float (&v)[32]) {
        if (!DOWN) { const int n0 = wv * 32; titem_store<true>(v, D, dst, i & 15, (n0 >> 7) * 256 + ((i >> 4) ? 128 : 0) + (n0 & 127), scr, F.lane); }
        else titem_store<true>(v, FF, dst, i >> 2, (wv + 8 * (i & 3)) * 32, scr, F.lane, WD_SCALE); };
    float v0[32], v1[32], v2[32], v3[32];
    ld(base, v0); ld(base + 1, v1); ld(base + 2, v2);
    for (int i = 0; i < PER_WAVE; i += 4) {
        ld(base + i + 3, v3); st(base + i, v0);
        if (i + 4 < PER_WAVE) ld(base + i + 4, v0);
        st(base + i + 1, v1);
        if (i + 5 < PER_WAVE) ld(base + i + 5, v1);
        st(base + i + 2, v2);
        if (i + 6 < PER_WAVE) ld(base + i + 6, v2);
        st(base + i + 3, v3);
    }
}

__device__ __forceinline__ void chunk_load(Frame& F, unsigned ch, int wv, float (&v)[32]) {
    if (ch < QG_CHUNKS) { const int e = (int)(ch >> 4), i = (int)(ch & 15); titem_load(ld_ptr(F.lds, 12) + (size_t)e * D * FF, FF, i, wv, F.lane, v); }
    else { const unsigned c2 = ch - QG_CHUNKS; const int e = (int)(c2 >> 4), i = (int)(c2 & 15); titem_load(ld_ptr(F.lds, 14) + (size_t)e * FF * D, D, i >> 2, wv + 8 * (i & 3), F.lane, v); }
}
__device__ __forceinline__ void chunk_store(Frame& F, unsigned ch, int wv, const float (&v)[32], LAS float* scr) {
    if (ch < QG_CHUNKS) { const int e = (int)(ch >> 4), i = (int)(ch & 15), n0 = wv * 32;
        titem_store<true>(v, D, F.ws + WS_WGU_T + (size_t)e * 512 * D, i, (n0 >> 7) * 256 + (n0 & 127), scr, F.lane, W_SCALE); }
    else { const unsigned c2 = ch - QG_CHUNKS; const int e = (int)(c2 >> 4), i = (int)(c2 & 15);
        titem_store<true>(v, FF, F.ws + WS_WD_T + (size_t)e * D * FF, i >> 2, (wv + 8 * (i & 3)) * 32, scr, F.lane, WD_SCALE); }
}
__device__ __forceinline__ void convert_chunk(Frame& F, unsigned ch) {
    const int wv = __builtin_amdgcn_readfirstlane(F.wave);
    LAS float* scr = (LAS float*)(F.lds + wv * 16384);
    float va[32], vb[32];
    chunk_load(F, ch, wv, va); chunk_load(F, ch + 1, wv, vb);
    chunk_store(F, ch, wv, va, scr); chunk_store(F, ch + 1, wv, vb, scr);
}
__device__ __forceinline__ void xcd_barrier_work(const XcdBarrier& b, Frame& F, unsigned chunk_end) {
    asm volatile("s_waitcnt vmcnt(0)" ::: "memory");
    __syncthreads();
    volatile LAS unsigned* st = b.st;
    unsigned* bar = b.bar; unsigned* qd = (unsigned*)(F.ws + WS_CTL) + CW_QD;
    if (threadIdx.x == 0) {
        __builtin_amdgcn_s_waitcnt(0);
        unsigned nloc = st[0], nx = st[1];
        if (nloc == 0u) { xcd_barrier_complete(bar, b.x, nloc, nx); st[0] = nloc; st[1] = nx; }
        const unsigned old = xb_add(&bar[XB_XSUB(b.x)], 1u);
        const unsigned gen = old / nloc;
        if (old + 1u == (gen + 1u) * nloc) {
            __builtin_amdgcn_fence(__ATOMIC_RELEASE, "agent");
            asm volatile("s_waitcnt vmcnt(0)" ::: "memory");
            const unsigned og = xb_add(&bar[XB_TOP], 1u);
            const unsigned tg = og / nx;
            if (og + 1u == (tg + 1u) * nx) xb_add(&bar[XB_TOPGEN], 1u);
            else XB_SPIN(xb_ld(&bar[XB_TOPGEN]) == tg, bar);
            __builtin_amdgcn_fence(__ATOMIC_ACQUIRE, "agent");
            xb_add(&bar[XB_XGEN(b.x)], 1u);
            asm volatile("s_waitcnt vmcnt(0)" ::: "memory");
            st[3] = 1u; st[6] = 1u;
        } else { st[2] = gen; st[3] = 0u; st[6] = 0u; }
    }
    __syncthreads();
    unsigned spins = 0;
    while (st[3] == 0u) {
        if (threadIdx.x == 0) {
            if (xb_ld(&bar[XB_XGEN(b.x)]) != st[2]) st[3] = 1u;
            else { if (st[5] < chunk_end) st[5] = xb_add(qd, 2u);
                if ((++spins & 1023u) == 0u) { if (xb_ld(&bar[XB_TMO])) st[3] = 1u; else if (spins > XB_SPIN_CAP) { atomicAdd(&bar[XB_TMO], 1u); st[3] = 1u; } } }
        }
        __syncthreads();
        if (st[3] != 0u) break;
        const unsigned ch = st[5];
        if (ch < QD_CHUNKS) convert_chunk(F, ch); else __builtin_amdgcn_s_sleep(8);
        __syncthreads();
    }
    if (threadIdx.x == 0 && st[6] == 0u) { __builtin_amdgcn_fence(__ATOMIC_ACQUIRE, "agent"); asm volatile("s_waitcnt vmcnt(0)" ::: "memory"); }
    __syncthreads();
}
__device__ __forceinline__ void drain_queue(Frame& F, unsigned limit) {
    volatile LAS unsigned* MISC = (volatile LAS unsigned*)(F.lds + MISC_OFF); unsigned* qd = (unsigned*)(F.ws + WS_CTL) + CW_QD;
    for (;;) {
        __syncthreads();
        if (threadIdx.x == 0) { const bool more = MISC[13] < limit; MISC[15] = more ? 1u : 0u; if (more) MISC[13] = xb_add(qd, 2u); }
        __syncthreads();
        if (MISC[15] == 0u) break;
        const unsigned ch = MISC[13];
        if (ch < QD_CHUNKS) convert_chunk(F, ch);
        if (ch >= limit) break;
    }
    __syncthreads();
}

__device__ __forceinline__ void p0_prologue(Frame& F) {
#define INP(i) ld_ptr(F.lds, (i))
    for (int job = F.bid; job < 256; job += F.G) {
      __syncthreads();
      if (job < 192) {
        const float* cptr = INP(1); const float* w_ada = INP(2); const float* b_ada = INP(3);
        LAS float* cs = (LAS float*)F.lds;
        LAS float* red = (LAS float*)(F.lds + 32768);
        for (int i = F.tid; i < NB * D; i += NTHREADS) { const float v = cptr[i]; cs[i] = v / (1.f + __expf(-v)); }
        __syncthreads();
        const int col = F.tid & 31, kg = F.tid >> 5, j = job * 32 + col;
        float a[NB], w[64];
#pragma unroll
        for (int b = 0; b < NB; ++b) a[b] = 0.f;
#pragma unroll
        for (int kk = 0; kk < 64; ++kk) w[kk] = w_ada[(size_t)(kg * 64 + kk) * 6144 + j];
#pragma unroll
        for (int kk = 0; kk < 64; ++kk) {
#pragma unroll
            for (int b = 0; b < NB; ++b) a[b] += cs[b * D + kg * 64 + kk] * w[kk]; }
#pragma unroll
        for (int b = 0; b < NB; ++b) red[(kg * NB + b) * 32 + col] = a[b];
        __syncthreads();
        if (F.tid < 256) { const int b = F.tid >> 5, cc = F.tid & 31; float s = 0.f;
#pragma unroll
            for (int g = 0; g < 16; ++g) s += red[(g * NB + b) * 32 + cc];
            ((float*)(F.ws + WS_MOD))[b * 6144 + job * 32 + cc] = s + b_ada[job * 32 + cc]; }
      } else {
        const float* wi = INP(5); float* colq = (float*)(F.ws + WS_COLSC); LAS float* red = (LAS float*)F.lds;
        const int cb = (job - 192) * 40, col = F.tid % 40, part = F.tid / 40;
        float am = 0.f;
        if (part < 12) for (int k = part; k < D; k += 12) am = fmaxf(am, fabsf(wi[(size_t)k * NPROJ + cb + col]));
        if (part < 12) red[part * 40 + col] = am;
        __syncthreads();
        if (F.tid < 40) { float m = 0.f; for (int q = 0; q < 12; ++q) m = fmaxf(m, red[q * 40 + F.tid]); colq[cb + F.tid] = 127.f / fmaxf(m, 1e-20f); }
      }
    }
    __syncthreads();
    if (F.bid == F.G - 1) { const float* pw = INP(6); bf16* pwt = (bf16*)(F.ws + WS_PWT);
        for (int i = F.tid; i < 4 * 64 * 64; i += NTHREADS) { const int g = i >> 12, d = (i >> 6) & 63, c = i & 63; pwt[i] = (bf16)f2bf(pw[(g * 64 + c) * 64 + d]); } }
    LAS float* scr = (LAS float*)(F.lds + F.wave * 16384);
    const int gw = F.bid * NWAVES + F.wave, NGW = F.G * NWAVES;
    constexpr int I_IN = 16 * 80, I_OUT = 8 * 32, I_R = 16 * 8, I_G = 16 * 8, I_D = 4 * 32;
    constexpr int I_SMALL = I_IN + I_OUT + I_R + 2 * I_G + I_D, I_EXP = 2 * I_G + I_D;
    constexpr int NITEMS = I_SMALL;
    unsigned char* win_t = F.ws + WS_WIN_T; bf16* wout_t = (bf16*)(F.ws + WS_WOUT_T); bf16* wr_t = (bf16*)(F.ws + WS_WR_T);
    unsigned char* wsgu_t = F.ws + WS_WSGU_T; unsigned char* wsd_t = F.ws + WS_WSD_T; unsigned char* wgu_t = F.ws + WS_WGU_T; unsigned char* wd_t = F.ws + WS_WD_T;
    for (int it = gw; it < NITEMS; it += NGW) {
        int r = it;
        if (r < I_IN) continue; r -= I_IN;
        if (r < I_OUT) { transpose_item<false>(INP(8), NMIX, D, wout_t, r / 32, r % 32, (r % 32) * 32, scr, F.lane); continue; } r -= I_OUT;
        if (r < I_R) { transpose_item<false>(INP(10), D, NE, wr_t, r / 8, r % 8, (r % 8) * 32, scr, F.lane); continue; } r -= I_R;
        const float *Wg, *Wu, *Wd; unsigned char *GU, *DN;
        if (r < 2 * I_G + I_D) { Wg = INP(15); Wu = INP(16); Wd = INP(17); GU = wsgu_t; DN = wsd_t; }
        else { r -= 2 * I_G + I_D; const int e = r / I_EXP; r -= e * I_EXP;
            Wg = INP(12) + (size_t)e * D * FF; Wu = INP(13) + (size_t)e * D * FF; Wd = INP(14) + (size_t)e * FF * D;
            GU = wgu_t + (size_t)e * 512 * D; DN = wd_t + (size_t)e * D * FF; }
        if (r < I_G) { const int nb = r % 8, n0 = nb * 32; transpose_item<true>(Wg, D, FF, GU, r / 8, nb, (n0 >> 7) * 256 + (n0 & 127), scr, F.lane); continue; } r -= I_G;
        if (r < I_G) { const int nb = r % 8, n0 = nb * 32; transpose_item<true>(Wu, D, FF, GU, r / 8, nb, (n0 >> 7) * 256 + 128 + (n0 & 127), scr, F.lane); continue; } r -= I_G;
        transpose_item<true>(Wd, FF, D, DN, r / 32, r % 32, (r % 32) * 32, scr, F.lane, WD_SCALE);
    }
#undef INP
}

__device__ __forceinline__ void win_int8_phase(Frame& F, const float* w_in) {
    __syncthreads();
    LAS float* scr = (LAS float*)(F.lds + F.wave * 16384);
    const float* colq = (const float*)(F.ws + WS_COLSC);
    for (int r = F.bid * NWAVES + F.wave; r < 16 * 80; r += F.G * NWAVES)
        transpose_item<2>(w_in, D, NPROJ, F.ws + WS_WIN_T, r / 80, r % 80, (r % 80) * 32, scr, F.lane, 1.f, colq);
}
template <bool HAS_DX, int OUT8, bool OUTB>
__device__ __forceinline__ void modnorm_phase(Frame& F, const float* X, const float* g, int shift_chunk, unsigned char* O8, bf16* Ob) {
    const float* mod = (const float*)(F.ws + WS_MOD);
    constexpr int RW = 4;
    const unsigned l16 = (unsigned)F.lane * 16u, l8 = (unsigned)F.lane * 8u, l4 = (unsigned)F.lane * 4u;
    const int wv = __builtin_amdgcn_readfirstlane(F.wave);
    for (int blk = F.bid; blk < NT / 128; blk += F.G) {
        const int b = (blk * 128) >> 12;
        const float* sh = mod + (size_t)b * 6144 + shift_chunk * D; const float* sc = sh + D; const float* g1 = mod + (size_t)b * 6144 + 2 * D;
        f32x4 gg[4], ss[4], ga[4];
#pragma unroll
        for (int j = 0; j < 4; ++j) { const f32x4 gv = *(const f32x4*)((const char*)g + 1024 * j + l16), scv = *(const f32x4*)((const char*)sc + 1024 * j + l16);
            gg[j] = gv * (scv + 1.f); ss[j] = *(const f32x4*)((const char*)sh + 1024 * j + l16); ga[j] = HAS_DX ? *(const f32x4*)((const char*)g1 + 1024 * j + l16) : (f32x4){0.f, 0.f, 0.f, 0.f}; }
#pragma nounroll
        for (int rr = 0; rr < 16; rr += RW) {
            const int row = blk * 128 + wv * 16 + rr;
            f32x4 v[RW][4]; v2u dv[RW][4];
#pragma unroll
            for (int q = 0; q < RW; ++q) { const char* xr = (const char*)(X + (size_t)(row + q) * D);
#pragma unroll
                for (int j = 0; j < 4; ++j) v[q][j] = *(const f32x4*)(xr + 1024 * j + l16);
                if (HAS_DX) { const char* dr = (const char*)F.out + (size_t)(row + q) * (4 * D);
#pragma unroll
                    for (int j = 0; j < 4; ++j) dv[q][j] = *(const v2u*)(dr + 512 * j + l8); } }
#pragma unroll
            for (int q = 0; q < RW; ++q) { float s = 0.f;
#pragma unroll
                for (int j = 0; j < 4; ++j) {
                    if (HAS_DX) v[q][j] = v[q][j] + ga[j] * (f32x4){bflo(dv[q][j].x), bfhi(dv[q][j].x), bflo(dv[q][j].y), bfhi(dv[q][j].y)};
                    s += (v[q][j].x * v[q][j].x + v[q][j].y * v[q][j].y) + (v[q][j].z * v[q][j].z + v[q][j].w * v[q][j].w); }
                const float rstd = 1.f / sqrtf(wave_sum(s) * (1.f / D) + NORM_EPS);
                if (HAS_DX) { char* xo = (char*)F.out + (size_t)(row + q) * (4 * D);
#pragma unroll
                    for (int j = 0; j < 4; ++j) *(v2u*)(xo + 512 * j + l8) = (v2u){pk2(v[q][j].x, v[q][j].y), pk2(v[q][j].z, v[q][j].w)}; }
                char* o8 = (char*)O8 + (size_t)(row + q) * D; char* ob = (char*)Ob + (size_t)(row + q) * (2 * D);
                if (OUT8 == 2) {
                    f32x4 y[4]; float am = 0.f;
#pragma unroll
                    for (int j = 0; j < 4; ++j) { y[j] = v[q][j] * rstd * gg[j] + ss[j]; am = fmaxf(am, fmaxf(fmaxf(fabsf(y[j].x), fabsf(y[j].y)), fmaxf(fabsf(y[j].z), fabsf(y[j].w)))); }
                    am = fmaxf(wave_max(am), 1e-20f); const float qs = 127.f / am;
#pragma unroll
                    for (int j = 0; j < 4; ++j) *(unsigned*)(o8 + 256 * j + l4) = pk4_i8(y[j].x * qs, y[j].y * qs, y[j].z * qs, y[j].w * qs);
                    if (F.lane == 0) ((float*)(F.ws + WS_ROWSC))[row + q] = am * (1.f / 127.f);
                } else {
#pragma unroll
                for (int j = 0; j < 4; ++j) { const f32x4 y = v[q][j] * rstd * gg[j] + ss[j]; if (OUT8 == 1) *(unsigned*)(o8 + 256 * j + l4) = pk4_fp8(y.x, y.y, y.z, y.w);
                    if (OUTB) *(v2u*)(ob + 512 * j + l8) = (v2u){pk2(y.x, y.y), pk2(y.z, y.w)}; } }
                __builtin_amdgcn_sched_barrier(0); }
        }
    }
}

constexpr int POOL_T = 64, POOL_PITCH = 528;
__device__ __forceinline__ void pool_phase(Frame& F, const float* pool_scale) {
    const bf16* proj = (const bf16*)(F.ws + WS_PROJ); bf16* mixin = (bf16*)(F.ws + WS_MIXIN); const bf16* pwt = (const bf16*)(F.ws + WS_PWT);
    LAS unsigned char* us = F.lds;
    LAS unsigned char* pl = F.lds + 80 * POOL_PITCH;
    const int lane = F.lane, fr = lane & 15, fq = lane >> 4;
    for (int tile = F.bid; tile < NT / POOL_T; tile += F.G) {
        const int row0 = tile * POOL_T, tl0 = row0 & (SEQ - 1);
        __syncthreads();
        for (int p = F.tid; p < (POOL_T + 15) * 32; p += NTHREADS) { const int rr = p >> 5, pc = p & 31; const int tl = tl0 - 15 + rr;
            v4u raw = (v4u){0u, 0u, 0u, 0u};
            if (tl >= 0) raw = *(const v4u*)(proj + (size_t)(row0 - 15 + rr) * NPROJ + pc * 8);
            *(LAS v4u*)(us + rr * POOL_PITCH + pc * 16) = raw; }
        __syncthreads();
        {
            const int c8 = F.tid & 31, q = F.tid >> 5, w = 2 << (c8 >> 3);
            float sm[8];
#pragma unroll
            for (int e = 0; e < 8; ++e) sm[e] = 0.f;
            const int i0 = 15 + q * 4;
            for (int k = 0; k < w; ++k) { const v4u r = *(const LAS v4u*)(us + (i0 - k) * POOL_PITCH + c8 * 16);
                sm[0] += bflo(r.x); sm[1] += bfhi(r.x); sm[2] += bflo(r.y); sm[3] += bfhi(r.y); sm[4] += bflo(r.z); sm[5] += bfhi(r.z); sm[6] += bflo(r.w); sm[7] += bfhi(r.w); }
#pragma unroll
            for (int i = 0; i < 4; ++i) { const int tt = q * 4 + i, tl = tl0 + tt;
                const v4u cur = *(const LAS v4u*)(us + (15 + tt) * POOL_PITCH + c8 * 16);
                if (i > 0) { const v4u old = *(const LAS v4u*)(us + (15 + tt - w) * POOL_PITCH + c8 * 16);
                    sm[0] += bflo(cur.x) - bflo(old.x); sm[1] += bfhi(cur.x) - bfhi(old.x); sm[2] += bflo(cur.y) - bflo(old.y); sm[3] += bfhi(cur.y) - bfhi(old.y);
                    sm[4] += bflo(cur.z) - bflo(old.z); sm[5] += bfhi(cur.z) - bfhi(old.z); sm[6] += bflo(cur.w) - bflo(old.w); sm[7] += bfhi(cur.w) - bfhi(old.w); }
                const float ic = 1.f / (float)((tl + 1) < w ? (tl + 1) : w);
                v4u o; o.x = pk2(sm[0] * ic - bflo(cur.x), sm[1] * ic - bfhi(cur.x)); o.y = pk2(sm[2] * ic - bflo(cur.y), sm[3] * ic - bfhi(cur.y));
                o.z = pk2(sm[4] * ic - bflo(cur.z), sm[5] * ic - bfhi(cur.z)); o.w = pk2(sm[6] * ic - bflo(cur.w), sm[7] * ic - bfhi(cur.w));
                *(LAS v4u*)(pl + tt * POOL_PITCH + c8 * 16) = o; }
        }
        __syncthreads();
        {
            const int g = F.wave >> 1, mh = F.wave & 1;
            bf16x8 af[2][2], bfr[4][2];
#pragma unroll
            for (int mt = 0; mt < 2; ++mt)
#pragma unroll
                for (int k = 0; k < 2; ++k) af[mt][k] = *(const LAS bf16x8*)(pl + (32 * mh + 16 * mt + fr) * POOL_PITCH + (g * 64 + k * 32 + fq * 8) * 2);
#pragma unroll
            for (int nt = 0; nt < 4; ++nt)
#pragma unroll
                for (int k = 0; k < 2; ++k) bfr[nt][k] = *(const bf16x8*)(pwt + ((size_t)(g * 64 + nt * 16 + fr) * 64 + k * 32 + fq * 8));
#pragma unroll
            for (int mt = 0; mt < 2; ++mt)
#pragma unroll
                for (int nt = 0; nt < 4; ++nt) { f32x4 acc = (f32x4){0.f, 0.f, 0.f, 0.f};
                    acc = __builtin_amdgcn_mfma_f32_16x16x32_bf16(bfr[nt][0], af[mt][0], acc, 0, 0, 0);
                    acc = __builtin_amdgcn_mfma_f32_16x16x32_bf16(bfr[nt][1], af[mt][1], acc, 0, 0, 0);
                    const int col = g * 64 + nt * 16 + 4 * fq; const f32x4 sc = *(const f32x4*)(pool_scale + col);
                    const f32x4 o = acc * sc;
                    *(v2u*)(mixin + (size_t)(row0 + 32 * mh + 16 * mt + fr) * NMIX + col) = (v2u){pk2(o.x, o.y), pk2(o.z, o.w)}; }
        }
    }
}

constexpr int KV_PITCH = 144;
__device__ __forceinline__ void attn_phase(Frame& F) {
    const bf16* proj = (const bf16*)(F.ws + WS_PROJ);
    bf16* atto = (bf16*)(F.ws + WS_ATTO); float* lse = (float*)(F.ws + WS_LSE);
    LAS unsigned char* Ks = F.lds; LAS unsigned char* Vs = F.lds + 256 * KV_PITCH;
    const int lane = F.lane, fr = lane & 15, fq = lane >> 4, w = F.wave;
    const int w_i0 = 16 * w, c0 = w >> 1, qi = w_i0 + fr;
#define ATT_DECODE(unit_, rowb_, d_, r_, n_, g_, h_, colQ_) \
        const int rn_##unit_ = (unit_) & 31; const int h_ = ((unit_) >> 5) & 3, g_ = ((unit_) >> 7) % 3; const size_t rowb_ = (size_t)((unit_) / 384) * SEQ; \
        const int d_ = 1 << (2 * g_), nbk_##unit_ = 32 >> (2 * g_), r_ = rn_##unit_ / nbk_##unit_, n_ = rn_##unit_ % nbk_##unit_; const int colQ_ = 256 + g_ * 256 + h_ * 64;
    v4u kreg[4], vreg[4]; bf16x8 qn[2];
    {   const int unit0 = F.bid;
        if (unit0 < NB * 3 * 4 * 32) { ATT_DECODE(unit0, rowb, d, r, n, g, h, colQ)
            const size_t qrow = rowb + (size_t)(n * 128 + qi) * d + r;
#pragma unroll
            for (int ks = 0; ks < 2; ++ks) qn[ks] = *(const bf16x8*)(proj + qrow * NPROJ + colQ + ks * 32 + fq * 8);
#pragma unroll
            for (int cidx = 0; cidx < 4; ++cidx) { const int ch = F.tid + 512 * cidx, j = ch >> 3, pc = ch & 7;
                int p = (n - 1) * 128 + j; p = p < 0 ? 0 : p; const size_t row = rowb + (size_t)p * d + r;
                kreg[cidx] = *(const v4u*)(proj + row * NPROJ + colQ + 768 + pc * 8); vreg[cidx] = *(const v4u*)(proj + row * NPROJ + colQ + 1536 + pc * 8); } } }
    for (int unit = F.bid; unit < NB * 3 * 4 * 32; unit += F.G) {
        ATT_DECODE(unit, rowb, d, r, n, g, h, colQ)
        __syncthreads();
#pragma unroll
        for (int cidx = 0; cidx < 4; ++cidx) { const int ch = F.tid + 512 * cidx, j = ch >> 3, pc = ch & 7;
            *(LAS v4u*)(Ks + j * KV_PITCH + pc * 16) = kreg[cidx]; *(LAS v4u*)(Vs + j * KV_PITCH + pc * 16) = vreg[cidx]; }
        const size_t qrow = rowb + (size_t)(n * 128 + qi) * d + r;
        bf16x8 qf[2]; qf[0] = qn[0]; qf[1] = qn[1];
        __syncthreads();
        {   const int unit2 = unit + F.G;
            if (unit2 < NB * 3 * 4 * 32) { ATT_DECODE(unit2, rowb2, d2, r2, n2, g2, h2, colQ2)
                const size_t qrow2 = rowb2 + (size_t)(n2 * 128 + qi) * d2 + r2;
#pragma unroll
                for (int ks = 0; ks < 2; ++ks) qn[ks] = *(const bf16x8*)(proj + qrow2 * NPROJ + colQ2 + ks * 32 + fq * 8);
#pragma unroll
                for (int cidx = 0; cidx < 4; ++cidx) { const int ch = F.tid + 512 * cidx, j = ch >> 3, pc = ch & 7;
                    int p = (n2 - 1) * 128 + j; p = p < 0 ? 0 : p; const size_t row = rowb2 + (size_t)p * d2 + r2;
                    kreg[cidx] = *(const v4u*)(proj + row * NPROJ + colQ2 + 768 + pc * 8); vreg[cidx] = *(const v4u*)(proj + row * NPROJ + colQ2 + 1536 + pc * 8); } } }
        f32x4 s[5][2];
#pragma unroll
        for (int cc = 0; cc < 5; ++cc)
#pragma unroll
            for (int hh = 0; hh < 2; ++hh) {
                const int j = 32 * (c0 + cc) + 8 * (fr >> 2) + 4 * hh + (fr & 3);
                const bf16x8 k0 = *(const LAS bf16x8*)(Ks + j * KV_PITCH + fq * 16), k1 = *(const LAS bf16x8*)(Ks + j * KV_PITCH + 64 + fq * 16);
                f32x4 a = (f32x4){0.f, 0.f, 0.f, 0.f};
                a = __builtin_amdgcn_mfma_f32_16x16x32_bf16(k0, qf[0], a, 0, 0, 0);
                a = __builtin_amdgcn_mfma_f32_16x16x32_bf16(k1, qf[1], a, 0, 0, 0);
                s[cc][hh] = a;
            }
        float mx = -1e30f;
        int qil = qi; asm volatile("" : "+v"(qil));
#pragma unroll
        for (int cc = 0; cc < 5; ++cc)
#pragma unroll
            for (int hh = 0; hh < 2; ++hh)
#pragma unroll
                for (int rr = 0; rr < 4; ++rr) { const int j = 32 * (c0 + cc) + 8 * fq + 4 * hh + rr; const int dist = 128 + qil - j;
                    const bool valid = (dist >= 0) && (dist <= 128) && (n > 0 || j >= 128);
                    const float v = valid ? s[cc][hh][rr] * 0.18033688f : -1e30f; s[cc][hh][rr] = v; mx = fmaxf(mx, v); }
        mx = fmaxf(mx, __shfl_xor(mx, 16)); mx = fmaxf(mx, __shfl_xor(mx, 32));
        float l = 0.f;
#pragma unroll
        for (int cc = 0; cc < 5; ++cc)
#pragma unroll
            for (int hh = 0; hh < 2; ++hh)
#pragma unroll
                for (int rr = 0; rr < 4; ++rr) { const float p = __builtin_amdgcn_exp2f(s[cc][hh][rr] - mx); s[cc][hh][rr] = p; l += p; }
        l += __shfl_xor(l, 16); l += __shfl_xor(l, 32);
        f32x4 o[4];
#pragma unroll
        for (int eb = 0; eb < 4; ++eb) o[eb] = (f32x4){0.f, 0.f, 0.f, 0.f};
#pragma unroll
        for (int cc = 0; cc < 5; ++cc) {
            const v4u pu = (v4u){pk2(s[cc][0][0], s[cc][0][1]), pk2(s[cc][0][2], s[cc][0][3]), pk2(s[cc][1][0], s[cc][1][1]), pk2(s[cc][1][2], s[cc][1][3])};
            const bf16x8 pf = __builtin_bit_cast(bf16x8, pu);
            const int key0 = 32 * (c0 + cc) + 8 * fq + (fr >> 2);
#pragma unroll
            for (int eb = 0; eb < 4; ++eb) {
                const LAS unsigned char* vp = Vs + key0 * KV_PITCH + (16 * eb + 4 * (fr & 3)) * 2;
                const s16x4 lo = __builtin_bit_cast(s16x4, __builtin_amdgcn_ds_read_tr16_b64_v4i16((LAS s16x4*)vp));
                const s16x4 hi = __builtin_bit_cast(s16x4, __builtin_amdgcn_ds_read_tr16_b64_v4i16((LAS s16x4*)(vp + 4 * KV_PITCH)));
                const bf16x8 vf = (bf16x8){lo[0], lo[1], lo[2], lo[3], hi[0], hi[1], hi[2], hi[3]};
                o[eb] = __builtin_amdgcn_mfma_f32_16x16x32_bf16(vf, pf, o[eb], 0, 0, 0);
            }
        }
        const float il = 1.f / l;
        bf16* op = atto + ((size_t)g * NT + qrow) * 256 + h * 64 + 4 * fq;
#pragma unroll
        for (int eb = 0; eb < 4; ++eb) { const f32x4 v = o[eb] * il; *(v2u*)(op + 16 * eb) = (v2u){pk2(v.x, v.y), pk2(v.z, v.w)}; }
        if (fq == 0) lse[((size_t)g * NT + qrow) * 4 + h] = mx + __builtin_amdgcn_logf(l);
    }
#undef ATT_DECODE
}

__device__ __forceinline__ void combine_phase(Frame& F) {
    const bf16* atto = (const bf16*)(F.ws + WS_ATTO); const float* lse = (const float*)(F.ws + WS_LSE); bf16* mixin = (bf16*)(F.ws + WS_MIXIN);
    for (size_t idx = (size_t)F.bid * NTHREADS + F.tid; idx < (size_t)NT * 32; idx += (size_t)F.G * NTHREADS) {
        const size_t t = idx >> 5; const int pc = (int)(idx & 31), h = pc >> 3;
        const float l0 = lse[(0 * (size_t)NT + t) * 4 + h], l1 = lse[(1 * (size_t)NT + t) * 4 + h], l2 = lse[(2 * (size_t)NT + t) * 4 + h];
        const float m = fmaxf(l0, fmaxf(l1, l2));
        float a0 = __builtin_amdgcn_exp2f(l0 - m), a1 = __builtin_amdgcn_exp2f(l1 - m), a2 = __builtin_amdgcn_exp2f(l2 - m);
        const float inv = 1.f / (a0 + a1 + a2); a0 *= inv; a1 *= inv; a2 *= inv;
        const v4u v0 = *(const v4u*)(atto + (0 * (size_t)NT + t) * 256 + pc * 8), v1 = *(const v4u*)(atto + (1 * (size_t)NT + t) * 256 + pc * 8), v2 = *(const v4u*)(atto + (2 * (size_t)NT + t) * 256 + pc * 8);
        v4u o;
        o.x = pk2(a0 * bflo(v0.x) + a1 * bflo(v1.x) + a2 * bflo(v2.x), a0 * bfhi(v0.x) + a1 * bfhi(v1.x) + a2 * bfhi(v2.x));
        o.y = pk2(a0 * bflo(v0.y) + a1 * bflo(v1.y) + a2 * bflo(v2.y), a0 * bfhi(v0.y) + a1 * bfhi(v1.y) + a2 * bfhi(v2.y));
        o.z = pk2(a0 * bflo(v0.z) + a1 * bflo(v1.z) + a2 * bflo(v2.z), a0 * bfhi(v0.z) + a1 * bfhi(v1.z) + a2 * bfhi(v2.z));
        o.w = pk2(a0 * bflo(v0.w) + a1 * bflo(v1.w) + a2 * bflo(v2.w), a0 * bfhi(v0.w) + a1 * bfhi(v1.w) + a2 * bfhi(v2.w));
        *(v4u*)(mixin + t * NMIX + 256 + pc * 8) = o;
    }
}

#if MK_NAIVE_ATTN
__device__ __forceinline__ void naive_attn_phase(Frame& F) {
    const bf16* proj = (const bf16*)(F.ws + WS_PROJ); bf16* mixin = (bf16*)(F.ws + WS_MIXIN);
    for (size_t idx = (size_t)F.bid * NTHREADS + F.tid; idx < (size_t)NT * 4; idx += (size_t)F.G * NTHREADS) {
        const size_t tg = idx >> 2; const int h = (int)(idx & 3), t = (int)(tg & (SEQ - 1)); const size_t rowb = tg - t;
        float m = -1e30f, l = 0.f, o[64];
        for (int e = 0; e < 64; ++e) o[e] = 0.f;
        for (int g = 0; g < 3; ++g) { const int d = 1 << (2 * g); const int colQ = 256 + g * 256 + h * 64;
            const bf16* q = proj + tg * NPROJ + colQ;
            for (int j = 0; j <= 128; ++j) { const int tk = t - j * d; if (tk < 0) break;
                const bf16* k = proj + (rowb + tk) * NPROJ + colQ + 768; const bf16* v = k + 768;
                float sdot = 0.f; for (int e = 0; e < 64; ++e) sdot += bf2f(q[e]) * bf2f(k[e]);
                sdot *= 0.125f;
                const float mn = fmaxf(m, sdot), corr = __expf(m - mn), p = __expf(sdot - mn);
                l = l * corr + p; for (int e = 0; e < 64; ++e) o[e] = o[e] * corr + p * bf2f(v[e]); m = mn; } }
        const float il = 1.f / l;
        for (int e = 0; e < 64; ++e) mixin[tg * NMIX + 256 + h * 64 + e] = (bf16)f2bf(o[e] * il);
    }
}
#endif

__device__ __forceinline__ void routing_phase(Frame& F, const float* router_bias) {
    const float* L0 = (const float*)(F.ws + WS_LOGIT);
    float* gatew = (float*)(F.ws + WS_GATEW); unsigned* bucket = (unsigned*)(F.ws + WS_BUCKET); unsigned* gcnt = (unsigned*)(F.ws + WS_CTL) + CW_GCNT;
    LAS unsigned* hist = (LAS unsigned*)F.lds; LAS unsigned* basel = hist + 256; LAS unsigned* asg = hist + 512;
    const int lane = F.lane;
    for (int blk = F.bid; blk < NT / 128; blk += F.G) {
        __syncthreads();
        if (F.tid < 256) hist[F.tid] = 0u;
        __syncthreads();
        const f32x4 bias = *(const f32x4*)(router_bias + 4 * lane);
        f32x4 lgn; { const size_t t0 = (size_t)blk * 128 + F.wave * 16; lgn = *(const f32x4*)(L0 + t0 * NE + 4 * lane); }
#pragma nounroll
        for (int tl = 0; tl < 16; ++tl) {
            const int tloc = F.wave * 16 + tl; const size_t t = (size_t)blk * 128 + tloc;
            const f32x4 lg = lgn;
            if (tl + 1 < 16) lgn = *(const f32x4*)(L0 + (t + 1) * NE + 4 * lane);
            float sc[4], cd[4];
#pragma unroll
            for (int i = 0; i < 4; ++i) { sc[i] = 1.f / (1.f + __expf(-lg[i])); cd[i] = sc[i] + bias[i]; }
            float a1 = fmaxf(cd[0], cd[1]), a2 = fminf(cd[0], cd[1]);
#pragma unroll
            for (int i = 2; i < 4; ++i) { const float v = cd[i]; a2 = fmaxf(a2, fminf(a1, v)); a1 = fmaxf(a1, v); }
            { float b1 = dppf<0xB1>(a1), b2 = dppf<0xB1>(a2); float n1 = fmaxf(a1, b1), n2 = fmaxf(fminf(a1, b1), fmaxf(a2, b2)); a1 = n1; a2 = n2;
              b1 = dppf<0x4E>(a1); b2 = dppf<0x4E>(a2); n1 = fmaxf(a1, b1); n2 = fmaxf(fminf(a1, b1), fmaxf(a2, b2)); a1 = n1; a2 = n2;
              b1 = dppf<0x141>(a1); b2 = dppf<0x141>(a2); n1 = fmaxf(a1, b1); n2 = fmaxf(fminf(a1, b1), fmaxf(a2, b2)); a1 = n1; a2 = n2; }
            const float gs = a1 + a2; const int myg = lane >> 3; int rank = 0;
#pragma unroll
            for (int gg = 0; gg < 8; ++gg) { const float o = __builtin_bit_cast(float, __builtin_amdgcn_readlane(__builtin_bit_cast(int, gs), gg * 8)); rank += (o > gs || (o == gs && gg < myg)) ? 1 : 0; }
            if (rank >= 4) {
#pragma unroll
                for (int i = 0; i < 4; ++i) cd[i] = -1e30f; }
            int sel_e = 0; float sel_s = 0.f, ssum = 0.f;
#pragma unroll
            for (int k = 0; k < TOPK; ++k) {
                const float lm = fmaxf(fmaxf(cd[0], cd[1]), fmaxf(cd[2], cd[3]));
                float v = fmaxf(lm, dppf<0xB1>(lm)); v = fmaxf(v, dppf<0x4E>(v)); v = fmaxf(v, dppf<0x141>(v)); v = fmaxf(v, dppf<0x140>(v));
                const float r0 = __builtin_bit_cast(float, __builtin_amdgcn_readlane(__builtin_bit_cast(int, v), 0)), r1 = __builtin_bit_cast(float, __builtin_amdgcn_readlane(__builtin_bit_cast(int, v), 16));
                const float r2 = __builtin_bit_cast(float, __builtin_amdgcn_readlane(__builtin_bit_cast(int, v), 32)), r3 = __builtin_bit_cast(float, __builtin_amdgcn_readlane(__builtin_bit_cast(int, v), 48));
                const float mx = fmaxf(fmaxf(r0, r1), fmaxf(r2, r3));
                const unsigned long long msk = __ballot(lm == mx);
                const int own = __builtin_ffsll((long long)msk) - 1;
                const int bi = cd[0] == mx ? 0 : (cd[1] == mx ? 1 : (cd[2] == mx ? 2 : 3));
                float myv = sc[0]; myv = bi == 1 ? sc[1] : myv; myv = bi == 2 ? sc[2] : myv; myv = bi == 3 ? sc[3] : myv;
                const int wi = __builtin_amdgcn_readlane(bi, own);
                const float sv = __builtin_bit_cast(float, __builtin_amdgcn_readlane(__builtin_bit_cast(int, myv), own));
                if (lane == own) {
#pragma unroll
                    for (int i = 0; i < 4; ++i) if (wi == i) cd[i] = -1e30f; }
                ssum += sv;
                if (lane == k) { sel_e = 4 * own + wi; sel_s = sv; }
            }
            if (lane < TOPK) {
                const unsigned rk = __hip_atomic_fetch_add(hist + sel_e, 1u, __ATOMIC_RELAXED, __HIP_MEMORY_SCOPE_WORKGROUP);
                asg[tloc * 8 + lane] = (unsigned)sel_e | (rk << 16);
                gatew[t * 8 + lane] = sel_s / ssum * 2.5f;
            }
        }
        __syncthreads();
        if (F.tid < 256) { const unsigned c = hist[F.tid]; basel[F.tid] = c ? atomicAdd(&gcnt[F.tid * 16], c) : 0u; }
        __syncthreads();
        for (int a = F.tid; a < 1024; a += NTHREADS) { const unsigned v = asg[a], e = v & 0xffffu, rk = v >> 16;
            bucket[(size_t)e * CAP + basel[e] + rk] = (unsigned)(blk * 1024 + a); }
    }
}

__device__ __forceinline__ void build_tables(Frame& F, int& nblk_total) {
    const unsigned* gcnt = (const unsigned*)(F.ws + WS_CTL) + CW_GCNT;
    LAS int* prefix = (LAS int*)(F.lds + TAB_OFF); LAS int* cnt = prefix + 260;
    __syncthreads();
    if (F.tid < 256) cnt[F.tid] = (int)__hip_atomic_load(&gcnt[F.tid * 16], __ATOMIC_RELAXED, __HIP_MEMORY_SCOPE_AGENT);
    __syncthreads();
    if (F.tid < 64) {
        int nb[4], sm = 0;
#pragma unroll
        for (int i = 0; i < 4; ++i) { nb[i] = (cnt[4 * F.tid + i] + 255) >> 8; sm += nb[i]; }
        int inc = sm;
#pragma unroll
        for (int o = 1; o < 64; o <<= 1) { const int t = __shfl_up(inc, o); if (F.tid >= o) inc += t; }
        int ex = inc - sm;
#pragma unroll
        for (int i = 0; i < 4; ++i) { prefix[4 * F.tid + i] = ex; ex += nb[i]; }
        if (F.tid == 63) prefix[NE] = inc;
    }
    __syncthreads();
    if (F.tid < 256) { LAS unsigned char* b2e = (LAS unsigned char*)(cnt + 256); for (int b = prefix[F.tid]; b < prefix[F.tid + 1]; ++b) b2e[b] = (unsigned char)F.tid; }
    __syncthreads();
    nblk_total = prefix[NE];
}

__device__ __forceinline__ void final_phase(Frame& F, const float* g_final) {
    const float* mod = (const float*)(F.ws + WS_MOD); const unsigned char* Y = (const unsigned char*)(F.ws + WS_Y);
    const unsigned* pos = (const unsigned*)(F.ws + WS_POS); const float* gatew = (const float*)(F.ws + WS_GATEW);
    const int c0 = 16 * F.lane;
    for (int blk = F.bid; blk < NT / 128; blk += F.G) {
        const int b = (blk * 128) >> 12; const float* g2 = mod + (size_t)b * 6144 + 5 * D + c0;
        f32x4 gb[4];
#pragma unroll
        for (int j = 0; j < 4; ++j) gb[j] = *(const f32x4*)(g2 + 4 * j);
        const size_t rowbase = (size_t)blk * 128 + F.wave * 16;
        const unsigned p0 = pos[rowbase * 8 + F.lane], p1 = pos[rowbase * 8 + 64 + F.lane];
        const float w0 = gatew[rowbase * 8 + F.lane] * Y_INV_SCALE, w1 = gatew[rowbase * 8 + 64 + F.lane] * Y_INV_SCALE;
#pragma nounroll
        for (int rr = 0; rr < 16; ++rr) {
            const size_t row = rowbase + rr;
            const v4u* dr = (const v4u*)((const bf16*)F.out + row * (2 * D) + c0);
            v4u xv[2], sv, yv[TOPK]; float wk[TOPK];
            xv[0] = dr[0]; xv[1] = dr[1]; sv = *(const v4u*)((const unsigned char*)F.out + row * (4 * D) + 2 * D + c0);
#pragma unroll
            for (int k = 0; k < TOPK; ++k) { const int idx = rr * 8 + k;
                const unsigned pk = (unsigned)__builtin_amdgcn_readlane((int)(idx < 64 ? p0 : p1), idx & 63);
                wk[k] = __builtin_bit_cast(float, __builtin_amdgcn_readlane(__builtin_bit_cast(int, idx < 64 ? w0 : w1), idx & 63));
                yv[k] = *(const v4u*)(Y + (size_t)pk * D + c0); }
            f32x4 v[4]; float s = 0.f;
#pragma unroll
            for (int j = 0; j < 4; ++j) {
                const auto slo = __builtin_amdgcn_cvt_pk_f32_fp8((int)sv[j], false), shi = __builtin_amdgcn_cvt_pk_f32_fp8((int)sv[j], true);
                f32x4 r = (f32x4){slo[0], slo[1], shi[0], shi[1]} * Y_INV_SCALE;
#pragma unroll
                for (int k = 0; k < TOPK; ++k) { const int wd = (int)yv[k][j];
                    const auto lo = __builtin_amdgcn_cvt_pk_f32_fp8(wd, false), hi = __builtin_amdgcn_cvt_pk_f32_fp8(wd, true);
                    r += wk[k] * (f32x4){lo[0], lo[1], hi[0], hi[1]}; }
                const unsigned xw0 = xv[j >> 1][(j & 1) * 2], xw1 = xv[j >> 1][(j & 1) * 2 + 1];
                v[j] = (f32x4){bflo(xw0), bfhi(xw0), bflo(xw1), bfhi(xw1)} + gb[j] * r;
                s += (v[j].x * v[j].x + v[j].y * v[j].y) + (v[j].z * v[j].z + v[j].w * v[j].w); }
            const float rstd = 1.f / sqrtf(wave_sum(s) * (1.f / D) + NORM_EPS);
            f32x4* orow = (f32x4*)(F.out + row * D + c0);
#pragma unroll
            for (int j = 0; j < 4; ++j) orow[j] = v[j] * rstd * *(const f32x4*)(g_final + c0 + 4 * j);
        }
    }
}

constexpr int N_PHASES = 12;
__global__ void __launch_bounds__(NTHREADS, 2) fwd(Args args) {
    extern __shared__ __attribute__((aligned(16))) unsigned char lds_raw[];
    Frame F;
    F.lds = (LAS unsigned char*)lds_raw;
    F.tid = threadIdx.x; F.lane = F.tid & 63; F.wave = __builtin_amdgcn_readfirstlane(F.tid >> 6); F.G = gridDim.x; F.bid = blockIdx.x;
#define INP(i) ld_ptr(F.lds, (i))
    F.out = args.out; F.ws = args.ws;
    unsigned char* ws = args.ws;
    volatile LAS unsigned* MISC = (volatile LAS unsigned*)(F.lds + MISC_OFF);
    if (F.tid < 16) MISC[F.tid] = 0u;
    if (F.tid == 0) { LAS unsigned long long* pt = (LAS unsigned long long*)(F.lds + PT_OFF);
#pragma unroll
        for (int i = 0; i < 19; ++i) pt[i] = (unsigned long long)args.in[i]; }
    __syncthreads();
    const int lo = args.ph_lo, hi = args.ph_hi;
    XcdBarrier bar; bar.bar = (unsigned*)(ws + WS_CTL) + CW_BAR; bar.x = 0; bar.st = nullptr;
    if (hi - lo > 1) bar = xcd_barrier_post((unsigned*)(ws + WS_CTL) + CW_BAR, MISC + 8);
#ifndef PH_MASK
#define PH_MASK 0xfff
#endif
#define IN(k) (((PH_MASK >> (k)) & 1) && lo <= (k) && (k) < hi)
#if MK_PROBE >= 1000
#define PH_T0(k) unsigned long long _pt##k = 0; if (MK_PROBE == 1000 + (k)) _pt##k = __builtin_amdgcn_s_memrealtime();
#define PH_T1(k) if (MK_PROBE == 1000 + (k) && blockIdx.x == MK_PROBE_BLK && F.tid == 0) MISC[12] += (unsigned)(__builtin_amdgcn_s_memrealtime() - _pt##k);
#else
#define PH_T0(k)
#define PH_T1(k)
#endif
#if MK_PROBE >= 2000
#define SEAM_T0() const unsigned long long _st0 = __builtin_amdgcn_s_memrealtime();
#ifndef MK_SEAM_MASK
#define MK_SEAM_MASK 0
#endif
#define SEAM_T1(k) if ((MK_PROBE == 2000 || MK_PROBE == 2001 + (k) || (MK_PROBE == 2100 && ((MK_SEAM_MASK >> (k)) & 1))) && blockIdx.x == MK_PROBE_BLK && F.tid == 0) MISC[12] += (unsigned)(__builtin_amdgcn_s_memrealtime() - _st0);
#else
#define SEAM_T0()
#define SEAM_T1(k)
#endif
#define SEAM(k) do { SEAM_T0() if (IN(k) && IN((k) + 1)) { if ((k) <= 8) xcd_barrier_work(bar, F, QD_CHUNKS); else xcd_barrier(bar); } SEAM_T1(k) { int _t = threadIdx.x; asm volatile("" : "+v"(_t)); F.tid = _t; F.lane = _t & 63; } } while (0)

    const int vcu = (F.G % 8 == 0) ? (F.bid % 8) * (F.G / 8) + F.bid / 8 : F.bid;
    unsigned char* h8 = ws + WS_H;
    bf16* h2b = (bf16*)(ws + WS_H2B); bf16* proj = (bf16*)(ws + WS_PROJ); bf16* mixin = (bf16*)(ws + WS_MIXIN);

    PH_T0(0) if (IN(0)) { p0_prologue(F); } PH_T1(0) SEAM(0);
    PH_T0(1) if (IN(1)) { modnorm_phase<false, 2, false>(F, INP(0), INP(4), 0, h8, nullptr); win_int8_phase(F, INP(5)); } PH_T1(1) SEAM(1);
    PH_T0(2) if (IN(2)) {
        typedef DenseSchedT<NT / 256, NPROJ / 256, 1> SchedP2; SchedP2 S; S.init(h8, ws + WS_WIN_T, D / 2, D / 2, 0, F.G, F.bid);
        EpiProj E{proj, (const float*)(ws + WS_ROWSC), (const float*)(ws + WS_COLSC)};
        const int ksplit = vcu % 6;
        S.i0 = 0; S.i1 = ksplit;
        gemm_phase<EpiProj, SchedP2>(F.lds, D / 2, D / 2, S, E);
        __syncthreads();
        for (int e = F.bid; e < NE; e += F.G)
            convert_expert<false>(F, INP(12) + (size_t)e * D * FF, INP(13) + (size_t)e * D * FF, ws + WS_WGU_T + (size_t)e * 512 * D, 16, 16);
        __syncthreads();
        S.i0 = ksplit; S.i1 = 0x3fffffff;
        gemm_phase<EpiProj, SchedP2>(F.lds, D / 2, D / 2, S, E);
    } PH_T1(2) SEAM(2);
    PH_T0(3) if (IN(3)) {
#if MK_PROBE == 1103
        const unsigned long long _pp0 = __builtin_amdgcn_s_memrealtime();
#endif
        pool_phase(F, INP(7));
#if MK_PROBE == 1103
        if (blockIdx.x == MK_PROBE_BLK && F.tid == 0) MISC[12] += (unsigned)(__builtin_amdgcn_s_memrealtime() - _pp0);
#endif
#if MK_NAIVE_ATTN
        naive_attn_phase(F);
#else
        attn_phase(F);
#endif
    } PH_T1(3) SEAM(3);
    PH_T0(4) if (IN(4)) {
#if !MK_NAIVE_ATTN
        combine_phase(F);
#endif
    } PH_T1(4) SEAM(4);
    PH_T0(5) if (IN(5)) {
        typedef DenseSchedT<NT / 256, D / 256, 1> SchedP5; SchedP5 S; S.init(mixin, ws + WS_WOUT_T, NMIX, NMIX, 0, F.G, F.bid);
        EpiOut E{(bf16*)F.out};
        gemm_phase<EpiOut, SchedP5>(F.lds, NMIX, NMIX, S, E);
    } PH_T1(5) SEAM(5);
    PH_T0(6) if (IN(6)) { modnorm_phase<true, 1, true>(F, INP(0), INP(9), 3, h8, h2b); } PH_T1(6) SEAM(6);
    PH_T0(7) if (IN(7)) {
        typedef DenseSchedT<NT / 256, NE / 256, 1> SchedP7; SchedP7 S; S.init(h2b, ws + WS_WR_T, D, D, 0, F.G, F.bid);
        EpiRouter E{(float*)(ws + WS_LOGIT)};
        gemm_phase<EpiRouter, SchedP7>(F.lds, D, D, S, E);
    } PH_T1(7) SEAM(7);
    PH_T0(8) if (IN(8)) { routing_phase(F, INP(11)); drain_queue(F, QG_CHUNKS); } PH_T1(8) SEAM(8);
    PH_T0(9) if (IN(9)) {
        int nblk; build_tables(F, nblk);
        MoeSched<2, false> S; S.prefix = (const LAS int*)(F.lds + TAB_OFF); S.cnt = S.prefix + 260; S.bucket = (const unsigned*)(ws + WS_BUCKET);
        S.Ar = (const char*)h8; S.As = (const char*)h8; S.Br = (const char*)(ws + WS_WGU_T); S.Bs = (const char*)(ws + WS_WSGU_T);
        S.nRouted = nblk * 2; S.total = S.nRouted + (NT / 256) * 2; S.G = F.G; S.c = vcu;
        EpiGU E{ws + WS_ACT, ws + WS_ACTS, (const unsigned*)(ws + WS_BUCKET), (unsigned*)(ws + WS_POS)};
        S.i0 = 0; S.i1 = 0x3fffffff;
        gemm_phase<EpiGU, MoeSched<2, false>>(F.lds, D / 2, D / 2, S, E);
        drain_queue(F, QD_CHUNKS);
    } PH_T1(9) SEAM(9);
    PH_T0(10) if (IN(10)) {
        int nblk; build_tables(F, nblk);
        MoeSched<4, true> S; S.prefix = (const LAS int*)(F.lds + TAB_OFF); S.cnt = S.prefix + 260; S.bucket = (const unsigned*)(ws + WS_BUCKET);
        S.Ar = (const char*)(ws + WS_ACT); S.As = (const char*)(ws + WS_ACTS); S.Br = (const char*)(ws + WS_WD_T); S.Bs = (const char*)(ws + WS_WSD_T);
        S.nRouted = nblk * 4; S.total = S.nRouted + (NT / 256) * 4; S.G = F.G; S.c = vcu; S.i0 = 0; S.i1 = 0x3fffffff;
        EpiDown E{(unsigned char*)(ws + WS_Y), (bf16*)F.out};
        gemm_phase<EpiDown, MoeSched<4, true>>(F.lds, FF / 2, FF / 2, S, E);
    } PH_T1(10) SEAM(10);
    PH_T0(11) if (IN(11)) { final_phase(F, INP(18)); } PH_T1(11)
#if MK_PROBE
    if (blockIdx.x == MK_PROBE_BLK) { __syncthreads();
        if (F.tid == 0) { const unsigned long long span = (unsigned long long)MISC[12] * MK_PROBE_MULT, t0 = __builtin_amdgcn_s_memrealtime();
            while (__builtin_amdgcn_s_memrealtime() - t0 < span) __builtin_amdgcn_s_sleep(16); } }
#endif
#undef IN
#undef SEAM
#undef INP
}

extern "C" void kernel_launch(void* const* d_in, const int* in_sizes, int n_in, void* d_out, int out_size, void* d_ws, size_t ws_size, hipStream_t stream) {
    static int grid = 0;
    if (grid == 0) {
        if (n_in != 19 || out_size != NT * D || ws_size < WS_END) { fprintf(stderr, "kernel_launch: unexpected shapes (n_in %d out %d ws %zu)\n", n_in, out_size, ws_size); grid = -1; return; }
        int dev = 0, cus = 0;
        if (hipGetDevice(&dev) != hipSuccess || hipDeviceGetAttribute(&cus, hipDeviceAttributeMultiprocessorCount, dev) != hipSuccess) { grid = -1; return; }
        if (hipFuncSetAttribute((const void*)fwd, hipFuncAttributeMaxDynamicSharedMemorySize, LDS_BYTES) != hipSuccess) { fprintf(stderr, "kernel_launch: hipFuncSetAttribute failed\n"); grid = -1; return; }
        int per_cu = 0;
        if (hipOccupancyMaxActiveBlocksPerMultiprocessor(&per_cu, (const void*)fwd, NTHREADS, LDS_BYTES) != hipSuccess || per_cu < 1) { fprintf(stderr, "kernel_launch: occupancy query says %d\n", per_cu); }
        (void)hipGetLastError();
        grid = cus;
    }
    if (grid < 0) return;
    (void)hipMemsetAsync((char*)d_ws + WS_CTL, 0, CTL_ZERO_BYTES, stream);
    Args a{};
    for (int i = 0; i < 19; ++i) a.in[i] = (const float*)d_in[i];
    a.out = (float*)d_out; a.ws = (unsigned char*)d_ws;
#if MK_ONE_LAUNCH
    a.ph_lo = 0; a.ph_hi = N_PHASES;
    hipLaunchKernelGGL(fwd, dim3(grid), dim3(NTHREADS), LDS_BYTES, stream, a);
#else
    for (int p = 0; p < N_PHASES; ++p) { a.ph_lo = p; a.ph_hi = p + 1; const int reps = ((MK_REP_MASK >> p) & 1) ? 2 : 1;
        for (int r = 0; r < reps; ++r) hipLaunchKernelGGL(fwd, dim3(grid), dim3(NTHREADS), LDS_BYTES, stream, a); }
#endif
}
```

```cpp
#include <hip/hip_runtime.h>
#include <cstdio>
#include <cstdint>

#ifndef MK_ONE_LAUNCH
#define MK_ONE_LAUNCH 1
#endif
#ifndef MK_FAST_GEMM
#define MK_FAST_GEMM 1
#endif
#ifndef MK_REP_MASK
#define MK_REP_MASK 0x000
#endif
#ifndef MK_MX
#define MK_MX 1
#endif
#ifndef MK_PROBE
#define MK_PROBE 0
#endif
#ifndef MK_PROBE_BLK
#define MK_PROBE_BLK 0
#endif
#ifndef MK_PROBE_WAVE
#define MK_PROBE_WAVE 0
#endif
#ifndef MK_PROBE_MULT
#define MK_PROBE_MULT 4
#endif
#ifndef MK_NAIVE_ATTN
#define MK_NAIVE_ATTN 0
#endif

#define LAS __attribute__((address_space(3)))
#define GAS __attribute__((address_space(1)))
typedef unsigned short bf16;
typedef short bf16x8 __attribute__((ext_vector_type(8)));
typedef short s16x4 __attribute__((ext_vector_type(4)));
typedef float f32x4 __attribute__((ext_vector_type(4)));
typedef float f32x2 __attribute__((ext_vector_type(2)));
typedef long l64x2 __attribute__((ext_vector_type(2)));
typedef int i32x8 __attribute__((ext_vector_type(8)));
typedef int i32x4 __attribute__((ext_vector_type(4)));
typedef unsigned v4u __attribute__((ext_vector_type(4)));
typedef unsigned v2u __attribute__((ext_vector_type(2)));

constexpr int D = 1024, NB = 8, SEQ = 4096, NT = NB * SEQ;
constexpr int NPROJ = 2560, NE = 256, TOPK = 8, FF = 256, NMIX = 512;
constexpr int CAP = NT;
constexpr int MAXBLK = NT * TOPK / 256 + NE;
constexpr float NORM_EPS = 1e-6f;
constexpr int NWAVES = 8, NTHREADS = 512;

constexpr size_t MiB = 1u << 20;
constexpr size_t WS_CTL = 0, CTL_ZERO_BYTES = 128 * 1024;
constexpr size_t WS_MOD = 1 * MiB;
constexpr size_t WS_GATEW = 2 * MiB;
constexpr size_t WS_WIN_T = 4 * MiB;
constexpr size_t WS_WOUT_T = 9 * MiB;
constexpr size_t WS_WR_T = 10 * MiB;
constexpr size_t WS_WSGU_T = 11 * MiB;
constexpr size_t WS_WSD_T = 12 * MiB;
constexpr size_t WS_LSE = 13 * MiB;
constexpr size_t WS_WD_T = 16 * MiB;
constexpr size_t WS_ACT = 144 * MiB;
constexpr size_t WS_ACTS = 304 * MiB;
constexpr size_t WS_BUCKET = 320 * MiB;
constexpr size_t WS_WGU_T = 352 * MiB;
constexpr size_t WS_PROJ = 608 * MiB;
constexpr size_t WS_H = 768 * MiB;
constexpr size_t WS_ATTO = 832 * MiB;
constexpr size_t WS_MIXIN = 880 * MiB;
constexpr size_t WS_LOGIT = 912 * MiB;
constexpr size_t WS_Y = 352 * MiB;
constexpr size_t WS_H2B = 832 * MiB;
constexpr size_t WS_ROWSC = 14 * MiB + 512 * 1024;
constexpr size_t WS_COLSC = 14 * MiB + 768 * 1024;
constexpr size_t WS_PWT = 15 * MiB;
constexpr size_t WS_POS = 3 * MiB;
constexpr size_t WS_END = 992 * MiB;
constexpr int CW_BAR = 4096;
constexpr int CW_GCNT = 16384;
constexpr int CW_QD = 24576;
constexpr int GQ = 16;
constexpr unsigned QG_CHUNKS = NE * GQ, QD_CHUNKS = QG_CHUNKS + NE * 16;

constexpr int RING_BYTES = 131072;
constexpr int TAB_OFF = RING_BYTES;
constexpr int MISC_OFF = TAB_OFF + 4096;
constexpr int PT_OFF = MISC_OFF + 256;
constexpr int OTAB_OFF = PT_OFF + 256, OTAB_UNITS = 11;
constexpr int LDS_BYTES = 147456;
static_assert(OTAB_OFF + OTAB_UNITS * 1024 <= LDS_BYTES, "LDS map");

__device__ __forceinline__ unsigned f2bf(float f) { unsigned u = __builtin_bit_cast(unsigned, f); return (u + 0x7fffu + ((u >> 16) & 1u)) >> 16; }
__device__ __forceinline__ unsigned pk2(float lo, float hi) { unsigned r; asm("v_cvt_pk_bf16_f32 %0, %1, %2" : "=v"(r) : "v"(lo), "v"(hi)); return r; }
constexpr float W_SCALE = 64.f, W_INV_SCALE = 1.f / 64.f;
constexpr float WD_SCALE = 4.f;
constexpr float ACT_SCALE = 4.f;
__device__ __forceinline__ unsigned pk4_fp8(float a, float b, float c, float d) {
    int w = __builtin_amdgcn_cvt_pk_fp8_f32(a, b, 0, false); w = __builtin_amdgcn_cvt_pk_fp8_f32(c, d, w, true); return (unsigned)w; }
__device__ __forceinline__ unsigned pk4_i8(float a, float b, float c, float d) {
    const int ia = (int)__builtin_rintf(a), ib = (int)__builtin_rintf(b), ic = (int)__builtin_rintf(c), id = (int)__builtin_rintf(d);
    return (unsigned)(ia & 255) | ((unsigned)(ib & 255) << 8) | ((unsigned)(ic & 255) << 16) | ((unsigned)id << 24); }
__device__ __forceinline__ float bf2f(unsigned short b) { return __builtin_bit_cast(float, ((unsigned)b) << 16); }
__device__ __forceinline__ float bflo(unsigned u) { return __builtin_bit_cast(float, u << 16); }
__device__ __forceinline__ float bfhi(unsigned u) { return __builtin_bit_cast(float, u & 0xffff0000u); }
template <int CTRL> __device__ __forceinline__ float dppf(float v) {
    return __builtin_bit_cast(float, __builtin_amdgcn_update_dpp(0, __builtin_bit_cast(int, v), CTRL, 0xF, 0xF, true)); }
__device__ __forceinline__ float wave_sum(float v) {
    v += dppf<0xB1>(v); v += dppf<0x4E>(v); v += dppf<0x141>(v); v += dppf<0x140>(v);
    const float r0 = __builtin_bit_cast(float, __builtin_amdgcn_readlane(__builtin_bit_cast(int, v), 0)), r1 = __builtin_bit_cast(float, __builtin_amdgcn_readlane(__builtin_bit_cast(int, v), 16));
    const float r2 = __builtin_bit_cast(float, __builtin_amdgcn_readlane(__builtin_bit_cast(int, v), 32)), r3 = __builtin_bit_cast(float, __builtin_amdgcn_readlane(__builtin_bit_cast(int, v), 48));
    return (r0 + r1) + (r2 + r3);
}
__device__ __forceinline__ float wave_max(float v) {
    v = fmaxf(v, dppf<0xB1>(v)); v = fmaxf(v, dppf<0x4E>(v)); v = fmaxf(v, dppf<0x141>(v)); v = fmaxf(v, dppf<0x140>(v));
    const float r0 = __builtin_bit_cast(float, __builtin_amdgcn_readlane(__builtin_bit_cast(int, v), 0)), r1 = __builtin_bit_cast(float, __builtin_amdgcn_readlane(__builtin_bit_cast(int, v), 16));
    const float r2 = __builtin_bit_cast(float, __builtin_amdgcn_readlane(__builtin_bit_cast(int, v), 32)), r3 = __builtin_bit_cast(float, __builtin_amdgcn_readlane(__builtin_bit_cast(int, v), 48));
    return fmaxf(fmaxf(r0, r1), fmaxf(r2, r3));
}
__device__ __forceinline__ float silu_f(float g) { return g * __builtin_amdgcn_rcpf(1.f + __builtin_amdgcn_exp2f(-1.44269504f * g)); }

__device__ __forceinline__ const float* ld_ptr(LAS unsigned char* lds, int i) {
    const unsigned long long v = ((const LAS unsigned long long*)(lds + PT_OFF))[i];
    const unsigned lo = __builtin_amdgcn_readfirstlane((unsigned)v), hi = __builtin_amdgcn_readfirstlane((unsigned)(v >> 32));
    return (const float*)(((unsigned long long)hi << 32) | lo);
}
#define XB_TMO      128
#define XB_XCNT(j)  (256  + 64 * (j))
#define XB_XSUB(j)  (1280 + 64 * (j))
#define XB_XGEN(j)  (2304 + 64 * (j))
#define XB_TOP      3328
#define XB_TOPGEN   3392
#define XCD_BAR_WORDS 3456
#define XB_SPIN_CAP (1u << 18)
__device__ __forceinline__ unsigned xb_ld(unsigned* p)              { return __hip_atomic_load(p, __ATOMIC_RELAXED, __HIP_MEMORY_SCOPE_AGENT); }
__device__ __forceinline__ unsigned xb_add(unsigned* p, unsigned v) { return __hip_atomic_fetch_add(p, v, __ATOMIC_RELAXED, __HIP_MEMORY_SCOPE_AGENT); }
__device__ __forceinline__ unsigned xb_xcc_id() { return (unsigned)__builtin_amdgcn_s_getreg((3 << 11) | 20) & 0xFu; }
#define XB_SPIN(cond, bar) do { unsigned _sp = 0; while (cond) { __builtin_amdgcn_s_sleep(1); \
    if ((++_sp & 255u) == 0u) { if (xb_ld(&(bar)[XB_TMO])) break; if (_sp > XB_SPIN_CAP) { atomicAdd(&(bar)[XB_TMO], 1u); break; } } } } while (0)
struct XcdBarrier { unsigned* bar; unsigned x; volatile LAS unsigned* st; };
__device__ __forceinline__ XcdBarrier xcd_barrier_post(unsigned* bar, volatile LAS unsigned* st) {
    XcdBarrier b; b.bar = bar; b.x = xb_xcc_id(); b.st = st;
    if (threadIdx.x == 0) (void)xb_add(&bar[XB_XCNT(b.x)], 1u);
    return b;
}
__device__ __forceinline__ void xcd_barrier_complete(unsigned* bar, unsigned x, unsigned& nloc, unsigned& nx) {
    const unsigned G = gridDim.x * gridDim.y * gridDim.z;
    unsigned sum, cnt, mine, sp = 0u;
    for (;;) {
        sum = 0u; cnt = 0u; mine = 0u;
#pragma unroll
        for (unsigned j = 0; j < 16; ++j) { const unsigned c = xb_ld(&bar[XB_XCNT(j)]); sum += c; cnt += (c > 0u) ? 1u : 0u; mine = (j == x) ? c : mine; }
        if (sum == G) break;
        __builtin_amdgcn_s_sleep(1);
        if ((++sp & 255u) == 0u) { if (xb_ld(&bar[XB_TMO])) break; if (sp > XB_SPIN_CAP) { atomicAdd(&bar[XB_TMO], 1u); break; } }
    }
    nloc = mine > 0u ? mine : 1u; nx = cnt > 0u ? cnt : 1u;
}
__device__ __forceinline__ void xcd_barrier(const XcdBarrier& b) {
    asm volatile("s_waitcnt vmcnt(0)" ::: "memory");
    __syncthreads();
    if (threadIdx.x == 0) {
        unsigned* bar = b.bar;
        __builtin_amdgcn_s_waitcnt(0);
        unsigned nloc = b.st[0], nx = b.st[1];
        if (nloc == 0u) { xcd_barrier_complete(bar, b.x, nloc, nx); b.st[0] = nloc; b.st[1] = nx; }
        const unsigned old = xb_add(&bar[XB_XSUB(b.x)], 1u);
        const unsigned gen = old / nloc;
        if (old + 1u == (gen + 1u) * nloc) {
            __builtin_amdgcn_fence(__ATOMIC_RELEASE, "agent");
            asm volatile("s_waitcnt vmcnt(0)" ::: "memory");
            const unsigned og = xb_add(&bar[XB_TOP], 1u);
            const unsigned tg = og / nx;
            if (og + 1u == (tg + 1u) * nx) xb_add(&bar[XB_TOPGEN], 1u);
            else XB_SPIN(xb_ld(&bar[XB_TOPGEN]) == tg, bar);
            __builtin_amdgcn_fence(__ATOMIC_ACQUIRE, "agent");
            xb_add(&bar[XB_XGEN(b.x)], 1u);
            asm volatile("s_waitcnt vmcnt(0)" ::: "memory");
        } else {
            XB_SPIN(xb_ld(&bar[XB_XGEN(b.x)]) == gen, bar);
            __builtin_amdgcn_fence(__ATOMIC_ACQUIRE, "agent");
            asm volatile("s_waitcnt vmcnt(0)" ::: "memory");
        }
    }
    __syncthreads();
}

constexpr int BK = 64, HALF = 128, HTB = HALF * BK * 2;
__device__ __forceinline__ int lds_byte(int r, int c) { const int st = (r >> 4) * 2 + (c >> 5), rr = r & 15, cc = c & 31, ob = rr * 64 + cc * 2; return st * 1024 + (ob ^ (((ob >> 9) & 1) << 5)); }
__device__ __forceinline__ void stage_rc(int b, int& R, int& C) { const int st = b / 1024, sb = b % 1024, swz = sb ^ (((sb >> 9) & 1) << 5); R = (st >> 1) * 16 + swz / 64; C = (st & 1) * 32 + (swz % 64) / 2; }
__device__ __forceinline__ int perm32(int rho) { const int n = rho >> 4, i = rho & 15; return 8 * (i >> 2) + 4 * n + (i & 3); }

template <class Epi, class Sched>
__device__ __forceinline__ void gemm_simple(const int K, const int ldb, const Sched& S, const Epi& E) {
    const int tid = threadIdx.x, wid = __builtin_amdgcn_readfirstlane(tid >> 6), lane = tid & 63, wr = wid >> 2, wc = wid & 3, fr = lane & 15, fq = lane >> 4;
    typename Sched::Unit u;
    for (int ui = 0; S.next(ui, u); ++ui) {
        f32x4 acc[2][2][4][2];
#pragma unroll
        for (int a = 0; a < 2; ++a)
#pragma unroll
            for (int b = 0; b < 2; ++b)
#pragma unroll
                for (int m = 0; m < 4; ++m)
#pragma unroll
                    for (int n = 0; n < 2; ++n) acc[a][b][m][n] = (f32x4){0.f, 0.f, 0.f, 0.f};
        const char* A = S.a_base(u); const char* B = S.b_base(u);
        unsigned aoff[2][4], boff[2][2];
#pragma unroll
        for (int ai = 0; ai < 2; ++ai)
#pragma unroll
            for (int m = 0; m < 4; ++m) aoff[ai][m] = S.a_off(u, 128 * ai + 64 * wr + 16 * m + fr) + fq * 16;
#pragma unroll
        for (int bj = 0; bj < 2; ++bj)
#pragma unroll
            for (int n = 0; n < 2; ++n) { const int row = Epi::PERM == 2 ? 64 * wc + 16 * (fr >> 2) + 8 * bj + 4 * n + (fr & 3) : 128 * bj + 32 * wc + (Epi::PERM == 1 ? perm32(16 * n + fr) : 16 * n + fr); boff[bj][n] = (unsigned)(row * ldb) * 2u + fq * 16; }
        for (int k = 0; k < K; k += 32) {
            bf16x8 a[2][4], b[2][2];
#pragma unroll
            for (int ai = 0; ai < 2; ++ai)
#pragma unroll
                for (int m = 0; m < 4; ++m) a[ai][m] = *(const bf16x8*)(A + aoff[ai][m] + k * 2);
#pragma unroll
            for (int bj = 0; bj < 2; ++bj)
#pragma unroll
                for (int n = 0; n < 2; ++n) b[bj][n] = *(const bf16x8*)(B + boff[bj][n] + k * 2);
#pragma unroll
            for (int ai = 0; ai < 2; ++ai)
#pragma unroll
                for (int bj = 0; bj < 2; ++bj)
#pragma unroll
                    for (int m = 0; m < 4; ++m)
#pragma unroll
                        for (int n = 0; n < 2; ++n) acc[ai][bj][m][n] = __builtin_amdgcn_mfma_f32_16x16x32_bf16(b[bj][n], a[ai][m], acc[ai][bj][m][n], 0, 0, 0);
        }
        E(acc, u, wr, wc, fr, fq);
    }
}

template <class Epi, class Sched>
__device__ __forceinline__ void gemm_fast(LAS unsigned char* lds, const int K, const int ldb, const Sched& S, const Epi& E) {
    int tid0 = threadIdx.x; asm volatile("" : "+v"(tid0));
    const int tid = tid0, wid = __builtin_amdgcn_readfirstlane(tid >> 6), lane = tid & 63, wr = wid >> 2, wc = wid & 3, fr = lane & 15, fq = lane >> 4;
    int nt = K / BK; asm volatile("" : "+s"(nt));
    unsigned voffB0[2], voffB1[2];
#pragma unroll
    for (int i = 0; i < 2; ++i) { int R, C; stage_rc(tid * 16 + i * 8192, R, C);
        if (Epi::PERM == 2) { const int cb = 64 * (R >> 5) + 16 * ((R & 15) >> 2) + 4 * ((R >> 4) & 1) + (R & 3);
            voffB0[i] = (unsigned)(cb * ldb + C) * 2u; voffB1[i] = (unsigned)((cb + 8) * ldb + C) * 2u; }
        else { const int Rb = Epi::PERM == 1 ? ((R & ~31) + perm32(R & 31)) : R;
            voffB0[i] = (unsigned)(Rb * ldb + C) * 2u; voffB1[i] = (unsigned)((Rb + HALF) * ldb + C) * 2u; } }
#define PG8_AOFF(u) do { int _tz = threadIdx.x; asm volatile("" : "+v"(_tz)); _Pragma("unroll") for (int _i = 0; _i < 2; ++_i) { int _R, _C; stage_rc(_tz * 16 + _i * 8192, _R, _C); \
        vA0[_i] = S.a_off(u, _R) + (unsigned)_C * 2u; vA1[_i] = S.a_off(u, HALF + _R) + (unsigned)_C * 2u; } } while (0)
    const size_t kstep = (size_t)(BK * 2);
    const unsigned ldsw = (unsigned)wid * 1024u;
    const int aoff = lds_byte(wr * 64 + fr, fq * 8), boff = lds_byte(wc * 32 + fr, fq * 8);
#if MK_PROBE
#define PRB_NOW() __builtin_amdgcn_s_memrealtime()
#define PRB_ADD(IV, t0, t1) do { if (MK_PROBE == Epi::PID * 10 + (IV) && blockIdx.x == MK_PROBE_BLK && wid == MK_PROBE_WAVE && lane == 0) \
        __hip_atomic_fetch_add((LAS unsigned*)(lds + MISC_OFF + 48), (unsigned)((t1) - (t0)), __ATOMIC_RELAXED, __HIP_MEMORY_SCOPE_WORKGROUP); } while (0)
#else
#define PRB_NOW() 0ull
#define PRB_ADD(IV, t0, t1) do { } while (0)
#endif
#define PG8_SA(b, h) (((b) * 2 + (h)) * HTB)
#define PG8_SB(b, h) ((4 + (b) * 2 + (h)) * HTB)
#define PG8_STAGE(bufoff, gbase, voff) do { _Pragma("unroll") for (int _i = 0; _i < 2; ++_i) \
        __builtin_amdgcn_global_load_lds((const unsigned*)((const char*)(gbase) + (voff)[_i]), (LAS unsigned*)(lds + (bufoff) + ldsw + _i * 8192), 16, 0, 0); } while (0)
#define PG8_LDA(dst, b, h) do { _Pragma("unroll") for (int m = 0; m < 4; ++m) _Pragma("unroll") for (int k = 0; k < 2; ++k) dst[m][k] = *(const LAS bf16x8*)(lds + PG8_SA(b, h) + aoff + m * 2048 + k * 1024); } while (0)
#define PG8_LDB(dst, b, h) do { _Pragma("unroll") for (int n = 0; n < 2; ++n) _Pragma("unroll") for (int k = 0; k < 2; ++k) dst[n][k] = *(const LAS bf16x8*)(lds + PG8_SB(b, h) + boff + n * 2048 + k * 1024); } while (0)
#define PG8_MMA(ai, bj, At, Bt) do { __builtin_amdgcn_s_setprio(1); _Pragma("unroll") for (int m = 0; m < 4; ++m) _Pragma("unroll") for (int n = 0; n < 2; ++n) _Pragma("unroll") for (int k = 0; k < 2; ++k) { \
        if constexpr (Epi::FP8 && MK_MX) { if (k == 0) { \
            const i32x8 _a = __builtin_shufflevector(__builtin_bit_cast(i32x4, At[m][0]), __builtin_bit_cast(i32x4, At[m][1]), 0, 1, 2, 3, 4, 5, 6, 7); \
            const i32x8 _b = __builtin_shufflevector(__builtin_bit_cast(i32x4, Bt[n][0]), __builtin_bit_cast(i32x4, Bt[n][1]), 0, 1, 2, 3, 4, 5, 6, 7); \
            acc[ai][bj][m][n] = __builtin_amdgcn_mfma_scale_f32_16x16x128_f8f6f4(_b, _a, acc[ai][bj][m][n], 0, 0, 0, 0, 0, 0);      } } \
        else if constexpr (Epi::I8) acc[ai][bj][m][n] = __builtin_bit_cast(f32x4, __builtin_amdgcn_mfma_i32_16x16x64_i8(__builtin_bit_cast(i32x4, Bt[n][k]), __builtin_bit_cast(i32x4, At[m][k]), __builtin_bit_cast(i32x4, acc[ai][bj][m][n]), 0, 0, 0)); \
        else if constexpr (Epi::FP8) { const l64x2 _a = __builtin_bit_cast(l64x2, At[m][k]), _b = __builtin_bit_cast(l64x2, Bt[n][k]); \
            acc[ai][bj][m][n] = __builtin_amdgcn_mfma_f32_16x16x32_fp8_fp8(_b[0], _a[0], acc[ai][bj][m][n], 0, 0, 0); \
            acc[ai][bj][m][n] = __builtin_amdgcn_mfma_f32_16x16x32_fp8_fp8(_b[1], _a[1], acc[ai][bj][m][n], 0, 0, 0); } \
        else acc[ai][bj][m][n] = __builtin_amdgcn_mfma_f32_16x16x32_bf16(Bt[n][k], At[m][k], acc[ai][bj][m][n], 0, 0, 0); } __builtin_amdgcn_s_setprio(0); } while (0)
#define PG8_WAIT_V(n) asm volatile("s_waitcnt vmcnt(" #n ")" ::: "memory")
#define PG8_WAIT_L(n) asm volatile("s_waitcnt lgkmcnt(" #n ")" ::: "memory")
#define PG8_BAR __builtin_amdgcn_s_barrier()
#define PG8_SCHED __builtin_amdgcn_sched_barrier(0)
    typename Sched::Unit cur, nxt; int ui = 0;
    if (!S.next(0, cur)) return;
    f32x4 acc[2][2][4][2];
#pragma unroll
    for (int a = 0; a < 2; ++a)
#pragma unroll
        for (int b = 0; b < 2; ++b)
#pragma unroll
            for (int m = 0; m < 4; ++m)
#pragma unroll
                for (int n = 0; n < 2; ++n) acc[a][b][m][n] = (f32x4){0.f, 0.f, 0.f, 0.f};
    bf16x8 At[4][2], B0[2][2], B1[2][2];
    const char* cA = S.a_base(cur); const char* cB = S.b_base(cur);
    unsigned vA0[2], vA1[2];
    PG8_AOFF(cur);
    PG8_STAGE(PG8_SB(0, 0), cB, voffB0); PG8_STAGE(PG8_SA(0, 0), cA, vA0); PG8_STAGE(PG8_SB(0, 1), cB, voffB1); PG8_STAGE(PG8_SA(0, 1), cA, vA1);
    if (wr == 1) PG8_BAR;
    PG8_WAIT_V(4); PG8_BAR;
    PG8_STAGE(PG8_SB(1, 0), cB + kstep, voffB0); PG8_STAGE(PG8_SA(1, 0), cA + kstep, vA0); PG8_STAGE(PG8_SB(1, 1), cB + kstep, voffB1);
    PG8_WAIT_V(6); PG8_BAR;
    for (;;) {
        const unsigned long long prb_a = PRB_NOW();
        const bool has_next = S.next(ui + 1, nxt);
        const char* nA = has_next ? S.a_base(nxt) : cA; const char* nB = has_next ? S.b_base(nxt) : cB;
        const unsigned long long prb_b = PRB_NOW(); PRB_ADD(1, prb_a, prb_b);
        for (int t = 0; t < nt; t += 2) {
            const unsigned long long prb_i0 = PRB_NOW();
            const bool last = (t == nt - 2);
            const char* a1 = cA + (size_t)(t + 1) * kstep;
            const char* a2 = last ? nA : cA + (size_t)(t + 2) * kstep; const char* b2 = last ? nB : cB + (size_t)(t + 2) * kstep;
            const char* a3 = a2 + kstep; const char* b3 = b2 + kstep;
            PG8_LDB(B0, 0, 0); PG8_SCHED; PG8_LDA(At, 0, 0); PG8_STAGE(PG8_SA(1, 1), a1, vA1);
            if (last && has_next) PG8_AOFF(nxt);
            PG8_WAIT_L(8); PG8_BAR; PG8_WAIT_L(0); PG8_MMA(0, 0, At, B0); PG8_BAR; PG8_SCHED;
            PG8_LDB(B1, 0, 1); PG8_STAGE(PG8_SB(0, 0), b2, voffB0);
            PG8_BAR; PG8_WAIT_L(0); PG8_MMA(0, 1, At, B1); PG8_BAR;
            PG8_LDA(At, 0, 1); PG8_STAGE(PG8_SA(0, 0), a2, vA0);
            PG8_BAR; PG8_WAIT_L(0); PG8_MMA(1, 0, At, B0); PG8_BAR; PG8_SCHED;
            PG8_STAGE(PG8_SB(0, 1), b2, voffB1);
            PG8_WAIT_V(6); PG8_BAR; PG8_MMA(1, 1, At, B1); PG8_BAR;
            PG8_LDB(B0, 1, 0); PG8_SCHED; PG8_LDA(At, 1, 0); PG8_STAGE(PG8_SA(0, 1), a2, vA1);
            PG8_WAIT_L(8); PG8_BAR; PG8_WAIT_L(0); PG8_MMA(0, 0, At, B0); PG8_BAR; PG8_SCHED;
            PG8_LDB(B1, 1, 1); PG8_STAGE(PG8_SB(1, 0), b3, voffB0);
            PG8_BAR; PG8_WAIT_L(0); PG8_MMA(0, 1, At, B1); PG8_BAR;
            PG8_LDA(At, 1, 1); PG8_STAGE(PG8_SA(1, 0), a3, vA0);
            PG8_BAR; PG8_WAIT_L(0); PG8_MMA(1, 0, At, B0);
            if constexpr (Epi::EARLY > 0) {
                int tz = threadIdx.x; asm volatile("" : "+v"(tz)); const int wz = tz >> 6, lz = tz & 63;
                E.template half<0>(acc, cur, wz >> 2, wz & 3, lz & 15, lz >> 4); }
            PG8_BAR; PG8_SCHED;
            PG8_STAGE(PG8_SB(1, 1), b3, voffB1);
            if constexpr (Epi::EARLY == 4) PG8_WAIT_V(10); else PG8_WAIT_V(6);
            PG8_BAR; PG8_MMA(1, 1, At, B1); PG8_BAR;
            { const unsigned long long prb_i1 = PRB_NOW(); if (t == 0) PRB_ADD(4, prb_i0, prb_i1); if (last) PRB_ADD(5, prb_i0, prb_i1); if (t != 0 && !last) PRB_ADD(6, prb_i0, prb_i1); }
        }
        const unsigned long long prb_c = PRB_NOW(); PRB_ADD(2, prb_b, prb_c);
        { int tz = threadIdx.x; asm volatile("" : "+v"(tz)); const int wz = tz >> 6, lz = tz & 63;
          E(acc, cur, wz >> 2, wz & 3, lz & 15, lz >> 4);
#if defined(MK_EPI_TWICE)
          if (Epi::TWICE) { asm volatile("" ::: "memory"); E(acc, cur, wz >> 2, wz & 3, lz & 15, lz >> 4); }
#endif
          }
        { const unsigned long long prb_d = PRB_NOW(); PRB_ADD(3, prb_c, prb_d); }
        if (!has_next) break;
#pragma unroll
        for (int a = 0; a < 2; ++a)
#pragma unroll
            for (int b = 0; b < 2; ++b)
#pragma unroll
                for (int m = 0; m < 4; ++m)
#pragma unroll
                    for (int n = 0; n < 2; ++n) acc[a][b][m][n] = (f32x4){0.f, 0.f, 0.f, 0.f};
        cur = nxt; cA = nA; cB = nB; ++ui;
    }
    PG8_WAIT_V(0);
    if (wr == 0) PG8_BAR;
    PG8_BAR;
#undef PG8_AOFF
#undef PRB_NOW
#undef PRB_ADD
#undef PG8_SA
#undef PG8_SB
#undef PG8_STAGE
#undef PG8_LDA
#undef PG8_LDB
#undef PG8_MMA
#undef PG8_WAIT_V
#undef PG8_WAIT_L
#undef PG8_BAR
#undef PG8_SCHED
}

template <class Epi, class Sched>
__device__ __forceinline__ void gemm_phase(LAS unsigned char* lds, const int K, const int ldb, const Sched& S, const Epi& E) {
#if MK_FAST_GEMM
    gemm_fast<Epi, Sched>(lds, K, ldb, S, E);
#else
    gemm_simple<Epi, Sched>(K, ldb, S, E);
#endif
}

struct DenseUnit { int pm, pn, ks; };
template <int NM, int NN, int KSPLIT>
struct DenseSchedT {
    typedef DenseUnit Unit;
    const char* A; const char* B; int lda2, ldb2, ksub2, G, c, i0, i1;
    __device__ __forceinline__ void init(const void* A_, const void* B_, int lda, int ldb, int Ksub, int G_, int c_) {
        A = (const char*)A_; B = (const char*)B_; lda2 = lda * 2; ldb2 = ldb * 2; ksub2 = Ksub * 2; G = G_; c = c_; i0 = 0; i1 = 0x3fffffff; }
    __device__ __forceinline__ bool next(int i, Unit& u) const {
        constexpr int nwg = NM * NN, total = nwg * KSPLIT;
        if (i + i0 >= i1) return false;
        const int L = (i + i0) * G + c; if (L >= total) return false;
        int id = L / KSPLIT; u.ks = L - id * KSPLIT;
        { constexpr int q = nwg / 8, r = nwg % 8; const int xcd = id % 8, off = id / 8; id = (xcd < r ? xcd * (q + 1) : r * (q + 1) + (xcd - r) * q) + off; }
        constexpr int nig = 8 * NN; const int gid = id / nig, fm = gid * 8, gsz = (NM - fm) < 8 ? (NM - fm) : 8;
        u.pm = fm + ((id % nig) % gsz); u.pn = (id % nig) / gsz; return true;
    }
    __device__ __forceinline__ const char* a_base(const Unit& u) const { return A + (size_t)u.pm * 256 * lda2 + (size_t)u.ks * ksub2; }
    __device__ __forceinline__ const char* b_base(const Unit& u) const { return B + (size_t)u.pn * 256 * ldb2 + (size_t)u.ks * ksub2; }
    __device__ __forceinline__ unsigned a_off(const Unit&, int r) const { return (unsigned)(r * lda2); }
};

template <int PN, bool DOWN>
struct MoeSched {
    struct Unit { int kind, e, rb, blk, valid, pm, pn, i; };
    const LAS int* prefix; const LAS int* cnt; const unsigned* bucket; const LAS unsigned* otab;
    const char* Ar; const char* As; const char* Br; const char* Bs;
    int nRouted, total, G, c, i0, i1;
    __device__ __forceinline__ bool next(int i, Unit& u) const {
        if (i + i0 >= i1) return false;
        const int id = (i + i0) * G + c; if (id >= total) return false;
        u.e = 0; u.rb = 0; u.blk = 0; u.pm = 0; u.i = i;
        if (id < nRouted) {
            const int blk = id / PN; u.pn = id % PN;
            const int lo = ((const LAS unsigned char*)(cnt + 256))[blk];
            u.kind = 0; u.e = lo; u.rb = blk - prefix[lo]; u.blk = blk; const int rem = cnt[lo] - u.rb * 256; u.valid = rem < 256 ? rem : 256;
        } else { const int s = id - nRouted; u.kind = 1; u.pm = s / PN; u.pn = s % PN; u.valid = 256; }
        return true;
    }
    __device__ __forceinline__ const char* a_base(const Unit& u) const { return u.kind == 0 ? Ar : As; }
    __device__ __forceinline__ const char* b_base(const Unit& u) const {
        if (!DOWN) return u.kind == 0 ? Br + ((size_t)u.e * 512 + (size_t)u.pn * 256) * D : Bs + (size_t)u.pn * 256 * D;
        else       return u.kind == 0 ? Br + ((size_t)u.e * 1024 + (size_t)u.pn * 256) * FF : Bs + (size_t)u.pn * 256 * FF;
    }
    __device__ __forceinline__ unsigned a_off(const Unit& u, int r) const {
        if (!DOWN && u.i < OTAB_UNITS) return otab[u.i * 256 + r];
        return a_off_direct(u, r);
    }
    __device__ __forceinline__ void fill_otab(LAS unsigned* tab, int tid) const {
#pragma unroll
        for (int j = 0; j < (OTAB_UNITS * 256 + NTHREADS - 1) / NTHREADS; ++j) { const int idx = tid + j * NTHREADS; Unit u;
            if (idx < OTAB_UNITS * 256 && next(idx >> 8, u)) tab[idx] = a_off_direct(u, idx & 255); }
    }
    __device__ __forceinline__ unsigned a_off_direct(const Unit& u, int r) const {
        if (!DOWN) {
            if (u.kind == 0) { const int rr = r < u.valid ? r : u.valid - 1; const unsigned slot = bucket[(size_t)u.e * CAP + u.rb * 256 + rr]; return (slot >> 3) * (unsigned)D; }
            return (unsigned)(u.pm * 256 + r) * (unsigned)D;
        } else {
            return (unsigned)((u.kind == 0 ? u.blk : u.pm) * 256 + r) * (unsigned)FF;
        }
    }
};

struct EpiProj {
    static constexpr int PID = 2, PERM = 2, EARLY = 0;
    static constexpr bool TWICE = false, FP8 = false, I8 = true;
    bf16* O; const float* rowsc; const float* colq;
    __device__ __forceinline__ void operator()(const f32x4 (&acc)[2][2][4][2], const DenseUnit& u, int wr, int wc, int fr, int fq) const {
        const int row0 = u.pm * 256 + wr * 64 + fr, col0 = u.pn * 256 + wc * 64 + 16 * fq;
        f32x4 cs[2][2];
#pragma unroll
        for (int bj = 0; bj < 2; ++bj)
#pragma unroll
            for (int n = 0; n < 2; ++n) { const f32x4 q = *(const f32x4*)(colq + col0 + 8 * bj + 4 * n);
                cs[bj][n] = (f32x4){__builtin_amdgcn_rcpf(q.x), __builtin_amdgcn_rcpf(q.y), __builtin_amdgcn_rcpf(q.z), __builtin_amdgcn_rcpf(q.w)}; }
#pragma unroll
        for (int ai = 0; ai < 2; ++ai)
#pragma unroll
            for (int m = 0; m < 4; ++m) { const int row = row0 + ai * 128 + m * 16; bf16* rowp = O + (size_t)row * NPROJ + col0; const float rs = rowsc[row];
#pragma unroll
                for (int bj = 0; bj < 2; ++bj) { const i32x4 a0 = __builtin_bit_cast(i32x4, acc[ai][bj][m][0]), a1 = __builtin_bit_cast(i32x4, acc[ai][bj][m][1]);
                    const f32x4 v0 = (f32x4){(float)a0[0], (float)a0[1], (float)a0[2], (float)a0[3]} * cs[bj][0] * rs, v1 = (f32x4){(float)a1[0], (float)a1[1], (float)a1[2], (float)a1[3]} * cs[bj][1] * rs;
                    *(v4u*)(rowp + bj * 8) = (v4u){pk2(v0[0], v0[1]), pk2(v0[2], v0[3]), pk2(v1[0], v1[1]), pk2(v1[2], v1[3])}; } }
    }
};
constexpr float OUT_INV = 1.f / (16.f * W_SCALE);
struct EpiOut {
    static constexpr int PID = 5, PERM = 2, EARLY = 0;
    static constexpr bool TWICE = false, FP8 = true, I8 = false;
    bf16* O;
    __device__ __forceinline__ void operator()(const f32x4 (&acc)[2][2][4][2], const DenseUnit& u, int wr, int wc, int fr, int fq) const {
        const int row0 = u.pm * 256 + wr * 64 + fr, col0 = u.pn * 256 + wc * 64 + 16 * fq;
#pragma unroll
        for (int ai = 0; ai < 2; ++ai)
#pragma unroll
            for (int m = 0; m < 4; ++m) { bf16* rowp = O + (size_t)(row0 + ai * 128 + m * 16) * (2 * D) + col0;
#pragma unroll
                for (int bj = 0; bj < 2; ++bj) { const f32x4 v0 = acc[ai][bj][m][0] * OUT_INV, v1 = acc[ai][bj][m][1] * OUT_INV;
                    *(v4u*)(rowp + bj * 8) = (v4u){pk2(v0[0], v0[1]), pk2(v0[2], v0[3]), pk2(v1[0], v1[1]), pk2(v1[2], v1[3])}; } }
    }
};
struct EpiRouter {
    static constexpr int PID = 7, PERM = 0, EARLY = 0;
    static constexpr bool TWICE = false, FP8 = false, I8 = false;
    float* L;
    __device__ __forceinline__ void operator()(const f32x4 (&acc)[2][2][4][2], const DenseUnit& u, int wr, int wc, int fr, int fq) const {
        const int row0 = u.pm * 256 + wr * 64 + fr, col0 = wc * 32 + 4 * fq;
        float* Lp = L + (size_t)u.ks * NT * NE;
#pragma unroll
        for (int ai = 0; ai < 2; ++ai)
#pragma unroll
            for (int m = 0; m < 4; ++m) { const size_t ro = (size_t)(row0 + ai * 128 + m * 16) * NE + col0;
#pragma unroll
                for (int bj = 0; bj < 2; ++bj)
#pragma unroll
                    for (int n = 0; n < 2; ++n) *(f32x4*)(Lp + ro + bj * 128 + n * 16) = acc[ai][bj][m][n]; }
    }
};
struct EpiGU {
    static constexpr int PID = 9, PERM = 1, EARLY = 0;
    static constexpr bool TWICE = false, FP8 = true, I8 = false;
    unsigned char* act; unsigned char* acts; const unsigned* bucket; unsigned* pos;
    __device__ __forceinline__ void operator()(const f32x4 (&acc)[2][2][4][2], const MoeSched<2, false>::Unit& u, int wr, int wc, int fr, int fq) const {
        unsigned char* O = u.kind == 0 ? act : acts;
        const int row0 = (u.kind == 0 ? u.blk : u.pm) * 256 + wr * 64 + fr, col0 = u.pn * 128 + wc * 32 + 8 * fq;
#pragma unroll
        for (int ai = 0; ai < 2; ++ai)
#pragma unroll
            for (int m = 0; m < 4; ++m) {
                const f32x4 g0 = acc[ai][0][m][0], g1 = acc[ai][0][m][1], u0 = acc[ai][1][m][0], u1 = acc[ai][1][m][1];
                float a[8];
#pragma unroll
                for (int j = 0; j < 4; j += 2) {
                    const f32x2 ga = (f32x2){g0[j], g0[j + 1]} * W_INV_SCALE, gb = (f32x2){g1[j], g1[j + 1]} * W_INV_SCALE;
                    const f32x2 ua = (f32x2){u0[j], u0[j + 1]} * (W_INV_SCALE * ACT_SCALE), ub = (f32x2){u1[j], u1[j + 1]} * (W_INV_SCALE * ACT_SCALE);
                    const f32x2 ea = ga * (-1.44269504f), eb = gb * (-1.44269504f);
                    f32x2 da, db; da.x = __builtin_amdgcn_exp2f(ea.x); da.y = __builtin_amdgcn_exp2f(ea.y); db.x = __builtin_amdgcn_exp2f(eb.x); db.y = __builtin_amdgcn_exp2f(eb.y);
                    da = da + 1.0f; db = db + 1.0f;
                    f32x2 ra, rb; ra.x = __builtin_amdgcn_rcpf(da.x); ra.y = __builtin_amdgcn_rcpf(da.y); rb.x = __builtin_amdgcn_rcpf(db.x); rb.y = __builtin_amdgcn_rcpf(db.y);
                    const f32x2 oa = (ga * ua) * ra, ob = (gb * ub) * rb;
                    a[j] = oa.x; a[j + 1] = oa.y; a[4 + j] = ob.x; a[4 + j + 1] = ob.y; }
                *(v2u*)(O + (size_t)(row0 + ai * 128 + m * 16) * FF + col0) = (v2u){pk4_fp8(a[0], a[1], a[2], a[3]), pk4_fp8(a[4], a[5], a[6], a[7])};
                __builtin_amdgcn_sched_barrier(0);
            }
    }
};
constexpr float Y_SCALE = ACT_SCALE * WD_SCALE, Y_INV_SCALE = 1.f / Y_SCALE;
struct EpiDown {
    static constexpr int PID = 10, PERM = 2, EARLY = 4;
    static constexpr bool TWICE = false, FP8 = true, I8 = false;
    unsigned char* Y; bf16* O;
    template <int AI>
    __device__ __forceinline__ void half(const f32x4 (&acc)[2][2][4][2], const MoeSched<4, true>::Unit& u, int wr, int wc, int fr, int fq) const {
        const int col0 = u.pn * 256 + wc * 64 + 16 * fq;
        unsigned char* base = u.kind == 0 ? Y + (size_t)(u.blk * 256) * D : (unsigned char*)O + (size_t)(u.pm * 256) * (4 * D) + 2 * D;
        const size_t pitch = u.kind == 0 ? (size_t)D : (size_t)(4 * D);
#pragma unroll
        for (int m = 0; m < 4; ++m) { unsigned char* rowp = base + (size_t)(AI * 128 + wr * 64 + m * 16 + fr) * pitch + col0;
            unsigned w[4];
#pragma unroll
            for (int bj = 0; bj < 2; ++bj)
#pragma unroll
                for (int n = 0; n < 2; ++n) { f32x4 v = acc[AI][bj][m][n];
#pragma unroll
                    for (int j = 0; j < 4; ++j) v[j] = __builtin_amdgcn_fmed3f(v[j], -448.f, 448.f);
                    w[bj * 2 + n] = pk4_fp8(v[0], v[1], v[2], v[3]); }
            *(v4u*)rowp = (v4u){w[0], w[1], w[2], w[3]}; }
    }
    __device__ __forceinline__ void operator()(const f32x4 (&acc)[2][2][4][2], const MoeSched<4, true>::Unit& u, int wr, int wc, int fr, int fq) const { half<1>(acc, u, wr, wc, fr, fq); }
};

struct Args { const float* in[19]; float* out; unsigned char* ws; int ph_lo, ph_hi; };

struct Frame {
    LAS unsigned char* lds; int tid, lane, wave, G, bid;
    float* out; unsigned char* ws;
};

__device__ __forceinline__ void titem_load(const float* W, int N, int kb, int nb, int lane, float (&v)[32]) {
    const float* Wu = W + (size_t)(64 * kb) * N + 32 * nb;
    const unsigned loff = (unsigned)((lane >> 3) * N + (lane & 7) * 4) * 4u;
#pragma unroll
    for (int i = 0; i < 8; ++i) { const f32x4 q = *(const f32x4*)((const char*)(Wu + (size_t)(8 * i) * N) + loff);
        v[4 * i] = q.x; v[4 * i + 1] = q.y; v[4 * i + 2] = q.z; v[4 * i + 3] = q.w; }
}
template <int FP8>
__device__ __forceinline__ void titem_store(const float (&v)[32], int K, void* WTv, int kb, int dst_row0, LAS float* scr, int lane, float wsc = W_SCALE, const float* colq = nullptr) {
    const int k0 = 64 * kb;
#pragma unroll
    for (int i = 0; i < 32; ++i) { const int kk = 8 * (i >> 2) + (lane >> 3); scr[kk * 33 + (lane & 7) * 4 + (i & 3)] = v[i]; }
    asm volatile("s_waitcnt lgkmcnt(0)" ::: "memory");
    const int c = lane & 7;
#pragma unroll
    for (int j = 0; j < 4; ++j) { const int n = (lane >> 3) + 8 * j; const LAS float* s = scr + (8 * c) * 33 + n;
        if (FP8 == 2) { const float qs = colq[dst_row0 + n]; v2u o; o.x = pk4_i8(s[0 * 33] * qs, s[1 * 33] * qs, s[2 * 33] * qs, s[3 * 33] * qs);
            o.y = pk4_i8(s[4 * 33] * qs, s[5 * 33] * qs, s[6 * 33] * qs, s[7 * 33] * qs);
            *(v2u*)((unsigned char*)WTv + (size_t)(dst_row0 + n) * K + k0 + 8 * c) = o; }
        else if (FP8 == 1) { v2u o; o.x = pk4_fp8(s[0 * 33] * wsc, s[1 * 33] * wsc, s[2 * 33] * wsc, s[3 * 33] * wsc);
            o.y = pk4_fp8(s[4 * 33] * wsc, s[5 * 33] * wsc, s[6 * 33] * wsc, s[7 * 33] * wsc);
            *(v2u*)((unsigned char*)WTv + (size_t)(dst_row0 + n) * K + k0 + 8 * c) = o; }
        else { v4u o; o.x = pk2(s[0 * 33], s[1 * 33]); o.y = pk2(s[2 * 33], s[3 * 33]); o.z = pk2(s[4 * 33], s[5 * 33]); o.w = pk2(s[6 * 33], s[7 * 33]);
            *(v4u*)((bf16*)WTv + (size_t)(dst_row0 + n) * K + k0 + 8 * c) = o; } }
    asm volatile("s_waitcnt lgkmcnt(0)" ::: "memory");
}
template <int FP8>
__device__ __forceinline__ void transpose_item(const float* W, int K, int N, void* WT, int kb, int nb, int dst_row0, LAS float* scr, int lane, float wsc = W_SCALE, const float* colq = nullptr) {
    float v[32]; titem_load(W, N, kb, nb, lane, v); titem_store<FP8>(v, K, WT, kb, dst_row0, scr, lane, wsc, colq);
}
template <bool DOWN>
__device__ __forceinline__ void convert_expert(Frame& F, const float* Wa, const float* Wb, unsigned char* dst, int base = 0, int PER_WAVE = (DOWN ? 16 : 32)) {
    LAS float* scr = (LAS float*)(F.lds + F.wave * 16384);
    const int wv = F.wave;
    auto ld = [&](int i, float (&v)[32]) {
        if (!DOWN) titem_load((i >> 4) ? Wb : Wa, FF, i & 15, wv, F.lane, v);
        else titem_load(Wa, D, i >> 2, wv + 8 * (i & 3), F.lane, v); };
    auto st = [&](int i, const float (&v)[32]) {
        if (!DOWN) { const int n0 = wv * 32; titem_store<true>(v, D, dst, i & 15, (n0 >> 7) * 256 + ((i >> 4) ? 128 : 0) + (n0 & 127), scr, F.lane); }
        else titem_store<true>(v, FF, dst, i >> 2, (wv + 8 * (i & 3)) * 32, scr, F.lane, WD_SCALE); };
    float v0[32], v1[32], v2[32], v3[32];
    for (int i = 0; i < PER_WAVE; i += 4) {
        ld(base + i, v0); ld(base + i + 1, v1); ld(base + i + 2, v2); ld(base + i + 3, v3);
        st(base + i, v0); st(base + i + 1, v1); st(base + i + 2, v2); st(base + i + 3, v3);
    }
}

__device__ __forceinline__ void chunk_load(Frame& F, unsigned ch, int wv, float (&v)[32]) {
    if (ch < QG_CHUNKS) { const int e = (int)(ch / GQ), i = (int)(ch % GQ); titem_load(ld_ptr(F.lds, 12) + (size_t)e * D * FF, FF, i, wv, F.lane, v); }
    else { const unsigned c2 = ch - QG_CHUNKS; const int e = (int)(c2 >> 4), i = (int)(c2 & 15); titem_load(ld_ptr(F.lds, 14) + (size_t)e * FF * D, D, i >> 2, wv + 8 * (i & 3), F.lane, v); }
}
__device__ __forceinline__ void chunk_store(Frame& F, unsigned ch, int wv, const float (&v)[32], LAS float* scr) {
    if (ch < QG_CHUNKS) { const int e = (int)(ch / GQ), i = (int)(ch % GQ), n0 = wv * 32;
        titem_store<true>(v, D, F.ws + WS_WGU_T + (size_t)e * 512 * D, i, (n0 >> 7) * 256 + (n0 & 127), scr, F.lane, W_SCALE); }
    else { const unsigned c2 = ch - QG_CHUNKS; const int e = (int)(c2 >> 4), i = (int)(c2 & 15);
        titem_store<true>(v, FF, F.ws + WS_WD_T + (size_t)e * D * FF, i >> 2, (wv + 8 * (i & 3)) * 32, scr, F.lane, WD_SCALE); }
}
__device__ __forceinline__ void convert_chunk(Frame& F, unsigned ch) {
    const int wv = __builtin_amdgcn_readfirstlane(F.wave);
    LAS float* scr = (LAS float*)(F.lds + wv * 16384);
    float va[32];
    chunk_load(F, ch, wv, va);
    chunk_store(F, ch, wv, va, scr);
}
__device__ __forceinline__ void xcd_barrier_work(const XcdBarrier& b, Frame& F, unsigned chunk_end) {
    asm volatile("s_waitcnt vmcnt(0)" ::: "memory");
    __syncthreads();
    volatile LAS unsigned* st = b.st;
    unsigned* bar = b.bar; unsigned* qd = (unsigned*)(F.ws + WS_CTL) + CW_QD;
    if (threadIdx.x == 0) {
        __builtin_amdgcn_s_waitcnt(0);
        unsigned nloc = st[0], nx = st[1];
        if (nloc == 0u) { xcd_barrier_complete(bar, b.x, nloc, nx); st[0] = nloc; st[1] = nx; }
        const unsigned old = xb_add(&bar[XB_XSUB(b.x)], 1u);
        const unsigned gen = old / nloc;
        if (old + 1u == (gen + 1u) * nloc) {
            __builtin_amdgcn_fence(__ATOMIC_RELEASE, "agent");
            asm volatile("s_waitcnt vmcnt(0)" ::: "memory");
            const unsigned og = xb_add(&bar[XB_TOP], 1u);
            const unsigned tg = og / nx;
            if (og + 1u == (tg + 1u) * nx) xb_add(&bar[XB_TOPGEN], 1u);
            else XB_SPIN(xb_ld(&bar[XB_TOPGEN]) == tg, bar);
            __builtin_amdgcn_fence(__ATOMIC_ACQUIRE, "agent");
            xb_add(&bar[XB_XGEN(b.x)], 1u);
            asm volatile("s_waitcnt vmcnt(0)" ::: "memory");
            st[3] = 1u; st[6] = 1u;
        } else { st[2] = gen; st[3] = 0u; st[6] = 0u; }
    }
    __syncthreads();
    unsigned spins = 0;
    if (st[6] == 0u)
    for (;;) {
        if (threadIdx.x == 0) {
            if (xb_ld(&bar[XB_XGEN(b.x)]) != st[2]) st[3] = 1u;
            else { if (st[5] < chunk_end) st[5] = xb_add(qd, 1u);
                if ((++spins & 1023u) == 0u) { if (xb_ld(&bar[XB_TMO])) st[3] = 1u; else if (spins > XB_SPIN_CAP) { atomicAdd(&bar[XB_TMO], 1u); st[3] = 1u; } } }
        }
        __syncthreads();
        if (st[3] != 0u) break;
        const unsigned ch = st[5];
        if (ch < QD_CHUNKS) convert_chunk(F, ch); else __builtin_amdgcn_s_sleep(8);
        __syncthreads();
    }
    if (threadIdx.x == 0 && st[6] == 0u) { __builtin_amdgcn_fence(__ATOMIC_ACQUIRE, "agent"); asm volatile("s_waitcnt vmcnt(0)" ::: "memory"); }
    __syncthreads();
}
__device__ __forceinline__ void drain_queue(Frame& F, unsigned limit) {
    volatile LAS unsigned* MISC = (volatile LAS unsigned*)(F.lds + MISC_OFF); unsigned* qd = (unsigned*)(F.ws + WS_CTL) + CW_QD;
    for (;;) {
        __syncthreads();
        if (threadIdx.x == 0) { const bool more = MISC[13] < limit; MISC[15] = more ? 1u : 0u; if (more) MISC[13] = xb_add(qd, 1u); }
        __syncthreads();
        if (MISC[15] == 0u) break;
        const unsigned ch = MISC[13];
        if (ch < QD_CHUNKS) convert_chunk(F, ch);
        if (ch >= limit) break;
    }
    __syncthreads();
}

__device__ __forceinline__ void p0_prologue(Frame& F) {
#define INP(i) ld_ptr(F.lds, (i))
    for (int job = F.bid; job < 256; job += F.G) {
      __syncthreads();
      if (job < 192) {
        const float* cptr = INP(1); const float* w_ada = INP(2); const float* b_ada = INP(3);
        LAS float* cs = (LAS float*)F.lds;
        LAS float* red = (LAS float*)(F.lds + 32768);
        { float cv[NB * D / NTHREADS];
#pragma unroll
          for (int q = 0; q < NB * D / NTHREADS; ++q) cv[q] = cptr[F.tid + q * NTHREADS];
#pragma unroll
          for (int q = 0; q < NB * D / NTHREADS; ++q) cs[F.tid + q * NTHREADS] = cv[q] / (1.f + __expf(-cv[q])); }
        __syncthreads();
        const int col = F.tid & 31, kg = F.tid >> 5, j = job * 32 + col;
        float a[NB], w[64];
#pragma unroll
        for (int b = 0; b < NB; ++b) a[b] = 0.f;
#pragma unroll
        for (int kk = 0; kk < 64; ++kk) w[kk] = w_ada[(size_t)(kg * 64 + kk) * 6144 + j];
#pragma unroll
        for (int kk = 0; kk < 64; ++kk) {
#pragma unroll
            for (int b = 0; b < NB; ++b) a[b] += cs[b * D + kg * 64 + kk] * w[kk]; }
#pragma unroll
        for (int b = 0; b < NB; ++b) red[(kg * NB + b) * 32 + col] = a[b];
        __syncthreads();
        if (F.tid < 256) { const int b = F.tid >> 5, cc = F.tid & 31; float s = 0.f;
#pragma unroll
            for (int g = 0; g < 16; ++g) s += red[(g * NB + b) * 32 + cc];
            ((float*)(F.ws + WS_MOD))[b * 6144 + job * 32 + cc] = s + b_ada[job * 32 + cc]; }
      } else {
        const float* wi = INP(5); float* colq = (float*)(F.ws + WS_COLSC); LAS float* red = (LAS float*)F.lds;
        const int cb = (job - 192) * 40, col = F.tid % 40, part = F.tid / 40;
        float am = 0.f;
        if (part < 12) {
            float a8[32];
#pragma unroll
            for (int q = 0; q < 32; ++q) a8[q] = 0.f;
            for (int k0 = part; k0 < D; k0 += 384) {
#pragma unroll
                for (int q = 0; q < 32; ++q) { const int k = k0 + 12 * q; const int kc = k < D ? k : part; a8[q] = fmaxf(a8[q], fabsf(wi[(size_t)kc * NPROJ + cb + col])); } }
#pragma unroll
            for (int q = 0; q < 32; ++q) am = fmaxf(am, a8[q]); }
        if (part < 12) red[part * 40 + col] = am;
        __syncthreads();
        if (F.tid < 40) { float m = 0.f; for (int q = 0; q < 12; ++q) m = fmaxf(m, red[q * 40 + F.tid]); colq[cb + F.tid] = 127.f / fmaxf(m, 1e-20f); }
      }
    }
    __syncthreads();
    if (F.bid == F.G - 1) { const float* pw = INP(6); bf16* pwt = (bf16*)(F.ws + WS_PWT);
        float pv[4 * 64 * 64 / NTHREADS];
#pragma unroll
        for (int q = 0; q < 4 * 64 * 64 / NTHREADS; ++q) { const int i = F.tid + q * NTHREADS; const int g = i >> 12, d = (i >> 6) & 63, c = i & 63; pv[q] = pw[(g * 64 + c) * 64 + d]; }
#pragma unroll
        for (int q = 0; q < 4 * 64 * 64 / NTHREADS; ++q) pwt[F.tid + q * NTHREADS] = (bf16)f2bf(pv[q]); }
    LAS float* scr = (LAS float*)(F.lds + F.wave * 16384);
    const int gw = F.bid * NWAVES + F.wave, NGW = F.G * NWAVES;
    constexpr int I_IN = 16 * 80, I_OUT = 8 * 32, I_R = 16 * 8, I_G = 16 * 8, I_D = 4 * 32;
    constexpr int I_SMALL = I_IN + I_OUT + I_R + 2 * I_G + I_D, I_EXP = 2 * I_G + I_D;
    constexpr int NITEMS = I_SMALL;
    unsigned char* win_t = F.ws + WS_WIN_T; bf16* wout_t = (bf16*)(F.ws + WS_WOUT_T); bf16* wr_t = (bf16*)(F.ws + WS_WR_T);
    unsigned char* wsgu_t = F.ws + WS_WSGU_T; unsigned char* wsd_t = F.ws + WS_WSD_T; unsigned char* wgu_t = F.ws + WS_WGU_T; unsigned char* wd_t = F.ws + WS_WD_T;
    for (int it = gw; it < NITEMS; it += NGW) {
        int r = it;
        if (r < I_IN) continue; r -= I_IN;
        if (r < I_OUT) { transpose_item<true>(INP(8), NMIX, D, (unsigned char*)wout_t, r / 32, r % 32, (r % 32) * 32, scr, F.lane); continue; } r -= I_OUT;
        if (r < I_R) { transpose_item<false>(INP(10), D, NE, wr_t, r / 8, r % 8, (r % 8) * 32, scr, F.lane); continue; } r -= I_R;
        const float *Wg, *Wu, *Wd; unsigned char *GU, *DN;
        if (r < 2 * I_G + I_D) { Wg = INP(15); Wu = INP(16); Wd = INP(17); GU = wsgu_t; DN = wsd_t; }
        else { r -= 2 * I_G + I_D; const int e = r / I_EXP; r -= e * I_EXP;
            Wg = INP(12) + (size_t)e * D * FF; Wu = INP(13) + (size_t)e * D * FF; Wd = INP(14) + (size_t)e * FF * D;
            GU = wgu_t + (size_t)e * 512 * D; DN = wd_t + (size_t)e * D * FF; }
        if (r < I_G) { const int nb = r % 8, n0 = nb * 32; transpose_item<true>(Wg, D, FF, GU, r / 8, nb, (n0 >> 7) * 256 + (n0 & 127), scr, F.lane); continue; } r -= I_G;
        if (r < I_G) { const int nb = r % 8, n0 = nb * 32; transpose_item<true>(Wu, D, FF, GU, r / 8, nb, (n0 >> 7) * 256 + 128 + (n0 & 127), scr, F.lane); continue; } r -= I_G;
        transpose_item<true>(Wd, FF, D, DN, r / 32, r % 32, (r % 32) * 32, scr, F.lane, WD_SCALE);
    }
#undef INP
}

__device__ __forceinline__ void win_int8_phase(Frame& F, const float* w_in) {
    __syncthreads();
    LAS float* scr = (LAS float*)(F.lds + F.wave * 16384);
    const float* colq = (const float*)(F.ws + WS_COLSC);
    for (int r = F.bid * NWAVES + F.wave; r < 16 * 80; r += F.G * NWAVES)
        transpose_item<2>(w_in, D, NPROJ, F.ws + WS_WIN_T, r / 80, r % 80, (r % 80) * 32, scr, F.lane, 1.f, colq);
}
template <bool HAS_DX, int OUT8, bool OUTB, int RW = 4>
__device__ __forceinline__ void modnorm_phase(Frame& F, const float* X, const float* g, int shift_chunk, unsigned char* O8, bf16* Ob) {
    const float* mod = (const float*)(F.ws + WS_MOD);
    const unsigned l16 = (unsigned)F.lane * 16u, l8 = (unsigned)F.lane * 8u, l4 = (unsigned)F.lane * 4u;
    const int wv = __builtin_amdgcn_readfirstlane(F.wave);
    for (int blk = F.bid; blk < NT / 128; blk += F.G) {
        const int b = (blk * 128) >> 12;
        const float* sh = mod + (size_t)b * 6144 + shift_chunk * D; const float* sc = sh + D; const float* g1 = mod + (size_t)b * 6144 + 2 * D;
        f32x4 gg[4], ss[4], ga[4];
#pragma unroll
        for (int j = 0; j < 4; ++j) { const f32x4 gv = *(const f32x4*)((const char*)g + 1024 * j + l16), scv = *(const f32x4*)((const char*)sc + 1024 * j + l16);
            gg[j] = gv * (scv + 1.f); ss[j] = *(const f32x4*)((const char*)sh + 1024 * j + l16); ga[j] = HAS_DX ? *(const f32x4*)((const char*)g1 + 1024 * j + l16) : (f32x4){0.f, 0.f, 0.f, 0.f}; }
#pragma nounroll
        for (int rr = 0; rr < 16; rr += RW) {
            const int row = blk * 128 + wv * 16 + rr;
            f32x4 v[RW][4]; v2u dv[RW][4];
#pragma unroll
            for (int q = 0; q < RW; ++q) { const char* xr = (const char*)(X + (size_t)(row + q) * D);
#pragma unroll
                for (int j = 0; j < 4; ++j) v[q][j] = *(const f32x4*)(xr + 1024 * j + l16);
                if (HAS_DX) { const char* dr = (const char*)F.out + (size_t)(row + q) * (4 * D);
#pragma unroll
                    for (int j = 0; j < 4; ++j) dv[q][j] = *(const v2u*)(dr + 512 * j + l8); } }
#pragma unroll
            for (int q = 0; q < RW; ++q) { float s = 0.f;
#pragma unroll
                for (int j = 0; j < 4; ++j) {
                    if (HAS_DX) v[q][j] = v[q][j] + ga[j] * (f32x4){bflo(dv[q][j].x), bfhi(dv[q][j].x), bflo(dv[q][j].y), bfhi(dv[q][j].y)};
                    s += (v[q][j].x * v[q][j].x + v[q][j].y * v[q][j].y) + (v[q][j].z * v[q][j].z + v[q][j].w * v[q][j].w); }
                const float rstd = 1.f / sqrtf(wave_sum(s) * (1.f / D) + NORM_EPS);
                if (HAS_DX) { char* xo = (char*)F.out + (size_t)(row + q) * (4 * D);
#pragma unroll
                    for (int j = 0; j < 4; ++j) *(v2u*)(xo + 512 * j + l8) = (v2u){pk2(v[q][j].x, v[q][j].y), pk2(v[q][j].z, v[q][j].w)}; }
                char* o8 = (char*)O8 + (size_t)(row + q) * D; char* ob = (char*)Ob + (size_t)(row + q) * (2 * D);
                if (OUT8 == 2) {
                    f32x4 y[4]; float am = 0.f;
#pragma unroll
                    for (int j = 0; j < 4; ++j) { y[j] = v[q][j] * rstd * gg[j] + ss[j]; am = fmaxf(am, fmaxf(fmaxf(fabsf(y[j].x), fabsf(y[j].y)), fmaxf(fabsf(y[j].z), fabsf(y[j].w)))); }
                    am = fmaxf(wave_max(am), 1e-20f); const float qs = 127.f / am;
#pragma unroll
                    for (int j = 0; j < 4; ++j) *(unsigned*)(o8 + 256 * j + l4) = pk4_i8(y[j].x * qs, y[j].y * qs, y[j].z * qs, y[j].w * qs);
                    if (F.lane == 0) ((float*)(F.ws + WS_ROWSC))[row + q] = am * (1.f / 127.f);
                } else {
#pragma unroll
                for (int j = 0; j < 4; ++j) { const f32x4 y = v[q][j] * rstd * gg[j] + ss[j]; if (OUT8 == 1) *(unsigned*)(o8 + 256 * j + l4) = pk4_fp8(y.x, y.y, y.z, y.w);
                    if (OUTB) *(v2u*)(ob + 512 * j + l8) = (v2u){pk2(y.x, y.y), pk2(y.z, y.w)}; } }
                __builtin_amdgcn_sched_barrier(0); }
        }
    }
}

constexpr float MIX_SCALE = 16.f;
__device__ __forceinline__ unsigned mix4(float a, float b, float c, float d) {
    return pk4_fp8(__builtin_amdgcn_fmed3f(a * MIX_SCALE, -448.f, 448.f), __builtin_amdgcn_fmed3f(b * MIX_SCALE, -448.f, 448.f), __builtin_amdgcn_fmed3f(c * MIX_SCALE, -448.f, 448.f), __builtin_amdgcn_fmed3f(d * MIX_SCALE, -448.f, 448.f)); }
constexpr int POOL_T = 64, POOL_PITCH = 528;
__device__ __forceinline__ void pool_phase(Frame& F, const float* pool_scale) {
    const bf16* proj = (const bf16*)(F.ws + WS_PROJ); bf16* mixin = (bf16*)(F.ws + WS_MIXIN); const bf16* pwt = (const bf16*)(F.ws + WS_PWT);
    LAS unsigned char* us = F.lds;
    LAS unsigned char* pl = F.lds + 80 * POOL_PITCH;
    const int lane = F.lane, fr = lane & 15, fq = lane >> 4;
    for (int tile = F.bid; tile < NT / POOL_T; tile += F.G) {
        const int row0 = tile * POOL_T, tl0 = row0 & (SEQ - 1);
        __syncthreads();
        {
            constexpr int NP = ((POOL_T + 15) * 32 + NTHREADS - 1) / NTHREADS;
            v4u raw[NP];
#pragma unroll
            for (int i = 0; i < NP; ++i) { const int p = F.tid + i * NTHREADS; const int rr = p >> 5, pc = p & 31; const int tl = tl0 - 15 + rr;
                raw[i] = (v4u){0u, 0u, 0u, 0u};
                if (p < (POOL_T + 15) * 32 && tl >= 0) raw[i] = *(const v4u*)(proj + (size_t)(row0 - 15 + rr) * NPROJ + pc * 8); }
#pragma unroll
            for (int i = 0; i < NP; ++i) { const int p = F.tid + i * NTHREADS; const int rr = p >> 5, pc = p & 31;
                if (p < (POOL_T + 15) * 32) *(LAS v4u*)(us + rr * POOL_PITCH + pc * 16) = raw[i]; }
        }
        __syncthreads();
        {
            const int c8 = F.tid & 31, q = F.tid >> 5, w = 2 << (c8 >> 3);
            float sm[8];
#pragma unroll
            for (int e = 0; e < 8; ++e) sm[e] = 0.f;
            const int i0 = 15 + q * 4;
            for (int k = 0; k < w; ++k) { const v4u r = *(const LAS v4u*)(us + (i0 - k) * POOL_PITCH + c8 * 16);
                sm[0] += bflo(r.x); sm[1] += bfhi(r.x); sm[2] += bflo(r.y); sm[3] += bfhi(r.y); sm[4] += bflo(r.z); sm[5] += bfhi(r.z); sm[6] += bflo(r.w); sm[7] += bfhi(r.w); }
#pragma unroll
            for (int i = 0; i < 4; ++i) { const int tt = q * 4 + i, tl = tl0 + tt;
                const v4u cur = *(const LAS v4u*)(us + (15 + tt) * POOL_PITCH + c8 * 16);
                if (i > 0) { const v4u old = *(const LAS v4u*)(us + (15 + tt - w) * POOL_PITCH + c8 * 16);
                    sm[0] += bflo(cur.x) - bflo(old.x); sm[1] += bfhi(cur.x) - bfhi(old.x); sm[2] += bflo(cur.y) - bflo(old.y); sm[3] += bfhi(cur.y) - bfhi(old.y);
                    sm[4] += bflo(cur.z) - bflo(old.z); sm[5] += bfhi(cur.z) - bfhi(old.z); sm[6] += bflo(cur.w) - bflo(old.w); sm[7] += bfhi(cur.w) - bfhi(old.w); }
                const float ic = 1.f / (float)((tl + 1) < w ? (tl + 1) : w);
                v4u o; o.x = pk2(sm[0] * ic - bflo(cur.x), sm[1] * ic - bfhi(cur.x)); o.y = pk2(sm[2] * ic - bflo(cur.y), sm[3] * ic - bfhi(cur.y));
                o.z = pk2(sm[4] * ic - bflo(cur.z), sm[5] * ic - bfhi(cur.z)); o.w = pk2(sm[6] * ic - bflo(cur.w), sm[7] * ic - bfhi(cur.w));
                *(LAS v4u*)(pl + tt * POOL_PITCH + c8 * 16) = o; }
        }
        __syncthreads();
        {
            const int g = F.wave >> 1, mh = F.wave & 1;
            bf16x8 af[2][2], bfr[4][2];
#pragma unroll
            for (int mt = 0; mt < 2; ++mt)
#pragma unroll
                for (int k = 0; k < 2; ++k) af[mt][k] = *(const LAS bf16x8*)(pl + (32 * mh + 16 * mt + fr) * POOL_PITCH + (g * 64 + k * 32 + fq * 8) * 2);
#pragma unroll
            for (int nt = 0; nt < 4; ++nt)
#pragma unroll
                for (int k = 0; k < 2; ++k) bfr[nt][k] = *(const bf16x8*)(pwt + ((size_t)(g * 64 + nt * 16 + fr) * 64 + k * 32 + fq * 8));
#pragma unroll
            for (int mt = 0; mt < 2; ++mt)
#pragma unroll
                for (int nt = 0; nt < 4; ++nt) { f32x4 acc = (f32x4){0.f, 0.f, 0.f, 0.f};
                    acc = __builtin_amdgcn_mfma_f32_16x16x32_bf16(bfr[nt][0], af[mt][0], acc, 0, 0, 0);
                    acc = __builtin_amdgcn_mfma_f32_16x16x32_bf16(bfr[nt][1], af[mt][1], acc, 0, 0, 0);
                    const int col = g * 64 + nt * 16 + 4 * fq; const f32x4 sc = *(const f32x4*)(pool_scale + col);
                    const f32x4 o = acc * sc;
                    *(unsigned*)((unsigned char*)mixin + (size_t)(row0 + 32 * mh + 16 * mt + fr) * NMIX + col) = mix4(o.x, o.y, o.z, o.w); }
        }
    }
}

constexpr int KV_PITCH = 144;
__device__ __forceinline__ void attn_phase(Frame& F) {
    const bf16* proj = (const bf16*)(F.ws + WS_PROJ);
    bf16* atto = (bf16*)(F.ws + WS_ATTO); float* lse = (float*)(F.ws + WS_LSE);
    LAS unsigned char* Ks = F.lds; LAS unsigned char* Vs = F.lds + 256 * KV_PITCH;
    const int lane = F.lane, fr = lane & 15, fq = lane >> 4, w = F.wave;
    const int w_i0 = 16 * w, c0 = w >> 1, qi = w_i0 + fr;
#define ATT_DECODE(unit_, rowb_, d_, r_, n_, g_, h_, colQ_) \
        const int rn_##unit_ = (unit_) & 31; const int h_ = ((unit_) >> 5) & 3, g_ = ((unit_) >> 7) % 3; const size_t rowb_ = (size_t)((unit_) / 384) * SEQ; \
        const int d_ = 1 << (2 * g_), nbk_##unit_ = 32 >> (2 * g_), r_ = rn_##unit_ / nbk_##unit_, n_ = rn_##unit_ % nbk_##unit_; const int colQ_ = 256 + g_ * 256 + h_ * 64;
    v4u kreg[4], vreg[4]; bf16x8 qn[2];
    {   const int unit0 = F.bid;
        if (unit0 < NB * 3 * 4 * 32) { ATT_DECODE(unit0, rowb, d, r, n, g, h, colQ)
            const size_t qrow = rowb + (size_t)(n * 128 + qi) * d + r;
#pragma unroll
            for (int ks = 0; ks < 2; ++ks) qn[ks] = *(const bf16x8*)(proj + qrow * NPROJ + colQ + ks * 32 + fq * 8);
#pragma unroll
            for (int cidx = 0; cidx < 4; ++cidx) { const int ch = F.tid + 512 * cidx, j = ch >> 3, pc = ch & 7;
                int p = (n - 1) * 128 + j; p = p < 0 ? 0 : p; const size_t row = rowb + (size_t)p * d + r;
                kreg[cidx] = *(const v4u*)(proj + row * NPROJ + colQ + 768 + pc * 8); vreg[cidx] = *(const v4u*)(proj + row * NPROJ + colQ + 1536 + pc * 8); } } }
    v2u po[4]; float plse = 0.f; bf16* pop = atto; float* plp = lse; bool phave = false;
#pragma unroll
    for (int eb = 0; eb < 4; ++eb) po[eb] = (v2u){0u, 0u};
    for (int unit = F.bid; unit < NB * 3 * 4 * 32; unit += F.G) {
        ATT_DECODE(unit, rowb, d, r, n, g, h, colQ)
        __syncthreads();
#pragma unroll
        for (int cidx = 0; cidx < 4; ++cidx) { const int ch = F.tid + 512 * cidx, j = ch >> 3, pc = ch & 7;
            *(LAS v4u*)(Ks + j * KV_PITCH + pc * 16) = kreg[cidx]; *(LAS v4u*)(Vs + j * KV_PITCH + pc * 16) = vreg[cidx]; }
        const size_t qrow = rowb + (size_t)(n * 128 + qi) * d + r;
        bf16x8 qf[2]; qf[0] = qn[0]; qf[1] = qn[1];
        if (phave) {
#pragma unroll
            for (int eb = 0; eb < 4; ++eb) *(v2u*)(pop + 16 * eb) = po[eb];
            if (fq == 0) *plp = plse; }
        __syncthreads();
        {   const int unit2 = unit + F.G;
            if (unit2 < NB * 3 * 4 * 32) { ATT_DECODE(unit2, rowb2, d2, r2, n2, g2, h2, colQ2)
                const size_t qrow2 = rowb2 + (size_t)(n2 * 128 + qi) * d2 + r2;
#pragma unroll
                for (int ks = 0; ks < 2; ++ks) qn[ks] = *(const bf16x8*)(proj + qrow2 * NPROJ + colQ2 + ks * 32 + fq * 8);
#pragma unroll
                for (int cidx = 0; cidx < 4; ++cidx) { const int ch = F.tid + 512 * cidx, j = ch >> 3, pc = ch & 7;
                    int p = (n2 - 1) * 128 + j; p = p < 0 ? 0 : p; const size_t row = rowb2 + (size_t)p * d2 + r2;
                    kreg[cidx] = *(const v4u*)(proj + row * NPROJ + colQ2 + 768 + pc * 8); vreg[cidx] = *(const v4u*)(proj + row * NPROJ + colQ2 + 1536 + pc * 8); } } }
        f32x4 s[5][2];
#pragma unroll
        for (int cc = 0; cc < 5; ++cc)
#pragma unroll
            for (int hh = 0; hh < 2; ++hh) {
                const int j = 32 * (c0 + cc) + 8 * (fr >> 2) + 4 * hh + (fr & 3);
                const bf16x8 k0 = *(const LAS bf16x8*)(Ks + j * KV_PITCH + fq * 16), k1 = *(const LAS bf16x8*)(Ks + j * KV_PITCH + 64 + fq * 16);
                f32x4 a = (f32x4){0.f, 0.f, 0.f, 0.f};
                a = __builtin_amdgcn_mfma_f32_16x16x32_bf16(k0, qf[0], a, 0, 0, 0);
                a = __builtin_amdgcn_mfma_f32_16x16x32_bf16(k1, qf[1], a, 0, 0, 0);
                s[cc][hh] = a;
            }
        float mx = -1e30f;
        int qil = qi; asm volatile("" : "+v"(qil));
#pragma unroll
        for (int cc = 0; cc < 5; ++cc)
#pragma unroll
            for (int hh = 0; hh < 2; ++hh)
#pragma unroll
                for (int rr = 0; rr < 4; ++rr) { const int j = 32 * (c0 + cc) + 8 * fq + 4 * hh + rr; const int dist = 128 + qil - j;
                    const bool valid = (dist >= 0) && (dist <= 128) && (n > 0 || j >= 128);
                    const float v = valid ? s[cc][hh][rr] * 0.18033688f : -1e30f; s[cc][hh][rr] = v; mx = fmaxf(mx, v); }
        mx = fmaxf(mx, __shfl_xor(mx, 16)); mx = fmaxf(mx, __shfl_xor(mx, 32));
        float l = 0.f;
#pragma unroll
        for (int cc = 0; cc < 5; ++cc)
#pragma unroll
            for (int hh = 0; hh < 2; ++hh)
#pragma unroll
                for (int rr = 0; rr < 4; ++rr) { const float p = __builtin_amdgcn_exp2f(s[cc][hh][rr] - mx); s[cc][hh][rr] = p; l += p; }
        l += __shfl_xor(l, 16); l += __shfl_xor(l, 32);
        f32x4 o[4];
#pragma unroll
        for (int eb = 0; eb < 4; ++eb) o[eb] = (f32x4){0.f, 0.f, 0.f, 0.f};
#pragma unroll
        for (int cc = 0; cc < 5; ++cc) {
            const v4u pu = (v4u){pk2(s[cc][0][0], s[cc][0][1]), pk2(s[cc][0][2], s[cc][0][3]), pk2(s[cc][1][0], s[cc][1][1]), pk2(s[cc][1][2], s[cc][1][3])};
            const bf16x8 pf = __builtin_bit_cast(bf16x8, pu);
            const int key0 = 32 * (c0 + cc) + 8 * fq + (fr >> 2);
#pragma unroll
            for (int eb = 0; eb < 4; ++eb) {
                const LAS unsigned char* vp = Vs + key0 * KV_PITCH + (16 * eb + 4 * (fr & 3)) * 2;
                const s16x4 lo = __builtin_bit_cast(s16x4, __builtin_amdgcn_ds_read_tr16_b64_v4i16((LAS s16x4*)vp));
                const s16x4 hi = __builtin_bit_cast(s16x4, __builtin_amdgcn_ds_read_tr16_b64_v4i16((LAS s16x4*)(vp + 4 * KV_PITCH)));
                const bf16x8 vf = (bf16x8){lo[0], lo[1], lo[2], lo[3], hi[0], hi[1], hi[2], hi[3]};
                o[eb] = __builtin_amdgcn_mfma_f32_16x16x32_bf16(vf, pf, o[eb], 0, 0, 0);
            }
        }
        const float il = 1.f / l;
        pop = atto + ((size_t)g * NT + qrow) * 256 + h * 64 + 4 * fq; plp = lse + ((size_t)g * NT + qrow) * 4 + h; phave = true;
#pragma unroll
        for (int eb = 0; eb < 4; ++eb) { const f32x4 v = o[eb] * il; po[eb] = (v2u){pk2(v.x, v.y), pk2(v.z, v.w)}; }
        plse = mx + __builtin_amdgcn_logf(l);
    }
    if (phave) {
#pragma unroll
        for (int eb = 0; eb < 4; ++eb) *(v2u*)(pop + 16 * eb) = po[eb];
        if (fq == 0) *plp = plse; }
#undef ATT_DECODE
}

__device__ __forceinline__ void combine_phase(Frame& F) {
    const bf16* atto = (const bf16*)(F.ws + WS_ATTO); const float* lse = (const float*)(F.ws + WS_LSE); bf16* mixin = (bf16*)(F.ws + WS_MIXIN);
    constexpr int CU_ = 4;
    const size_t stride = (size_t)F.G * NTHREADS;
    for (size_t idx0 = (size_t)F.bid * NTHREADS + F.tid; idx0 < (size_t)NT * 32; idx0 += CU_ * stride) {
        float l[CU_][3]; v4u a[CU_][3]; bool ok[CU_];
#pragma unroll
        for (int u = 0; u < CU_; ++u) { const size_t idx = idx0 + u * stride; ok[u] = idx < (size_t)NT * 32; const size_t ic = ok[u] ? idx : idx0;
            const size_t t = ic >> 5; const int pc = (int)(ic & 31), h = pc >> 3;
#pragma unroll
            for (int g = 0; g < 3; ++g) { l[u][g] = lse[(g * (size_t)NT + t) * 4 + h]; a[u][g] = *(const v4u*)(atto + (g * (size_t)NT + t) * 256 + pc * 8); } }
#pragma unroll
        for (int u = 0; u < CU_; ++u) { const size_t idx = idx0 + u * stride; const size_t t = idx >> 5; const int pc = (int)(idx & 31);
            const float l0 = l[u][0], l1 = l[u][1], l2 = l[u][2];
            const float m = fmaxf(l0, fmaxf(l1, l2));
            float a0 = __builtin_amdgcn_exp2f(l0 - m), a1 = __builtin_amdgcn_exp2f(l1 - m), a2 = __builtin_amdgcn_exp2f(l2 - m);
            const float inv = 1.f / (a0 + a1 + a2); a0 *= inv; a1 *= inv; a2 *= inv;
            const v4u v0 = a[u][0], v1 = a[u][1], v2 = a[u][2];
            v2u o;
            o.x = mix4(a0 * bflo(v0.x) + a1 * bflo(v1.x) + a2 * bflo(v2.x), a0 * bfhi(v0.x) + a1 * bfhi(v1.x) + a2 * bfhi(v2.x),
                       a0 * bflo(v0.y) + a1 * bflo(v1.y) + a2 * bflo(v2.y), a0 * bfhi(v0.y) + a1 * bfhi(v1.y) + a2 * bfhi(v2.y));
            o.y = mix4(a0 * bflo(v0.z) + a1 * bflo(v1.z) + a2 * bflo(v2.z), a0 * bfhi(v0.z) + a1 * bfhi(v1.z) + a2 * bfhi(v2.z),
                       a0 * bflo(v0.w) + a1 * bflo(v1.w) + a2 * bflo(v2.w), a0 * bfhi(v0.w) + a1 * bfhi(v1.w) + a2 * bfhi(v2.w));
            if (ok[u]) *(v2u*)((unsigned char*)mixin + t * NMIX + 256 + pc * 8) = o; }
    }
}

#if MK_NAIVE_ATTN
__device__ __forceinline__ void naive_attn_phase(Frame& F) {
    const bf16* proj = (const bf16*)(F.ws + WS_PROJ); bf16* mixin = (bf16*)(F.ws + WS_MIXIN);
    for (size_t idx = (size_t)F.bid * NTHREADS + F.tid; idx < (size_t)NT * 4; idx += (size_t)F.G * NTHREADS) {
        const size_t tg = idx >> 2; const int h = (int)(idx & 3), t = (int)(tg & (SEQ - 1)); const size_t rowb = tg - t;
        float m = -1e30f, l = 0.f, o[64];
        for (int e = 0; e < 64; ++e) o[e] = 0.f;
        for (int g = 0; g < 3; ++g) { const int d = 1 << (2 * g); const int colQ = 256 + g * 256 + h * 64;
            const bf16* q = proj + tg * NPROJ + colQ;
            for (int j = 0; j <= 128; ++j) { const int tk = t - j * d; if (tk < 0) break;
                const bf16* k = proj + (rowb + tk) * NPROJ + colQ + 768; const bf16* v = k + 768;
                float sdot = 0.f; for (int e = 0; e < 64; ++e) sdot += bf2f(q[e]) * bf2f(k[e]);
                sdot *= 0.125f;
                const float mn = fmaxf(m, sdot), corr = __expf(m - mn), p = __expf(sdot - mn);
                l = l * corr + p; for (int e = 0; e < 64; ++e) o[e] = o[e] * corr + p * bf2f(v[e]); m = mn; } }
        const float il = 1.f / l;
        for (int e = 0; e < 64; ++e) mixin[tg * NMIX + 256 + h * 64 + e] = (bf16)f2bf(o[e] * il);
    }
}
#endif

__device__ __forceinline__ void routing_phase(Frame& F, const float* router_bias) {
    const float* L0 = (const float*)(F.ws + WS_LOGIT);
    float* gatew = (float*)(F.ws + WS_GATEW); unsigned* bucket = (unsigned*)(F.ws + WS_BUCKET); unsigned* gcnt = (unsigned*)(F.ws + WS_CTL) + CW_GCNT;
    LAS unsigned* hist = (LAS unsigned*)F.lds; LAS unsigned* basel = hist + 256; LAS unsigned* asg = hist + 512;
    LAS float* gwl = (LAS float*)(hist + 1536);
    const int lane = F.lane;
    for (int blk = F.bid; blk < NT / 128; blk += F.G) {
        __syncthreads();
        if (F.tid < 256) hist[F.tid] = 0u;
        __syncthreads();
        const f32x4 bias = *(const f32x4*)(router_bias + 4 * lane);
        f32x4 lgn; { const size_t t0 = (size_t)blk * 128 + F.wave * 16; lgn = *(const f32x4*)(L0 + t0 * NE + 4 * lane); }
#pragma nounroll
        for (int tl = 0; tl < 16; ++tl) {
            const int tloc = F.wave * 16 + tl; const size_t t = (size_t)blk * 128 + tloc;
            const f32x4 lg = lgn;
            if (tl + 1 < 16) lgn = *(const f32x4*)(L0 + (t + 1) * NE + 4 * lane);
            float sc[4], cd[4];
#pragma unroll
            for (int i = 0; i < 4; ++i) { sc[i] = 1.f / (1.f + __expf(-lg[i])); cd[i] = sc[i] + bias[i]; }
            float a1 = fmaxf(cd[0], cd[1]), a2 = fminf(cd[0], cd[1]);
#pragma unroll
            for (int i = 2; i < 4; ++i) { const float v = cd[i]; a2 = fmaxf(a2, fminf(a1, v)); a1 = fmaxf(a1, v); }
            { float b1 = dppf<0xB1>(a1), b2 = dppf<0xB1>(a2); float n1 = fmaxf(a1, b1), n2 = fmaxf(fminf(a1, b1), fmaxf(a2, b2)); a1 = n1; a2 = n2;
              b1 = dppf<0x4E>(a1); b2 = dppf<0x4E>(a2); n1 = fmaxf(a1, b1); n2 = fmaxf(fminf(a1, b1), fmaxf(a2, b2)); a1 = n1; a2 = n2;
              b1 = dppf<0x141>(a1); b2 = dppf<0x141>(a2); n1 = fmaxf(a1, b1); n2 = fmaxf(fminf(a1, b1), fmaxf(a2, b2)); a1 = n1; a2 = n2; }
            const float gs = a1 + a2; const int myg = lane >> 3; int rank = 0;
#pragma unroll
            for (int gg = 0; gg < 8; ++gg) { const float o = __builtin_bit_cast(float, __builtin_amdgcn_readlane(__builtin_bit_cast(int, gs), gg * 8)); rank += (o > gs || (o == gs && gg < myg)) ? 1 : 0; }
            if (rank >= 4) {
#pragma unroll
                for (int i = 0; i < 4; ++i) cd[i] = -1e30f; }
            int sel_e = 0; float sel_s = 0.f, ssum = 0.f;
#pragma unroll
            for (int k = 0; k < TOPK; ++k) {
                const float lm = fmaxf(fmaxf(cd[0], cd[1]), fmaxf(cd[2], cd[3]));
                float v = fmaxf(lm, dppf<0xB1>(lm)); v = fmaxf(v, dppf<0x4E>(v)); v = fmaxf(v, dppf<0x141>(v)); v = fmaxf(v, dppf<0x140>(v));
                const float r0 = __builtin_bit_cast(float, __builtin_amdgcn_readlane(__builtin_bit_cast(int, v), 0)), r1 = __builtin_bit_cast(float, __builtin_amdgcn_readlane(__builtin_bit_cast(int, v), 16));
                const float r2 = __builtin_bit_cast(float, __builtin_amdgcn_readlane(__builtin_bit_cast(int, v), 32)), r3 = __builtin_bit_cast(float, __builtin_amdgcn_readlane(__builtin_bit_cast(int, v), 48));
                const float mx = fmaxf(fmaxf(r0, r1), fmaxf(r2, r3));
                const unsigned long long msk = __ballot(lm == mx);
                const int own = __builtin_ffsll((long long)msk) - 1;
                const int bi = cd[0] == mx ? 0 : (cd[1] == mx ? 1 : (cd[2] == mx ? 2 : 3));
                float myv = sc[0]; myv = bi == 1 ? sc[1] : myv; myv = bi == 2 ? sc[2] : myv; myv = bi == 3 ? sc[3] : myv;
                const int wi = __builtin_amdgcn_readlane(bi, own);
                const float sv = __builtin_bit_cast(float, __builtin_amdgcn_readlane(__builtin_bit_cast(int, myv), own));
                if (lane == own) {
#pragma unroll
                    for (int i = 0; i < 4; ++i) if (wi == i) cd[i] = -1e30f; }
                ssum += sv;
                if (lane == k) { sel_e = 4 * own + wi; sel_s = sv; }
            }
            if (lane < TOPK) {
                const unsigned rk = __hip_atomic_fetch_add(hist + sel_e, 1u, __ATOMIC_RELAXED, __HIP_MEMORY_SCOPE_WORKGROUP);
                asg[tloc * 8 + lane] = (unsigned)sel_e | (rk << 16);
                gwl[tloc * 8 + lane] = sel_s / ssum * 2.5f;
            }
        }
        __syncthreads();
        if (F.tid < 256) { const unsigned c = hist[F.tid]; basel[F.tid] = c ? atomicAdd(&gcnt[F.tid * 16], c) : 0u; }
        __syncthreads();
        for (int a = F.tid; a < 1024; a += NTHREADS) { const unsigned v = asg[a], e = v & 0xffffu, rk = v >> 16;
            bucket[(size_t)e * CAP + basel[e] + rk] = (unsigned)(blk * 1024 + a); gatew[(size_t)blk * 1024 + a] = gwl[a]; }
    }
}

__device__ __forceinline__ void build_tables(Frame& F, int& nblk_total) {
    const unsigned* gcnt = (const unsigned*)(F.ws + WS_CTL) + CW_GCNT;
    LAS int* prefix = (LAS int*)(F.lds + TAB_OFF); LAS int* cnt = prefix + 260;
    __syncthreads();
    if (F.tid < 256) cnt[F.tid] = (int)__hip_atomic_load(&gcnt[F.tid * 16], __ATOMIC_RELAXED, __HIP_MEMORY_SCOPE_AGENT);
    __syncthreads();
    if (F.tid < 64) {
        int nb[4], sm = 0;
#pragma unroll
        for (int i = 0; i < 4; ++i) { nb[i] = (cnt[4 * F.tid + i] + 255) >> 8; sm += nb[i]; }
        int inc = sm;
#pragma unroll
        for (int o = 1; o < 64; o <<= 1) { const int t = __shfl_up(inc, o); if (F.tid >= o) inc += t; }
        int ex = inc - sm;
#pragma unroll
        for (int i = 0; i < 4; ++i) { prefix[4 * F.tid + i] = ex; ex += nb[i]; }
        if (F.tid == 63) prefix[NE] = inc;
    }
    __syncthreads();
    if (F.tid < 256) { LAS unsigned char* b2e = (LAS unsigned char*)(cnt + 256); for (int b = prefix[F.tid]; b < prefix[F.tid + 1]; ++b) b2e[b] = (unsigned char)F.tid; }
    __syncthreads();
    nblk_total = prefix[NE];
}

__device__ __forceinline__ void final_phase(Frame& F, const float* g_final) {
    const float* mod = (const float*)(F.ws + WS_MOD); const unsigned char* Y = (const unsigned char*)(F.ws + WS_Y);
    const unsigned* pos = (const unsigned*)(F.ws + WS_POS); const float* gatew = (const float*)(F.ws + WS_GATEW);
    const int c0 = 16 * F.lane;
    for (int blk = F.bid; blk < NT / 128; blk += F.G) {
        const int b = (blk * 128) >> 12; const float* g2 = mod + (size_t)b * 6144 + 5 * D + c0;
        f32x4 gb[4];
#pragma unroll
        for (int j = 0; j < 4; ++j) gb[j] = *(const f32x4*)(g2 + 4 * j);
        const size_t rowbase = (size_t)blk * 128 + F.wave * 16;
        const unsigned p0 = pos[rowbase * 8 + F.lane], p1 = pos[rowbase * 8 + 64 + F.lane];
        const float w0 = gatew[rowbase * 8 + F.lane] * Y_INV_SCALE, w1 = gatew[rowbase * 8 + 64 + F.lane] * Y_INV_SCALE;
        f32x4 gf[4];
#pragma unroll
        for (int j = 0; j < 4; ++j) gf[j] = *(const f32x4*)(g_final + c0 + 4 * j);
        asm volatile("" :: "v"(p0), "v"(p1), "v"(w0), "v"(w1), "v"(gf[0]), "v"(gf[1]), "v"(gf[2]), "v"(gf[3]), "v"(gb[0]), "v"(gb[1]), "v"(gb[2]), "v"(gb[3]));
#define FIN_LOAD(RR, XV, SV, YV, WK) do { const size_t row_ = rowbase + (RR); \
            const v4u* dr_ = (const v4u*)((const bf16*)F.out + row_ * (2 * D) + c0); \
            XV[0] = dr_[0]; XV[1] = dr_[1]; SV = *(const v4u*)((const unsigned char*)F.out + row_ * (4 * D) + 2 * D + c0); \
            _Pragma("unroll") for (int k = 0; k < TOPK; ++k) { const int idx = (RR) * 8 + k; \
                const unsigned pk = (unsigned)__builtin_amdgcn_readlane((int)(idx < 64 ? p0 : p1), idx & 63); \
                WK[k] = __builtin_bit_cast(float, __builtin_amdgcn_readlane(__builtin_bit_cast(int, idx < 64 ? w0 : w1), idx & 63)); \
                YV[k] = *(const v4u*)(Y + (size_t)pk * D + c0); } } while (0)
#define FIN_ROW(RR, XV, SV, YV, WK) do { const size_t row_ = rowbase + (RR); \
            f32x4 v[4]; float s = 0.f; \
            _Pragma("unroll") for (int j = 0; j < 4; ++j) { \
                const auto slo = __builtin_amdgcn_cvt_pk_f32_fp8((int)SV[j], false), shi = __builtin_amdgcn_cvt_pk_f32_fp8((int)SV[j], true); \
                f32x4 r = (f32x4){slo[0], slo[1], shi[0], shi[1]} * Y_INV_SCALE; \
                _Pragma("unroll") for (int k = 0; k < TOPK; ++k) { const int wd = (int)YV[k][j]; \
                    const auto lo = __builtin_amdgcn_cvt_pk_f32_fp8(wd, false), hi = __builtin_amdgcn_cvt_pk_f32_fp8(wd, true); \
                    r += WK[k] * (f32x4){lo[0], lo[1], hi[0], hi[1]}; } \
                const unsigned xw0 = XV[j >> 1][(j & 1) * 2], xw1 = XV[j >> 1][(j & 1) * 2 + 1]; \
                v[j] = (f32x4){bflo(xw0), bfhi(xw0), bflo(xw1), bfhi(xw1)} + gb[j] * r; \
                s += (v[j].x * v[j].x + v[j].y * v[j].y) + (v[j].z * v[j].z + v[j].w * v[j].w); } \
            const float rstd = 1.f / sqrtf(wave_sum(s) * (1.f / D) + NORM_EPS); \
            f32x4* orow = (f32x4*)(F.out + row_ * D + c0); \
            _Pragma("unroll") for (int j = 0; j < 4; ++j) orow[j] = v[j] * rstd * gf[j]; } while (0)
#pragma nounroll
        for (int rr = 0; rr < 16; rr += 2) {
            v4u xa[2], sa, ya[TOPK], xb[2], sb, yb[TOPK]; float wa[TOPK], wb[TOPK];
            FIN_LOAD(rr, xa, sa, ya, wa);
            FIN_LOAD(rr + 1, xb, sb, yb, wb);
            FIN_ROW(rr, xa, sa, ya, wa);
            FIN_ROW(rr + 1, xb, sb, yb, wb);
        }
#undef FIN_LOAD
#undef FIN_ROW
    }
}

constexpr int N_PHASES = 12;
__global__ void __launch_bounds__(NTHREADS, 2) fwd(Args args) {
    extern __shared__ __attribute__((aligned(16))) unsigned char lds_raw[];
    Frame F;
    F.lds = (LAS unsigned char*)lds_raw;
    F.tid = threadIdx.x; F.lane = F.tid & 63; F.wave = __builtin_amdgcn_readfirstlane(F.tid >> 6); F.G = gridDim.x; F.bid = blockIdx.x;
#define INP(i) ld_ptr(F.lds, (i))
    F.out = args.out; F.ws = args.ws;
    unsigned char* ws = args.ws;
    volatile LAS unsigned* MISC = (volatile LAS unsigned*)(F.lds + MISC_OFF);
    if (F.tid < 16) MISC[F.tid] = 0u;
    if (F.tid == 0) { LAS unsigned long long* pt = (LAS unsigned long long*)(F.lds + PT_OFF);
#pragma unroll
        for (int i = 0; i < 19; ++i) pt[i] = (unsigned long long)args.in[i]; }
    __syncthreads();
    const int lo = args.ph_lo, hi = args.ph_hi;
    XcdBarrier bar; bar.bar = (unsigned*)(ws + WS_CTL) + CW_BAR; bar.x = 0; bar.st = nullptr;
    if (hi - lo > 1) bar = xcd_barrier_post((unsigned*)(ws + WS_CTL) + CW_BAR, MISC + 8);
#ifndef PH_MASK
#define PH_MASK 0xfff
#endif
#define IN(k) (((PH_MASK >> (k)) & 1) && lo <= (k) && (k) < hi)
#if MK_PROBE >= 1000
#define PH_T0(k) unsigned long long _pt##k = 0; if (MK_PROBE == 1000 + (k)) _pt##k = __builtin_amdgcn_s_memrealtime();
#define PH_T1(k) if (MK_PROBE == 1000 + (k) && blockIdx.x == MK_PROBE_BLK && F.tid == 0) MISC[12] += (unsigned)(__builtin_amdgcn_s_memrealtime() - _pt##k);
#else
#define PH_T0(k)
#define PH_T1(k)
#endif
#if MK_PROBE >= 2000
#define SEAM_T0() const unsigned long long _st0 = __builtin_amdgcn_s_memrealtime();
#ifndef MK_SEAM_MASK
#define MK_SEAM_MASK 0
#endif
#define SEAM_T1(k) if ((MK_PROBE == 2000 || MK_PROBE == 2001 + (k) || (MK_PROBE == 2100 && ((MK_SEAM_MASK >> (k)) & 1))) && blockIdx.x == MK_PROBE_BLK && F.tid == 0) MISC[12] += (unsigned)(__builtin_amdgcn_s_memrealtime() - _st0);
#else
#define SEAM_T0()
#define SEAM_T1(k)
#endif
#define SEAM(k) do { SEAM_T0() if (IN(k) && IN((k) + 1)) { if ((k) <= 8) xcd_barrier_work(bar, F, QD_CHUNKS); else xcd_barrier(bar); } SEAM_T1(k) { int _t = threadIdx.x; asm volatile("" : "+v"(_t)); F.tid = _t; F.lane = _t & 63; } } while (0)

    const int vcu = (F.G % 8 == 0) ? (F.bid % 8) * (F.G / 8) + F.bid / 8 : F.bid;
    unsigned char* h8 = ws + WS_H;
    bf16* h2b = (bf16*)(ws + WS_H2B); bf16* proj = (bf16*)(ws + WS_PROJ); bf16* mixin = (bf16*)(ws + WS_MIXIN);

    PH_T0(0) if (IN(0)) { p0_prologue(F); } PH_T1(0) SEAM(0);
    PH_T0(1) if (IN(1)) { modnorm_phase<false, 2, false, 8>(F, INP(0), INP(4), 0, h8, nullptr); win_int8_phase(F, INP(5)); } PH_T1(1) SEAM(1);
    PH_T0(2) if (IN(2)) {
        typedef DenseSchedT<NT / 256, NPROJ / 256, 1> SchedP2; SchedP2 S; S.init(h8, ws + WS_WIN_T, D / 2, D / 2, 0, F.G, F.bid);
        EpiProj E{proj, (const float*)(ws + WS_ROWSC), (const float*)(ws + WS_COLSC)};
        const int ksplit = vcu % 6;
        S.i0 = 0; S.i1 = ksplit;
        gemm_phase<EpiProj, SchedP2>(F.lds, D / 2, D / 2, S, E);
        __syncthreads();
        for (int e = F.bid; e < NE; e += F.G)
            convert_expert<false>(F, INP(12) + (size_t)e * D * FF, INP(13) + (size_t)e * D * FF, ws + WS_WGU_T + (size_t)e * 512 * D, GQ, 32 - GQ);
        __syncthreads();
        S.i0 = ksplit; S.i1 = 0x3fffffff;
        gemm_phase<EpiProj, SchedP2>(F.lds, D / 2, D / 2, S, E);
    } PH_T1(2) SEAM(2);
    PH_T0(3) if (IN(3)) {
#if MK_PROBE == 1103
        const unsigned long long _pp0 = __builtin_amdgcn_s_memrealtime();
#endif
        pool_phase(F, INP(7));
#if MK_PROBE == 1103
        if (blockIdx.x == MK_PROBE_BLK && F.tid == 0) MISC[12] += (unsigned)(__builtin_amdgcn_s_memrealtime() - _pp0);
#endif
#if MK_NAIVE_ATTN
        naive_attn_phase(F);
#else
        attn_phase(F);
#endif
    } PH_T1(3) SEAM(3);
    PH_T0(4) if (IN(4)) {
#if !MK_NAIVE_ATTN
        combine_phase(F);
#endif
    } PH_T1(4) SEAM(4);
    PH_T0(5) if (IN(5)) {
        typedef DenseSchedT<NT / 256, D / 256, 1> SchedP5; SchedP5 S; S.init(mixin, ws + WS_WOUT_T, NMIX / 2, NMIX / 2, 0, F.G, F.bid);
        EpiOut E{(bf16*)F.out};
        gemm_phase<EpiOut, SchedP5>(F.lds, NMIX / 2, NMIX / 2, S, E);
    } PH_T1(5) SEAM(5);
    PH_T0(6) if (IN(6)) { modnorm_phase<true, 1, true>(F, INP(0), INP(9), 3, h8, h2b); } PH_T1(6) SEAM(6);
    PH_T0(7) if (IN(7)) {
        typedef DenseSchedT<NT / 256, NE / 256, 1> SchedP7; SchedP7 S; S.init(h2b, ws + WS_WR_T, D, D, 0, F.G, F.bid);
        EpiRouter E{(float*)(ws + WS_LOGIT)};
        gemm_phase<EpiRouter, SchedP7>(F.lds, D, D, S, E);
    } PH_T1(7) SEAM(7);
    PH_T0(8) if (IN(8)) { routing_phase(F, INP(11)); drain_queue(F, QG_CHUNKS); } PH_T1(8) SEAM(8);
    PH_T0(9) if (IN(9)) {
        int nblk; build_tables(F, nblk);
        MoeSched<2, false> S; S.prefix = (const LAS int*)(F.lds + TAB_OFF); S.cnt = S.prefix + 260; S.bucket = (const unsigned*)(ws + WS_BUCKET);
        S.Ar = (const char*)h8; S.As = (const char*)h8; S.Br = (const char*)(ws + WS_WGU_T); S.Bs = (const char*)(ws + WS_WSGU_T);
        S.nRouted = nblk * 2; S.total = S.nRouted + (NT / 256) * 2; S.G = F.G; S.c = vcu;
        EpiGU E{ws + WS_ACT, ws + WS_ACTS, (const unsigned*)(ws + WS_BUCKET), (unsigned*)(ws + WS_POS)};
        S.i0 = 0; S.i1 = 0x3fffffff; S.otab = (const LAS unsigned*)(F.lds + OTAB_OFF);
        S.fill_otab((LAS unsigned*)(F.lds + OTAB_OFF), F.tid);
        for (int e = F.bid; e < NE; e += F.G) {
            const int c = S.cnt[e], base = S.prefix[e] * 256; const unsigned* be = (const unsigned*)(ws + WS_BUCKET) + (size_t)e * CAP; unsigned* pos = (unsigned*)(ws + WS_POS);
            for (int sidx = F.tid; sidx < c; sidx += NTHREADS) pos[be[sidx]] = (unsigned)(base + sidx); }
        __syncthreads();
        gemm_phase<EpiGU, MoeSched<2, false>>(F.lds, D / 2, D / 2, S, E);
        drain_queue(F, QD_CHUNKS);
    } PH_T1(9) SEAM(9);
    PH_T0(10) if (IN(10)) {
        int nblk; build_tables(F, nblk);
        MoeSched<4, true> S; S.prefix = (const LAS int*)(F.lds + TAB_OFF); S.cnt = S.prefix + 260; S.bucket = (const unsigned*)(ws + WS_BUCKET);
        S.Ar = (const char*)(ws + WS_ACT); S.As = (const char*)(ws + WS_ACTS); S.Br = (const char*)(ws + WS_WD_T); S.Bs = (const char*)(ws + WS_WSD_T);
        S.nRouted = nblk * 4; S.total = S.nRouted + (NT / 256) * 4; S.G = F.G; S.c = vcu; S.i0 = 0; S.i1 = 0x3fffffff;
        EpiDown E{(unsigned char*)(ws + WS_Y), (bf16*)F.out};
        gemm_phase<EpiDown, MoeSched<4, true>>(F.lds, FF / 2, FF / 2, S, E);
    } PH_T1(10) SEAM(10);
    PH_T0(11) if (IN(11)) { final_phase(F, INP(18)); } PH_T1(11)
#if MK_PROBE
    if (blockIdx.x == MK_PROBE_BLK) { __syncthreads();
        if (F.tid == 0) { const unsigned long long span = (unsigned long long)MISC[12] * MK_PROBE_MULT, t0 = __builtin_amdgcn_s_memrealtime();
            while (__builtin_amdgcn_s_memrealtime() - t0 < span) __builtin_amdgcn_s_sleep(16); } }
#endif
#undef IN
#undef SEAM
#undef INP
}

extern "C" void kernel_launch(void* const* d_in, const int* in_sizes, int n_in, void* d_out, int out_size, void* d_ws, size_t ws_size, hipStream_t stream) {
    static int grid = 0;
    if (grid == 0) {
        if (n_in != 19 || out_size != NT * D || ws_size < WS_END) { fprintf(stderr, "kernel_launch: unexpected shapes (n_in %d out %d ws %zu)\n", n_in, out_size, ws_size); grid = -1; return; }
        int dev = 0, cus = 0;
        if (hipGetDevice(&dev) != hipSuccess || hipDeviceGetAttribute(&cus, hipDeviceAttributeMultiprocessorCount, dev) != hipSuccess) { grid = -1; return; }
        if (hipFuncSetAttribute((const void*)fwd, hipFuncAttributeMaxDynamicSharedMemorySize, LDS_BYTES) != hipSuccess) { fprintf(stderr, "kernel_launch: hipFuncSetAttribute failed\n"); grid = -1; return; }
        int per_cu = 0;
        if (hipOccupancyMaxActiveBlocksPerMultiprocessor(&per_cu, (const void*)fwd, NTHREADS, LDS_BYTES) != hipSuccess || per_cu < 1) { fprintf(stderr, "kernel_launch: occupancy query says %d\n", per_cu); }
        (void)hipGetLastError();
        grid = cus;
    }
    if (grid < 0) return;
    (void)hipMemsetAsync((char*)d_ws + WS_CTL, 0, CTL_ZERO_BYTES, stream);
    Args a{};
    for (int i = 0; i < 19; ++i) a.in[i] = (const float*)d_in[i];
    a.out = (float*)d_out; a.ws = (unsigned char*)d_ws;
#if MK_ONE_LAUNCH
    a.ph_lo = 0; a.ph_hi = N_PHASES;
    hipLaunchKernelGGL(fwd, dim3(grid), dim3(NTHREADS), LDS_BYTES, stream, a);
#else
    for (int p = 0; p < N_PHASES; ++p) { a.ph_lo = p; a.ph_hi = p + 1; const int reps = ((MK_REP_MASK >> p) & 1) ? 2 : 1;
        for (int r = 0; r < reps; ++r) hipLaunchKernelGGL(fwd, dim3(grid), dim3(NTHREADS), LDS_BYTES, stream, a); }
#endif
}
```
